# Optimizing an MI355X kernel written in HIP

```python
import jax, jax.numpy as jnp
from jax import lax
import numpy as np

D_MODEL = 1024
BATCH = 16
SEQ = 4096
DEPTH = 1

GRID_W = 64
NA_WIDTH = D_MODEL // 2
NA_HEADS = 8
NA_HEAD_DIM = NA_WIDTH // NA_HEADS
WIN_ROWS_MAX = 8
WIN_COLS = 16
POOL_WIDTH = D_MODEL - NA_WIDTH
POOL_WINDOWS = (2, 4, 8, 16)
POOL_GROUPS = len(POOL_WINDOWS)
POOL_GROUP_DIM = POOL_WIDTH // POOL_GROUPS
MIX_WIDTH = NA_WIDTH + POOL_WIDTH
IN_WIDTH = 3 * NA_WIDTH + POOL_WIDTH
D_FF = -(-8 * D_MODEL // (3 * 256)) * 256
EPS = 1e-6

kernel_name = "hybrid_neighbourhood_attn_multiscale_pool_block"


def rms_norm(x, g):
    xf = x.astype(jnp.float32)
    y = xf * lax.rsqrt(jnp.mean(xf * xf, axis=-1, keepdims=True) + EPS)
    return (y * g.astype(jnp.float32)).astype(x.dtype)


def neighbourhood_attention(q, k, v, rpb):
    B, T, H, Dh = q.shape
    rows = T // GRID_W
    wr = min(WIN_ROWS_MAX, rows)
    q = q.reshape(B, rows, GRID_W, H, Dh)
    k = k.reshape(B, rows, GRID_W, H, Dh)
    v = v.reshape(B, rows, GRID_W, H, Dh)
    row_start = jnp.clip(jnp.arange(rows) - wr // 2, 0, rows - wr)
    cols = jnp.arange(GRID_W)
    col_idx = jnp.clip(cols - WIN_COLS // 2, 0, GRID_W - WIN_COLS)[:, None] + jnp.arange(WIN_COLS)
    col_rel = col_idx - cols[:, None] + (WIN_COLS - 1)
    rpb_cols = rpb.astype(jnp.float32)[:, :, col_rel]
    scale = Dh ** -0.5

    def one_row(r):
        rs = row_start[r]
        kb = lax.dynamic_slice_in_dim(k, rs, wr, axis=1)
        vb = lax.dynamic_slice_in_dim(v, rs, wr, axis=1)
        kg = kb[:, :, col_idx]
        vg = vb[:, :, col_idx]
        qr = lax.dynamic_index_in_dim(q, r, axis=1, keepdims=False)
        row_rel = rs + jnp.arange(wr) - r + (WIN_ROWS_MAX - 1)
        bias = jnp.transpose(rpb_cols[:, row_rel], (0, 2, 1, 3))
        s = jnp.einsum('bqhd,bwqkhd->bhqwk', qr, kg,
                       preferred_element_type=jnp.float32) * scale + bias[None]
        p = jax.nn.softmax(s.reshape(B, H, GRID_W, wr * WIN_COLS), axis=-1)
        p = p.reshape(B, H, GRID_W, wr, WIN_COLS).astype(v.dtype)
        return jnp.einsum('bhqwk,bwqkhd->bqhd', p, vg)

    out = lax.map(one_row, jnp.arange(rows))
    return jnp.moveaxis(out, 0, 1).reshape(B, T, H * Dh)


def multiscale_pool(u, w_pool, pool_scale):
    B, T, C = u.shape
    uf = u.astype(jnp.float32)
    csum = jnp.concatenate([jnp.zeros((B, 1, C), jnp.float32), jnp.cumsum(uf, axis=1)], axis=1)
    t = jnp.arange(T)
    outs = []
    for g, w in enumerate(POOL_WINDOWS):
        sl = slice(g * POOL_GROUP_DIM, (g + 1) * POOL_GROUP_DIM)
        lo = jnp.clip(t - w // 2, 0, T)
        hi = jnp.clip(t + w // 2, 0, T)
        cg = csum[:, :, sl]
        mean = (cg[:, hi] - cg[:, lo]) / (hi - lo).astype(jnp.float32)[:, None]
        outs.append(mean - uf[:, :, sl])
    d = jnp.stack(outs, axis=2).astype(u.dtype)
    y = jnp.einsum('btgc,gcd->btgd', d, w_pool).reshape(B, T, C)
    return y * pool_scale


def setup_inputs(seed: int = 0) -> dict:
    key = jax.random.key(seed)
    ks = jax.random.split(key, 14)
    f32 = jnp.float32
    nrm = lambda k, shape, fan_in: jax.random.normal(k, shape, f32) * fan_in ** -0.5
    gain = lambda k, shape: 1.0 + 0.02 * jax.random.normal(k, shape, f32)
    return {
        "x": jax.random.normal(ks[0], (BATCH, SEQ, D_MODEL), f32),
        "norm1_g": gain(ks[1], (DEPTH, D_MODEL)),
        "w_in": nrm(ks[2], (DEPTH, D_MODEL, IN_WIDTH), D_MODEL),
        "q_norm_g": gain(ks[3], (DEPTH, NA_HEAD_DIM)),
        "k_norm_g": gain(ks[4], (DEPTH, NA_HEAD_DIM)),
        "rpb": 0.1 * jax.random.normal(ks[5], (DEPTH, NA_HEADS, 2 * WIN_ROWS_MAX - 1, 2 * WIN_COLS - 1), f32),
        "w_pool": nrm(ks[6], (DEPTH, POOL_GROUPS, POOL_GROUP_DIM, POOL_GROUP_DIM), POOL_GROUP_DIM),
        "pool_scale": gain(ks[7], (DEPTH, POOL_WIDTH)),
        "w_out": nrm(ks[8], (DEPTH, MIX_WIDTH, D_MODEL), MIX_WIDTH),
        "norm2_g": gain(ks[9], (DEPTH, D_MODEL)),
        "w_gate": nrm(ks[10], (DEPTH, D_MODEL, D_FF), D_MODEL),
        "w_up": nrm(ks[11], (DEPTH, D_MODEL, D_FF), D_MODEL),
        "w_down": nrm(ks[12], (DEPTH, D_FF, D_MODEL), D_FF),
    }


def reference(x, norm1_g, w_in, q_norm_g, k_norm_g, rpb, w_pool, pool_scale, w_out,
              norm2_g, w_gate, w_up, w_down):
    B, T, _ = x.shape
    for l in range(DEPTH):
        h = rms_norm(x, norm1_g[l])
        proj = h @ w_in[l]
        q = proj[..., :NA_WIDTH].reshape(B, T, NA_HEADS, NA_HEAD_DIM)
        k = proj[..., NA_WIDTH:2 * NA_WIDTH].reshape(B, T, NA_HEADS, NA_HEAD_DIM)
        v = proj[..., 2 * NA_WIDTH:3 * NA_WIDTH].reshape(B, T, NA_HEADS, NA_HEAD_DIM)
        u = proj[..., 3 * NA_WIDTH:]
        q = rms_norm(q, q_norm_g[l])
        k = rms_norm(k, k_norm_g[l])
        a = neighbourhood_attention(q, k, v, rpb[l])
        p = multiscale_pool(u, w_pool[l], pool_scale[l])
        x = x + jnp.concatenate([a, p], axis=-1) @ w_out[l]
        h2 = rms_norm(x, norm2_g[l])
        x = x + (jax.nn.silu(h2 @ w_gate[l]) * (h2 @ w_up[l])) @ w_down[l]
    return x
```

```cpp
#include <hip/hip_runtime.h>
#include <cstdio>
#include <cstdint>

#define LAS __attribute__((address_space(3)))
#define GAS __attribute__((address_space(1)))
typedef unsigned short bf16_t;
typedef short bf16x8 __attribute__((ext_vector_type(8)));
typedef short s16x4 __attribute__((ext_vector_type(4)));
typedef float f32x4 __attribute__((ext_vector_type(4)));
typedef float f32x2 __attribute__((ext_vector_type(2)));
typedef unsigned u32x4 __attribute__((ext_vector_type(4)));
typedef unsigned u32x2 __attribute__((ext_vector_type(2)));

constexpr int BATCH = 16, SEQ = 4096, D = 1024, M = BATCH * SEQ;
constexpr int NA = 512, NHEAD = 8, HD = 64, NIN = 2048, FF = 2816, NGU = 2 * FF;
constexpr float EPS = 1e-6f;
constexpr float LOG2E = 1.4426950408889634f;

__device__ __forceinline__ unsigned cvt_pk_bf16(float lo, float hi) { unsigned r; asm volatile("v_cvt_pk_bf16_f32 %0, %1, %2" : "=v"(r) : "v"(lo), "v"(hi)); return r; }

namespace pg8 {
constexpr int BM = 256, BK = 64, HALF = 128, HTB = HALF * BK * 2, STAGE_BYTES = 8 * HTB, NXCD = 8, WGM = 8;

__host__ __device__ __forceinline__ int lds_byte(int r, int c) { const int st = (r >> 4) * 2 + (c >> 5), rr = r & 15, cc = c & 31, ob = rr * 64 + cc * 2; return st * 1024 + (ob ^ (((ob >> 9) & 1) << 5)); }
__host__ __device__ __forceinline__ void stage_rc(int b, int& R, int& C) { const int st = b / 1024, sb = b % 1024, swz = sb ^ (((sb >> 9) & 1) << 5); R = (st >> 1) * 16 + swz / 64; C = (st & 1) * 32 + (swz % 64) / 2; }
__host__ __device__ __forceinline__ int perm32(int rho) { const int n = rho >> 4, i = rho & 15; return 8 * (i >> 2) + 4 * n + (i & 3); }

struct Unit { int pm, pn; };
struct Gemm { const bf16_t* A; const bf16_t* Bt; int M, N, K; };

struct StaticOrder {
    int nM, nN, nwg, G, c;
    __host__ __device__ void init(int M_, int N_, int G_, int c_) { nM = M_ / BM; nN = N_ / BM; nwg = nM * nN; G = G_; c = c_; }
    __host__ __device__ bool next(int i, Unit& u) const {
        const long L = (long)i * G + c; if (L >= nwg) return false;
        int wgid = (int)L; { const int q = nwg / NXCD, r = nwg % NXCD, xcd = wgid % NXCD, off = wgid / NXCD; wgid = (xcd < r ? xcd * (q + 1) : r * (q + 1) + (xcd - r) * q) + off; }
        const int nig = WGM * nN, gid = wgid / nig, fm = gid * WGM, gsz = (nM - fm) < WGM ? (nM - fm) : WGM;
        u.pm = fm + ((wgid % nig) % gsz); u.pn = (wgid % nig) / gsz; return true;
    }
    __device__ __forceinline__ void a_ready(const Unit&) const {}
    __device__ __forceinline__ void done(const Unit&) const {}
};


struct EpiIn {
    static constexpr bool PERM = true, AFTER_DRAIN = false;
    bf16_t* QKVZ; const float* gq; const float* gk;
    __device__ __forceinline__ void operator()(const f32x4 (&acc)[2][2][4][2], const Unit& u, int wr, int wc, int fr, int fq) const {
        const int kind = u.pn >> 1;
        bf16_t* base = QKVZ + (size_t)kind * ((size_t)M * NA) + (u.pn & 1) * 256 + wc * 64 + 8 * fq;
        const int row0 = u.pm * BM + wr * 64 + fr;
        if (kind < 2) {
            const float* g = kind == 0 ? gq : gk; const float qs = kind == 0 ? 0.125f * LOG2E : 1.0f;
            f32x4 gv[2][2];
#pragma unroll
            for (int bj = 0; bj < 2; ++bj)
#pragma unroll
                for (int n = 0; n < 2; ++n) gv[bj][n] = *(const f32x4*)(g + 32 * bj + 8 * fq + 4 * n) * qs;
#pragma unroll
            for (int ai = 0; ai < 2; ++ai)
#pragma unroll
                for (int m = 0; m < 4; ++m) {
                    bf16_t* rowp = base + (size_t)(row0 + ai * HALF + m * 16) * NA;
                    float ss = 0.f;
#pragma unroll
                    for (int bj = 0; bj < 2; ++bj)
#pragma unroll
                        for (int n = 0; n < 2; ++n) { const f32x4 v = acc[ai][bj][m][n]; ss += (v[0] * v[0] + v[1] * v[1]) + (v[2] * v[2] + v[3] * v[3]); }
                    ss += __shfl_xor(ss, 16); ss += __shfl_xor(ss, 32);
                    const float r = __builtin_amdgcn_rsqf(ss * (1.0f / 64.0f) + EPS);
#pragma unroll
                    for (int bj = 0; bj < 2; ++bj) {
                        const f32x4 v0 = acc[ai][bj][m][0] * r * gv[bj][0], v1 = acc[ai][bj][m][1] * r * gv[bj][1];
                        u32x4 w; w.x = cvt_pk_bf16(v0[0], v0[1]); w.y = cvt_pk_bf16(v0[2], v0[3]); w.z = cvt_pk_bf16(v1[0], v1[1]); w.w = cvt_pk_bf16(v1[2], v1[3]);
                        *(u32x4*)(rowp + bj * 32) = w; }
                }
        } else {
#pragma unroll
            for (int ai = 0; ai < 2; ++ai)
#pragma unroll
                for (int m = 0; m < 4; ++m) {
                    bf16_t* rowp = base + (size_t)(row0 + ai * HALF + m * 16) * NA;
#pragma unroll
                    for (int bj = 0; bj < 2; ++bj) {
                        const f32x4 v0 = acc[ai][bj][m][0], v1 = acc[ai][bj][m][1];
                        u32x4 w; w.x = cvt_pk_bf16(v0[0], v0[1]); w.y = cvt_pk_bf16(v0[2], v0[3]); w.z = cvt_pk_bf16(v1[0], v1[1]); w.w = cvt_pk_bf16(v1[2], v1[3]);
                        *(u32x4*)(rowp + bj * 32) = w; }
                }
        }
    }
};

struct EpiOut {
    static constexpr bool PERM = true, AFTER_DRAIN = false;
    const float* x; float* out; bf16_t* XB; float* ss;
    __device__ __forceinline__ void operator()(const f32x4 (&acc)[2][2][4][2], const Unit& u, int wr, int wc, int fr, int fq) const {
        const int row0 = u.pm * BM + wr * 64 + fr, col0 = u.pn * BM + wc * 32 + 8 * fq;
#pragma unroll
        for (int ai = 0; ai < 2; ++ai)
#pragma unroll
            for (int m = 0; m < 4; ++m) {
                const int row = row0 + ai * HALF + m * 16; const size_t off = (size_t)row * D + col0; float part = 0.f;
#pragma unroll
                for (int bj = 0; bj < 2; ++bj) {
                    const f32x4 a = *(const f32x4*)(x + off + bj * HALF), b = *(const f32x4*)(x + off + bj * HALF + 4);
                    const f32x4 v0 = acc[ai][bj][m][0] + a, v1 = acc[ai][bj][m][1] + b;
                    *(f32x4*)(out + off + bj * HALF) = v0; *(f32x4*)(out + off + bj * HALF + 4) = v1;
                    u32x4 w; w.x = cvt_pk_bf16(v0[0], v0[1]); w.y = cvt_pk_bf16(v0[2], v0[3]); w.z = cvt_pk_bf16(v1[0], v1[1]); w.w = cvt_pk_bf16(v1[2], v1[3]);
                    *(u32x4*)(XB + off + bj * HALF) = w;
                    part += (v0[0] * v0[0] + v0[1] * v0[1]) + (v0[2] * v0[2] + v0[3] * v0[3]) + (v1[0] * v1[0] + v1[1] * v1[1]) + (v1[2] * v1[2] + v1[3] * v1[3]); }
                part += __shfl_xor(part, 16); part += __shfl_xor(part, 32);
                if (fq == 0) atomicAdd(ss + row, part);
            }
    }
};

struct EpiGU {
    static constexpr bool PERM = true, AFTER_DRAIN = false;
    bf16_t* ACT; const float* ss;
    __device__ __forceinline__ void operator()(const f32x4 (&acc)[2][2][4][2], const Unit& u, int wr, int wc, int fr, int fq) const {
        const int row0 = u.pm * BM + wr * 64 + fr, col0 = u.pn * HALF + wc * 32 + 8 * fq;
#pragma unroll
        for (int ai = 0; ai < 2; ++ai)
#pragma unroll
            for (int m = 0; m < 4; ++m) {
                const int row = row0 + ai * HALF + m * 16;
                const float rstd = __builtin_amdgcn_rsqf(ss[row] * (1.0f / (float)D) + EPS);
                unsigned w[4];
#pragma unroll
                for (int n = 0; n < 2; ++n) {
                    const f32x4 g = acc[ai][0][m][n] * rstd, up = acc[ai][1][m][n] * rstd; float a[4];
#pragma unroll
                    for (int e = 0; e < 4; ++e) a[e] = g[e] * up[e] * __builtin_amdgcn_rcpf(1.0f + __builtin_amdgcn_exp2f(-LOG2E * g[e]));
                    w[2 * n] = cvt_pk_bf16(a[0], a[1]); w[2 * n + 1] = cvt_pk_bf16(a[2], a[3]); }
                *(u32x4*)(ACT + (size_t)row * FF + col0) = (u32x4){w[0], w[1], w[2], w[3]};
            }
    }
};

struct EpiDown {
    static constexpr bool PERM = true, AFTER_DRAIN = false;
    float* out;
    __device__ __forceinline__ void operator()(const f32x4 (&acc)[2][2][4][2], const Unit& u, int wr, int wc, int fr, int fq) const {
        const int row0 = u.pm * BM + wr * 64 + fr, col0 = u.pn * BM + wc * 32 + 8 * fq;
#pragma unroll
        for (int ai = 0; ai < 2; ++ai)
#pragma unroll
            for (int m = 0; m < 4; ++m) {
                const size_t off = (size_t)(row0 + ai * HALF + m * 16) * D + col0;
#pragma unroll
                for (int bj = 0; bj < 2; ++bj) {
                    float* p = out + off + bj * HALF;
                    const f32x4 a = *(const f32x4*)p, b = *(const f32x4*)(p + 4);
                    *(f32x4*)p = acc[ai][bj][m][0] + a; *(f32x4*)(p + 4) = acc[ai][bj][m][1] + b; }
            }
    }
};

template <class Epi, class Sched, bool ALIGN_EPI = false, bool SP2 = false>
__device__ __forceinline__ void gemm_phase(LAS unsigned char* lds, const Gemm g, const Sched& S, const Epi& E) {
    const int tid = threadIdx.x, wid = __builtin_amdgcn_readfirstlane(tid >> 6), lane = tid & 63, wr = wid >> 2, wc = wid & 3, fr = lane & 15, fq = lane >> 4;
    const int K = g.K, nt = K / BK;
    unsigned voffA[2], voffB[2];
#pragma unroll
    for (int i = 0; i < 2; ++i) { int R, C; stage_rc(tid * 16 + i * 8192, R, C); const int Rb = Epi::PERM ? ((R & ~31) + perm32(R & 31)) : R;
        voffA[i] = (unsigned)(R * K + C) * 2u; voffB[i] = (unsigned)(Rb * K + C) * 2u; }
    const size_t kstep = (size_t)(BK * 2);
    const size_t hstep = (size_t)HALF * K * 2;
    const size_t tstep = 2 * hstep;
    const unsigned ldsw = (unsigned)wid * 1024u;
    const int aoff = lds_byte(wr * 64 + fr, fq * 8), boff = lds_byte(wc * 32 + fr, fq * 8);
#define PG8_SA(b, h) (((b) * 2 + (h)) * HTB)
#define PG8_SB(b, h) ((4 + (b) * 2 + (h)) * HTB)
#define PG8_STAGE(bufoff, gbase, voff) do { _Pragma("unroll") for (int _i = 0; _i < 2; ++_i) \
        __builtin_amdgcn_global_load_lds((const unsigned*)((const char*)(gbase) + (voff)[_i]), (LAS unsigned*)(lds + (bufoff) + ldsw + _i * 8192), 16, 0, 0); } while (0)
#define PG8_LDA(dst, b, h) do { _Pragma("unroll") for (int m = 0; m < 4; ++m) _Pragma("unroll") for (int k = 0; k < 2; ++k) dst[m][k] = *(const LAS bf16x8*)(lds + PG8_SA(b, h) + aoff + m * 2048 + k * 1024); } while (0)
#define PG8_LDB(dst, b, h) do { _Pragma("unroll") for (int n = 0; n < 2; ++n) _Pragma("unroll") for (int k = 0; k < 2; ++k) dst[n][k] = *(const LAS bf16x8*)(lds + PG8_SB(b, h) + boff + n * 2048 + k * 1024); } while (0)
#define PG8_MMA(ai, bj, At, Bt) do { __builtin_amdgcn_s_setprio(1); _Pragma("unroll") for (int m = 0; m < 4; ++m) _Pragma("unroll") for (int n = 0; n < 2; ++n) _Pragma("unroll") for (int k = 0; k < 2; ++k) \
        acc[ai][bj][m][n] = __builtin_amdgcn_mfma_f32_16x16x32_bf16(Bt[n][k], At[m][k], acc[ai][bj][m][n], 0, 0, 0); __builtin_amdgcn_s_setprio(0); } while (0)
#define PG8_WAIT_V(n) asm volatile("s_waitcnt vmcnt(" #n ")" ::: "memory")
#define PG8_WAIT_L(n) asm volatile("s_waitcnt lgkmcnt(" #n ")" ::: "memory")
#define PG8_BAR __builtin_amdgcn_s_barrier()
#define PG8_SCHED __builtin_amdgcn_sched_barrier(0)
    Unit cur, nxt; int ui = 0;
    if (!S.next(0, cur)) return;
    f32x4 acc[2][2][4][2];
#pragma unroll
    for (int a = 0; a < 2; ++a)
#pragma unroll
        for (int b = 0; b < 2; ++b)
#pragma unroll
            for (int m = 0; m < 4; ++m)
#pragma unroll
                for (int n = 0; n < 2; ++n) acc[a][b][m][n] = (f32x4){0.f, 0.f, 0.f, 0.f};
    bf16x8 At[4][2], B0[2][2], B1[2][2];
    const char* cA = (const char*)g.A + (size_t)cur.pm * tstep; const char* cB = (const char*)g.Bt + (size_t)cur.pn * tstep;
    S.a_ready(cur);
    if constexpr (SP2) {
        PG8_STAGE(PG8_SB(0, 0), cB, voffB); PG8_STAGE(PG8_SB(0, 1), cB + hstep, voffB); PG8_STAGE(PG8_SA(0, 0), cA, voffA); PG8_STAGE(PG8_SA(0, 1), cA + hstep, voffA);
        if (wr == 1) PG8_BAR;
        PG8_WAIT_V(2); PG8_BAR;
        PG8_STAGE(PG8_SB(1, 0), cB + kstep, voffB); PG8_STAGE(PG8_SA(1, 0), cA + kstep, voffA); PG8_STAGE(PG8_SB(1, 1), cB + hstep + kstep, voffB);
        PG8_WAIT_V(6); PG8_BAR;
    } else {
        PG8_STAGE(PG8_SB(0, 0), cB, voffB); PG8_STAGE(PG8_SA(0, 0), cA, voffA); PG8_STAGE(PG8_SB(0, 1), cB + hstep, voffB); PG8_STAGE(PG8_SA(0, 1), cA + hstep, voffA);
        if (wr == 1) PG8_BAR;
        PG8_WAIT_V(4); PG8_BAR;
        PG8_STAGE(PG8_SB(1, 0), cB + kstep, voffB); PG8_STAGE(PG8_SA(1, 0), cA + kstep, voffA); PG8_STAGE(PG8_SB(1, 1), cB + hstep + kstep, voffB);
        PG8_WAIT_V(6); PG8_BAR;
    }
    for (;;) {
        const bool has_next = S.next(ui + 1, nxt);
        const char* nA = has_next ? (const char*)g.A + (size_t)nxt.pm * tstep : cA; const char* nB = has_next ? (const char*)g.Bt + (size_t)nxt.pn * tstep : cB;
        for (int t = 0; t < nt; t += 2) {
            const bool last = (t == nt - 2);
            const char* a1 = cA + (size_t)(t + 1) * kstep;
            const char* a2 = last ? nA : cA + (size_t)(t + 2) * kstep; const char* b2 = last ? nB : cB + (size_t)(t + 2) * kstep;
            const char* a3 = a2 + kstep; const char* b3 = b2 + kstep;
            if (last && has_next) S.a_ready(nxt);
            if constexpr (SP2) {
            PG8_LDB(B0, 0, 0); PG8_LDB(B1, 0, 1); PG8_SCHED; PG8_LDA(At, 0, 0); PG8_STAGE(PG8_SA(1, 1), a1 + hstep, voffA);
            PG8_WAIT_V(8); PG8_WAIT_L(0); PG8_BAR; PG8_MMA(0, 0, At, B0); PG8_MMA(0, 1, At, B1); PG8_BAR; PG8_SCHED;
            PG8_LDA(At, 0, 1); PG8_STAGE(PG8_SB(0, 0), b2, voffB); PG8_STAGE(PG8_SB(0, 1), b2 + hstep, voffB); PG8_STAGE(PG8_SA(0, 0), a2, voffA);
            PG8_WAIT_V(8); PG8_WAIT_L(0); PG8_BAR; PG8_MMA(1, 0, At, B0); PG8_MMA(1, 1, At, B1); PG8_BAR; PG8_SCHED;
            PG8_LDB(B0, 1, 0); PG8_LDB(B1, 1, 1); PG8_SCHED; PG8_LDA(At, 1, 0); PG8_STAGE(PG8_SA(0, 1), a2 + hstep, voffA);
            PG8_WAIT_V(8); PG8_WAIT_L(0); PG8_BAR; PG8_MMA(0, 0, At, B0); PG8_MMA(0, 1, At, B1); PG8_BAR; PG8_SCHED;
            PG8_LDA(At, 1, 1); PG8_STAGE(PG8_SB(1, 0), b3, voffB); PG8_STAGE(PG8_SB(1, 1), b3 + hstep, voffB); PG8_STAGE(PG8_SA(1, 0), a3, voffA);
            PG8_WAIT_V(8); PG8_WAIT_L(0); PG8_BAR; PG8_MMA(1, 0, At, B0); PG8_MMA(1, 1, At, B1); PG8_BAR; PG8_SCHED;
            } else {
            PG8_LDB(B0, 0, 0); PG8_SCHED; PG8_LDA(At, 0, 0); PG8_STAGE(PG8_SA(1, 1), a1 + hstep, voffA);
            PG8_WAIT_L(8); PG8_BAR; PG8_WAIT_L(0); PG8_MMA(0, 0, At, B0); PG8_BAR; PG8_SCHED;
            PG8_LDB(B1, 0, 1); PG8_STAGE(PG8_SB(0, 0), b2, voffB);
            PG8_BAR; PG8_WAIT_L(0); PG8_MMA(0, 1, At, B1); PG8_BAR;
            PG8_LDA(At, 0, 1); PG8_STAGE(PG8_SA(0, 0), a2, voffA);
            PG8_BAR; PG8_WAIT_L(0); PG8_MMA(1, 0, At, B0); PG8_BAR; PG8_SCHED;
            PG8_STAGE(PG8_SB(0, 1), b2 + hstep, voffB);
            PG8_WAIT_V(6); PG8_BAR; PG8_MMA(1, 1, At, B1); PG8_BAR;
            PG8_LDB(B0, 1, 0); PG8_SCHED; PG8_LDA(At, 1, 0); PG8_STAGE(PG8_SA(0, 1), a2 + hstep, voffA);
            PG8_WAIT_L(8); PG8_BAR; PG8_WAIT_L(0); PG8_MMA(0, 0, At, B0); PG8_BAR; PG8_SCHED;
            PG8_LDB(B1, 1, 1); PG8_STAGE(PG8_SB(1, 0), b3, voffB);
            PG8_BAR; PG8_WAIT_L(0); PG8_MMA(0, 1, At, B1); PG8_BAR;
            PG8_LDA(At, 1, 1); PG8_STAGE(PG8_SA(1, 0), a3, voffA);
            PG8_BAR; PG8_WAIT_L(0); PG8_MMA(1, 0, At, B0); PG8_BAR; PG8_SCHED;
            PG8_STAGE(PG8_SB(1, 1), b3 + hstep, voffB);
            PG8_WAIT_V(6); PG8_BAR; PG8_MMA(1, 1, At, B1); PG8_BAR;
            }
        }
        if constexpr (ALIGN_EPI) { if (wr == 0) PG8_BAR; }
        if constexpr (!Epi::AFTER_DRAIN) { E(acc, cur, wr, wc, fr, fq); S.done(cur); }
        if (!has_next) break;
#pragma unroll
        for (int a = 0; a < 2; ++a)
#pragma unroll
            for (int b = 0; b < 2; ++b)
#pragma unroll
                for (int m = 0; m < 4; ++m)
#pragma unroll
                    for (int n = 0; n < 2; ++n) acc[a][b][m][n] = (f32x4){0.f, 0.f, 0.f, 0.f};
        cur = nxt; cA = nA; cB = nB; ++ui;
        if constexpr (ALIGN_EPI) { if (wr == 1) PG8_BAR; }
    }
    PG8_WAIT_V(0);
    if constexpr (!ALIGN_EPI) { if (wr == 0) PG8_BAR; }
    PG8_BAR;
#undef PG8_SA
#undef PG8_SB
#undef PG8_STAGE
#undef PG8_LDA
#undef PG8_LDB
#undef PG8_MMA
#undef PG8_WAIT_V
#undef PG8_WAIT_L
#undef PG8_BAR
#undef PG8_SCHED
}
}

constexpr int NWAVES = 8;
#ifndef MK_N_LAUNCHES
#define MK_N_LAUNCHES 1
#endif
constexpr int N_LAUNCHES = MK_N_LAUNCHES;
constexpr int PER_PHASE = 6;
#ifndef PG8_SP2
#define PG8_SP2 true
#endif

constexpr size_t MiB = 1u << 20;
constexpr size_t WS_CTL = 0, CTL_ZERO_BYTES = 1 * MiB;
constexpr size_t WS_WIN = 2 * MiB;
constexpr size_t WS_WOUT = 6 * MiB;
constexpr size_t WS_WGU = 8 * MiB;
constexpr size_t WS_WDN = 20 * MiB;
constexpr size_t WS_XN = 32 * MiB;
constexpr size_t WS_QKVZ = 160 * MiB;
constexpr size_t WS_ACT = 416 * MiB;
constexpr size_t WS_END = 768 * MiB;
static_assert(WS_WGU + (size_t)NGU * D * 2 <= WS_WDN && WS_WDN + (size_t)D * FF * 2 <= WS_XN && WS_ACT + (size_t)M * FF * 2 <= WS_END, "d_ws map");
constexpr int CW_BAR = 4096;
constexpr int CW_SS = 65536;
static_assert((size_t)(CW_SS + M) * 4 <= CTL_ZERO_BYTES, "ss inside the memset region");

constexpr int RING_OFF = 0, RING_BYTES = 131072;
constexpr int LDSCTL_OFF = RING_BYTES, MISC_OFF = LDSCTL_OFF + 320;
constexpr int LDS_BYTES = 147456;

typedef GAS unsigned gu32;
#define RLX_AGENT __ATOMIC_RELAXED, __HIP_MEMORY_SCOPE_AGENT
#define LDS_WAIT() asm volatile("s_waitcnt lgkmcnt(0)" ::: "memory")
__device__ __forceinline__ unsigned f2bf(float f) { unsigned u = __builtin_bit_cast(unsigned, f); return (u + 0x7fffu + ((u >> 16) & 1u)) >> 16; }
__device__ __forceinline__ unsigned pk2(float lo, float hi) { return f2bf(lo) | (f2bf(hi) << 16); }
__device__ __forceinline__ float bflo(unsigned w) { return __builtin_bit_cast(float, w << 16); }
__device__ __forceinline__ float bfhi(unsigned w) { return __builtin_bit_cast(float, w & 0xffff0000u); }

#define XB_TMO      128
#define XB_XCNT(j)  (256  + 64 * (j))
#define XB_XSUB(j)  (1280 + 64 * (j))
#define XB_XGEN(j)  (2304 + 64 * (j))
#define XB_TOP      3328
#define XB_TOPGEN   3392
#define XCD_BAR_WORDS 3456
#define XB_SPIN_CAP (1u << 18)

__device__ __forceinline__ unsigned xb_ld(unsigned* p)              { return __hip_atomic_load(p, __ATOMIC_RELAXED, __HIP_MEMORY_SCOPE_AGENT); }
__device__ __forceinline__ unsigned xb_add(unsigned* p, unsigned v) { return __hip_atomic_fetch_add(p, v, __ATOMIC_RELAXED, __HIP_MEMORY_SCOPE_AGENT); }
__device__ __forceinline__ unsigned xb_xcc_id() { return (unsigned)__builtin_amdgcn_s_getreg((3 << 11) | 20) & 0xFu; }
#define XB_SPIN(cond, bar) do { unsigned _sp = 0; while (cond) { __builtin_amdgcn_s_sleep(1); \
    if ((++_sp & 255u) == 0u) { if (xb_ld(&(bar)[XB_TMO])) break; if (_sp > XB_SPIN_CAP) { atomicAdd(&(bar)[XB_TMO], 1u); break; } } } } while (0)

struct XcdBarrier { unsigned* bar; unsigned x; volatile LAS unsigned* st; };

__device__ __forceinline__ XcdBarrier xcd_barrier_post(unsigned* bar, volatile LAS unsigned* st) {
    XcdBarrier b; b.bar = bar; b.x = xb_xcc_id(); b.st = st;
    if (threadIdx.x == 0) (void)xb_add(&bar[XB_XCNT(b.x)], 1u);
    return b;
}
__device__ __forceinline__ void xcd_barrier_complete(unsigned* bar, unsigned x, unsigned& nloc, unsigned& nx) {
    const unsigned G = gridDim.x * gridDim.y * gridDim.z;
    unsigned sum, cnt, mine, sp = 0u;
    for (;;) {
        sum = 0u; cnt = 0u; mine = 0u;
#pragma unroll
        for (unsigned j = 0; j < 16; ++j) { const unsigned c = xb_ld(&bar[XB_XCNT(j)]); sum += c; cnt += (c > 0u) ? 1u : 0u; mine = (j == x) ? c : mine; }
        if (sum == G) break;
        __builtin_amdgcn_s_sleep(1);
        if ((++sp & 255u) == 0u) { if (xb_ld(&bar[XB_TMO])) break; if (sp > XB_SPIN_CAP) { atomicAdd(&bar[XB_TMO], 1u); break; } }
    }
    nloc = mine > 0u ? mine : 1u; nx = cnt > 0u ? cnt : 1u;
}
__device__ __forceinline__ void xcd_barrier(const XcdBarrier& b) {
    asm volatile("s_waitcnt vmcnt(0)" ::: "memory");
    __syncthreads();
    if (threadIdx.x == 0) {
        unsigned* bar = b.bar;
        __builtin_amdgcn_s_waitcnt(0);
        unsigned nloc = b.st[0], nx = b.st[1];
        if (nloc == 0u) { xcd_barrier_complete(bar, b.x, nloc, nx); b.st[0] = nloc; b.st[1] = nx; }
        const unsigned old = xb_add(&bar[XB_XSUB(b.x)], 1u);
        const unsigned gen = old / nloc;
        if (old + 1u == (gen + 1u) * nloc) {
            __builtin_amdgcn_fence(__ATOMIC_RELEASE, "agent");
            asm volatile("s_waitcnt vmcnt(0)" ::: "memory");
            const unsigned og = xb_add(&bar[XB_TOP], 1u);
            const unsigned tg = og / nx;
            if (og + 1u == (tg + 1u) * nx) xb_add(&bar[XB_TOPGEN], 1u);
            else XB_SPIN(xb_ld(&bar[XB_TOPGEN]) == tg, bar);
            __builtin_amdgcn_fence(__ATOMIC_ACQUIRE, "agent");
            xb_add(&bar[XB_XGEN(b.x)], 1u);
            asm volatile("s_waitcnt vmcnt(0)" ::: "memory");
        } else {
            XB_SPIN(xb_ld(&bar[XB_XGEN(b.x)]) == gen, bar);
            __builtin_amdgcn_fence(__ATOMIC_ACQUIRE, "agent");
            asm volatile("s_waitcnt vmcnt(0)" ::: "memory");
        }
    }
    __syncthreads();
}

struct Frame {
    LAS unsigned char* lds;
    volatile LAS unsigned* MISC;
    gu32* ctl;
    int tid, lane, wave;
    int vcu, G;
    const float *x, *g1, *w_in, *gq, *gk, *rpb, *w_pool, *pscale, *w_out, *g2, *w_gate, *w_up, *w_down;
    float* out;
    bf16_t *Win_t, *Wout_t, *Wgu_t, *Wdn_t;
    bf16_t *XN, *QKVZ, *XB, *ACT;
    float* ss;
};

__device__ __forceinline__ float wave_sum(float v) {
#pragma unroll
    for (int o = 1; o < 64; o <<= 1) v += __shfl_xor(v, o);
    return v;
}

__device__ __forceinline__ void p0_tile_out(bf16_t* WT, int K, int drow0, int k0, LAS float* scr, int lane) {
    LDS_WAIT(); asm volatile("" ::: "memory");
    const int c = lane & 7;
#pragma unroll
    for (int j = 0; j < 4; ++j) { const int n = (lane >> 3) + 8 * j; const LAS float* s = scr + (8 * c) * 33 + n;
        u32x4 o; o.x = pk2(s[0 * 33], s[1 * 33]); o.y = pk2(s[2 * 33], s[3 * 33]); o.z = pk2(s[4 * 33], s[5 * 33]); o.w = pk2(s[6 * 33], s[7 * 33]);
        *(GAS u32x4*)(WT + (size_t)(drow0 + n) * K + k0 + 8 * c) = o; }
    LDS_WAIT(); asm volatile("" ::: "memory");
}
__device__ __forceinline__ void p0_transpose_item(const float* W, int ldw, int K, int k0, int n0, const float* gkv, bf16_t* WT, int drow0, LAS float* scr, int lane) {
#pragma unroll 8
    for (int i = 0; i < 32; ++i) { const int kk = 2 * i + (lane >> 5); float v = W[(size_t)(k0 + kk) * ldw + n0 + (lane & 31)]; if (gkv) v *= gkv[k0 + kk]; scr[kk * 33 + (lane & 31)] = v; }
    p0_tile_out(WT, K, drow0, k0, scr, lane);
}
__device__ __forceinline__ void p0_fold_item(const float* w_in, const float* w_pool, const float* pscale, int k0, int n0z, bf16_t* WT, int drow0, LAS float* scr, int lane) {
    const int n = lane & 31, kh = lane >> 5, g = n0z >> 7, d = (n0z & 127) + n;
    float acc[32];
#pragma unroll
    for (int i = 0; i < 32; ++i) acc[i] = 0.f;
    const float* wrow = w_in + (size_t)(k0 + kh * 32) * NIN + 3 * NA + 128 * g;
    const float* wp = w_pool + (size_t)g * 128 * 128 + d;
    for (int c4 = 0; c4 < 32; ++c4) {
        const float p0 = wp[(4 * c4 + 0) * 128], p1 = wp[(4 * c4 + 1) * 128], p2 = wp[(4 * c4 + 2) * 128], p3 = wp[(4 * c4 + 3) * 128];
#pragma unroll
        for (int i = 0; i < 32; ++i) { const f32x4 w = *(const f32x4*)(wrow + (size_t)i * NIN + 4 * c4); acc[i] += (w[0] * p0 + w[1] * p1) + (w[2] * p2 + w[3] * p3); }
    }
    const float ps = pscale[n0z + n];
#pragma unroll
    for (int i = 0; i < 32; ++i) scr[(kh * 32 + i) * 33 + n] = acc[i] * ps;
    p0_tile_out(WT, D, drow0, k0, scr, lane);
}
__device__ __forceinline__ int win_drow(int n0) { const int pn = n0 >> 8, c = n0 & 255; return 256 * pn + 128 * ((c >> 5) & 1) + 32 * (c >> 6); }

__device__ __forceinline__ void rms_row_to_bf16(const float* xrow, const float* g, bf16_t* orow, int lane) {
    const GAS f32x4* xr = (const GAS f32x4*)xrow + lane;
    f32x4 v[4]; float s = 0.f;
#pragma unroll
    for (int j = 0; j < 4; ++j) { v[j] = xr[64 * j]; s += (v[j].x * v[j].x + v[j].y * v[j].y) + (v[j].z * v[j].z + v[j].w * v[j].w); }
    const float rstd = __builtin_amdgcn_rsqf(wave_sum(s) * (1.f / D) + EPS);
    GAS unsigned long long* o8 = (GAS unsigned long long*)orow + lane;
#pragma unroll
    for (int j = 0; j < 4; ++j) { const f32x4 gg = *((const f32x4*)g + lane + 64 * j);
        o8[64 * j] = (unsigned long long)pk2(v[j].x * rstd * gg.x, v[j].y * rstd * gg.y) | ((unsigned long long)pk2(v[j].z * rstd * gg.z, v[j].w * rstd * gg.w) << 32); }
}

__device__ __forceinline__ void p0_prologue(Frame& F) {
    LAS float* scr = (LAS float*)(F.lds + RING_OFF + F.wave * 16384);
    const int gw = F.vcu * NWAVES + F.wave, NGW = F.G * NWAVES;
    constexpr int KB = D / 64;
    constexpr int I_QKV = KB * (3 * NA / 32), I_Z = KB * (NA / 32), I_O = KB * (D / 32), I_G = KB * (FF / 32), I_DN = (FF / 64) * (D / 32);
    constexpr int NITEMS = I_Z + I_QKV + I_O + 2 * I_G + I_DN;
    for (int it = gw; it < NITEMS; it += NGW) {
        int r = it;
        if (r < I_Z) { const int nb = r % (NA / 32), kb = r / (NA / 32); p0_fold_item(F.w_in, F.w_pool, F.pscale, 64 * kb, 32 * nb, F.Win_t, win_drow(3 * NA + 32 * nb), scr, F.lane); continue; } r -= I_Z;
        if (r < I_QKV) { const int nb = r % (3 * NA / 32), kb = r / (3 * NA / 32); p0_transpose_item(F.w_in, NIN, D, 64 * kb, 32 * nb, nullptr, F.Win_t, win_drow(32 * nb), scr, F.lane); continue; } r -= I_QKV;
        if (r < I_O) { const int nb = r % (D / 32), kb = r / (D / 32); p0_transpose_item(F.w_out, D, D, 64 * kb, 32 * nb, nullptr, F.Wout_t, 32 * nb, scr, F.lane); continue; } r -= I_O;
        if (r < 2 * I_G) { const int up = r >= I_G; if (up) r -= I_G; const int nb = r % (FF / 32), kb = r / (FF / 32), n0 = 32 * nb;
            p0_transpose_item(up ? F.w_up : F.w_gate, FF, D, 64 * kb, n0, F.g2, F.Wgu_t, 256 * (n0 >> 7) + (n0 & 127) + 128 * up, scr, F.lane); continue; } r -= 2 * I_G;
        { const int nb = r % (D / 32), kb = r / (D / 32); p0_transpose_item(F.w_down, D, FF, 64 * kb, 32 * nb, nullptr, F.Wdn_t, 32 * nb, scr, F.lane); }
    }
    for (int m = gw; m < M; m += NGW) rms_row_to_bf16(F.x + (size_t)m * D, F.g1, F.XN + (size_t)m * D, F.lane);
}

constexpr int AT_K = 0;
constexpr int AT_V = 61568;
constexpr int AT_TAB = 2 * 61568;
static_assert(AT_TAB + 15 * 64 * 4 <= RING_BYTES, "attention LDS map");
__device__ __forceinline__ int rs_of(int r) { int v = r - 4; v = v < 0 ? 0 : v; return v > 56 ? 56 : v; }

__device__ __forceinline__ void attn_unit(Frame& F, const bf16_t* Qg, const bf16_t* Kg, const bf16_t* Vg, bf16_t* MIX, int b, int h, int j, int rc) {
    const int tid = F.tid, lane = F.lane, wid = F.wave;
    LAS unsigned char* lds = F.lds;
    const int r0 = 8 * rc, krow_lo = rs_of(r0), nrows = rs_of(r0 + 7) + 8 - krow_lo;
    const int kc0 = (j == 0) ? 0 : (j == 1) ? 8 : (j == 2) ? 24 : 32;
    __syncthreads();
    {
        const int c = tid & 7, kk = (tid >> 3) & 31, par = tid >> 8;
        const int posK = ((kk >> 2) & 1) * 16 + (kk >> 3) * 4 + (kk & 3);
        const int posV = (kk & 0x13) | ((kk & 4) << 1) | ((kk & 8) >> 1);
        const size_t g0 = ((size_t)(b * SEQ + krow_lo * 64 + kc0 + kk)) * NA + h * HD + 8 * c;
        LAS unsigned char* kdst = lds + AT_K + c * 7680 + (c >> 2) * 64;
        LAS unsigned char* vdst = lds + AT_V + (c >> 1) * 15392 + (c & 1) * 16;
        for (int w = par; w < nrows; w += 2) {
            const u32x4 kv = *(const u32x4*)(Kg + g0 + (size_t)w * 64 * NA);
            const u32x4 vv = *(const u32x4*)(Vg + g0 + (size_t)w * 64 * NA);
            *(LAS u32x4*)(kdst + (((32 * w + posK) ^ (c & 3)) * 16)) = kv;
            *(LAS u32x4*)(vdst + (32 * w + posV) * 32) = vv;
        }
    }
    __syncthreads();
    const int r = r0 + wid, rs = rs_of(r), wbase = rs - krow_lo;
    const int q = lane & 15, g = lane >> 4, cq = 16 * j + q;
    int cs = cq - 8; cs = cs < 0 ? 0 : cs; cs = cs > 48 ? 48 : cs;
    const bf16_t* qp = Qg + ((size_t)(b * SEQ + r * 64 + cq)) * NA + h * HD + 8 * g;
    const bf16x8 qf0 = *(const bf16x8*)qp, qf1 = *(const bf16x8*)(qp + 32);
    f32x4 sc[8][2];
    {
        const LAS unsigned char* kb0 = lds + AT_K + g * 7680;
        const LAS unsigned char* kb1 = lds + AT_K + (4 + g) * 7680 + 64;
#pragma unroll
        for (int wl = 0; wl < 8; ++wl)
#pragma unroll
            for (int blk = 0; blk < 2; ++blk) {
                const int slot = ((32 * (wbase + wl) + 16 * blk + q) ^ g) * 16;
                const bf16x8 k0 = *(const LAS bf16x8*)(kb0 + slot), k1 = *(const LAS bf16x8*)(kb1 + slot);
                f32x4 a = (f32x4){0.f, 0.f, 0.f, 0.f};
                a = __builtin_amdgcn_mfma_f32_16x16x32_bf16(k0, qf0, a, 0, 0, 0);
                a = __builtin_amdgcn_mfma_f32_16x16x32_bf16(k1, qf1, a, 0, 0, 0);
                sc[wl][blk] = a;
            }
    }
    const LAS float* tab = (const LAS float*)(lds + AT_TAB) + (rs - r + 7) * 64 + 16 + (kc0 - cq + 15) + 8 * g;
    const int voff = kc0 + 8 * g - cs;
    float mx = -INFINITY;
#pragma unroll
    for (int wl = 0; wl < 8; ++wl)
#pragma unroll
        for (int blk = 0; blk < 2; ++blk)
#pragma unroll
            for (int e = 0; e < 4; ++e) {
                const int ep = 4 * blk + e;
                float s = sc[wl][blk][e] + tab[wl * 64 + ep];
                s = ((unsigned)(voff + ep) < 16u) ? s : -INFINITY;
                sc[wl][blk][e] = s; mx = fmaxf(mx, s);
            }
    mx = fmaxf(mx, __shfl_xor(mx, 16)); mx = fmaxf(mx, __shfl_xor(mx, 32));
    float l = 0.f;
#pragma unroll
    for (int wl = 0; wl < 8; ++wl)
#pragma unroll
        for (int blk = 0; blk < 2; ++blk)
#pragma unroll
            for (int e = 0; e < 4; ++e) { const float p = __builtin_amdgcn_exp2f(sc[wl][blk][e] - mx); sc[wl][blk][e] = p; l += p; }
    l += __shfl_xor(l, 16); l += __shfl_xor(l, 32);
    f32x4 o[4];
#pragma unroll
    for (int n = 0; n < 4; ++n) o[n] = (f32x4){0.f, 0.f, 0.f, 0.f};
    {
        const int qr = (lane & 15) >> 2, p = lane & 3;
        const int pos_lo = (g >> 1) * 16 + (g & 1) * 4 + qr;
        const LAS unsigned char* vb = lds + AT_V + pos_lo * 32 + 8 * p;
#pragma unroll
        for (int wl = 0; wl < 8; ++wl) {
            u32x4 pw; pw.x = cvt_pk_bf16(sc[wl][0][0], sc[wl][0][1]); pw.y = cvt_pk_bf16(sc[wl][0][2], sc[wl][0][3]); pw.z = cvt_pk_bf16(sc[wl][1][0], sc[wl][1][1]); pw.w = cvt_pk_bf16(sc[wl][1][2], sc[wl][1][3]);
            const bf16x8 pf = __builtin_bit_cast(bf16x8, pw);
            const LAS unsigned char* vr = vb + (wbase + wl) * 1024;
#pragma unroll
            for (int n = 0; n < 4; ++n) {
                const s16x4 lo = __builtin_bit_cast(s16x4, __builtin_amdgcn_ds_read_tr16_b64_v4i16((LAS s16x4*)(vr + n * 15392)));
                const s16x4 hi = __builtin_bit_cast(s16x4, __builtin_amdgcn_ds_read_tr16_b64_v4i16((LAS s16x4*)(vr + n * 15392 + 256)));
                const bf16x8 vf = (bf16x8){lo[0], lo[1], lo[2], lo[3], hi[0], hi[1], hi[2], hi[3]};
                o[n] = __builtin_amdgcn_mfma_f32_16x16x32_bf16(vf, pf, o[n], 0, 0, 0);
            }
        }
    }
    const float il = __builtin_amdgcn_rcpf(l);
    bf16_t* op = MIX + ((size_t)(b * SEQ + r * 64 + cq)) * D + h * HD + 4 * g;
#pragma unroll
    for (int n = 0; n < 4; ++n) { u32x2 w; w.x = cvt_pk_bf16(o[n][0] * il, o[n][1] * il); w.y = cvt_pk_bf16(o[n][2] * il, o[n][3] * il); *(u32x2*)(op + 16 * n) = w; }
}

__device__ __forceinline__ void ld8(const bf16_t* p, float (&v)[8]) {
    const u32x4 w = *(const u32x4*)p;
    v[0] = bflo(w.x); v[1] = bfhi(w.x); v[2] = bflo(w.y); v[3] = bfhi(w.y); v[4] = bflo(w.z); v[5] = bfhi(w.z); v[6] = bflo(w.w); v[7] = bfhi(w.w);
}
__device__ __forceinline__ void pool_run(const bf16_t* Zg, bf16_t* MIX, int gw, int lane) {
    const int tb = 32 * gw, b = tb >> 12, t0 = tb & (SEQ - 1);
    const int half = 1 << (lane >> 4);
    const bf16_t* zb = Zg + (size_t)(b * SEQ) * NA + 8 * lane;
    bf16_t* ob = MIX + (size_t)(b * SEQ) * D + NA + 8 * lane;
    float S[8];
#pragma unroll
    for (int e = 0; e < 8; ++e) S[e] = 0.f;
    for (int d = -8; d < 8; ++d) { const int i = t0 + d;
        if (d >= -half && d < half && i >= 0 && i < SEQ) { float v[8]; ld8(zb + (size_t)i * NA, v);
#pragma unroll
            for (int e = 0; e < 8; ++e) S[e] += v[e]; } }
    for (int tt = 0; tt < 32; ++tt) {
        const int t = t0 + tt;
        const int lo = (t - half) < 0 ? 0 : (t - half), hi = (t + half) > SEQ ? SEQ : (t + half);
        const float inv = 1.0f / (float)(hi - lo);
        float zt[8]; ld8(zb + (size_t)t * NA, zt);
        u32x4 w;
        w.x = cvt_pk_bf16(S[0] * inv - zt[0], S[1] * inv - zt[1]); w.y = cvt_pk_bf16(S[2] * inv - zt[2], S[3] * inv - zt[3]);
        w.z = cvt_pk_bf16(S[4] * inv - zt[4], S[5] * inv - zt[5]); w.w = cvt_pk_bf16(S[6] * inv - zt[6], S[7] * inv - zt[7]);
        *(u32x4*)(ob + (size_t)t * D) = w;
        if (t + half < SEQ) { float v[8]; ld8(zb + (size_t)(t + half) * NA, v);
#pragma unroll
            for (int e = 0; e < 8; ++e) S[e] += v[e]; }
        if (t - half >= 0) { float v[8]; ld8(zb + (size_t)(t - half) * NA, v);
#pragma unroll
            for (int e = 0; e < 8; ++e) S[e] -= v[e]; }
    }
}

__device__ __forceinline__ void p2_mixer(Frame& F) {
    const bf16_t* Qg = F.QKVZ; const bf16_t* Kg = F.QKVZ + (size_t)M * NA; const bf16_t* Vg = F.QKVZ + 2 * (size_t)M * NA; const bf16_t* Zg = F.QKVZ + 3 * (size_t)M * NA;
    bf16_t* MIX = F.XN;
    for (int gw = F.vcu * NWAVES + F.wave; gw < M / 32; gw += F.G * NWAVES) pool_run(Zg, MIX, gw, F.lane);
    constexpr int NUNITS = BATCH * NHEAD * 32;
    int cur_bh = -1;
    for (int uidx = F.vcu * 16; uidx < NUNITS; uidx += F.G * 16) {
        for (int ui = 0; ui < 16; ++ui) {
            const int un = uidx + ui, bh = un >> 5, rc = (un >> 2) & 7, j = un & 3, b = bh >> 3, h = bh & 7;
            if (bh != cur_bh) {
                __syncthreads();
                LAS float* tab = (LAS float*)(F.lds + AT_TAB);
                for (int i = F.tid; i < 15 * 64; i += NWAVES * 64) tab[i] = 0.f;
                __syncthreads();
                for (int i = F.tid; i < 15 * 31; i += NWAVES * 64) tab[(i / 31) * 64 + 16 + (i % 31)] = F.rpb[h * 465 + i] * LOG2E;
                cur_bh = bh;
            }
            attn_unit(F, Qg, Kg, Vg, MIX, b, h, j, rc);
        }
    }
    __syncthreads();
}

struct Args { const float* in[13]; float* out; unsigned char* ws; int ph_lo, ph_hi, li, pad; };
__global__ void __launch_bounds__(NWAVES * 64, 2) fwd_megakernel(Args args) {
    extern __shared__ __attribute__((aligned(16))) unsigned char lds[];
    Frame F;
    F.lds = (LAS unsigned char*)lds;
    F.MISC = (volatile LAS unsigned*)(F.lds + MISC_OFF);
    F.tid = threadIdx.x; F.lane = F.tid & 63; F.wave = __builtin_amdgcn_readfirstlane(F.tid >> 6);
    F.G = gridDim.x; { const int bx = blockIdx.x; F.vcu = (F.G % 8 == 0) ? (bx % 8) * (F.G / 8) + bx / 8 : bx; }
    unsigned char* ws = args.ws;
    F.ctl = (gu32*)(ws + WS_CTL);
    F.x = args.in[0]; F.g1 = args.in[1]; F.w_in = args.in[2]; F.gq = args.in[3]; F.gk = args.in[4]; F.rpb = args.in[5]; F.w_pool = args.in[6];
    F.pscale = args.in[7]; F.w_out = args.in[8]; F.g2 = args.in[9]; F.w_gate = args.in[10]; F.w_up = args.in[11]; F.w_down = args.in[12]; F.out = args.out;
    F.Win_t = (bf16_t*)(ws + WS_WIN); F.Wout_t = (bf16_t*)(ws + WS_WOUT); F.Wgu_t = (bf16_t*)(ws + WS_WGU); F.Wdn_t = (bf16_t*)(ws + WS_WDN);
    F.XN = (bf16_t*)(ws + WS_XN); F.QKVZ = (bf16_t*)(ws + WS_QKVZ); F.XB = (bf16_t*)(ws + WS_QKVZ); F.ACT = (bf16_t*)(ws + WS_ACT);
    F.ss = (float*)(ws + WS_CTL) + CW_SS;
    for (int u = F.tid; u < (LDS_BYTES - LDSCTL_OFF) / 4; u += NWAVES * 64) ((LAS unsigned*)(F.lds + LDSCTL_OFF))[u] = 0u;
    __syncthreads();
    XcdBarrier bar; bar.bar = (unsigned*)(F.ctl + CW_BAR); bar.x = 0; bar.st = nullptr;
    if (N_LAUNCHES != PER_PHASE) bar = xcd_barrier_post((unsigned*)(F.ctl + CW_BAR), F.MISC + 8);
#define GRID_BAR() do { if (N_LAUNCHES != PER_PHASE) xcd_barrier(bar); } while (0)
    const int lo = args.ph_lo, hi = args.ph_hi;
#define IN(k) (lo <= (k) && (k) < hi)
#define BOTH(k) (IN(k) && IN((k) + 1))

    if (IN(0)) { p0_prologue(F); if (BOTH(0)) GRID_BAR(); }

    if (IN(1)) {
        pg8::Gemm g{F.XN, F.Win_t, M, NIN, D}; pg8::StaticOrder S; S.init(M, NIN, F.G, (int)blockIdx.x);
        pg8::EpiIn E{F.QKVZ, F.gq, F.gk};
        pg8::gemm_phase<pg8::EpiIn, pg8::StaticOrder, true, PG8_SP2>(F.lds + RING_OFF, g, S, E);
        if (BOTH(1)) GRID_BAR();
    }

    if (IN(2)) { p2_mixer(F); if (BOTH(2)) GRID_BAR(); }

    if (IN(3)) {
        pg8::Gemm g{F.XN, F.Wout_t, M, D, D}; pg8::StaticOrder S; S.init(M, D, F.G, (int)blockIdx.x);
        pg8::EpiOut E{F.x, F.out, F.XB, F.ss};
        pg8::gemm_phase<pg8::EpiOut, pg8::StaticOrder, true, PG8_SP2>(F.lds + RING_OFF, g, S, E);
        if (BOTH(3)) GRID_BAR();
    }

    if (IN(4)) {
        pg8::Gemm g{F.XB, F.Wgu_t, M, NGU, D}; pg8::StaticOrder S; S.init(M, NGU, F.G, (int)blockIdx.x);
        pg8::EpiGU E{F.ACT, F.ss};
        pg8::gemm_phase<pg8::EpiGU, pg8::StaticOrder, true, PG8_SP2>(F.lds + RING_OFF, g, S, E);
        if (BOTH(4)) GRID_BAR();
    }

    if (IN(5)) {
        pg8::Gemm g{F.ACT, F.Wdn_t, M, D, FF}; pg8::StaticOrder S; S.init(M, D, F.G, (int)blockIdx.x);
        pg8::EpiDown E{F.out};
        pg8::gemm_phase<pg8::EpiDown, pg8::StaticOrder, true, PG8_SP2>(F.lds + RING_OFF, g, S, E);
    }
#undef IN
#undef BOTH
#undef GRID_BAR
}

extern "C" void kernel_launch(void* const* d_in, const int* in_sizes, int n_in, void* d_out, int out_size, void* d_ws, size_t ws_size, hipStream_t stream) {
    static int grid = 0;
    if (grid == 0) {
        if (n_in != 13 || in_sizes[0] != M * D || out_size != M * D || ws_size < WS_END) { fprintf(stderr, "kernel_launch: unexpected shapes (n_in %d, in0 %d, out %d, ws %zu); nothing launched\n", n_in, n_in > 0 ? in_sizes[0] : -1, out_size, ws_size); grid = -1; return; }
        int dev = 0, cus = 0, per_cu = 0;
        if (hipGetDevice(&dev) != hipSuccess || hipDeviceGetAttribute(&cus, hipDeviceAttributeMultiprocessorCount, dev) != hipSuccess) { fprintf(stderr, "kernel_launch: device query failed\n"); grid = -1; return; }
        if (hipFuncSetAttribute((const void*)fwd_megakernel, hipFuncAttributeMaxDynamicSharedMemorySize, LDS_BYTES) != hipSuccess) { fprintf(stderr, "kernel_launch: hipFuncSetAttribute failed\n"); grid = -1; return; }
        if (hipOccupancyMaxActiveBlocksPerMultiprocessor(&per_cu, (const void*)fwd_megakernel, NWAVES * 64, LDS_BYTES) != hipSuccess || per_cu < 1) {
            fprintf(stderr, "kernel_launch: occupancy query reports %d workgroups per CU; nothing launched\n", per_cu); (void)hipGetLastError(); grid = -1; return; }
        (void)hipGetLastError();
        grid = cus;
    }
    if (grid < 0) return;
    if (hipMemsetAsync((char*)d_ws + WS_CTL, 0, CTL_ZERO_BYTES, stream) != hipSuccess) { fprintf(stderr, "kernel_launch: hipMemsetAsync failed\n"); return; }
    Args a{};
    for (int i = 0; i < 13; ++i) a.in[i] = (const float*)d_in[i];
    a.out = (float*)d_out; a.ws = (unsigned char*)d_ws;
    for (int li = 0; li < N_LAUNCHES; ++li) {
        a.ph_lo = (N_LAUNCHES == PER_PHASE) ? li : 0; a.ph_hi = (N_LAUNCHES == PER_PHASE) ? li + 1 : PER_PHASE; a.li = li;
        hipLaunchKernelGGL(fwd_megakernel, dim3(grid), dim3(NWAVES * 64), LDS_BYTES, stream, a);
        const hipError_t le = hipPeekAtLastError();
        if (le != hipSuccess) { fprintf(stderr, "kernel_launch: launch %d failed: %s\n", li, hipGetErrorName(le)); break; }
    }
}
```

```cpp
#include <hip/hip_runtime.h>
#include <cstdio>
#include <cstdint>

#define LAS __attribute__((address_space(3)))
#define GAS __attribute__((address_space(1)))
typedef unsigned short bf16_t;
typedef short bf16x8 __attribute__((ext_vector_type(8)));
typedef short s16x4 __attribute__((ext_vector_type(4)));
typedef float f32x4 __attribute__((ext_vector_type(4)));
typedef float f32x2 __attribute__((ext_vector_type(2)));
typedef unsigned u32x4 __attribute__((ext_vector_type(4)));
typedef unsigned u32x2 __attribute__((ext_vector_type(2)));

constexpr int BATCH = 16, SEQ = 4096, D = 1024, M = BATCH * SEQ;
constexpr int NA = 512, NHEAD = 8, HD = 64, NIN = 2048, FF = 2816, NGU = 2 * FF;
constexpr float EPS = 1e-6f;
constexpr float LOG2E = 1.4426950408889634f;

__device__ __forceinline__ unsigned cvt_pk_bf16(float lo, float hi) { unsigned r; asm volatile("v_cvt_pk_bf16_f32 %0, %1, %2" : "=v"(r) : "v"(lo), "v"(hi)); return r; }

namespace pg8 {
constexpr int BM = 256, BK = 64, HALF = 128, HTB = HALF * BK * 2, STAGE_BYTES = 8 * HTB, NXCD = 8, WGM = 8;

__host__ __device__ __forceinline__ int lds_byte(int r, int c) { const int st = (r >> 4) * 2 + (c >> 5), rr = r & 15, cc = c & 31, ob = rr * 64 + cc * 2; return st * 1024 + (ob ^ (((ob >> 9) & 1) << 5)); }
__host__ __device__ __forceinline__ void stage_rc(int b, int& R, int& C) { const int st = b / 1024, sb = b % 1024, swz = sb ^ (((sb >> 9) & 1) << 5); R = (st >> 1) * 16 + swz / 64; C = (st & 1) * 32 + (swz % 64) / 2; }
__host__ __device__ __forceinline__ int perm32(int rho) { const int n = rho >> 4, i = rho & 15; return 8 * (i >> 2) + 4 * n + (i & 3); }

struct Unit { int pm, pn; };
struct Gemm { const bf16_t* A; const bf16_t* Bt; int M, N, K; };

struct StaticOrder {
    int nM, nN, nwg, G, c;
    __host__ __device__ void init(int M_, int N_, int G_, int c_) { nM = M_ / BM; nN = N_ / BM; nwg = nM * nN; G = G_; c = c_; }
    __host__ __device__ bool next(int i, Unit& u) const {
        const long L = (long)i * G + c; if (L >= nwg) return false;
        int wgid = (int)L; { const int q = nwg / NXCD, r = nwg % NXCD, xcd = wgid % NXCD, off = wgid / NXCD; wgid = (xcd < r ? xcd * (q + 1) : r * (q + 1) + (xcd - r) * q) + off; }
        const int nig = WGM * nN, gid = wgid / nig, fm = gid * WGM, gsz = (nM - fm) < WGM ? (nM - fm) : WGM;
        u.pm = fm + ((wgid % nig) % gsz); u.pn = (wgid % nig) / gsz; return true;
    }
    __device__ __forceinline__ void a_ready(const Unit&) const {}
    __device__ __forceinline__ void done(const Unit&) const {}
};


struct EpiIn {
    static constexpr bool PERM = true, AFTER_DRAIN = false;
    bf16_t* QKVZ; const float* gq; const float* gk;
    __device__ __forceinline__ void operator()(const f32x4 (&acc)[2][2][4][2], const Unit& u, int wr, int wc, int fr, int fq) const {
        const int kind = u.pn >> 1;
        bf16_t* base = QKVZ + (size_t)kind * ((size_t)M * NA) + (u.pn & 1) * 256 + wc * 64 + 8 * fq;
        const int row0 = u.pm * BM + wr * 64 + fr;
        if (kind < 2) {
            const float* g = kind == 0 ? gq : gk; const float qs = kind == 0 ? 0.125f * LOG2E : 1.0f;
            f32x4 gv[2][2];
#pragma unroll
            for (int bj = 0; bj < 2; ++bj)
#pragma unroll
                for (int n = 0; n < 2; ++n) gv[bj][n] = *(const f32x4*)(g + 32 * bj + 8 * fq + 4 * n) * qs;
#pragma unroll
            for (int ai = 0; ai < 2; ++ai)
#pragma unroll
                for (int m = 0; m < 4; ++m) {
                    bf16_t* rowp = base + (size_t)(row0 + ai * HALF + m * 16) * NA;
                    float ss = 0.f;
#pragma unroll
                    for (int bj = 0; bj < 2; ++bj)
#pragma unroll
                        for (int n = 0; n < 2; ++n) { const f32x4 v = acc[ai][bj][m][n]; ss += (v[0] * v[0] + v[1] * v[1]) + (v[2] * v[2] + v[3] * v[3]); }
                    ss += __shfl_xor(ss, 16); ss += __shfl_xor(ss, 32);
                    const float r = __builtin_amdgcn_rsqf(ss * (1.0f / 64.0f) + EPS);
#pragma unroll
                    for (int bj = 0; bj < 2; ++bj) {
                        const f32x4 v0 = acc[ai][bj][m][0] * r * gv[bj][0], v1 = acc[ai][bj][m][1] * r * gv[bj][1];
                        u32x4 w; w.x = cvt_pk_bf16(v0[0], v0[1]); w.y = cvt_pk_bf16(v0[2], v0[3]); w.z = cvt_pk_bf16(v1[0], v1[1]); w.w = cvt_pk_bf16(v1[2], v1[3]);
                        *(u32x4*)(rowp + bj * 32) = w; }
                }
        } else {
#pragma unroll
            for (int ai = 0; ai < 2; ++ai)
#pragma unroll
                for (int m = 0; m < 4; ++m) {
                    bf16_t* rowp = base + (size_t)(row0 + ai * HALF + m * 16) * NA;
#pragma unroll
                    for (int bj = 0; bj < 2; ++bj) {
                        const f32x4 v0 = acc[ai][bj][m][0], v1 = acc[ai][bj][m][1];
                        u32x4 w; w.x = cvt_pk_bf16(v0[0], v0[1]); w.y = cvt_pk_bf16(v0[2], v0[3]); w.z = cvt_pk_bf16(v1[0], v1[1]); w.w = cvt_pk_bf16(v1[2], v1[3]);
                        *(u32x4*)(rowp + bj * 32) = w; }
                }
        }
    }
};

struct EpiOut {
    static constexpr bool PERM = true, AFTER_DRAIN = false;
    const float* x; float* out; bf16_t* XB; float* ss;
    __device__ __forceinline__ void operator()(const f32x4 (&acc)[2][2][4][2], const Unit& u, int wr, int wc, int fr, int fq) const {
        const int row0 = u.pm * BM + wr * 64 + fr, col0 = u.pn * BM + wc * 32 + 8 * fq;
#pragma unroll
        for (int ai = 0; ai < 2; ++ai)
#pragma unroll
            for (int m = 0; m < 4; ++m) {
                const int row = row0 + ai * HALF + m * 16; const size_t off = (size_t)row * D + col0; float part = 0.f;
#pragma unroll
                for (int bj = 0; bj < 2; ++bj) {
                    const f32x4 a = *(const f32x4*)(x + off + bj * HALF), b = *(const f32x4*)(x + off + bj * HALF + 4);
                    const f32x4 v0 = acc[ai][bj][m][0] + a, v1 = acc[ai][bj][m][1] + b;
                    *(f32x4*)(out + off + bj * HALF) = v0; *(f32x4*)(out + off + bj * HALF + 4) = v1;
                    u32x4 w; w.x = cvt_pk_bf16(v0[0], v0[1]); w.y = cvt_pk_bf16(v0[2], v0[3]); w.z = cvt_pk_bf16(v1[0], v1[1]); w.w = cvt_pk_bf16(v1[2], v1[3]);
                    *(u32x4*)(XB + off + bj * HALF) = w;
                    part += (v0[0] * v0[0] + v0[1] * v0[1]) + (v0[2] * v0[2] + v0[3] * v0[3]) + (v1[0] * v1[0] + v1[1] * v1[1]) + (v1[2] * v1[2] + v1[3] * v1[3]); }
                part += __shfl_xor(part, 16); part += __shfl_xor(part, 32);
                if (fq == 0) atomicAdd(ss + row, part);
            }
    }
};

struct EpiGU {
    static constexpr bool PERM = true, AFTER_DRAIN = false;
    bf16_t* ACT; const float* ss;
    __device__ __forceinline__ void operator()(const f32x4 (&acc)[2][2][4][2], const Unit& u, int wr, int wc, int fr, int fq) const {
        const int row0 = u.pm * BM + wr * 64 + fr, col0 = u.pn * HALF + wc * 32 + 8 * fq;
#pragma unroll
        for (int ai = 0; ai < 2; ++ai)
#pragma unroll
            for (int m = 0; m < 4; ++m) {
                const int row = row0 + ai * HALF + m * 16;
                const float rstd = __builtin_amdgcn_rsqf(ss[row] * (1.0f / (float)D) + EPS);
                unsigned w[4];
#pragma unroll
                for (int n = 0; n < 2; ++n) {
                    const f32x4 g = acc[ai][0][m][n] * rstd, up = acc[ai][1][m][n] * rstd; float a[4];
#pragma unroll
                    for (int e = 0; e < 4; ++e) a[e] = g[e] * up[e] * __builtin_amdgcn_rcpf(1.0f + __builtin_amdgcn_exp2f(-LOG2E * g[e]));
                    w[2 * n] = cvt_pk_bf16(a[0], a[1]); w[2 * n + 1] = cvt_pk_bf16(a[2], a[3]); }
                *(u32x4*)(ACT + (size_t)row * FF + col0) = (u32x4){w[0], w[1], w[2], w[3]};
            }
    }
};

struct EpiDown {
    static constexpr bool PERM = true, AFTER_DRAIN = false;
    float* out;
    __device__ __forceinline__ void operator()(const f32x4 (&acc)[2][2][4][2], const Unit& u, int wr, int wc, int fr, int fq) const {
        const int row0 = u.pm * BM + wr * 64 + fr, col0 = u.pn * BM + wc * 32 + 8 * fq;
#pragma unroll
        for (int ai = 0; ai < 2; ++ai)
#pragma unroll
            for (int m = 0; m < 4; ++m) {
                const size_t off = (size_t)(row0 + ai * HALF + m * 16) * D + col0;
#pragma unroll
                for (int bj = 0; bj < 2; ++bj) {
                    float* p = out + off + bj * HALF;
                    const f32x4 a = *(const f32x4*)p, b = *(const f32x4*)(p + 4);
                    *(f32x4*)p = acc[ai][bj][m][0] + a; *(f32x4*)(p + 4) = acc[ai][bj][m][1] + b; }
            }
    }
};

template <class Epi, class Sched, bool ALIGN_EPI = false, bool SP2 = false>
__device__ __forceinline__ void gemm_phase(LAS unsigned char* lds, const Gemm g, const Sched& S, const Epi& E) {
    const int tid = threadIdx.x, wid = __builtin_amdgcn_readfirstlane(tid >> 6), lane = tid & 63, wr = wid >> 2, wc = wid & 3, fr = lane & 15, fq = lane >> 4;
    const int K = g.K, nt = K / BK;
    unsigned voffA[2], voffB[2];
#pragma unroll
    for (int i = 0; i < 2; ++i) { int R, C; stage_rc(tid * 16 + i * 8192, R, C); const int Rb = Epi::PERM ? ((R & ~31) + perm32(R & 31)) : R;
        voffA[i] = (unsigned)(R * K + C) * 2u; voffB[i] = (unsigned)(Rb * K + C) * 2u; }
    const size_t kstep = (size_t)(BK * 2);
    const size_t hstep = (size_t)HALF * K * 2;
    const size_t tstep = 2 * hstep;
    const unsigned ldsw = (unsigned)wid * 1024u;
    const int aoff = lds_byte(wr * 64 + fr, fq * 8), boff = lds_byte(wc * 32 + fr, fq * 8);
#define PG8_SA(b, h) (((b) * 2 + (h)) * HTB)
#define PG8_SB(b, h) ((4 + (b) * 2 + (h)) * HTB)
#define PG8_STAGE(bufoff, gbase, voff) do { _Pragma("unroll") for (int _i = 0; _i < 2; ++_i) \
        __builtin_amdgcn_global_load_lds((const unsigned*)((const char*)(gbase) + (voff)[_i]), (LAS unsigned*)(lds + (bufoff) + ldsw + _i * 8192), 16, 0, 0); } while (0)
#define PG8_LDA(dst, b, h) do { _Pragma("unroll") for (int m = 0; m < 4; ++m) _Pragma("unroll") for (int k = 0; k < 2; ++k) dst[m][k] = *(const LAS bf16x8*)(lds + PG8_SA(b, h) + aoff + m * 2048 + k * 1024); } while (0)
#define PG8_LDB(dst, b, h) do { _Pragma("unroll") for (int n = 0; n < 2; ++n) _Pragma("unroll") for (int k = 0; k < 2; ++k) dst[n][k] = *(const LAS bf16x8*)(lds + PG8_SB(b, h) + boff + n * 2048 + k * 1024); } while (0)
#define PG8_MMA(ai, bj, At, Bt) do { __builtin_amdgcn_s_setprio(1); _Pragma("unroll") for (int m = 0; m < 4; ++m) _Pragma("unroll") for (int n = 0; n < 2; ++n) _Pragma("unroll") for (int k = 0; k < 2; ++k) \
        acc[ai][bj][m][n] = __builtin_amdgcn_mfma_f32_16x16x32_bf16(Bt[n][k], At[m][k], acc[ai][bj][m][n], 0, 0, 0); __builtin_amdgcn_s_setprio(0); } while (0)
#define PG8_WAIT_V(n) asm volatile("s_waitcnt vmcnt(" #n ")" ::: "memory")
#define PG8_WAIT_L(n) asm volatile("s_waitcnt lgkmcnt(" #n ")" ::: "memory")
#define PG8_BAR __builtin_amdgcn_s_barrier()
#define PG8_SCHED __builtin_amdgcn_sched_barrier(0)
    Unit cur, nxt; int ui = 0;
    if (!S.next(0, cur)) return;
    f32x4 acc[2][2][4][2];
#pragma unroll
    for (int a = 0; a < 2; ++a)
#pragma unroll
        for (int b = 0; b < 2; ++b)
#pragma unroll
            for (int m = 0; m < 4; ++m)
#pragma unroll
                for (int n = 0; n < 2; ++n) acc[a][b][m][n] = (f32x4){0.f, 0.f, 0.f, 0.f};
    bf16x8 At[4][2], B0[2][2], B1[2][2];
    const char* cA = (const char*)g.A + (size_t)cur.pm * tstep; const char* cB = (const char*)g.Bt + (size_t)cur.pn * tstep;
    S.a_ready(cur);
    if constexpr (SP2) {
        PG8_STAGE(PG8_SB(0, 0), cB, voffB); PG8_STAGE(PG8_SB(0, 1), cB + hstep, voffB); PG8_STAGE(PG8_SA(0, 0), cA, voffA); PG8_STAGE(PG8_SA(0, 1), cA + hstep, voffA);
        if (wr == 1) PG8_BAR;
        PG8_WAIT_V(2); PG8_BAR;
        PG8_STAGE(PG8_SB(1, 0), cB + kstep, voffB); PG8_STAGE(PG8_SA(1, 0), cA + kstep, voffA); PG8_STAGE(PG8_SB(1, 1), cB + hstep + kstep, voffB);
        PG8_WAIT_V(6); PG8_BAR;
    } else {
        PG8_STAGE(PG8_SB(0, 0), cB, voffB); PG8_STAGE(PG8_SA(0, 0), cA, voffA); PG8_STAGE(PG8_SB(0, 1), cB + hstep, voffB); PG8_STAGE(PG8_SA(0, 1), cA + hstep, voffA);
        if (wr == 1) PG8_BAR;
        PG8_WAIT_V(4); PG8_BAR;
        PG8_STAGE(PG8_SB(1, 0), cB + kstep, voffB); PG8_STAGE(PG8_SA(1, 0), cA + kstep, voffA); PG8_STAGE(PG8_SB(1, 1), cB + hstep + kstep, voffB);
        PG8_WAIT_V(6); PG8_BAR;
    }
    for (;;) {
        const bool has_next = S.next(ui + 1, nxt);
        const char* nA = has_next ? (const char*)g.A + (size_t)nxt.pm * tstep : cA; const char* nB = has_next ? (const char*)g.Bt + (size_t)nxt.pn * tstep : cB;
        for (int t = 0; t < nt; t += 2) {
            const bool last = (t == nt - 2);
            const char* a1 = cA + (size_t)(t + 1) * kstep;
            const char* a2 = last ? nA : cA + (size_t)(t + 2) * kstep; const char* b2 = last ? nB : cB + (size_t)(t + 2) * kstep;
            const char* a3 = a2 + kstep; const char* b3 = b2 + kstep;
            if (last && has_next) S.a_ready(nxt);
            if constexpr (SP2) {
            PG8_LDB(B0, 0, 0); PG8_LDB(B1, 0, 1); PG8_SCHED; PG8_LDA(At, 0, 0); PG8_STAGE(PG8_SA(1, 1), a1 + hstep, voffA);
            PG8_WAIT_V(8); PG8_WAIT_L(0); PG8_BAR; PG8_MMA(0, 0, At, B0); PG8_MMA(0, 1, At, B1); PG8_BAR; PG8_SCHED;
            PG8_LDA(At, 0, 1); PG8_STAGE(PG8_SB(0, 0), b2, voffB); PG8_STAGE(PG8_SB(0, 1), b2 + hstep, voffB); PG8_STAGE(PG8_SA(0, 0), a2, voffA);
            PG8_WAIT_V(8); PG8_WAIT_L(0); PG8_BAR; PG8_MMA(1, 0, At, B0); PG8_MMA(1, 1, At, B1); PG8_BAR; PG8_SCHED;
            PG8_LDB(B0, 1, 0); PG8_LDB(B1, 1, 1); PG8_SCHED; PG8_LDA(At, 1, 0); PG8_STAGE(PG8_SA(0, 1), a2 + hstep, voffA);
            PG8_WAIT_V(8); PG8_WAIT_L(0); PG8_BAR; PG8_MMA(0, 0, At, B0); PG8_MMA(0, 1, At, B1); PG8_BAR; PG8_SCHED;
            PG8_LDA(At, 1, 1); PG8_STAGE(PG8_SB(1, 0), b3, voffB); PG8_STAGE(PG8_SB(1, 1), b3 + hstep, voffB); PG8_STAGE(PG8_SA(1, 0), a3, voffA);
            PG8_WAIT_V(8); PG8_WAIT_L(0); PG8_BAR; PG8_MMA(1, 0, At, B0); PG8_MMA(1, 1, At, B1); PG8_BAR; PG8_SCHED;
            } else {
            PG8_LDB(B0, 0, 0); PG8_SCHED; PG8_LDA(At, 0, 0); PG8_STAGE(PG8_SA(1, 1), a1 + hstep, voffA);
            PG8_WAIT_L(8); PG8_BAR; PG8_WAIT_L(0); PG8_MMA(0, 0, At, B0); PG8_BAR; PG8_SCHED;
            PG8_LDB(B1, 0, 1); PG8_STAGE(PG8_SB(0, 0), b2, voffB);
            PG8_BAR; PG8_WAIT_L(0); PG8_MMA(0, 1, At, B1); PG8_BAR;
            PG8_LDA(At, 0, 1); PG8_STAGE(PG8_SA(0, 0), a2, voffA);
            PG8_BAR; PG8_WAIT_L(0); PG8_MMA(1, 0, At, B0); PG8_BAR; PG8_SCHED;
            PG8_STAGE(PG8_SB(0, 1), b2 + hstep, voffB);
            PG8_WAIT_V(6); PG8_BAR; PG8_MMA(1, 1, At, B1); PG8_BAR;
            PG8_LDB(B0, 1, 0); PG8_SCHED; PG8_LDA(At, 1, 0); PG8_STAGE(PG8_SA(0, 1), a2 + hstep, voffA);
            PG8_WAIT_L(8); PG8_BAR; PG8_WAIT_L(0); PG8_MMA(0, 0, At, B0); PG8_BAR; PG8_SCHED;
            PG8_LDB(B1, 1, 1); PG8_STAGE(PG8_SB(1, 0), b3, voffB);
            PG8_BAR; PG8_WAIT_L(0); PG8_MMA(0, 1, At, B1); PG8_BAR;
            PG8_LDA(At, 1, 1); PG8_STAGE(PG8_SA(1, 0), a3, voffA);
            PG8_BAR; PG8_WAIT_L(0); PG8_MMA(1, 0, At, B0); PG8_BAR; PG8_SCHED;
            PG8_STAGE(PG8_SB(1, 1), b3 + hstep, voffB);
            PG8_WAIT_V(6); PG8_BAR; PG8_MMA(1, 1, At, B1); PG8_BAR;
            }
        }
        if constexpr (ALIGN_EPI) { if (wr == 0) PG8_BAR; }
        if constexpr (!Epi::AFTER_DRAIN) { E(acc, cur, wr, wc, fr, fq); S.done(cur); }
        if (!has_next) break;
#pragma unroll
        for (int a = 0; a < 2; ++a)
#pragma unroll
            for (int b = 0; b < 2; ++b)
#pragma unroll
                for (int m = 0; m < 4; ++m)
#pragma unroll
                    for (int n = 0; n < 2; ++n) acc[a][b][m][n] = (f32x4){0.f, 0.f, 0.f, 0.f};
        cur = nxt; cA = nA; cB = nB; ++ui;
        if constexpr (ALIGN_EPI) { if (wr == 1) PG8_BAR; }
    }
    PG8_WAIT_V(0);
    if constexpr (!ALIGN_EPI) { if (wr == 0) PG8_BAR; }
    PG8_BAR;
#undef PG8_SA
#undef PG8_SB
#undef PG8_STAGE
#undef PG8_LDA
#undef PG8_LDB
#undef PG8_MMA
#undef PG8_WAIT_V
#undef PG8_WAIT_L
#undef PG8_BAR
#undef PG8_SCHED
}
}

constexpr int NWAVES = 8;
#ifndef MK_N_LAUNCHES
#define MK_N_LAUNCHES 1
#endif
constexpr int N_LAUNCHES = MK_N_LAUNCHES;
constexpr int PER_PHASE = 6;
#ifndef PG8_SP2
#define PG8_SP2 true
#endif

constexpr size_t MiB = 1u << 20;
constexpr size_t WS_CTL = 0, CTL_ZERO_BYTES = 1 * MiB;
constexpr size_t WS_WIN = 2 * MiB;
constexpr size_t WS_WOUT = 6 * MiB;
constexpr size_t WS_WGU = 8 * MiB;
constexpr size_t WS_WDN = 20 * MiB;
constexpr size_t WS_XN = 32 * MiB;
constexpr size_t WS_QKVZ = 160 * MiB;
constexpr size_t WS_ACT = 416 * MiB;
constexpr size_t WS_END = 768 * MiB;
static_assert(WS_WGU + (size_t)NGU * D * 2 <= WS_WDN && WS_WDN + (size_t)D * FF * 2 <= WS_XN && WS_ACT + (size_t)M * FF * 2 <= WS_END, "d_ws map");
constexpr int CW_BAR = 4096;
constexpr int CW_SS = 65536;
static_assert((size_t)(CW_SS + M) * 4 <= CTL_ZERO_BYTES, "ss inside the memset region");

constexpr int RING_OFF = 0, RING_BYTES = 131072;
constexpr int LDSCTL_OFF = RING_BYTES, MISC_OFF = LDSCTL_OFF + 320;
constexpr int LDS_BYTES = 147456;

typedef GAS unsigned gu32;
#define RLX_AGENT __ATOMIC_RELAXED, __HIP_MEMORY_SCOPE_AGENT
#define LDS_WAIT() asm volatile("s_waitcnt lgkmcnt(0)" ::: "memory")
__device__ __forceinline__ unsigned f2bf(float f) { unsigned u = __builtin_bit_cast(unsigned, f); return (u + 0x7fffu + ((u >> 16) & 1u)) >> 16; }
__device__ __forceinline__ unsigned pk2(float lo, float hi) { return f2bf(lo) | (f2bf(hi) << 16); }
__device__ __forceinline__ float bflo(unsigned w) { return __builtin_bit_cast(float, w << 16); }
__device__ __forceinline__ float bfhi(unsigned w) { return __builtin_bit_cast(float, w & 0xffff0000u); }

#define XB_TMO      128
#define XB_XCNT(j)  (256  + 64 * (j))
#define XB_XSUB(j)  (1280 + 64 * (j))
#define XB_XGEN(j)  (2304 + 64 * (j))
#define XB_TOP      3328
#define XB_TOPGEN   3392
#define XCD_BAR_WORDS 3456
#define XB_SPIN_CAP (1u << 18)

__device__ __forceinline__ unsigned xb_ld(unsigned* p)              { return __hip_atomic_load(p, __ATOMIC_RELAXED, __HIP_MEMORY_SCOPE_AGENT); }
__device__ __forceinline__ unsigned xb_add(unsigned* p, unsigned v) { return __hip_atomic_fetch_add(p, v, __ATOMIC_RELAXED, __HIP_MEMORY_SCOPE_AGENT); }
__device__ __forceinline__ unsigned xb_xcc_id() { return (unsigned)__builtin_amdgcn_s_getreg((3 << 11) | 20) & 0xFu; }
#define XB_SPIN(cond, bar) do { unsigned _sp = 0; while (cond) { __builtin_amdgcn_s_sleep(1); \
    if ((++_sp & 255u) == 0u) { if (xb_ld(&(bar)[XB_TMO])) break; if (_sp > XB_SPIN_CAP) { atomicAdd(&(bar)[XB_TMO], 1u); break; } } } } while (0)

struct XcdBarrier { unsigned* bar; unsigned x; volatile LAS unsigned* st; };

__device__ __forceinline__ XcdBarrier xcd_barrier_post(unsigned* bar, volatile LAS unsigned* st) {
    XcdBarrier b; b.bar = bar; b.x = xb_xcc_id(); b.st = st;
    if (threadIdx.x == 0) (void)xb_add(&bar[XB_XCNT(b.x)], 1u);
    return b;
}
__device__ __forceinline__ void xcd_barrier_complete(unsigned* bar, unsigned x, unsigned& nloc, unsigned& nx) {
    const unsigned G = gridDim.x * gridDim.y * gridDim.z;
    unsigned sum, cnt, mine, sp = 0u;
    for (;;) {
        sum = 0u; cnt = 0u; mine = 0u;
#pragma unroll
        for (unsigned j = 0; j < 16; ++j) { const unsigned c = xb_ld(&bar[XB_XCNT(j)]); sum += c; cnt += (c > 0u) ? 1u : 0u; mine = (j == x) ? c : mine; }
        if (sum == G) break;
        __builtin_amdgcn_s_sleep(1);
        if ((++sp & 255u) == 0u) { if (xb_ld(&bar[XB_TMO])) break; if (sp > XB_SPIN_CAP) { atomicAdd(&bar[XB_TMO], 1u); break; } }
    }
    nloc = mine > 0u ? mine : 1u; nx = cnt > 0u ? cnt : 1u;
}
__device__ __forceinline__ void xcd_barrier(const XcdBarrier& b) {
    asm volatile("s_waitcnt vmcnt(0)" ::: "memory");
    __syncthreads();
    if (threadIdx.x == 0) {
        unsigned* bar = b.bar;
        __builtin_amdgcn_s_waitcnt(0);
        unsigned nloc = b.st[0], nx = b.st[1];
        if (nloc == 0u) { xcd_barrier_complete(bar, b.x, nloc, nx); b.st[0] = nloc; b.st[1] = nx; }
        const unsigned old = xb_add(&bar[XB_XSUB(b.x)], 1u);
        const unsigned gen = old / nloc;
        if (old + 1u == (gen + 1u) * nloc) {
            __builtin_amdgcn_fence(__ATOMIC_RELEASE, "agent");
            asm volatile("s_waitcnt vmcnt(0)" ::: "memory");
            const unsigned og = xb_add(&bar[XB_TOP], 1u);
            const unsigned tg = og / nx;
            if (og + 1u == (tg + 1u) * nx) xb_add(&bar[XB_TOPGEN], 1u);
            else XB_SPIN(xb_ld(&bar[XB_TOPGEN]) == tg, bar);
            __builtin_amdgcn_fence(__ATOMIC_ACQUIRE, "agent");
            xb_add(&bar[XB_XGEN(b.x)], 1u);
            asm volatile("s_waitcnt vmcnt(0)" ::: "memory");
        } else {
            XB_SPIN(xb_ld(&bar[XB_XGEN(b.x)]) == gen, bar);
            __builtin_amdgcn_fence(__ATOMIC_ACQUIRE, "agent");
            asm volatile("s_waitcnt vmcnt(0)" ::: "memory");
        }
    }
    __syncthreads();
}

struct Frame {
    LAS unsigned char* lds;
    volatile LAS unsigned* MISC;
    gu32* ctl;
    int tid, lane, wave;
    int vcu, G;
    const float *x, *g1, *w_in, *gq, *gk, *rpb, *w_pool, *pscale, *w_out, *g2, *w_gate, *w_up, *w_down;
    float* out;
    bf16_t *Win_t, *Wout_t, *Wgu_t, *Wdn_t;
    bf16_t *XN, *QKVZ, *XB, *ACT;
    float* ss;
};

__device__ __forceinline__ float wave_sum(float v) {
#pragma unroll
    for (int o = 1; o < 64; o <<= 1) v += __shfl_xor(v, o);
    return v;
}

__device__ __forceinline__ void p0_tile_out(bf16_t* WT, int K, int drow0, int k0, LAS float* scr, int lane) {
    LDS_WAIT(); asm volatile("" ::: "memory");
    const int c = lane & 7;
#pragma unroll
    for (int j = 0; j < 4; ++j) { const int n = (lane >> 3) + 8 * j; const LAS float* s = scr + (8 * c) * 33 + n;
        u32x4 o; o.x = pk2(s[0 * 33], s[1 * 33]); o.y = pk2(s[2 * 33], s[3 * 33]); o.z = pk2(s[4 * 33], s[5 * 33]); o.w = pk2(s[6 * 33], s[7 * 33]);
        *(GAS u32x4*)(WT + (size_t)(drow0 + n) * K + k0 + 8 * c) = o; }
    LDS_WAIT(); asm volatile("" ::: "memory");
}
__device__ __forceinline__ void p0_transpose_item(const float* W, int ldw, int K, int k0, int n0, const float* gkv, bf16_t* WT, int drow0, LAS float* scr, int lane) {
#pragma unroll 8
    for (int i = 0; i < 32; ++i) { const int kk = 2 * i + (lane >> 5); float v = W[(size_t)(k0 + kk) * ldw + n0 + (lane & 31)]; if (gkv) v *= gkv[k0 + kk]; scr[kk * 33 + (lane & 31)] = v; }
    p0_tile_out(WT, K, drow0, k0, scr, lane);
}
__device__ __forceinline__ void p0_fold_item(const float* w_in, const float* w_pool, const float* pscale, int k0, int n0z, bf16_t* WT, int drow0, int lane) {
    const int n = lane & 31, kh = lane >> 5, g = n0z >> 7, d = (n0z & 127) + n;
    float acc[4] = {0.f, 0.f, 0.f, 0.f};
    const float* wrow = w_in + (size_t)(k0 + 4 * kh) * NIN + 3 * NA + 128 * g;
    const float* wp = w_pool + (size_t)g * 128 * 128 + d;
#pragma unroll 4
    for (int c4 = 0; c4 < 32; ++c4) {
        const float p0 = wp[(4 * c4 + 0) * 128], p1 = wp[(4 * c4 + 1) * 128], p2 = wp[(4 * c4 + 2) * 128], p3 = wp[(4 * c4 + 3) * 128];
#pragma unroll
        for (int i = 0; i < 4; ++i) { const f32x4 w = *(const f32x4*)(wrow + (size_t)i * NIN + 4 * c4); acc[i] += (w[0] * p0 + w[1] * p1) + (w[2] * p2 + w[3] * p3); }
    }
    const float ps = pscale[n0z + n];
    float hi[4];
#pragma unroll
    for (int i = 0; i < 4; ++i) { acc[i] *= ps; hi[i] = __shfl(acc[i], (lane + 32) & 63); }
    if (lane < 32) { u32x4 o; o.x = pk2(acc[0], acc[1]); o.y = pk2(acc[2], acc[3]); o.z = pk2(hi[0], hi[1]); o.w = pk2(hi[2], hi[3]);
        *(GAS u32x4*)(WT + (size_t)(drow0 + n) * D + k0) = o; }
}
__device__ __forceinline__ int win_drow(int n0) { const int pn = n0 >> 8, c = n0 & 255; return 256 * pn + 128 * ((c >> 5) & 1) + 32 * (c >> 6); }

__device__ __forceinline__ void rms_rows4(const float* x, const f32x4 (&gg)[4], bf16_t* XN, int m0, int mstride, int lane) {
    f32x4 v[4][4]; float s[4];
#pragma unroll
    for (int r = 0; r < 4; ++r) { const GAS f32x4* xr = (const GAS f32x4*)(x + (size_t)(m0 + r * mstride) * D) + lane;
#pragma unroll
        for (int j = 0; j < 4; ++j) v[r][j] = xr[64 * j]; }
#pragma unroll
    for (int r = 0; r < 4; ++r) { float a = 0.f;
#pragma unroll
        for (int j = 0; j < 4; ++j) a += (v[r][j].x * v[r][j].x + v[r][j].y * v[r][j].y) + (v[r][j].z * v[r][j].z + v[r][j].w * v[r][j].w);
        s[r] = a; }
#pragma unroll
    for (int o = 1; o < 64; o <<= 1) {
#pragma unroll
        for (int r = 0; r < 4; ++r) s[r] += __shfl_xor(s[r], o); }
#pragma unroll
    for (int r = 0; r < 4; ++r) { const float rstd = __builtin_amdgcn_rsqf(s[r] * (1.f / D) + EPS);
        GAS unsigned long long* o8 = (GAS unsigned long long*)(XN + (size_t)(m0 + r * mstride) * D) + lane;
#pragma unroll
        for (int j = 0; j < 4; ++j) o8[64 * j] = (unsigned long long)pk2(v[r][j].x * rstd * gg[j].x, v[r][j].y * rstd * gg[j].y) | ((unsigned long long)pk2(v[r][j].z * rstd * gg[j].z, v[r][j].w * rstd * gg[j].w) << 32); }
}

__device__ __forceinline__ void p0_prologue(Frame& F) {
    LAS float* scr = (LAS float*)(F.lds + RING_OFF + F.wave * 16384);
    const int gw = F.vcu * NWAVES + F.wave, NGW = F.G * NWAVES;
    constexpr int KB = D / 64;
    constexpr int I_QKV = KB * (3 * NA / 32), I_O = KB * (D / 32), I_G = KB * (FF / 32), I_DN = (FF / 64) * (D / 32);
    constexpr int NITEMS = I_QKV + I_O + 2 * I_G + I_DN;
    for (int it = gw; it < (D / 8) * (NA / 32); it += NGW) { const int nb = it & 15, kb = it >> 4; p0_fold_item(F.w_in, F.w_pool, F.pscale, 8 * kb, 32 * nb, F.Win_t, win_drow(3 * NA + 32 * nb), F.lane); }
    for (int it = gw; it < NITEMS; it += NGW) {
        int r = it;
        if (r < I_QKV) { const int nb = r % (3 * NA / 32), kb = r / (3 * NA / 32); p0_transpose_item(F.w_in, NIN, D, 64 * kb, 32 * nb, nullptr, F.Win_t, win_drow(32 * nb), scr, F.lane); continue; } r -= I_QKV;
        if (r < I_O) { const int nb = r % (D / 32), kb = r / (D / 32); p0_transpose_item(F.w_out, D, D, 64 * kb, 32 * nb, nullptr, F.Wout_t, 32 * nb, scr, F.lane); continue; } r -= I_O;
        if (r < 2 * I_G) { const int up = r >= I_G; if (up) r -= I_G; const int nb = r % (FF / 32), kb = r / (FF / 32), n0 = 32 * nb;
            p0_transpose_item(up ? F.w_up : F.w_gate, FF, D, 64 * kb, n0, F.g2, F.Wgu_t, 256 * (n0 >> 7) + (n0 & 127) + 128 * up, scr, F.lane); continue; } r -= 2 * I_G;
        { const int nb = r % (D / 32), kb = r / (D / 32); p0_transpose_item(F.w_down, D, FF, 64 * kb, 32 * nb, nullptr, F.Wdn_t, 32 * nb, scr, F.lane); }
    }
    f32x4 gg[4];
#pragma unroll
    for (int j = 0; j < 4; ++j) gg[j] = *((const f32x4*)F.g1 + F.lane + 64 * j);
    int m0 = gw;
    for (; m0 + 3 * NGW < M; m0 += 4 * NGW) rms_rows4(F.x, gg, F.XN, m0, NGW, F.lane);
    for (; m0 < M; m0 += NGW) rms_rows4(F.x, gg, F.XN, m0, 0, F.lane);
}

constexpr int AT_A = 0;
constexpr int AT_B = 61440;
constexpr int AT_TAB = 122880;
static_assert(AT_TAB + 15 * 64 * 4 <= RING_BYTES, "attention LDS map");
__device__ __forceinline__ int rs_of(int r) { int v = r - 4; v = v < 0 ? 0 : v; return v > 56 ? 56 : v; }

struct AttnUnit { int b, h, j, r0, krow_lo, nrows, kc0; };
__device__ __forceinline__ AttnUnit attn_decode(int un) {
    AttnUnit u; const int bh = un >> 5, rc = (un >> 2) & 7; u.j = un & 3; u.b = bh >> 3; u.h = bh & 7;
    u.r0 = 8 * rc; u.krow_lo = rs_of(u.r0); u.nrows = rs_of(u.r0 + 7) + 8 - u.krow_lo;
    u.kc0 = (u.j == 0) ? 0 : (u.j == 1) ? 8 : (u.j == 2) ? 24 : 32;
    return u;
}
__device__ __forceinline__ void glds16(const void* gsrc, unsigned lds_dst) { unsigned keep;
    asm volatile("s_mov_b32 %0, m0\n\ts_mov_b32 m0, %2\n\ts_nop 0\n\tglobal_load_lds_dwordx4 %1, off\n\ts_mov_b32 m0, %0" : "=&s"(keep) : "v"(gsrc), "s"(lds_dst) : "memory"); }
#define ATT_WAIT_BAR() do { asm volatile("s_waitcnt vmcnt(0) lgkmcnt(0)" ::: "memory"); __builtin_amdgcn_s_barrier(); asm volatile("" ::: "memory"); } while (0)
template <int KIND> __device__ __forceinline__ void attn_dma(unsigned dst, const bf16_t* src, const AttnUnit& u, int wid, int lane) {
    const int np = u.nrows * 4;
    const char* base = (const char*)(src + ((size_t)(u.b * SEQ + u.krow_lo * 64 + u.kc0)) * NA + u.h * HD);
#pragma unroll
    for (int it = 0; it < 8; ++it) {
        const int pi = it * 8 + wid;
        if (pi < np) {
            const int ts = 8 * pi + (lane >> 3), pos = ts & 31, w = ts >> 5;
            int kk, sw;
            if (KIND == 0) { kk = ((pos >> 4) & 1) * 4 + ((pos >> 2) & 3) * 8 + (pos & 3); sw = (ts >> 1) & 7; }
            else { kk = (pos & 0x13) | ((pos & 4) << 1) | ((pos & 8) >> 1); sw = ((ts >> 1) & 3) << 1; }
            const int ch = (lane & 7) ^ sw;
            const char* gp = base + (size_t)(w * 64 + kk) * (NA * 2) + ch * 16;
            glds16(gp, (unsigned)__builtin_amdgcn_readfirstlane(dst + pi * 1024));
        }
    }
}

__device__ __forceinline__ void p2_attention(Frame& F, const bf16_t* Qg, const bf16_t* Kg, const bf16_t* Vg, bf16_t* MIX) {
    const int lane = F.lane, wid = F.wave;
    LAS unsigned char* lds = F.lds;
    const unsigned lds0 = (unsigned)(size_t)F.lds;
    const int q = lane & 15, g = lane >> 4;
    constexpr int NUNITS = BATCH * NHEAD * 32;
    for (int uidx = F.vcu * 16; uidx < NUNITS; uidx += F.G * 16) {
        const int h = (uidx >> 5) & 7;
        __syncthreads();
        {   LAS float* tab = (LAS float*)(lds + AT_TAB);
            for (int i = F.tid; i < 15 * 64; i += NWAVES * 64) { const int rr = i >> 6, cc = (i & 63) - 16; tab[i] = (cc >= 0 && cc < 31) ? F.rpb[h * 465 + rr * 31 + cc] * LOG2E : 0.f; } }
        AttnUnit u = attn_decode(uidx);
        attn_dma<0>(lds0 + AT_A, Kg, u, wid, lane);
        bf16x8 qf0, qf1;
        { const bf16_t* qp = Qg + ((size_t)(u.b * SEQ + (u.r0 + wid) * 64 + 16 * u.j + q)) * NA + u.h * HD + 8 * g; qf0 = *(const bf16x8*)qp; qf1 = *(const bf16x8*)(qp + 32); }
        ATT_WAIT_BAR();
        for (int ui = 0; ui < 16; ++ui) {
            asm volatile("" : "+v"(qf0), "+v"(qf1));
            attn_dma<1>(lds0 + AT_B, Vg, u, wid, lane);
            const int r = u.r0 + wid, rs = rs_of(r), wbase = rs - u.krow_lo;
            const int cq = 16 * u.j + q;
            int cs = cq - 8; cs = cs < 0 ? 0 : cs; cs = cs > 48 ? 48 : cs;
            f32x4 sc[8][2];
            {
                const int x0 = g ^ (q >> 1);
                const LAS unsigned char* ka = lds + AT_A + wbase * 4096 + q * 128;
                const LAS unsigned char* k0p = ka + x0 * 16;
                const LAS unsigned char* k1p = ka + (x0 ^ 4) * 16;
#pragma unroll
                for (int wl = 0; wl < 8; ++wl)
#pragma unroll
                    for (int blk = 0; blk < 2; ++blk) {
                        const bf16x8 k0 = *(const LAS bf16x8*)(k0p + wl * 4096 + blk * 2048), k1 = *(const LAS bf16x8*)(k1p + wl * 4096 + blk * 2048);
                        f32x4 a = (f32x4){0.f, 0.f, 0.f, 0.f};
                        a = __builtin_amdgcn_mfma_f32_16x16x32_bf16(k0, qf0, a, 0, 0, 0);
                        a = __builtin_amdgcn_mfma_f32_16x16x32_bf16(k1, qf1, a, 0, 0, 0);
                        sc[wl][blk] = a;
                    }
            }
            const LAS float* tab = (const LAS float*)(lds + AT_TAB) + (rs - r + 7) * 64 + 16 + (u.kc0 - cq + 15) + 8 * g;
            const int voff = u.kc0 + 8 * g - cs;
            float mx = -INFINITY;
#pragma unroll
            for (int wl = 0; wl < 8; ++wl)
#pragma unroll
                for (int blk = 0; blk < 2; ++blk)
#pragma unroll
                    for (int e = 0; e < 4; ++e) {
                        const int ep = 4 * blk + e;
                        float s = sc[wl][blk][e] + tab[wl * 64 + ep];
                        s = ((unsigned)(voff + ep) < 16u) ? s : -INFINITY;
                        sc[wl][blk][e] = s; mx = fmaxf(mx, s);
                    }
            mx = fmaxf(mx, __shfl_xor(mx, 16)); mx = fmaxf(mx, __shfl_xor(mx, 32));
            float l = 0.f; u32x4 pw[8];
#pragma unroll
            for (int wl = 0; wl < 8; ++wl) {
                float p[8];
#pragma unroll
                for (int blk = 0; blk < 2; ++blk)
#pragma unroll
                    for (int e = 0; e < 4; ++e) { p[4 * blk + e] = __builtin_amdgcn_exp2f(sc[wl][blk][e] - mx); l += p[4 * blk + e]; }
                pw[wl].x = cvt_pk_bf16(p[0], p[1]); pw[wl].y = cvt_pk_bf16(p[2], p[3]); pw[wl].z = cvt_pk_bf16(p[4], p[5]); pw[wl].w = cvt_pk_bf16(p[6], p[7]);
            }
            l += __shfl_xor(l, 16); l += __shfl_xor(l, 32);
            const float il = __builtin_amdgcn_rcpf(l);
            ATT_WAIT_BAR();
            AttnUnit un = u; bf16x8 nq0 = qf0, nq1 = qf1;
            if (ui < 15) {
                un = attn_decode(uidx + ui + 1);
                attn_dma<0>(lds0 + AT_A, Kg, un, wid, lane);
                const bf16_t* qp = Qg + ((size_t)(un.b * SEQ + (un.r0 + wid) * 64 + 16 * un.j + q)) * NA + un.h * HD + 8 * g; nq0 = *(const bf16x8*)qp; nq1 = *(const bf16x8*)(qp + 32);
            }
            f32x4 o[4];
#pragma unroll
            for (int n = 0; n < 4; ++n) o[n] = (f32x4){0.f, 0.f, 0.f, 0.f};
            {
                const int qr = q >> 2, p = lane & 3;
                const int pos_lo = (g >> 1) * 16 + (g & 1) * 4 + qr, sw = ((g & 1) * 2 + (qr >> 1)) << 1;
                const LAS unsigned char* vb = lds + AT_B + (wbase * 32 + pos_lo) * 128 + (p >> 1) * 16 + (p & 1) * 8;
                const LAS unsigned char* vn[4];
#pragma unroll
                for (int n = 0; n < 4; ++n) vn[n] = vb + ((2 * n) ^ sw) * 16;
#pragma unroll
                for (int wl = 0; wl < 8; ++wl) {
                    const bf16x8 pf = __builtin_bit_cast(bf16x8, pw[wl]);
#pragma unroll
                    for (int n = 0; n < 4; ++n) {
                        const s16x4 lo = __builtin_bit_cast(s16x4, __builtin_amdgcn_ds_read_tr16_b64_v4i16((LAS s16x4*)(vn[n] + wl * 4096)));
                        const s16x4 hi = __builtin_bit_cast(s16x4, __builtin_amdgcn_ds_read_tr16_b64_v4i16((LAS s16x4*)(vn[n] + wl * 4096 + 1024)));
                        const bf16x8 vf = (bf16x8){lo[0], lo[1], lo[2], lo[3], hi[0], hi[1], hi[2], hi[3]};
                        o[n] = __builtin_amdgcn_mfma_f32_16x16x32_bf16(vf, pf, o[n], 0, 0, 0);
                    }
                }
            }
            bf16_t* op = MIX + ((size_t)(u.b * SEQ + r * 64 + cq)) * D + u.h * HD + 4 * g;
#pragma unroll
            for (int n = 0; n < 4; ++n) { u32x2 w; w.x = cvt_pk_bf16(o[n][0] * il, o[n][1] * il); w.y = cvt_pk_bf16(o[n][2] * il, o[n][3] * il); *(u32x2*)(op + 16 * n) = w; }
            ATT_WAIT_BAR();
            u = un; qf0 = nq0; qf1 = nq1;
        }
    }
}

__device__ __forceinline__ void up8(const u32x4 w, float (&v)[8]) {
    v[0] = bflo(w.x); v[1] = bfhi(w.x); v[2] = bflo(w.y); v[3] = bfhi(w.y); v[4] = bflo(w.z); v[5] = bfhi(w.z); v[6] = bflo(w.w); v[7] = bfhi(w.w);
}
__device__ __forceinline__ void pool_run(const bf16_t* __restrict__ Zg, bf16_t* __restrict__ MIX, int gw, int lane) {
    const int tb = 32 * gw, b = tb >> 12, t0 = tb & (SEQ - 1);
    const int half = 1 << (lane >> 4);
    const bf16_t* zb = Zg + (size_t)(b * SEQ) * NA + 8 * lane;
    bf16_t* ob = MIX + (size_t)(b * SEQ) * D + NA + 8 * lane;
    float S[8];
#pragma unroll
    for (int e = 0; e < 8; ++e) S[e] = 0.f;
    {   u32x4 w[16];
#pragma unroll
        for (int d = 0; d < 16; ++d) { int i = t0 + d - 8; i = i < 0 ? 0 : i; i = i > SEQ - 1 ? SEQ - 1 : i; w[d] = *(const u32x4*)(zb + (size_t)i * NA); }
#pragma unroll
        for (int d = 0; d < 16; ++d) { const int dd = d - 8, i = t0 + dd; const float mk = (dd >= -half && dd < half && i >= 0 && i < SEQ) ? 1.f : 0.f; float v[8]; up8(w[d], v);
#pragma unroll
            for (int e = 0; e < 8; ++e) S[e] += mk * v[e]; } }
    for (int c = 0; c < 4; ++c) {
        u32x4 zt[8], za[8], zs[8];
#pragma unroll
        for (int k = 0; k < 8; ++k) { const int t = t0 + 8 * c + k; int ia = t + half, is = t - half; ia = ia > SEQ - 1 ? SEQ - 1 : ia; is = is < 0 ? 0 : is;
            zt[k] = *(const u32x4*)(zb + (size_t)t * NA); za[k] = *(const u32x4*)(zb + (size_t)ia * NA); zs[k] = *(const u32x4*)(zb + (size_t)is * NA); }
#pragma unroll
        for (int k = 0; k < 8; ++k) { const int t = t0 + 8 * c + k;
            const int lo = (t - half) < 0 ? 0 : (t - half), hi = (t + half) > SEQ ? SEQ : (t + half);
            const float inv = 1.0f / (float)(hi - lo);
            float v[8]; up8(zt[k], v);
            u32x4 w;
            w.x = cvt_pk_bf16(S[0] * inv - v[0], S[1] * inv - v[1]); w.y = cvt_pk_bf16(S[2] * inv - v[2], S[3] * inv - v[3]);
            w.z = cvt_pk_bf16(S[4] * inv - v[4], S[5] * inv - v[5]); w.w = cvt_pk_bf16(S[6] * inv - v[6], S[7] * inv - v[7]);
            *(u32x4*)(ob + (size_t)t * D) = w;
            const float ma = (t + half < SEQ) ? 1.f : 0.f, ms = (t - half >= 0) ? 1.f : 0.f;
            float a[8], s[8]; up8(za[k], a); up8(zs[k], s);
#pragma unroll
            for (int e = 0; e < 8; ++e) S[e] += ma * a[e] - ms * s[e]; }
    }
}

__device__ __forceinline__ void p2_mixer(Frame& F) {
    const bf16_t* Qg = F.QKVZ; const bf16_t* Kg = F.QKVZ + (size_t)M * NA; const bf16_t* Vg = F.QKVZ + 2 * (size_t)M * NA; const bf16_t* Zg = F.QKVZ + 3 * (size_t)M * NA;
    bf16_t* MIX = F.XN;
    for (int gw = F.vcu * NWAVES + F.wave; gw < M / 32; gw += F.G * NWAVES) pool_run(Zg, MIX, gw, F.lane);
    p2_attention(F, Qg, Kg, Vg, MIX);
    __syncthreads();
}

struct Args { const float* in[13]; float* out; unsigned char* ws; int ph_lo, ph_hi, li, pad; };
__global__ void __launch_bounds__(NWAVES * 64, 2) fwd_megakernel(Args args) {
    extern __shared__ __attribute__((aligned(16))) unsigned char lds[];
    Frame F;
    F.lds = (LAS unsigned char*)lds;
    F.MISC = (volatile LAS unsigned*)(F.lds + MISC_OFF);
    F.tid = threadIdx.x; F.lane = F.tid & 63; F.wave = __builtin_amdgcn_readfirstlane(F.tid >> 6);
    F.G = gridDim.x; { const int bx = blockIdx.x; F.vcu = (F.G % 8 == 0) ? (bx % 8) * (F.G / 8) + bx / 8 : bx; }
    unsigned char* ws = args.ws;
    F.ctl = (gu32*)(ws + WS_CTL);
    F.x = args.in[0]; F.g1 = args.in[1]; F.w_in = args.in[2]; F.gq = args.in[3]; F.gk = args.in[4]; F.rpb = args.in[5]; F.w_pool = args.in[6];
    F.pscale = args.in[7]; F.w_out = args.in[8]; F.g2 = args.in[9]; F.w_gate = args.in[10]; F.w_up = args.in[11]; F.w_down = args.in[12]; F.out = args.out;
    F.Win_t = (bf16_t*)(ws + WS_WIN); F.Wout_t = (bf16_t*)(ws + WS_WOUT); F.Wgu_t = (bf16_t*)(ws + WS_WGU); F.Wdn_t = (bf16_t*)(ws + WS_WDN);
    F.XN = (bf16_t*)(ws + WS_XN); F.QKVZ = (bf16_t*)(ws + WS_QKVZ); F.XB = (bf16_t*)(ws + WS_QKVZ); F.ACT = (bf16_t*)(ws + WS_ACT);
    F.ss = (float*)(ws + WS_CTL) + CW_SS;
    for (int u = F.tid; u < (LDS_BYTES - LDSCTL_OFF) / 4; u += NWAVES * 64) ((LAS unsigned*)(F.lds + LDSCTL_OFF))[u] = 0u;
    __syncthreads();
    XcdBarrier bar; bar.bar = (unsigned*)(F.ctl + CW_BAR); bar.x = 0; bar.st = nullptr;
    if (N_LAUNCHES != PER_PHASE) bar = xcd_barrier_post((unsigned*)(F.ctl + CW_BAR), F.MISC + 8);
#define GRID_BAR() do { if (N_LAUNCHES != PER_PHASE) xcd_barrier(bar); } while (0)
    const int lo = args.ph_lo, hi = args.ph_hi;
#define IN(k) (lo <= (k) && (k) < hi)
#define BOTH(k) (IN(k) && IN((k) + 1))

    if (IN(0)) { p0_prologue(F); if (BOTH(0)) GRID_BAR(); }

    if (IN(1)) {
        pg8::Gemm g{F.XN, F.Win_t, M, NIN, D}; pg8::StaticOrder S; S.init(M, NIN, F.G, (int)blockIdx.x);
        pg8::EpiIn E{F.QKVZ, F.gq, F.gk};
        pg8::gemm_phase<pg8::EpiIn, pg8::StaticOrder, true, PG8_SP2>(F.lds + RING_OFF, g, S, E);
        if (BOTH(1)) GRID_BAR();
    }

    if (IN(2)) { p2_mixer(F); if (BOTH(2)) GRID_BAR(); }

    if (IN(3)) {
        pg8::Gemm g{F.XN, F.Wout_t, M, D, D}; pg8::StaticOrder S; S.init(M, D, F.G, (int)blockIdx.x);
        pg8::EpiOut E{F.x, F.out, F.XB, F.ss};
        pg8::gemm_phase<pg8::EpiOut, pg8::StaticOrder, true, PG8_SP2>(F.lds + RING_OFF, g, S, E);
        if (BOTH(3)) GRID_BAR();
    }

    if (IN(4)) {
        pg8::Gemm g{F.XB, F.Wgu_t, M, NGU, D}; pg8::StaticOrder S; S.init(M, NGU, F.G, (int)blockIdx.x);
        pg8::EpiGU E{F.ACT, F.ss};
        pg8::gemm_phase<pg8::EpiGU, pg8::StaticOrder, true, PG8_SP2>(F.lds + RING_OFF, g, S, E);
        if (BOTH(4)) GRID_BAR();
    }

    if (IN(5)) {
        pg8::Gemm g{F.ACT, F.Wdn_t, M, D, FF}; pg8::StaticOrder S; S.init(M, D, F.G, (int)blockIdx.x);
        pg8::EpiDown E{F.out};
        pg8::gemm_phase<pg8::EpiDown, pg8::StaticOrder, true, PG8_SP2>(F.lds + RING_OFF, g, S, E);
    }
#undef IN
#undef BOTH
#undef GRID_BAR
}

extern "C" void kernel_launch(void* const* d_in, const int* in_sizes, int n_in, void* d_out, int out_size, void* d_ws, size_t ws_size, hipStream_t stream) {
    static int grid = 0;
    if (grid == 0) {
        if (n_in != 13 || in_sizes[0] != M * D || out_size != M * D || ws_size < WS_END) { fprintf(stderr, "kernel_launch: unexpected shapes (n_in %d, in0 %d, out %d, ws %zu); nothing launched\n", n_in, n_in > 0 ? in_sizes[0] : -1, out_size, ws_size); grid = -1; return; }
        int dev = 0, cus = 0, per_cu = 0;
        if (hipGetDevice(&dev) != hipSuccess || hipDeviceGetAttribute(&cus, hipDeviceAttributeMultiprocessorCount, dev) != hipSuccess) { fprintf(stderr, "kernel_launch: device query failed\n"); grid = -1; return; }
        if (hipFuncSetAttribute((const void*)fwd_megakernel, hipFuncAttributeMaxDynamicSharedMemorySize, LDS_BYTES) != hipSuccess) { fprintf(stderr, "kernel_launch: hipFuncSetAttribute failed\n"); grid = -1; return; }
        if (hipOccupancyMaxActiveBlocksPerMultiprocessor(&per_cu, (const void*)fwd_megakernel, NWAVES * 64, LDS_BYTES) != hipSuccess || per_cu < 1) {
            fprintf(stderr, "kernel_launch: occupancy query reports %d workgroups per CU; nothing launched\n", per_cu); (void)hipGetLastError(); grid = -1; return; }
        (void)hipGetLastError();
        grid = cus;
    }
    if (grid < 0) return;
    if (hipMemsetAsync((char*)d_ws + WS_CTL, 0, CTL_ZERO_BYTES, stream) != hipSuccess) { fprintf(stderr, "kernel_launch: hipMemsetAsync failed\n"); return; }
    Args a{};
    for (int i = 0; i < 13; ++i) a.in[i] = (const float*)d_in[i];
    a.out = (float*)d_out; a.ws = (unsigned char*)d_ws;
    for (int li = 0; li < N_LAUNCHES; ++li) {
        a.ph_lo = (N_LAUNCHES == PER_PHASE) ? li : 0; a.ph_hi = (N_LAUNCHES == PER_PHASE) ? li + 1 : PER_PHASE; a.li = li;
        hipLaunchKernelGGL(fwd_megakernel, dim3(grid), dim3(NWAVES * 64), LDS_BYTES, stream, a);
        const hipError_t le = hipPeekAtLastError();
        if (le != hipSuccess) { fprintf(stderr, "kernel_launch: launch %d failed: %s\n", li, hipGetErrorName(le)); break; }
    }
}
```

```cpp
#include <hip/hip_runtime.h>
#include <cstdio>
#include <cstdint>

#define LAS __attribute__((address_space(3)))
#define GAS __attribute__((address_space(1)))
typedef unsigned short bf16_t;
typedef short bf16x8 __attribute__((ext_vector_type(8)));
typedef short s16x4 __attribute__((ext_vector_type(4)));
typedef float f32x4 __attribute__((ext_vector_type(4)));
typedef float f32x2 __attribute__((ext_vector_type(2)));
typedef unsigned u32x4 __attribute__((ext_vector_type(4)));
typedef unsigned u32x2 __attribute__((ext_vector_type(2)));

constexpr int BATCH = 16, SEQ = 4096, D = 1024, M = BATCH * SEQ;
constexpr int NA = 512, NHEAD = 8, HD = 64, NIN = 2048, FF = 2816, NGU = 2 * FF;
constexpr float EPS = 1e-6f;
constexpr float LOG2E = 1.4426950408889634f;

__device__ __forceinline__ unsigned cvt_pk_bf16(float lo, float hi) { unsigned r; asm volatile("v_cvt_pk_bf16_f32 %0, %1, %2" : "=v"(r) : "v"(lo), "v"(hi)); return r; }

namespace pg8 {
constexpr int BM = 256, BK = 64, HALF = 128, HTB = HALF * BK * 2, STAGE_BYTES = 8 * HTB, NXCD = 8, WGM = 8;

__host__ __device__ __forceinline__ int lds_byte(int r, int c) { const int st = (r >> 4) * 2 + (c >> 5), rr = r & 15, cc = c & 31, ob = rr * 64 + cc * 2; return st * 1024 + (ob ^ (((ob >> 9) & 1) << 5)); }
__host__ __device__ __forceinline__ void stage_rc(int b, int& R, int& C) { const int st = b / 1024, sb = b % 1024, swz = sb ^ (((sb >> 9) & 1) << 5); R = (st >> 1) * 16 + swz / 64; C = (st & 1) * 32 + (swz % 64) / 2; }
__host__ __device__ __forceinline__ int perm32(int rho) { const int n = rho >> 4, i = rho & 15; return 8 * (i >> 2) + 4 * n + (i & 3); }

struct Unit { int pm, pn; };
struct Gemm { const bf16_t* A; const bf16_t* Bt; int M, N, K; };

struct StaticOrder {
    int nM, nN, nwg, G, c;
    __host__ __device__ void init(int M_, int N_, int G_, int c_) { nM = M_ / BM; nN = N_ / BM; nwg = nM * nN; G = G_; c = c_; }
    __host__ __device__ bool next(int i, Unit& u) const {
        const long L = (long)i * G + c; if (L >= nwg) return false;
        int wgid = (int)L; { const int q = nwg / NXCD, r = nwg % NXCD, xcd = wgid % NXCD, off = wgid / NXCD; wgid = (xcd < r ? xcd * (q + 1) : r * (q + 1) + (xcd - r) * q) + off; }
        const int nig = WGM * nN, gid = wgid / nig, fm = gid * WGM, gsz = (nM - fm) < WGM ? (nM - fm) : WGM;
        u.pm = fm + ((wgid % nig) % gsz); u.pn = (wgid % nig) / gsz; return true;
    }
    __device__ __forceinline__ void a_ready(const Unit&) const {}
    __device__ __forceinline__ void done(const Unit&) const {}
};


struct EpiIn {
    static constexpr bool PERM = true, AFTER_DRAIN = false;
    bf16_t* QKVZ; const LAS float* gl;
    __device__ __forceinline__ void operator()(const f32x4 (&acc)[2][2][4][2], const Unit& u, int wr, int wc, int fr, int fq) const {
        const int kind = u.pn >> 1;
        bf16_t* base = QKVZ + (size_t)kind * ((size_t)M * NA) + (u.pn & 1) * 256 + wc * 64 + 8 * fq;
        const int row0 = u.pm * BM + wr * 64 + fr;
        if (kind < 2) {
            const LAS float* g = gl + 64 * kind + 8 * fq;
            f32x4 gv[2][2];
#pragma unroll
            for (int bj = 0; bj < 2; ++bj)
#pragma unroll
                for (int n = 0; n < 2; ++n) gv[bj][n] = *(const LAS f32x4*)(g + 32 * bj + 4 * n);
            float ss[8];
#pragma unroll
            for (int i = 0; i < 8; ++i) { const int ai = i >> 2, m = i & 3; float a = 0.f;
#pragma unroll
                for (int bj = 0; bj < 2; ++bj)
#pragma unroll
                    for (int n = 0; n < 2; ++n) { const f32x4 v = acc[ai][bj][m][n]; a += (v[0] * v[0] + v[1] * v[1]) + (v[2] * v[2] + v[3] * v[3]); }
                ss[i] = a; }
#pragma unroll
            for (int i = 0; i < 8; ++i) ss[i] += __shfl_xor(ss[i], 16);
#pragma unroll
            for (int i = 0; i < 8; ++i) ss[i] += __shfl_xor(ss[i], 32);
#pragma unroll
            for (int i = 0; i < 8; ++i) { const int ai = i >> 2, m = i & 3;
                bf16_t* rowp = base + (size_t)(row0 + ai * HALF + m * 16) * NA;
                const float r = __builtin_amdgcn_rsqf(ss[i] * (1.0f / 64.0f) + EPS);
#pragma unroll
                for (int bj = 0; bj < 2; ++bj) {
                    const f32x4 v0 = acc[ai][bj][m][0] * r * gv[bj][0], v1 = acc[ai][bj][m][1] * r * gv[bj][1];
                    u32x4 w; w.x = cvt_pk_bf16(v0[0], v0[1]); w.y = cvt_pk_bf16(v0[2], v0[3]); w.z = cvt_pk_bf16(v1[0], v1[1]); w.w = cvt_pk_bf16(v1[2], v1[3]);
                    *(u32x4*)(rowp + bj * 32) = w; }
            }
        } else {
#pragma unroll
            for (int ai = 0; ai < 2; ++ai)
#pragma unroll
                for (int m = 0; m < 4; ++m) {
                    bf16_t* rowp = base + (size_t)(row0 + ai * HALF + m * 16) * NA;
#pragma unroll
                    for (int bj = 0; bj < 2; ++bj) {
                        const f32x4 v0 = acc[ai][bj][m][0], v1 = acc[ai][bj][m][1];
                        u32x4 w; w.x = cvt_pk_bf16(v0[0], v0[1]); w.y = cvt_pk_bf16(v0[2], v0[3]); w.z = cvt_pk_bf16(v1[0], v1[1]); w.w = cvt_pk_bf16(v1[2], v1[3]);
                        *(u32x4*)(rowp + bj * 32) = w; }
                }
        }
    }
};

struct EpiOut {
    static constexpr bool PERM = true, AFTER_DRAIN = false;
    const float* x; float* out; bf16_t* XB; float* ss;
    __device__ __forceinline__ void operator()(const f32x4 (&acc)[2][2][4][2], const Unit& u, int wr, int wc, int fr, int fq) const {
        const int row0 = u.pm * BM + wr * 64 + fr, col0 = u.pn * BM + wc * 32 + 8 * fq;
        const size_t off0 = (size_t)row0 * D + col0;
        const float* __restrict__ xp = x + off0; float* __restrict__ op = out + off0; bf16_t* __restrict__ bp = XB + off0;
        f32x4 xa[8][4]; float part[8];
#define EO_LOAD(i) do { const size_t o_ = (size_t)(((i) >> 2) * HALF + ((i) & 3) * 16) * D; \
        xa[i][0] = *(const f32x4*)(xp + o_); xa[i][1] = *(const f32x4*)(xp + o_ + 4); xa[i][2] = *(const f32x4*)(xp + o_ + HALF); xa[i][3] = *(const f32x4*)(xp + o_ + HALF + 4); } while (0)
        EO_LOAD(0); EO_LOAD(1); EO_LOAD(2); EO_LOAD(3);
        asm volatile("" ::: "memory");
#pragma unroll
        for (int i = 0; i < 8; ++i) { const int ai = i >> 2, m = i & 3; const size_t o_ = (size_t)(ai * HALF + m * 16) * D; float p = 0.f;
#pragma unroll
            for (int bj = 0; bj < 2; ++bj) {
                const f32x4 v0 = acc[ai][bj][m][0] + xa[i][2 * bj], v1 = acc[ai][bj][m][1] + xa[i][2 * bj + 1];
                *(f32x4*)(op + o_ + bj * HALF) = v0; *(f32x4*)(op + o_ + bj * HALF + 4) = v1;
                u32x4 w; w.x = cvt_pk_bf16(v0[0], v0[1]); w.y = cvt_pk_bf16(v0[2], v0[3]); w.z = cvt_pk_bf16(v1[0], v1[1]); w.w = cvt_pk_bf16(v1[2], v1[3]);
                *(u32x4*)(bp + o_ + bj * HALF) = w;
                p += (v0[0] * v0[0] + v0[1] * v0[1]) + (v0[2] * v0[2] + v0[3] * v0[3]) + (v1[0] * v1[0] + v1[1] * v1[1]) + (v1[2] * v1[2] + v1[3] * v1[3]); }
            part[i] = p;
            if (i + 4 < 8) { EO_LOAD((i + 4) & 7); }
            asm volatile("" ::: "memory"); }
#undef EO_LOAD
#pragma unroll
        for (int i = 0; i < 8; ++i) part[i] += __shfl_xor(part[i], 16);
#pragma unroll
        for (int i = 0; i < 8; ++i) part[i] += __shfl_xor(part[i], 32);
        if (fq == 0) {
#pragma unroll
            for (int i = 0; i < 8; ++i) atomicAdd(ss + row0 + (i >> 2) * HALF + (i & 3) * 16, part[i]);
        }
    }
};

struct EpiGU {
    static constexpr bool PERM = true, AFTER_DRAIN = false;
    bf16_t* ACT; const float* ss;
    __device__ __forceinline__ void operator()(const f32x4 (&acc)[2][2][4][2], const Unit& u, int wr, int wc, int fr, int fq) const {
        const int row0 = u.pm * BM + wr * 64 + fr, col0 = u.pn * HALF + wc * 32 + 8 * fq;
        float sv[8];
#pragma unroll
        for (int i = 0; i < 8; ++i) sv[i] = ss[row0 + (i >> 2) * HALF + (i & 3) * 16];
        asm volatile("" ::: "memory");
#pragma unroll
        for (int i = 0; i < 8; ++i) { const int ai = i >> 2, m = i & 3;
            const float rstd = __builtin_amdgcn_rsqf(sv[i] * (1.0f / (float)D) + EPS), ne = -LOG2E * rstd, r2 = rstd * rstd;
            unsigned w[4];
#pragma unroll
            for (int n = 0; n < 2; ++n) { float a[4];
#pragma unroll
                for (int e = 0; e < 4; ++e) { const float g = acc[ai][0][m][n][e], up = acc[ai][1][m][n][e];
                    a[e] = (g * up) * (r2 * __builtin_amdgcn_rcpf(1.0f + __builtin_amdgcn_exp2f(g * ne))); }
                w[2 * n] = cvt_pk_bf16(a[0], a[1]); w[2 * n + 1] = cvt_pk_bf16(a[2], a[3]); }
            *(u32x4*)(ACT + (size_t)(row0 + ai * HALF + m * 16) * FF + col0) = (u32x4){w[0], w[1], w[2], w[3]};
        }
    }
};

struct EpiDown {
    static constexpr bool PERM = true, AFTER_DRAIN = false;
    float* out;
    __device__ __forceinline__ void operator()(const f32x4 (&acc)[2][2][4][2], const Unit& u, int wr, int wc, int fr, int fq) const {
        const int row0 = u.pm * BM + wr * 64 + fr, col0 = u.pn * BM + wc * 32 + 8 * fq;
        float* op = out + (size_t)row0 * D + col0;
        f32x4 xa[8][4];
#define ED_LOAD(i) do { const size_t o_ = (size_t)(((i) >> 2) * HALF + ((i) & 3) * 16) * D; \
        xa[i][0] = *(const f32x4*)(op + o_); xa[i][1] = *(const f32x4*)(op + o_ + 4); xa[i][2] = *(const f32x4*)(op + o_ + HALF); xa[i][3] = *(const f32x4*)(op + o_ + HALF + 4); } while (0)
        ED_LOAD(0); ED_LOAD(1); ED_LOAD(2); ED_LOAD(3);
        asm volatile("" ::: "memory");
#pragma unroll
        for (int i = 0; i < 8; ++i) { const int ai = i >> 2, m = i & 3; const size_t o_ = (size_t)(ai * HALF + m * 16) * D;
#pragma unroll
            for (int bj = 0; bj < 2; ++bj) { *(f32x4*)(op + o_ + bj * HALF) = acc[ai][bj][m][0] + xa[i][2 * bj]; *(f32x4*)(op + o_ + bj * HALF + 4) = acc[ai][bj][m][1] + xa[i][2 * bj + 1]; }
            if (i + 4 < 8) { ED_LOAD((i + 4) & 7); }
            asm volatile("" ::: "memory"); }
#undef ED_LOAD
    }
};

template <class Epi, class Sched, bool ALIGN_EPI = false, bool SP2 = false>
__device__ __forceinline__ void gemm_phase(LAS unsigned char* lds, const Gemm g, const Sched& S, const Epi& E) {
    const int tid = threadIdx.x, wid = __builtin_amdgcn_readfirstlane(tid >> 6), lane = tid & 63, wr = wid >> 2, wc = wid & 3, fr = lane & 15, fq = lane >> 4;
    const int K = g.K, nt = K / BK;
    unsigned voffA[2], voffB[2];
#pragma unroll
    for (int i = 0; i < 2; ++i) { int R, C; stage_rc(tid * 16 + i * 8192, R, C); const int Rb = Epi::PERM ? ((R & ~31) + perm32(R & 31)) : R;
        voffA[i] = (unsigned)(R * K + C) * 2u; voffB[i] = (unsigned)(Rb * K + C) * 2u; }
    const size_t kstep = (size_t)(BK * 2);
    const size_t hstep = (size_t)HALF * K * 2;
    const size_t tstep = 2 * hstep;
    const unsigned ldsw = (unsigned)wid * 1024u;
    const int aoff = lds_byte(wr * 64 + fr, fq * 8), boff = lds_byte(wc * 32 + fr, fq * 8);
#define PG8_SA(b, h) (((b) * 2 + (h)) * HTB)
#define PG8_SB(b, h) ((4 + (b) * 2 + (h)) * HTB)
#define PG8_STAGE(bufoff, gbase, voff) do { _Pragma("unroll") for (int _i = 0; _i < 2; ++_i) \
        __builtin_amdgcn_global_load_lds((const unsigned*)((const char*)(gbase) + (voff)[_i]), (LAS unsigned*)(lds + (bufoff) + ldsw + _i * 8192), 16, 0, 0); } while (0)
#define PG8_LDA(dst, b, h) do { _Pragma("unroll") for (int m = 0; m < 4; ++m) _Pragma("unroll") for (int k = 0; k < 2; ++k) dst[m][k] = *(const LAS bf16x8*)(lds + PG8_SA(b, h) + aoff + m * 2048 + k * 1024); } while (0)
#define PG8_LDB(dst, b, h) do { _Pragma("unroll") for (int n = 0; n < 2; ++n) _Pragma("unroll") for (int k = 0; k < 2; ++k) dst[n][k] = *(const LAS bf16x8*)(lds + PG8_SB(b, h) + boff + n * 2048 + k * 1024); } while (0)
#define PG8_MMA(ai, bj, At, Bt) do { __builtin_amdgcn_s_setprio(1); _Pragma("unroll") for (int m = 0; m < 4; ++m) _Pragma("unroll") for (int n = 0; n < 2; ++n) _Pragma("unroll") for (int k = 0; k < 2; ++k) \
        acc[ai][bj][m][n] = __builtin_amdgcn_mfma_f32_16x16x32_bf16(Bt[n][k], At[m][k], acc[ai][bj][m][n], 0, 0, 0); __builtin_amdgcn_s_setprio(0); } while (0)
#define PG8_WAIT_V(n) asm volatile("s_waitcnt vmcnt(" #n ")" ::: "memory")
#define PG8_WAIT_L(n) asm volatile("s_waitcnt lgkmcnt(" #n ")" ::: "memory")
#define PG8_BAR __builtin_amdgcn_s_barrier()
#define PG8_SCHED __builtin_amdgcn_sched_barrier(0)
    Unit cur, nxt; int ui = 0;
    if (!S.next(0, cur)) return;
    f32x4 acc[2][2][4][2];
#pragma unroll
    for (int a = 0; a < 2; ++a)
#pragma unroll
        for (int b = 0; b < 2; ++b)
#pragma unroll
            for (int m = 0; m < 4; ++m)
#pragma unroll
                for (int n = 0; n < 2; ++n) acc[a][b][m][n] = (f32x4){0.f, 0.f, 0.f, 0.f};
    bf16x8 At[4][2], B0[2][2], B1[2][2];
    const char* cA = (const char*)g.A + (size_t)cur.pm * tstep; const char* cB = (const char*)g.Bt + (size_t)cur.pn * tstep;
    S.a_ready(cur);
    if constexpr (SP2) {
        PG8_STAGE(PG8_SB(0, 0), cB, voffB); PG8_STAGE(PG8_SB(0, 1), cB + hstep, voffB); PG8_STAGE(PG8_SA(0, 0), cA, voffA); PG8_STAGE(PG8_SA(0, 1), cA + hstep, voffA);
        if (wr == 1) PG8_BAR;
        PG8_WAIT_V(2); PG8_BAR;
        PG8_STAGE(PG8_SB(1, 0), cB + kstep, voffB); PG8_STAGE(PG8_SA(1, 0), cA + kstep, voffA); PG8_STAGE(PG8_SB(1, 1), cB + hstep + kstep, voffB);
        PG8_WAIT_V(6); PG8_BAR;
    } else {
        PG8_STAGE(PG8_SB(0, 0), cB, voffB); PG8_STAGE(PG8_SA(0, 0), cA, voffA); PG8_STAGE(PG8_SB(0, 1), cB + hstep, voffB); PG8_STAGE(PG8_SA(0, 1), cA + hstep, voffA);
        if (wr == 1) PG8_BAR;
        PG8_WAIT_V(4); PG8_BAR;
        PG8_STAGE(PG8_SB(1, 0), cB + kstep, voffB); PG8_STAGE(PG8_SA(1, 0), cA + kstep, voffA); PG8_STAGE(PG8_SB(1, 1), cB + hstep + kstep, voffB);
        PG8_WAIT_V(6); PG8_BAR;
    }
    for (;;) {
        const bool has_next = S.next(ui + 1, nxt);
        const char* nA = has_next ? (const char*)g.A + (size_t)nxt.pm * tstep : cA; const char* nB = has_next ? (const char*)g.Bt + (size_t)nxt.pn * tstep : cB;
        for (int t = 0; t < nt; t += 2) {
            const bool last = (t == nt - 2);
            const char* a1 = cA + (size_t)(t + 1) * kstep;
            const char* a2 = last ? nA : cA + (size_t)(t + 2) * kstep; const char* b2 = last ? nB : cB + (size_t)(t + 2) * kstep;
            const char* a3 = a2 + kstep; const char* b3 = b2 + kstep;
            if (last && has_next) S.a_ready(nxt);
            if constexpr (SP2) {
            PG8_LDB(B0, 0, 0); PG8_LDB(B1, 0, 1); PG8_SCHED; PG8_LDA(At, 0, 0); PG8_STAGE(PG8_SA(1, 1), a1 + hstep, voffA);
            PG8_WAIT_V(8); PG8_WAIT_L(0); PG8_BAR; PG8_MMA(0, 0, At, B0); PG8_MMA(0, 1, At, B1); PG8_BAR; PG8_SCHED;
            PG8_LDA(At, 0, 1); PG8_STAGE(PG8_SB(0, 0), b2, voffB); PG8_STAGE(PG8_SB(0, 1), b2 + hstep, voffB); PG8_STAGE(PG8_SA(0, 0), a2, voffA);
            PG8_WAIT_V(8); PG8_WAIT_L(0); PG8_BAR; PG8_MMA(1, 0, At, B0); PG8_MMA(1, 1, At, B1); PG8_BAR; PG8_SCHED;
            PG8_LDB(B0, 1, 0); PG8_LDB(B1, 1, 1); PG8_SCHED; PG8_LDA(At, 1, 0); PG8_STAGE(PG8_SA(0, 1), a2 + hstep, voffA);
            PG8_WAIT_V(8); PG8_WAIT_L(0); PG8_BAR; PG8_MMA(0, 0, At, B0); PG8_MMA(0, 1, At, B1); PG8_BAR; PG8_SCHED;
            PG8_LDA(At, 1, 1); PG8_STAGE(PG8_SB(1, 0), b3, voffB); PG8_STAGE(PG8_SB(1, 1), b3 + hstep, voffB); PG8_STAGE(PG8_SA(1, 0), a3, voffA);
            PG8_WAIT_V(8); PG8_WAIT_L(0); PG8_BAR; PG8_MMA(1, 0, At, B0); PG8_MMA(1, 1, At, B1); PG8_BAR; PG8_SCHED;
            } else {
            PG8_LDB(B0, 0, 0); PG8_SCHED; PG8_LDA(At, 0, 0); PG8_STAGE(PG8_SA(1, 1), a1 + hstep, voffA);
            PG8_WAIT_L(8); PG8_BAR; PG8_WAIT_L(0); PG8_MMA(0, 0, At, B0); PG8_BAR; PG8_SCHED;
            PG8_LDB(B1, 0, 1); PG8_STAGE(PG8_SB(0, 0), b2, voffB);
            PG8_BAR; PG8_WAIT_L(0); PG8_MMA(0, 1, At, B1); PG8_BAR;
            PG8_LDA(At, 0, 1); PG8_STAGE(PG8_SA(0, 0), a2, voffA);
            PG8_BAR; PG8_WAIT_L(0); PG8_MMA(1, 0, At, B0); PG8_BAR; PG8_SCHED;
            PG8_STAGE(PG8_SB(0, 1), b2 + hstep, voffB);
            PG8_WAIT_V(6); PG8_BAR; PG8_MMA(1, 1, At, B1); PG8_BAR;
            PG8_LDB(B0, 1, 0); PG8_SCHED; PG8_LDA(At, 1, 0); PG8_STAGE(PG8_SA(0, 1), a2 + hstep, voffA);
            PG8_WAIT_L(8); PG8_BAR; PG8_WAIT_L(0); PG8_MMA(0, 0, At, B0); PG8_BAR; PG8_SCHED;
            PG8_LDB(B1, 1, 1); PG8_STAGE(PG8_SB(1, 0), b3, voffB);
            PG8_BAR; PG8_WAIT_L(0); PG8_MMA(0, 1, At, B1); PG8_BAR;
            PG8_LDA(At, 1, 1); PG8_STAGE(PG8_SA(1, 0), a3, voffA);
            PG8_BAR; PG8_WAIT_L(0); PG8_MMA(1, 0, At, B0); PG8_BAR; PG8_SCHED;
            PG8_STAGE(PG8_SB(1, 1), b3 + hstep, voffB);
            PG8_WAIT_V(6); PG8_BAR; PG8_MMA(1, 1, At, B1); PG8_BAR;
            }
        }
        if constexpr (ALIGN_EPI) { if (wr == 0) PG8_BAR; }
        if constexpr (!Epi::AFTER_DRAIN) { E(acc, cur, wr, wc, fr, fq); S.done(cur); }
        if (!has_next) break;
#pragma unroll
        for (int a = 0; a < 2; ++a)
#pragma unroll
            for (int b = 0; b < 2; ++b)
#pragma unroll
                for (int m = 0; m < 4; ++m)
#pragma unroll
                    for (int n = 0; n < 2; ++n) acc[a][b][m][n] = (f32x4){0.f, 0.f, 0.f, 0.f};
        cur = nxt; cA = nA; cB = nB; ++ui;
        if constexpr (ALIGN_EPI) { if (wr == 1) PG8_BAR; }
    }
    PG8_WAIT_V(0);
    if constexpr (!ALIGN_EPI) { if (wr == 0) PG8_BAR; }
    PG8_BAR;
#undef PG8_SA
#undef PG8_SB
#undef PG8_STAGE
#undef PG8_LDA
#undef PG8_LDB
#undef PG8_MMA
#undef PG8_WAIT_V
#undef PG8_WAIT_L
#undef PG8_BAR
#undef PG8_SCHED
}
}

constexpr int NWAVES = 8;
#ifndef MK_N_LAUNCHES
#define MK_N_LAUNCHES 1
#endif
constexpr int N_LAUNCHES = MK_N_LAUNCHES;
constexpr int PER_PHASE = 6;
#ifndef PG8_SP2
#define PG8_SP2 true
#endif

constexpr size_t MiB = 1u << 20;
constexpr size_t WS_CTL = 0, CTL_ZERO_BYTES = 1 * MiB;
constexpr size_t WS_WIN = 2 * MiB;
constexpr size_t WS_WOUT = 6 * MiB;
constexpr size_t WS_WGU = 8 * MiB;
constexpr size_t WS_WDN = 20 * MiB;
constexpr size_t WS_XN = 32 * MiB;
constexpr size_t WS_QKVZ = 160 * MiB;
constexpr size_t WS_ACT = 416 * MiB;
constexpr size_t WS_END = 768 * MiB;
static_assert(WS_WGU + (size_t)NGU * D * 2 <= WS_WDN && WS_WDN + (size_t)D * FF * 2 <= WS_XN && WS_ACT + (size_t)M * FF * 2 <= WS_END, "d_ws map");
constexpr int CW_BAR = 4096;
constexpr int CW_SS = 65536;
static_assert((size_t)(CW_SS + M) * 4 <= CTL_ZERO_BYTES, "ss inside the memset region");

constexpr int RING_OFF = 0, RING_BYTES = 131072;
constexpr int LDSCTL_OFF = RING_BYTES, MISC_OFF = LDSCTL_OFF + 320;
constexpr int LDS_GAIN_OFF = LDSCTL_OFF + 512;
constexpr int LDS_BYTES = 147456;

typedef GAS unsigned gu32;
#define RLX_AGENT __ATOMIC_RELAXED, __HIP_MEMORY_SCOPE_AGENT
#define LDS_WAIT() asm volatile("s_waitcnt lgkmcnt(0)" ::: "memory")
__device__ __forceinline__ unsigned f2bf(float f) { unsigned u = __builtin_bit_cast(unsigned, f); return (u + 0x7fffu + ((u >> 16) & 1u)) >> 16; }
__device__ __forceinline__ unsigned pk2(float lo, float hi) { return f2bf(lo) | (f2bf(hi) << 16); }
__device__ __forceinline__ float bflo(unsigned w) { return __builtin_bit_cast(float, w << 16); }
__device__ __forceinline__ float bfhi(unsigned w) { return __builtin_bit_cast(float, w & 0xffff0000u); }

#define XB_TMO      128
#define XB_XCNT(j)  (256  + 64 * (j))
#define XB_XSUB(j)  (1280 + 64 * (j))
#define XB_XGEN(j)  (2304 + 64 * (j))
#define XB_TOP      3328
#define XB_TOPGEN   3392
#define XCD_BAR_WORDS 3456
#define XB_SPIN_CAP (1u << 18)

__device__ __forceinline__ unsigned xb_ld(unsigned* p)              { return __hip_atomic_load(p, __ATOMIC_RELAXED, __HIP_MEMORY_SCOPE_AGENT); }
__device__ __forceinline__ unsigned xb_add(unsigned* p, unsigned v) { return __hip_atomic_fetch_add(p, v, __ATOMIC_RELAXED, __HIP_MEMORY_SCOPE_AGENT); }
__device__ __forceinline__ unsigned xb_xcc_id() { return (unsigned)__builtin_amdgcn_s_getreg((3 << 11) | 20) & 0xFu; }
#define XB_SPIN(cond, bar) do { unsigned _sp = 0; while (cond) { __builtin_amdgcn_s_sleep(1); \
    if ((++_sp & 255u) == 0u) { if (xb_ld(&(bar)[XB_TMO])) break; if (_sp > XB_SPIN_CAP) { atomicAdd(&(bar)[XB_TMO], 1u); break; } } } } while (0)

struct XcdBarrier { unsigned* bar; unsigned x; volatile LAS unsigned* st; };

__device__ __forceinline__ XcdBarrier xcd_barrier_post(unsigned* bar, volatile LAS unsigned* st) {
    XcdBarrier b; b.bar = bar; b.x = xb_xcc_id(); b.st = st;
    if (threadIdx.x == 0) (void)xb_add(&bar[XB_XCNT(b.x)], 1u);
    return b;
}
__device__ __forceinline__ void xcd_barrier_complete(unsigned* bar, unsigned x, unsigned& nloc, unsigned& nx) {
    const unsigned G = gridDim.x * gridDim.y * gridDim.z;
    unsigned sum, cnt, mine, sp = 0u;
    for (;;) {
        sum = 0u; cnt = 0u; mine = 0u;
#pragma unroll
        for (unsigned j = 0; j < 16; ++j) { const unsigned c = xb_ld(&bar[XB_XCNT(j)]); sum += c; cnt += (c > 0u) ? 1u : 0u; mine = (j == x) ? c : mine; }
        if (sum == G) break;
        __builtin_amdgcn_s_sleep(1);
        if ((++sp & 255u) == 0u) { if (xb_ld(&bar[XB_TMO])) break; if (sp > XB_SPIN_CAP) { atomicAdd(&bar[XB_TMO], 1u); break; } }
    }
    nloc = mine > 0u ? mine : 1u; nx = cnt > 0u ? cnt : 1u;
}
__device__ __forceinline__ void xcd_barrier(const XcdBarrier& b) {
    asm volatile("s_waitcnt vmcnt(0)" ::: "memory");
    __syncthreads();
    if (threadIdx.x == 0) {
        unsigned* bar = b.bar;
        __builtin_amdgcn_s_waitcnt(0);
        unsigned nloc = b.st[0], nx = b.st[1];
        if (nloc == 0u) { xcd_barrier_complete(bar, b.x, nloc, nx); b.st[0] = nloc; b.st[1] = nx; }
        const unsigned old = xb_add(&bar[XB_XSUB(b.x)], 1u);
        const unsigned gen = old / nloc;
        if (old + 1u == (gen + 1u) * nloc) {
            __builtin_amdgcn_fence(__ATOMIC_RELEASE, "agent");
            asm volatile("s_waitcnt vmcnt(0)" ::: "memory");
            const unsigned og = xb_add(&bar[XB_TOP], 1u);
            const unsigned tg = og / nx;
            if (og + 1u == (tg + 1u) * nx) xb_add(&bar[XB_TOPGEN], 1u);
            else XB_SPIN(xb_ld(&bar[XB_TOPGEN]) == tg, bar);
            __builtin_amdgcn_fence(__ATOMIC_ACQUIRE, "agent");
            xb_add(&bar[XB_XGEN(b.x)], 1u);
            asm volatile("s_waitcnt vmcnt(0)" ::: "memory");
        } else {
            XB_SPIN(xb_ld(&bar[XB_XGEN(b.x)]) == gen, bar);
            __builtin_amdgcn_fence(__ATOMIC_ACQUIRE, "agent");
            asm volatile("s_waitcnt vmcnt(0)" ::: "memory");
        }
    }
    __syncthreads();
}

struct Frame {
    LAS unsigned char* lds;
    volatile LAS unsigned* MISC;
    gu32* ctl;
    int tid, lane, wave;
    int vcu, G;
    const float *x, *g1, *w_in, *gq, *gk, *rpb, *w_pool, *pscale, *w_out, *g2, *w_gate, *w_up, *w_down;
    float* out;
    bf16_t *Win_t, *Wout_t, *Wgu_t, *Wdn_t;
    bf16_t *XN, *QKVZ, *XB, *ACT;
    float* ss;
};

__device__ __forceinline__ float wave_sum(float v) {
#pragma unroll
    for (int o = 1; o < 64; o <<= 1) v += __shfl_xor(v, o);
    return v;
}

__device__ __forceinline__ void p0_tile_out(bf16_t* WT, int K, int drow0, int k0, LAS float* scr, int lane) {
    LDS_WAIT(); asm volatile("" ::: "memory");
    const int c = lane & 7;
#pragma unroll
    for (int j = 0; j < 4; ++j) { const int n = (lane >> 3) + 8 * j; const LAS float* s = scr + (8 * c) * 33 + n;
        u32x4 o; o.x = pk2(s[0 * 33], s[1 * 33]); o.y = pk2(s[2 * 33], s[3 * 33]); o.z = pk2(s[4 * 33], s[5 * 33]); o.w = pk2(s[6 * 33], s[7 * 33]);
        *(GAS u32x4*)(WT + (size_t)(drow0 + n) * K + k0 + 8 * c) = o; }
    LDS_WAIT(); asm volatile("" ::: "memory");
}
__device__ __forceinline__ void p0_transpose_item(const float* W, int ldw, int K, int k0, int n0, const float* gkv, bf16_t* WT, int drow0, LAS float* scr, int lane) {
#pragma unroll
    for (int i = 0; i < 32; ++i) { const int kk = 2 * i + (lane >> 5); float v = W[(size_t)(k0 + kk) * ldw + n0 + (lane & 31)]; if (gkv) v *= gkv[k0 + kk]; scr[kk * 33 + (lane & 31)] = v; }
    p0_tile_out(WT, K, drow0, k0, scr, lane);
}
__device__ __forceinline__ void p0_fold_item(const float* w_in, const float* w_pool, const float* pscale, int k0, int n0z, bf16_t* WT, int drow0, int lane) {
    const int n = lane & 31, kh = lane >> 5, g = n0z >> 7, d = (n0z & 127) + n;
    float acc[4] = {0.f, 0.f, 0.f, 0.f};
    const float* wrow = w_in + (size_t)(k0 + 4 * kh) * NIN + 3 * NA + 128 * g;
    const float* wp = w_pool + (size_t)g * 128 * 128 + d;
#pragma unroll 8
    for (int c4 = 0; c4 < 32; ++c4) {
        const float p0 = wp[(4 * c4 + 0) * 128], p1 = wp[(4 * c4 + 1) * 128], p2 = wp[(4 * c4 + 2) * 128], p3 = wp[(4 * c4 + 3) * 128];
#pragma unroll
        for (int i = 0; i < 4; ++i) { const f32x4 w = *(const f32x4*)(wrow + (size_t)i * NIN + 4 * c4); acc[i] += (w[0] * p0 + w[1] * p1) + (w[2] * p2 + w[3] * p3); }
    }
    const float ps = pscale[n0z + n];
    float hi[4];
#pragma unroll
    for (int i = 0; i < 4; ++i) { acc[i] *= ps; hi[i] = __shfl(acc[i], (lane + 32) & 63); }
    if (lane < 32) { u32x4 o; o.x = pk2(acc[0], acc[1]); o.y = pk2(acc[2], acc[3]); o.z = pk2(hi[0], hi[1]); o.w = pk2(hi[2], hi[3]);
        *(GAS u32x4*)(WT + (size_t)(drow0 + n) * D + k0) = o; }
}
__device__ __forceinline__ int win_drow(int n0) { const int pn = n0 >> 8, c = n0 & 255; return 256 * pn + 128 * ((c >> 5) & 1) + 32 * (c >> 6); }

__device__ __forceinline__ void rms_rows4(const float* x, const f32x4 (&gg)[4], bf16_t* XN, int m0, int mstride, int lane) {
    f32x4 v[4][4]; float s[4];
#pragma unroll
    for (int r = 0; r < 4; ++r) { const GAS f32x4* xr = (const GAS f32x4*)(x + (size_t)(m0 + r * mstride) * D) + lane;
#pragma unroll
        for (int j = 0; j < 4; ++j) v[r][j] = xr[64 * j]; }
#pragma unroll
    for (int r = 0; r < 4; ++r) { float a = 0.f;
#pragma unroll
        for (int j = 0; j < 4; ++j) a += (v[r][j].x * v[r][j].x + v[r][j].y * v[r][j].y) + (v[r][j].z * v[r][j].z + v[r][j].w * v[r][j].w);
        s[r] = a; }
#pragma unroll
    for (int o = 1; o < 64; o <<= 1) {
#pragma unroll
        for (int r = 0; r < 4; ++r) s[r] += __shfl_xor(s[r], o); }
#pragma unroll
    for (int r = 0; r < 4; ++r) { const float rstd = __builtin_amdgcn_rsqf(s[r] * (1.f / D) + EPS);
        GAS unsigned long long* o8 = (GAS unsigned long long*)(XN + (size_t)(m0 + r * mstride) * D) + lane;
#pragma unroll
        for (int j = 0; j < 4; ++j) o8[64 * j] = (unsigned long long)pk2(v[r][j].x * rstd * gg[j].x, v[r][j].y * rstd * gg[j].y) | ((unsigned long long)pk2(v[r][j].z * rstd * gg[j].z, v[r][j].w * rstd * gg[j].w) << 32); }
}

__device__ __forceinline__ void p0_prologue(Frame& F) {
    LAS float* scr = (LAS float*)(F.lds + RING_OFF + F.wave * 16384);
    const int gw = F.vcu * NWAVES + F.wave, NGW = F.G * NWAVES;
    constexpr int KB = D / 64;
    constexpr int I_QKV = KB * (3 * NA / 32), I_O = KB * (D / 32), I_G = KB * (FF / 32), I_DN = (FF / 64) * (D / 32);
    constexpr int NITEMS = I_QKV + I_O + 2 * I_G + I_DN;
    for (int it = gw; it < (D / 8) * (NA / 32); it += NGW) { const int nb = it & 15, kb = it >> 4; p0_fold_item(F.w_in, F.w_pool, F.pscale, 8 * kb, 32 * nb, F.Win_t, win_drow(3 * NA + 32 * nb), F.lane); }
    for (int it = gw; it < NITEMS; it += NGW) {
        int r = it;
        if (r < I_QKV) { const int nb = r % (3 * NA / 32), kb = r / (3 * NA / 32); p0_transpose_item(F.w_in, NIN, D, 64 * kb, 32 * nb, nullptr, F.Win_t, win_drow(32 * nb), scr, F.lane); continue; } r -= I_QKV;
        if (r < I_O) { const int nb = r % (D / 32), kb = r / (D / 32); p0_transpose_item(F.w_out, D, D, 64 * kb, 32 * nb, nullptr, F.Wout_t, 32 * nb, scr, F.lane); continue; } r -= I_O;
        if (r < 2 * I_G) { const int up = r >= I_G; if (up) r -= I_G; const int nb = r % (FF / 32), kb = r / (FF / 32), n0 = 32 * nb;
            p0_transpose_item(up ? F.w_up : F.w_gate, FF, D, 64 * kb, n0, F.g2, F.Wgu_t, 256 * (n0 >> 7) + (n0 & 127) + 128 * up, scr, F.lane); continue; } r -= 2 * I_G;
        { const int nb = r % (D / 32), kb = r / (D / 32); p0_transpose_item(F.w_down, D, FF, 64 * kb, 32 * nb, nullptr, F.Wdn_t, 32 * nb, scr, F.lane); }
    }
    f32x4 gg[4];
#pragma unroll
    for (int j = 0; j < 4; ++j) gg[j] = *((const f32x4*)F.g1 + F.lane + 64 * j);
    int m0 = gw;
    for (; m0 + 3 * NGW < M; m0 += 4 * NGW) rms_rows4(F.x, gg, F.XN, m0, NGW, F.lane);
    for (; m0 < M; m0 += NGW) rms_rows4(F.x, gg, F.XN, m0, 0, F.lane);
}

constexpr int AT_A = 0;
constexpr int AT_B = 61440;
constexpr int AT_TAB = 122880;
static_assert(AT_TAB + 15 * 64 * 4 <= RING_BYTES, "attention LDS map");
__device__ __forceinline__ int rs_of(int r) { int v = r - 4; v = v < 0 ? 0 : v; return v > 56 ? 56 : v; }

struct AttnUnit { int b, h, j, r0, krow_lo, nrows, kc0; };
__device__ __forceinline__ AttnUnit attn_decode(int un) {
    AttnUnit u; const int bh = un >> 5, rc = (un >> 2) & 7; u.j = un & 3; u.b = bh >> 3; u.h = bh & 7;
    u.r0 = 8 * rc; u.krow_lo = rs_of(u.r0); u.nrows = rs_of(u.r0 + 7) + 8 - u.krow_lo;
    u.kc0 = (u.j == 0) ? 0 : (u.j == 1) ? 8 : (u.j == 2) ? 24 : 32;
    return u;
}
__device__ __forceinline__ void glds16(const void* gsrc, unsigned lds_dst) { unsigned keep;
    asm volatile("s_mov_b32 %0, m0\n\ts_mov_b32 m0, %2\n\ts_nop 0\n\tglobal_load_lds_dwordx4 %1, off\n\ts_mov_b32 m0, %0" : "=&s"(keep) : "v"(gsrc), "s"(lds_dst) : "memory"); }
#define ATT_WAIT_BAR() do { asm volatile("s_waitcnt vmcnt(0) lgkmcnt(0)" ::: "memory"); __builtin_amdgcn_s_barrier(); asm volatile("" ::: "memory"); } while (0)
template <int KIND> __device__ __forceinline__ void attn_dma(unsigned dst, const bf16_t* src, const AttnUnit& u, int wid, int lane) {
    const int np = u.nrows * 4;
    const char* base = (const char*)(src + ((size_t)(u.b * SEQ + u.krow_lo * 64 + u.kc0)) * NA + u.h * HD);
#pragma unroll
    for (int it = 0; it < 8; ++it) {
        const int pi = it * 8 + wid;
        if (pi < np) {
            const int ts = 8 * pi + (lane >> 3), pos = ts & 31, w = ts >> 5;
            int kk, sw;
            if (KIND == 0) { kk = ((pos >> 4) & 1) * 4 + ((pos >> 2) & 3) * 8 + (pos & 3); sw = (ts >> 1) & 7; }
            else { kk = (pos & 0x13) | ((pos & 4) << 1) | ((pos & 8) >> 1); sw = ((ts >> 1) & 3) << 1; }
            const int ch = (lane & 7) ^ sw;
            const char* gp = base + (size_t)(w * 64 + kk) * (NA * 2) + ch * 16;
            glds16(gp, (unsigned)__builtin_amdgcn_readfirstlane(dst + pi * 1024));
        }
    }
}

__device__ __forceinline__ void p2_attention(Frame& F, const bf16_t* Qg, const bf16_t* Kg, const bf16_t* Vg, bf16_t* MIX) {
    const int lane = F.lane, wid = F.wave;
    LAS unsigned char* lds = F.lds;
    const unsigned lds0 = (unsigned)(size_t)F.lds;
    const int q = lane & 15, g = lane >> 4;
    constexpr int NUNITS = BATCH * NHEAD * 32;
    for (int uidx = F.vcu * 16; uidx < NUNITS; uidx += F.G * 16) {
        const int h = (uidx >> 5) & 7;
        __syncthreads();
        {   LAS float* tab = (LAS float*)(lds + AT_TAB);
            for (int i = F.tid; i < 15 * 64; i += NWAVES * 64) { const int rr = i >> 6, cc = (i & 63) - 16; tab[i] = (cc >= 0 && cc < 31) ? F.rpb[h * 465 + rr * 31 + cc] * LOG2E : 0.f; } }
        AttnUnit u = attn_decode(uidx);
        attn_dma<0>(lds0 + AT_A, Kg, u, wid, lane);
        bf16x8 qf0, qf1;
        { const bf16_t* qp = Qg + ((size_t)(u.b * SEQ + (u.r0 + wid) * 64 + 16 * u.j + q)) * NA + u.h * HD + 8 * g; qf0 = *(const bf16x8*)qp; qf1 = *(const bf16x8*)(qp + 32); }
        ATT_WAIT_BAR();
        for (int ui = 0; ui < 16; ++ui) {
            asm volatile("" : "+v"(qf0), "+v"(qf1));
            attn_dma<1>(lds0 + AT_B, Vg, u, wid, lane);
            const int r = u.r0 + wid, rs = rs_of(r), wbase = rs - u.krow_lo;
            const int cq = 16 * u.j + q;
            int cs = cq - 8; cs = cs < 0 ? 0 : cs; cs = cs > 48 ? 48 : cs;
            f32x4 sc[8][2];
            {
                const int x0 = g ^ (q >> 1);
                const LAS unsigned char* ka = lds + AT_A + wbase * 4096 + q * 128;
                const LAS unsigned char* k0p = ka + x0 * 16;
                const LAS unsigned char* k1p = ka + (x0 ^ 4) * 16;
#pragma unroll
                for (int wl = 0; wl < 8; ++wl)
#pragma unroll
                    for (int blk = 0; blk < 2; ++blk) {
                        const bf16x8 k0 = *(const LAS bf16x8*)(k0p + wl * 4096 + blk * 2048), k1 = *(const LAS bf16x8*)(k1p + wl * 4096 + blk * 2048);
                        f32x4 a = (f32x4){0.f, 0.f, 0.f, 0.f};
                        a = __builtin_amdgcn_mfma_f32_16x16x32_bf16(k0, qf0, a, 0, 0, 0);
                        a = __builtin_amdgcn_mfma_f32_16x16x32_bf16(k1, qf1, a, 0, 0, 0);
                        sc[wl][blk] = a;
                    }
            }
            const LAS float* tab = (const LAS float*)(lds + AT_TAB) + (rs - r + 7) * 64 + 16 + (u.kc0 - cq + 15) + 8 * g;
            const int voff = u.kc0 + 8 * g - cs;
            float mx = -INFINITY;
#pragma unroll
            for (int wl = 0; wl < 8; ++wl)
#pragma unroll
                for (int blk = 0; blk < 2; ++blk)
#pragma unroll
                    for (int e = 0; e < 4; ++e) {
                        const int ep = 4 * blk + e;
                        float s = sc[wl][blk][e] + tab[wl * 64 + ep];
                        s = ((unsigned)(voff + ep) < 16u) ? s : -INFINITY;
                        sc[wl][blk][e] = s; mx = fmaxf(mx, s);
                    }
            mx = fmaxf(mx, __shfl_xor(mx, 16)); mx = fmaxf(mx, __shfl_xor(mx, 32));
            float l = 0.f; u32x4 pw[8];
#pragma unroll
            for (int wl = 0; wl < 8; ++wl) {
                float p[8];
#pragma unroll
                for (int blk = 0; blk < 2; ++blk)
#pragma unroll
                    for (int e = 0; e < 4; ++e) { p[4 * blk + e] = __builtin_amdgcn_exp2f(sc[wl][blk][e] - mx); l += p[4 * blk + e]; }
                pw[wl].x = cvt_pk_bf16(p[0], p[1]); pw[wl].y = cvt_pk_bf16(p[2], p[3]); pw[wl].z = cvt_pk_bf16(p[4], p[5]); pw[wl].w = cvt_pk_bf16(p[6], p[7]);
            }
            l += __shfl_xor(l, 16); l += __shfl_xor(l, 32);
            const float il = __builtin_amdgcn_rcpf(l);
            ATT_WAIT_BAR();
            AttnUnit un = u; bf16x8 nq0 = qf0, nq1 = qf1;
            if (ui < 15) {
                un = attn_decode(uidx + ui + 1);
                attn_dma<0>(lds0 + AT_A, Kg, un, wid, lane);
                const bf16_t* qp = Qg + ((size_t)(un.b * SEQ + (un.r0 + wid) * 64 + 16 * un.j + q)) * NA + un.h * HD + 8 * g; nq0 = *(const bf16x8*)qp; nq1 = *(const bf16x8*)(qp + 32);
            }
            f32x4 o[4];
#pragma unroll
            for (int n = 0; n < 4; ++n) o[n] = (f32x4){0.f, 0.f, 0.f, 0.f};
            {
                const int qr = q >> 2, p = lane & 3;
                const int pos_lo = (g >> 1) * 16 + (g & 1) * 4 + qr, sw = ((g & 1) * 2 + (qr >> 1)) << 1;
                const LAS unsigned char* vb = lds + AT_B + (wbase * 32 + pos_lo) * 128 + (p >> 1) * 16 + (p & 1) * 8;
                const LAS unsigned char* vn[4];
#pragma unroll
                for (int n = 0; n < 4; ++n) vn[n] = vb + ((2 * n) ^ sw) * 16;
#pragma unroll
                for (int wl = 0; wl < 8; ++wl) {
                    const bf16x8 pf = __builtin_bit_cast(bf16x8, pw[wl]);
#pragma unroll
                    for (int n = 0; n < 4; ++n) {
                        const s16x4 lo = __builtin_bit_cast(s16x4, __builtin_amdgcn_ds_read_tr16_b64_v4i16((LAS s16x4*)(vn[n] + wl * 4096)));
                        const s16x4 hi = __builtin_bit_cast(s16x4, __builtin_amdgcn_ds_read_tr16_b64_v4i16((LAS s16x4*)(vn[n] + wl * 4096 + 1024)));
                        const bf16x8 vf = (bf16x8){lo[0], lo[1], lo[2], lo[3], hi[0], hi[1], hi[2], hi[3]};
                        o[n] = __builtin_amdgcn_mfma_f32_16x16x32_bf16(vf, pf, o[n], 0, 0, 0);
                    }
                }
            }
            bf16_t* op = MIX + ((size_t)(u.b * SEQ + r * 64 + cq)) * D + u.h * HD + 4 * g;
#pragma unroll
            for (int n = 0; n < 4; ++n) { u32x2 w; w.x = cvt_pk_bf16(o[n][0] * il, o[n][1] * il); w.y = cvt_pk_bf16(o[n][2] * il, o[n][3] * il); *(u32x2*)(op + 16 * n) = w; }
            ATT_WAIT_BAR();
            u = un; qf0 = nq0; qf1 = nq1;
        }
    }
}

__device__ __forceinline__ void up8(const u32x4 w, float (&v)[8]) {
    v[0] = bflo(w.x); v[1] = bfhi(w.x); v[2] = bflo(w.y); v[3] = bfhi(w.y); v[4] = bflo(w.z); v[5] = bfhi(w.z); v[6] = bflo(w.w); v[7] = bfhi(w.w);
}
__device__ __forceinline__ void pool_run(const bf16_t* __restrict__ Zg, bf16_t* __restrict__ MIX, int gw, int lane) {
    const int tb = 32 * gw, b = tb >> 12, t0 = tb & (SEQ - 1);
    const int half = 1 << (lane >> 4);
    const bf16_t* zb = Zg + (size_t)(b * SEQ) * NA + 8 * lane;
    bf16_t* ob = MIX + (size_t)(b * SEQ) * D + NA + 8 * lane;
    float S[8];
#pragma unroll
    for (int e = 0; e < 8; ++e) S[e] = 0.f;
    {   u32x4 w[16];
#pragma unroll
        for (int d = 0; d < 16; ++d) { int i = t0 + d - 8; i = i < 0 ? 0 : i; i = i > SEQ - 1 ? SEQ - 1 : i; w[d] = *(const u32x4*)(zb + (size_t)i * NA); }
#pragma unroll
        for (int d = 0; d < 16; ++d) { const int dd = d - 8, i = t0 + dd; const float mk = (dd >= -half && dd < half && i >= 0 && i < SEQ) ? 1.f : 0.f; float v[8]; up8(w[d], v);
#pragma unroll
            for (int e = 0; e < 8; ++e) S[e] += mk * v[e]; } }
    for (int c = 0; c < 4; ++c) {
        u32x4 zt[8], za[8], zs[8];
#pragma unroll
        for (int k = 0; k < 8; ++k) { const int t = t0 + 8 * c + k; int ia = t + half, is = t - half; ia = ia > SEQ - 1 ? SEQ - 1 : ia; is = is < 0 ? 0 : is;
            zt[k] = *(const u32x4*)(zb + (size_t)t * NA); za[k] = *(const u32x4*)(zb + (size_t)ia * NA); zs[k] = *(const u32x4*)(zb + (size_t)is * NA); }
#pragma unroll
        for (int k = 0; k < 8; ++k) { const int t = t0 + 8 * c + k;
            const int lo = (t - half) < 0 ? 0 : (t - half), hi = (t + half) > SEQ ? SEQ : (t + half);
            const float inv = 1.0f / (float)(hi - lo);
            float v[8]; up8(zt[k], v);
            u32x4 w;
            w.x = cvt_pk_bf16(S[0] * inv - v[0], S[1] * inv - v[1]); w.y = cvt_pk_bf16(S[2] * inv - v[2], S[3] * inv - v[3]);
            w.z = cvt_pk_bf16(S[4] * inv - v[4], S[5] * inv - v[5]); w.w = cvt_pk_bf16(S[6] * inv - v[6], S[7] * inv - v[7]);
            *(u32x4*)(ob + (size_t)t * D) = w;
            const float ma = (t + half < SEQ) ? 1.f : 0.f, ms = (t - half >= 0) ? 1.f : 0.f;
            float a[8], s[8]; up8(za[k], a); up8(zs[k], s);
#pragma unroll
            for (int e = 0; e < 8; ++e) S[e] += ma * a[e] - ms * s[e]; }
    }
}

__device__ __forceinline__ void p2_mixer(Frame& F) {
    const bf16_t* Qg = F.QKVZ; const bf16_t* Kg = F.QKVZ + (size_t)M * NA; const bf16_t* Vg = F.QKVZ + 2 * (size_t)M * NA; const bf16_t* Zg = F.QKVZ + 3 * (size_t)M * NA;
    bf16_t* MIX = F.XN;
    for (int gw = F.vcu * NWAVES + F.wave; gw < M / 32; gw += F.G * NWAVES) pool_run(Zg, MIX, gw, F.lane);
    p2_attention(F, Qg, Kg, Vg, MIX);
    __syncthreads();
}

struct Args { const float* in[13]; float* out; unsigned char* ws; int ph_lo, ph_hi, li, pad; };
__global__ void __launch_bounds__(NWAVES * 64, 2) fwd_megakernel(Args args) {
    extern __shared__ __attribute__((aligned(16))) unsigned char lds[];
    Frame F;
    F.lds = (LAS unsigned char*)lds;
    F.MISC = (volatile LAS unsigned*)(F.lds + MISC_OFF);
    F.tid = threadIdx.x; F.lane = F.tid & 63; F.wave = __builtin_amdgcn_readfirstlane(F.tid >> 6);
    F.G = gridDim.x; { const int bx = blockIdx.x; F.vcu = (F.G % 8 == 0) ? (bx % 8) * (F.G / 8) + bx / 8 : bx; }
    unsigned char* ws = args.ws;
    F.ctl = (gu32*)(ws + WS_CTL);
    F.x = args.in[0]; F.g1 = args.in[1]; F.w_in = args.in[2]; F.gq = args.in[3]; F.gk = args.in[4]; F.rpb = args.in[5]; F.w_pool = args.in[6];
    F.pscale = args.in[7]; F.w_out = args.in[8]; F.g2 = args.in[9]; F.w_gate = args.in[10]; F.w_up = args.in[11]; F.w_down = args.in[12]; F.out = args.out;
    F.Win_t = (bf16_t*)(ws + WS_WIN); F.Wout_t = (bf16_t*)(ws + WS_WOUT); F.Wgu_t = (bf16_t*)(ws + WS_WGU); F.Wdn_t = (bf16_t*)(ws + WS_WDN);
    F.XN = (bf16_t*)(ws + WS_XN); F.QKVZ = (bf16_t*)(ws + WS_QKVZ); F.XB = (bf16_t*)(ws + WS_QKVZ); F.ACT = (bf16_t*)(ws + WS_ACT);
    F.ss = (float*)(ws + WS_CTL) + CW_SS;
    for (int u = F.tid; u < (LDS_BYTES - LDSCTL_OFF) / 4; u += NWAVES * 64) ((LAS unsigned*)(F.lds + LDSCTL_OFF))[u] = 0u;
    __syncthreads();
    XcdBarrier bar; bar.bar = (unsigned*)(F.ctl + CW_BAR); bar.x = 0; bar.st = nullptr;
    if (N_LAUNCHES != PER_PHASE) bar = xcd_barrier_post((unsigned*)(F.ctl + CW_BAR), F.MISC + 8);
#define GRID_BAR() do { if (N_LAUNCHES != PER_PHASE) xcd_barrier(bar); } while (0)
    const int lo = args.ph_lo, hi = args.ph_hi;
#define IN(k) (lo <= (k) && (k) < hi)
#define BOTH(k) (IN(k) && IN((k) + 1))

    if (IN(0)) { p0_prologue(F); if (BOTH(0)) GRID_BAR(); }

    if (IN(1)) {
        pg8::Gemm g{F.XN, F.Win_t, M, NIN, D}; pg8::StaticOrder S; S.init(M, NIN, F.G, (int)blockIdx.x);
        { LAS float* gl = (LAS float*)(F.lds + LDS_GAIN_OFF);
          if (F.tid < 64) gl[F.tid] = F.gq[F.tid] * (0.125f * LOG2E); else if (F.tid < 128) gl[F.tid] = F.gk[F.tid - 64];
          __syncthreads(); }
        pg8::EpiIn E{F.QKVZ, (const LAS float*)(F.lds + LDS_GAIN_OFF)};
        pg8::gemm_phase<pg8::EpiIn, pg8::StaticOrder, true, PG8_SP2>(F.lds + RING_OFF, g, S, E);
        if (BOTH(1)) GRID_BAR();
    }

    if (IN(2)) { p2_mixer(F); if (BOTH(2)) GRID_BAR(); }

    if (IN(3)) {
        pg8::Gemm g{F.XN, F.Wout_t, M, D, D}; pg8::StaticOrder S; S.init(M, D, F.G, (int)blockIdx.x);
        pg8::EpiOut E{F.x, F.out, F.XB, F.ss};
        pg8::gemm_phase<pg8::EpiOut, pg8::StaticOrder, true, PG8_SP2>(F.lds + RING_OFF, g, S, E);
        if (BOTH(3)) GRID_BAR();
    }

    if (IN(4)) {
        pg8::Gemm g{F.XB, F.Wgu_t, M, NGU, D}; pg8::StaticOrder S; S.init(M, NGU, F.G, (int)blockIdx.x);
        pg8::EpiGU E{F.ACT, F.ss};
        pg8::gemm_phase<pg8::EpiGU, pg8::StaticOrder, true, PG8_SP2>(F.lds + RING_OFF, g, S, E);
        if (BOTH(4)) GRID_BAR();
    }

    if (IN(5)) {
        pg8::Gemm g{F.ACT, F.Wdn_t, M, D, FF}; pg8::StaticOrder S; S.init(M, D, F.G, (int)blockIdx.x);
        pg8::EpiDown E{F.out};
        pg8::gemm_phase<pg8::EpiDown, pg8::StaticOrder, true, PG8_SP2>(F.lds + RING_OFF, g, S, E);
    }
#undef IN
#undef BOTH
#undef GRID_BAR
}

extern "C" void kernel_launch(void* const* d_in, const int* in_sizes, int n_in, void* d_out, int out_size, void* d_ws, size_t ws_size, hipStream_t stream) {
    static int grid = 0;
    if (grid == 0) {
        if (n_in != 13 || in_sizes[0] != M * D || out_size != M * D || ws_size < WS_END) { fprintf(stderr, "kernel_launch: unexpected shapes (n_in %d, in0 %d, out %d, ws %zu); nothing launched\n", n_in, n_in > 0 ? in_sizes[0] : -1, out_size, ws_size); grid = -1; return; }
        int dev = 0, cus = 0, per_cu = 0;
        if (hipGetDevice(&dev) != hipSuccess || hipDeviceGetAttribute(&cus, hipDeviceAttributeMultiprocessorCount, dev) != hipSuccess) { fprintf(stderr, "kernel_launch: device query failed\n"); grid = -1; return; }
        if (hipFuncSetAttribute((const void*)fwd_megakernel, hipFuncAttributeMaxDynamicSharedMemorySize, LDS_BYTES) != hipSuccess) { fprintf(stderr, "kernel_launch: hipFuncSetAttribute failed\n"); grid = -1; return; }
        if (hipOccupancyMaxActiveBlocksPerMultiprocessor(&per_cu, (const void*)fwd_megakernel, NWAVES * 64, LDS_BYTES) != hipSuccess || per_cu < 1) {
            fprintf(stderr, "kernel_launch: occupancy query reports %d workgroups per CU; nothing launched\n", per_cu); (void)hipGetLastError(); grid = -1; return; }
        (void)hipGetLastError();
        grid = cus;
    }
    if (grid < 0) return;
    if (hipMemsetAsync((char*)d_ws + WS_CTL, 0, CTL_ZERO_BYTES, stream) != hipSuccess) { fprintf(stderr, "kernel_launch: hipMemsetAsync failed\n"); return; }
    Args a{};
    for (int i = 0; i < 13; ++i) a.in[i] = (const float*)d_in[i];
    a.out = (float*)d_out; a.ws = (unsigned char*)d_ws;
    for (int li = 0; li < N_LAUNCHES; ++li) {
        a.ph_lo = (N_LAUNCHES == PER_PHASE) ? li : 0; a.ph_hi = (N_LAUNCHES == PER_PHASE) ? li + 1 : PER_PHASE; a.li = li;
        hipLaunchKernelGGL(fwd_megakernel, dim3(grid), dim3(NWAVES * 64), LDS_BYTES, stream, a);
        const hipError_t le = hipPeekAtLastError();
        if (le != hipSuccess) { fprintf(stderr, "kernel_launch: launch %d failed: %s\n", li, hipGetErrorName(le)); break; }
    }
}
```

```cpp
#include <hip/hip_runtime.h>
#include <cstdio>
#include <cstdint>

#define LAS __attribute__((address_space(3)))
#define GAS __attribute__((address_space(1)))
typedef unsigned short bf16_t;
typedef short bf16x8 __attribute__((ext_vector_type(8)));
typedef short s16x4 __attribute__((ext_vector_type(4)));
typedef float f32x4 __attribute__((ext_vector_type(4)));
typedef float f32x2 __attribute__((ext_vector_type(2)));
typedef unsigned u32x4 __attribute__((ext_vector_type(4)));
typedef unsigned u32x2 __attribute__((ext_vector_type(2)));

constexpr int BATCH = 16, SEQ = 4096, D = 1024, M = BATCH * SEQ;
constexpr int NA = 512, NHEAD = 8, HD = 64, NIN = 2048, FF = 2816, NGU = 2 * FF;
constexpr float EPS = 1e-6f;
constexpr float LOG2E = 1.4426950408889634f;

__device__ __forceinline__ unsigned cvt_pk_bf16(float lo, float hi) { unsigned r; asm volatile("v_cvt_pk_bf16_f32 %0, %1, %2" : "=v"(r) : "v"(lo), "v"(hi)); return r; }

namespace pg8 {
constexpr int BM = 256, BK = 64, HALF = 128, HTB = HALF * BK * 2, STAGE_BYTES = 8 * HTB, NXCD = 8, WGM = 8;

__host__ __device__ __forceinline__ int lds_byte(int r, int c) { const int st = (r >> 4) * 2 + (c >> 5), rr = r & 15, cc = c & 31, ob = rr * 64 + cc * 2; return st * 1024 + (ob ^ (((ob >> 9) & 1) << 5)); }
__host__ __device__ __forceinline__ void stage_rc(int b, int& R, int& C) { const int st = b / 1024, sb = b % 1024, swz = sb ^ (((sb >> 9) & 1) << 5); R = (st >> 1) * 16 + swz / 64; C = (st & 1) * 32 + (swz % 64) / 2; }
__host__ __device__ __forceinline__ int perm32(int rho) { const int n = rho >> 4, i = rho & 15; return 8 * (i >> 2) + 4 * n + (i & 3); }

struct Unit { int pm, pn; };
struct Gemm { const bf16_t* A; const bf16_t* Bt; int M, N, K; };

struct StaticOrder {
    int nM, nN, nwg, G, c;
    __host__ __device__ void init(int M_, int N_, int G_, int c_) { nM = M_ / BM; nN = N_ / BM; nwg = nM * nN; G = G_; c = c_; }
    __host__ __device__ bool next(int i, Unit& u) const {
        const long L = (long)i * G + c; if (L >= nwg) return false;
        int wgid = (int)L; { const int q = nwg / NXCD, r = nwg % NXCD, xcd = wgid % NXCD, off = wgid / NXCD; wgid = (xcd < r ? xcd * (q + 1) : r * (q + 1) + (xcd - r) * q) + off; }
        const int nig = WGM * nN, gid = wgid / nig, fm = gid * WGM, gsz = (nM - fm) < WGM ? (nM - fm) : WGM;
        u.pm = fm + ((wgid % nig) % gsz); u.pn = (wgid % nig) / gsz; return true;
    }
    __device__ __forceinline__ void a_ready(const Unit&) const {}
    __device__ __forceinline__ void done(const Unit&) const {}
};


struct EpiIn {
    static constexpr bool PERM = true, AFTER_DRAIN = false;
    bf16_t* QKVZ; const LAS float* gl;
    __device__ __forceinline__ void operator()(const f32x4 (&acc)[2][2][4][2], const Unit& u, int wr, int wc, int fr, int fq) const {
        const int kind = u.pn >> 1;
        bf16_t* base = QKVZ + (size_t)kind * ((size_t)M * NA) + (u.pn & 1) * 256 + wc * 64 + 8 * fq;
        const int row0 = u.pm * BM + wr * 64 + fr;
        if (kind < 2) {
            const LAS float* g = gl + 64 * kind + 8 * fq;
            f32x4 gv[2][2];
#pragma unroll
            for (int bj = 0; bj < 2; ++bj)
#pragma unroll
                for (int n = 0; n < 2; ++n) gv[bj][n] = *(const LAS f32x4*)(g + 32 * bj + 4 * n);
            float ss[8];
#pragma unroll
            for (int i = 0; i < 8; ++i) { const int ai = i >> 2, m = i & 3; float a = 0.f;
#pragma unroll
                for (int bj = 0; bj < 2; ++bj)
#pragma unroll
                    for (int n = 0; n < 2; ++n) { const f32x4 v = acc[ai][bj][m][n]; a += (v[0] * v[0] + v[1] * v[1]) + (v[2] * v[2] + v[3] * v[3]); }
                ss[i] = a; }
#pragma unroll
            for (int i = 0; i < 8; ++i) ss[i] += __shfl_xor(ss[i], 16);
#pragma unroll
            for (int i = 0; i < 8; ++i) ss[i] += __shfl_xor(ss[i], 32);
#pragma unroll
            for (int i = 0; i < 8; ++i) { const int ai = i >> 2, m = i & 3;
                bf16_t* rowp = base + (size_t)(row0 + ai * HALF + m * 16) * NA;
                const float r = __builtin_amdgcn_rsqf(ss[i] * (1.0f / 64.0f) + EPS);
#pragma unroll
                for (int bj = 0; bj < 2; ++bj) {
                    const f32x4 v0 = acc[ai][bj][m][0] * r * gv[bj][0], v1 = acc[ai][bj][m][1] * r * gv[bj][1];
                    u32x4 w; w.x = cvt_pk_bf16(v0[0], v0[1]); w.y = cvt_pk_bf16(v0[2], v0[3]); w.z = cvt_pk_bf16(v1[0], v1[1]); w.w = cvt_pk_bf16(v1[2], v1[3]);
                    *(u32x4*)(rowp + bj * 32) = w; }
            }
        } else {
#pragma unroll
            for (int ai = 0; ai < 2; ++ai)
#pragma unroll
                for (int m = 0; m < 4; ++m) {
                    bf16_t* rowp = base + (size_t)(row0 + ai * HALF + m * 16) * NA;
#pragma unroll
                    for (int bj = 0; bj < 2; ++bj) {
                        const f32x4 v0 = acc[ai][bj][m][0], v1 = acc[ai][bj][m][1];
                        u32x4 w; w.x = cvt_pk_bf16(v0[0], v0[1]); w.y = cvt_pk_bf16(v0[2], v0[3]); w.z = cvt_pk_bf16(v1[0], v1[1]); w.w = cvt_pk_bf16(v1[2], v1[3]);
                        *(u32x4*)(rowp + bj * 32) = w; }
                }
        }
    }
};

struct EpiOut {
    static constexpr bool PERM = true, AFTER_DRAIN = false;
    const float* x; bf16_t* XB; float* ss;
    __device__ __forceinline__ void operator()(const f32x4 (&acc)[2][2][4][2], const Unit& u, int wr, int wc, int fr, int fq) const {
        const int row0 = u.pm * BM + wr * 64 + fr, col0 = u.pn * BM + wc * 32 + 8 * fq;
        const size_t off0 = (size_t)row0 * D + col0;
        const float* __restrict__ xp = x + off0; bf16_t* __restrict__ bp = XB + off0;
        f32x4 xa[8][4]; float part[8];
#define EO_LOAD(i) do { const size_t o_ = (size_t)(((i) >> 2) * HALF + ((i) & 3) * 16) * D; \
        xa[i][0] = *(const f32x4*)(xp + o_); xa[i][1] = *(const f32x4*)(xp + o_ + 4); xa[i][2] = *(const f32x4*)(xp + o_ + HALF); xa[i][3] = *(const f32x4*)(xp + o_ + HALF + 4); } while (0)
        EO_LOAD(0); EO_LOAD(1); EO_LOAD(2); EO_LOAD(3);
        asm volatile("" ::: "memory");
#pragma unroll
        for (int i = 0; i < 8; ++i) { const int ai = i >> 2, m = i & 3; const size_t o_ = (size_t)(ai * HALF + m * 16) * D; float p = 0.f;
#pragma unroll
            for (int bj = 0; bj < 2; ++bj) {
                const f32x4 v0 = acc[ai][bj][m][0] + xa[i][2 * bj], v1 = acc[ai][bj][m][1] + xa[i][2 * bj + 1];
                u32x4 w; w.x = cvt_pk_bf16(v0[0], v0[1]); w.y = cvt_pk_bf16(v0[2], v0[3]); w.z = cvt_pk_bf16(v1[0], v1[1]); w.w = cvt_pk_bf16(v1[2], v1[3]);
                *(u32x4*)(bp + o_ + bj * HALF) = w;
                p += (v0[0] * v0[0] + v0[1] * v0[1]) + (v0[2] * v0[2] + v0[3] * v0[3]) + (v1[0] * v1[0] + v1[1] * v1[1]) + (v1[2] * v1[2] + v1[3] * v1[3]); }
            part[i] = p;
            if (i + 4 < 8) { EO_LOAD((i + 4) & 7); }
            asm volatile("" ::: "memory"); }
#undef EO_LOAD
#pragma unroll
        for (int i = 0; i < 8; ++i) part[i] += __shfl_xor(part[i], 16);
#pragma unroll
        for (int i = 0; i < 8; ++i) part[i] += __shfl_xor(part[i], 32);
        if (fq == 0) {
#pragma unroll
            for (int i = 0; i < 8; ++i) atomicAdd(ss + row0 + (i >> 2) * HALF + (i & 3) * 16, part[i]);
        }
    }
};

struct EpiGU {
    static constexpr bool PERM = true, AFTER_DRAIN = false;
    bf16_t* ACT; const float* ss;
    __device__ __forceinline__ void operator()(const f32x4 (&acc)[2][2][4][2], const Unit& u, int wr, int wc, int fr, int fq) const {
        const int row0 = u.pm * BM + wr * 64 + fr, col0 = u.pn * HALF + wc * 32 + 8 * fq;
        float sv[8];
#pragma unroll
        for (int i = 0; i < 8; ++i) sv[i] = ss[row0 + (i >> 2) * HALF + (i & 3) * 16];
        asm volatile("" ::: "memory");
#pragma unroll
        for (int i = 0; i < 8; ++i) { const int ai = i >> 2, m = i & 3;
            const float rstd = __builtin_amdgcn_rsqf(sv[i] * (1.0f / (float)D) + EPS), ne = -LOG2E * rstd, r2 = rstd * rstd;
            unsigned w[4];
#pragma unroll
            for (int n = 0; n < 2; ++n)
#pragma unroll
                for (int h = 0; h < 2; ++h) {
                    const f32x2 g = {acc[ai][0][m][n][2 * h], acc[ai][0][m][n][2 * h + 1]}, up = {acc[ai][1][m][n][2 * h], acc[ai][1][m][n][2 * h + 1]};
                    const f32x2 t = g * ne; f32x2 e; e.x = __builtin_amdgcn_exp2f(t.x); e.y = __builtin_amdgcn_exp2f(t.y);
                    const f32x2 d = e + 1.0f; f32x2 r; r.x = __builtin_amdgcn_rcpf(d.x); r.y = __builtin_amdgcn_rcpf(d.y);
                    const f32x2 a = (g * up) * (r * r2);
                    w[2 * n + h] = cvt_pk_bf16(a.x, a.y); }
            *(u32x4*)(ACT + (size_t)(row0 + ai * HALF + m * 16) * FF + col0) = (u32x4){w[0], w[1], w[2], w[3]};
        }
    }
};

struct EpiDown {
    static constexpr bool PERM = true, AFTER_DRAIN = false;
    const bf16_t* XB; float* out;
    __device__ __forceinline__ void operator()(const f32x4 (&acc)[2][2][4][2], const Unit& u, int wr, int wc, int fr, int fq) const {
        const int row0 = u.pm * BM + wr * 64 + fr, col0 = u.pn * BM + wc * 32 + 8 * fq;
        const size_t off0 = (size_t)row0 * D + col0;
        const bf16_t* __restrict__ bp = XB + off0; float* __restrict__ op = out + off0;
        u32x4 xa[8][2];
#define ED_LOAD(i) do { const size_t o_ = (size_t)(((i) >> 2) * HALF + ((i) & 3) * 16) * D; xa[i][0] = *(const u32x4*)(bp + o_); xa[i][1] = *(const u32x4*)(bp + o_ + HALF); } while (0)
        ED_LOAD(0); ED_LOAD(1); ED_LOAD(2); ED_LOAD(3);
        asm volatile("" ::: "memory");
#pragma unroll
        for (int i = 0; i < 8; ++i) { const int ai = i >> 2, m = i & 3; const size_t o_ = (size_t)(ai * HALF + m * 16) * D;
#pragma unroll
            for (int bj = 0; bj < 2; ++bj) { const u32x4 w = xa[i][bj];
                const f32x4 r0 = {__builtin_bit_cast(float, w.x << 16), __builtin_bit_cast(float, w.x & 0xffff0000u), __builtin_bit_cast(float, w.y << 16), __builtin_bit_cast(float, w.y & 0xffff0000u)};
                const f32x4 r1 = {__builtin_bit_cast(float, w.z << 16), __builtin_bit_cast(float, w.z & 0xffff0000u), __builtin_bit_cast(float, w.w << 16), __builtin_bit_cast(float, w.w & 0xffff0000u)};
                *(f32x4*)(op + o_ + bj * HALF) = acc[ai][bj][m][0] + r0; *(f32x4*)(op + o_ + bj * HALF + 4) = acc[ai][bj][m][1] + r1; }
            if (i + 4 < 8) { ED_LOAD((i + 4) & 7); }
            asm volatile("" ::: "memory"); }
#undef ED_LOAD
    }
};

template <class Epi, class Sched, bool ALIGN_EPI = false, bool SP2 = false>
__device__ __forceinline__ void gemm_phase(LAS unsigned char* lds, const Gemm g, const Sched& S, const Epi& E) {
    const int tid = threadIdx.x, wid = __builtin_amdgcn_readfirstlane(tid >> 6), lane = tid & 63, wr = wid >> 2, wc = wid & 3, fr = lane & 15, fq = lane >> 4;
    const int K = g.K, nt = K / BK;
    unsigned voffA[2], voffB[2];
#pragma unroll
    for (int i = 0; i < 2; ++i) { int R, C; stage_rc(tid * 16 + i * 8192, R, C); const int Rb = Epi::PERM ? ((R & ~31) + perm32(R & 31)) : R;
        voffA[i] = (unsigned)(R * K + C) * 2u; voffB[i] = (unsigned)(Rb * K + C) * 2u; }
    const size_t kstep = (size_t)(BK * 2);
    const size_t hstep = (size_t)HALF * K * 2;
    const size_t tstep = 2 * hstep;
    const unsigned ldsw = (unsigned)wid * 1024u;
    const int aoff = lds_byte(wr * 64 + fr, fq * 8), boff = lds_byte(wc * 32 + fr, fq * 8);
#define PG8_SA(b, h) (((b) * 2 + (h)) * HTB)
#define PG8_SB(b, h) ((4 + (b) * 2 + (h)) * HTB)
#define PG8_STAGE(bufoff, gbase, voff) do { _Pragma("unroll") for (int _i = 0; _i < 2; ++_i) \
        __builtin_amdgcn_global_load_lds((const unsigned*)((const char*)(gbase) + (voff)[_i]), (LAS unsigned*)(lds + (bufoff) + ldsw + _i * 8192), 16, 0, 0); } while (0)
#define PG8_LDA(dst, b, h) do { _Pragma("unroll") for (int m = 0; m < 4; ++m) _Pragma("unroll") for (int k = 0; k < 2; ++k) dst[m][k] = *(const LAS bf16x8*)(lds + PG8_SA(b, h) + aoff + m * 2048 + k * 1024); } while (0)
#define PG8_LDB(dst, b, h) do { _Pragma("unroll") for (int n = 0; n < 2; ++n) _Pragma("unroll") for (int k = 0; k < 2; ++k) dst[n][k] = *(const LAS bf16x8*)(lds + PG8_SB(b, h) + boff + n * 2048 + k * 1024); } while (0)
#define PG8_MMA(ai, bj, At, Bt) do { __builtin_amdgcn_s_setprio(1); _Pragma("unroll") for (int m = 0; m < 4; ++m) _Pragma("unroll") for (int n = 0; n < 2; ++n) _Pragma("unroll") for (int k = 0; k < 2; ++k) \
        acc[ai][bj][m][n] = __builtin_amdgcn_mfma_f32_16x16x32_bf16(Bt[n][k], At[m][k], acc[ai][bj][m][n], 0, 0, 0); __builtin_amdgcn_s_setprio(0); } while (0)
#define PG8_WAIT_V(n) asm volatile("s_waitcnt vmcnt(" #n ")" ::: "memory")
#define PG8_WAIT_L(n) asm volatile("s_waitcnt lgkmcnt(" #n ")" ::: "memory")
#define PG8_BAR __builtin_amdgcn_s_barrier()
#define PG8_SCHED __builtin_amdgcn_sched_barrier(0)
    Unit cur, nxt; int ui = 0;
    if (!S.next(0, cur)) return;
    f32x4 acc[2][2][4][2];
#pragma unroll
    for (int a = 0; a < 2; ++a)
#pragma unroll
        for (int b = 0; b < 2; ++b)
#pragma unroll
            for (int m = 0; m < 4; ++m)
#pragma unroll
                for (int n = 0; n < 2; ++n) acc[a][b][m][n] = (f32x4){0.f, 0.f, 0.f, 0.f};
    bf16x8 At[4][2], B0[2][2], B1[2][2];
    const char* cA = (const char*)g.A + (size_t)cur.pm * tstep; const char* cB = (const char*)g.Bt + (size_t)cur.pn * tstep;
    S.a_ready(cur);
    if constexpr (SP2) {
        PG8_STAGE(PG8_SB(0, 0), cB, voffB); PG8_STAGE(PG8_SB(0, 1), cB + hstep, voffB); PG8_STAGE(PG8_SA(0, 0), cA, voffA); PG8_STAGE(PG8_SA(0, 1), cA + hstep, voffA);
        if (wr == 1) PG8_BAR;
        PG8_WAIT_V(2); PG8_BAR;
        PG8_STAGE(PG8_SB(1, 0), cB + kstep, voffB); PG8_STAGE(PG8_SA(1, 0), cA + kstep, voffA); PG8_STAGE(PG8_SB(1, 1), cB + hstep + kstep, voffB);
        PG8_WAIT_V(6); PG8_BAR;
    } else {
        PG8_STAGE(PG8_SB(0, 0), cB, voffB); PG8_STAGE(PG8_SA(0, 0), cA, voffA); PG8_STAGE(PG8_SB(0, 1), cB + hstep, voffB); PG8_STAGE(PG8_SA(0, 1), cA + hstep, voffA);
        if (wr == 1) PG8_BAR;
        PG8_WAIT_V(4); PG8_BAR;
        PG8_STAGE(PG8_SB(1, 0), cB + kstep, voffB); PG8_STAGE(PG8_SA(1, 0), cA + kstep, voffA); PG8_STAGE(PG8_SB(1, 1), cB + hstep + kstep, voffB);
        PG8_WAIT_V(6); PG8_BAR;
    }
    for (;;) {
        const bool has_next = S.next(ui + 1, nxt);
        const char* nA = has_next ? (const char*)g.A + (size_t)nxt.pm * tstep : cA; const char* nB = has_next ? (const char*)g.Bt + (size_t)nxt.pn * tstep : cB;
        for (int t = 0; t < nt; t += 2) {
            const bool last = (t == nt - 2);
            const char* a1 = cA + (size_t)(t + 1) * kstep;
            const char* a2 = last ? nA : cA + (size_t)(t + 2) * kstep; const char* b2 = last ? nB : cB + (size_t)(t + 2) * kstep;
            const char* a3 = a2 + kstep; const char* b3 = b2 + kstep;
            if (last && has_next) S.a_ready(nxt);
            if constexpr (SP2) {
            PG8_LDB(B0, 0, 0); PG8_LDB(B1, 0, 1); PG8_SCHED; PG8_LDA(At, 0, 0); PG8_STAGE(PG8_SA(1, 1), a1 + hstep, voffA);
            PG8_WAIT_V(8); PG8_WAIT_L(0); PG8_BAR; PG8_MMA(0, 0, At, B0); PG8_MMA(0, 1, At, B1); PG8_BAR; PG8_SCHED;
            PG8_LDA(At, 0, 1); PG8_STAGE(PG8_SB(0, 0), b2, voffB); PG8_STAGE(PG8_SB(0, 1), b2 + hstep, voffB); PG8_STAGE(PG8_SA(0, 0), a2, voffA);
            PG8_WAIT_V(8); PG8_WAIT_L(0); PG8_BAR; PG8_MMA(1, 0, At, B0); PG8_MMA(1, 1, At, B1); PG8_BAR; PG8_SCHED;
            PG8_LDB(B0, 1, 0); PG8_LDB(B1, 1, 1); PG8_SCHED; PG8_LDA(At, 1, 0); PG8_STAGE(PG8_SA(0, 1), a2 + hstep, voffA);
            PG8_WAIT_V(8); PG8_WAIT_L(0); PG8_BAR; PG8_MMA(0, 0, At, B0); PG8_MMA(0, 1, At, B1); PG8_BAR; PG8_SCHED;
            PG8_LDA(At, 1, 1); PG8_STAGE(PG8_SB(1, 0), b3, voffB); PG8_STAGE(PG8_SB(1, 1), b3 + hstep, voffB); PG8_STAGE(PG8_SA(1, 0), a3, voffA);
            PG8_WAIT_V(8); PG8_WAIT_L(0); PG8_BAR; PG8_MMA(1, 0, At, B0); PG8_MMA(1, 1, At, B1); PG8_BAR; PG8_SCHED;
            } else {
            PG8_LDB(B0, 0, 0); PG8_SCHED; PG8_LDA(At, 0, 0); PG8_STAGE(PG8_SA(1, 1), a1 + hstep, voffA);
            PG8_WAIT_L(8); PG8_BAR; PG8_WAIT_L(0); PG8_MMA(0, 0, At, B0); PG8_BAR; PG8_SCHED;
            PG8_LDB(B1, 0, 1); PG8_STAGE(PG8_SB(0, 0), b2, voffB);
            PG8_BAR; PG8_WAIT_L(0); PG8_MMA(0, 1, At, B1); PG8_BAR;
            PG8_LDA(At, 0, 1); PG8_STAGE(PG8_SA(0, 0), a2, voffA);
            PG8_BAR; PG8_WAIT_L(0); PG8_MMA(1, 0, At, B0); PG8_BAR; PG8_SCHED;
            PG8_STAGE(PG8_SB(0, 1), b2 + hstep, voffB);
            PG8_WAIT_V(6); PG8_BAR; PG8_MMA(1, 1, At, B1); PG8_BAR;
            PG8_LDB(B0, 1, 0); PG8_SCHED; PG8_LDA(At, 1, 0); PG8_STAGE(PG8_SA(0, 1), a2 + hstep, voffA);
            PG8_WAIT_L(8); PG8_BAR; PG8_WAIT_L(0); PG8_MMA(0, 0, At, B0); PG8_BAR; PG8_SCHED;
            PG8_LDB(B1, 1, 1); PG8_STAGE(PG8_SB(1, 0), b3, voffB);
            PG8_BAR; PG8_WAIT_L(0); PG8_MMA(0, 1, At, B1); PG8_BAR;
            PG8_LDA(At, 1, 1); PG8_STAGE(PG8_SA(1, 0), a3, voffA);
            PG8_BAR; PG8_WAIT_L(0); PG8_MMA(1, 0, At, B0); PG8_BAR; PG8_SCHED;
            PG8_STAGE(PG8_SB(1, 1), b3 + hstep, voffB);
            PG8_WAIT_V(6); PG8_BAR; PG8_MMA(1, 1, At, B1); PG8_BAR;
            }
        }
        if constexpr (ALIGN_EPI) { if (wr == 0) PG8_BAR; }
        if constexpr (!Epi::AFTER_DRAIN) { E(acc, cur, wr, wc, fr, fq); S.done(cur); }
        if (!has_next) break;
#pragma unroll
        for (int a = 0; a < 2; ++a)
#pragma unroll
            for (int b = 0; b < 2; ++b)
#pragma unroll
                for (int m = 0; m < 4; ++m)
#pragma unroll
                    for (int n = 0; n < 2; ++n) acc[a][b][m][n] = (f32x4){0.f, 0.f, 0.f, 0.f};
        cur = nxt; cA = nA; cB = nB; ++ui;
        if constexpr (ALIGN_EPI) { if (wr == 1) PG8_BAR; }
    }
    PG8_WAIT_V(0);
    if constexpr (!ALIGN_EPI) { if (wr == 0) PG8_BAR; }
    PG8_BAR;
#undef PG8_SA
#undef PG8_SB
#undef PG8_STAGE
#undef PG8_LDA
#undef PG8_LDB
#undef PG8_MMA
#undef PG8_WAIT_V
#undef PG8_WAIT_L
#undef PG8_BAR
#undef PG8_SCHED
}
}

constexpr int NWAVES = 8;
#ifndef MK_N_LAUNCHES
#define MK_N_LAUNCHES 1
#endif
constexpr int N_LAUNCHES = MK_N_LAUNCHES;
constexpr int PER_PHASE = 6;
#ifndef PG8_SP2
#define PG8_SP2 true
#endif

constexpr size_t MiB = 1u << 20;
constexpr size_t WS_CTL = 0, CTL_ZERO_BYTES = 1 * MiB;
constexpr size_t WS_WIN = 2 * MiB;
constexpr size_t WS_WOUT = 6 * MiB;
constexpr size_t WS_WGU = 8 * MiB;
constexpr size_t WS_WDN = 20 * MiB;
constexpr size_t WS_XN = 32 * MiB;
constexpr size_t WS_QKVZ = 160 * MiB;
constexpr size_t WS_ACT = 416 * MiB;
constexpr size_t WS_XB = 768 * MiB;
constexpr size_t WS_END = 896 * MiB;
static_assert(WS_WGU + (size_t)NGU * D * 2 <= WS_WDN && WS_WDN + (size_t)D * FF * 2 <= WS_XN && WS_ACT + (size_t)M * FF * 2 <= WS_END, "d_ws map");
constexpr int CW_BAR = 4096;
constexpr int CW_SS = 65536;
static_assert((size_t)(CW_SS + M) * 4 <= CTL_ZERO_BYTES, "ss inside the memset region");

constexpr int RING_OFF = 0, RING_BYTES = 131072;
constexpr int LDSCTL_OFF = RING_BYTES, MISC_OFF = LDSCTL_OFF + 320;
constexpr int LDS_GAIN_OFF = LDSCTL_OFF + 512;
constexpr int LDS_BYTES = 147456;

typedef GAS unsigned gu32;
#define RLX_AGENT __ATOMIC_RELAXED, __HIP_MEMORY_SCOPE_AGENT
#define LDS_WAIT() asm volatile("s_waitcnt lgkmcnt(0)" ::: "memory")
__device__ __forceinline__ unsigned f2bf(float f) { unsigned u = __builtin_bit_cast(unsigned, f); return (u + 0x7fffu + ((u >> 16) & 1u)) >> 16; }
__device__ __forceinline__ unsigned pk2(float lo, float hi) { return f2bf(lo) | (f2bf(hi) << 16); }
__device__ __forceinline__ float bflo(unsigned w) { return __builtin_bit_cast(float, w << 16); }
__device__ __forceinline__ float bfhi(unsigned w) { return __builtin_bit_cast(float, w & 0xffff0000u); }

#define XB_TMO      128
#define XB_XCNT(j)  (256  + 64 * (j))
#define XB_XSUB(j)  (1280 + 64 * (j))
#define XB_XGEN(j)  (2304 + 64 * (j))
#define XB_TOP      3328
#define XB_TOPGEN   3392
#define XCD_BAR_WORDS 3456
#define XB_SPIN_CAP (1u << 18)

__device__ __forceinline__ unsigned xb_ld(unsigned* p)              { return __hip_atomic_load(p, __ATOMIC_RELAXED, __HIP_MEMORY_SCOPE_AGENT); }
__device__ __forceinline__ unsigned xb_add(unsigned* p, unsigned v) { return __hip_atomic_fetch_add(p, v, __ATOMIC_RELAXED, __HIP_MEMORY_SCOPE_AGENT); }
__device__ __forceinline__ unsigned xb_xcc_id() { return (unsigned)__builtin_amdgcn_s_getreg((3 << 11) | 20) & 0xFu; }
#define XB_SPIN(cond, bar) do { unsigned _sp = 0; while (cond) { __builtin_amdgcn_s_sleep(1); \
    if ((++_sp & 255u) == 0u) { if (xb_ld(&(bar)[XB_TMO])) break; if (_sp > XB_SPIN_CAP) { atomicAdd(&(bar)[XB_TMO], 1u); break; } } } } while (0)

struct XcdBarrier { unsigned* bar; unsigned x; volatile LAS unsigned* st; };

__device__ __forceinline__ XcdBarrier xcd_barrier_post(unsigned* bar, volatile LAS unsigned* st) {
    XcdBarrier b; b.bar = bar; b.x = xb_xcc_id(); b.st = st;
    if (threadIdx.x == 0) (void)xb_add(&bar[XB_XCNT(b.x)], 1u);
    return b;
}
__device__ __forceinline__ void xcd_barrier_complete(unsigned* bar, unsigned x, unsigned& nloc, unsigned& nx) {
    const unsigned G = gridDim.x * gridDim.y * gridDim.z;
    unsigned sum, cnt, mine, sp = 0u;
    for (;;) {
        sum = 0u; cnt = 0u; mine = 0u;
#pragma unroll
        for (unsigned j = 0; j < 16; ++j) { const unsigned c = xb_ld(&bar[XB_XCNT(j)]); sum += c; cnt += (c > 0u) ? 1u : 0u; mine = (j == x) ? c : mine; }
        if (sum == G) break;
        __builtin_amdgcn_s_sleep(1);
        if ((++sp & 255u) == 0u) { if (xb_ld(&bar[XB_TMO])) break; if (sp > XB_SPIN_CAP) { atomicAdd(&bar[XB_TMO], 1u); break; } }
    }
    nloc = mine > 0u ? mine : 1u; nx = cnt > 0u ? cnt : 1u;
}
__device__ __forceinline__ void xcd_barrier(const XcdBarrier& b) {
    asm volatile("s_waitcnt vmcnt(0)" ::: "memory");
    __syncthreads();
    if (threadIdx.x == 0) {
        unsigned* bar = b.bar;
        __builtin_amdgcn_s_waitcnt(0);
        unsigned nloc = b.st[0], nx = b.st[1];
        if (nloc == 0u) { xcd_barrier_complete(bar, b.x, nloc, nx); b.st[0] = nloc; b.st[1] = nx; }
        const unsigned old = xb_add(&bar[XB_XSUB(b.x)], 1u);
        const unsigned gen = old / nloc;
        if (old + 1u == (gen + 1u) * nloc) {
            __builtin_amdgcn_fence(__ATOMIC_RELEASE, "agent");
            asm volatile("s_waitcnt vmcnt(0)" ::: "memory");
            const unsigned og = xb_add(&bar[XB_TOP], 1u);
            const unsigned tg = og / nx;
            if (og + 1u == (tg + 1u) * nx) xb_add(&bar[XB_TOPGEN], 1u);
            else XB_SPIN(xb_ld(&bar[XB_TOPGEN]) == tg, bar);
            __builtin_amdgcn_fence(__ATOMIC_ACQUIRE, "agent");
            xb_add(&bar[XB_XGEN(b.x)], 1u);
            asm volatile("s_waitcnt vmcnt(0)" ::: "memory");
        } else {
            XB_SPIN(xb_ld(&bar[XB_XGEN(b.x)]) == gen, bar);
            __builtin_amdgcn_fence(__ATOMIC_ACQUIRE, "agent");
            asm volatile("s_waitcnt vmcnt(0)" ::: "memory");
        }
    }
    __syncthreads();
}

struct Frame {
    LAS unsigned char* lds;
    volatile LAS unsigned* MISC;
    gu32* ctl;
    int tid, lane, wave;
    int vcu, G;
    const float *x, *g1, *w_in, *gq, *gk, *rpb, *w_pool, *pscale, *w_out, *g2, *w_gate, *w_up, *w_down;
    float* out;
    bf16_t *Win_t, *Wout_t, *Wgu_t, *Wdn_t;
    bf16_t *XN, *QKVZ, *XB, *ACT;
    float* ss;
};

__device__ __forceinline__ float wave_sum(float v) {
#pragma unroll
    for (int o = 1; o < 64; o <<= 1) v += __shfl_xor(v, o);
    return v;
}

__device__ __forceinline__ void p0_tile_out(bf16_t* WT, int K, int drow0, int k0, LAS float* scr, int lane) {
    LDS_WAIT(); asm volatile("" ::: "memory");
    const int c = lane & 7;
#pragma unroll
    for (int j = 0; j < 4; ++j) { const int n = (lane >> 3) + 8 * j; const LAS float* s = scr + (8 * c) * 33 + n;
        u32x4 o; o.x = pk2(s[0 * 33], s[1 * 33]); o.y = pk2(s[2 * 33], s[3 * 33]); o.z = pk2(s[4 * 33], s[5 * 33]); o.w = pk2(s[6 * 33], s[7 * 33]);
        *(GAS u32x4*)(WT + (size_t)(drow0 + n) * K + k0 + 8 * c) = o; }
    LDS_WAIT(); asm volatile("" ::: "memory");
}
__device__ __forceinline__ void p0_transpose_item(const float* W, int ldw, int K, int k0, int n0, const float* gkv, bf16_t* WT, int drow0, LAS float* scr, int lane) {
#pragma unroll
    for (int i = 0; i < 32; ++i) { const int kk = 2 * i + (lane >> 5); float v = W[(size_t)(k0 + kk) * ldw + n0 + (lane & 31)]; if (gkv) v *= gkv[k0 + kk]; scr[kk * 33 + (lane & 31)] = v; }
    p0_tile_out(WT, K, drow0, k0, scr, lane);
}
__device__ __forceinline__ void p0_fold_item(const float* w_in, const float* w_pool, const float* pscale, int k0, int n0z, bf16_t* WT, int drow0, int lane) {
    const int n = lane & 31, kh = lane >> 5, g = n0z >> 7, d = (n0z & 127) + n;
    float acc[4] = {0.f, 0.f, 0.f, 0.f};
    const float* wrow = w_in + (size_t)(k0 + 4 * kh) * NIN + 3 * NA + 128 * g;
    const float* wp = w_pool + (size_t)g * 128 * 128 + d;
#pragma unroll 8
    for (int c4 = 0; c4 < 32; ++c4) {
        const float p0 = wp[(4 * c4 + 0) * 128], p1 = wp[(4 * c4 + 1) * 128], p2 = wp[(4 * c4 + 2) * 128], p3 = wp[(4 * c4 + 3) * 128];
#pragma unroll
        for (int i = 0; i < 4; ++i) { const f32x4 w = *(const f32x4*)(wrow + (size_t)i * NIN + 4 * c4); acc[i] += (w[0] * p0 + w[1] * p1) + (w[2] * p2 + w[3] * p3); }
    }
    const float ps = pscale[n0z + n];
    float hi[4];
#pragma unroll
    for (int i = 0; i < 4; ++i) { acc[i] *= ps; hi[i] = __shfl(acc[i], (lane + 32) & 63); }
    if (lane < 32) { u32x4 o; o.x = pk2(acc[0], acc[1]); o.y = pk2(acc[2], acc[3]); o.z = pk2(hi[0], hi[1]); o.w = pk2(hi[2], hi[3]);
        *(GAS u32x4*)(WT + (size_t)(drow0 + n) * D + k0) = o; }
}
__device__ __forceinline__ int win_drow(int n0) { const int pn = n0 >> 8, c = n0 & 255; return 256 * pn + 128 * ((c >> 5) & 1) + 32 * (c >> 6); }

template <int R> __device__ __forceinline__ void rms_rows(const float* x, const f32x4 (&gg)[4], bf16_t* XN, int m0, int lane) {
    f32x4 v[R][4]; float s[R];
#pragma unroll
    for (int r = 0; r < R; ++r) { const GAS f32x4* xr = (const GAS f32x4*)(x + (size_t)(m0 + r) * D) + lane;
#pragma unroll
        for (int j = 0; j < 4; ++j) v[r][j] = xr[64 * j]; }
#pragma unroll
    for (int r = 0; r < R; ++r) { float a = 0.f;
#pragma unroll
        for (int j = 0; j < 4; ++j) a += (v[r][j].x * v[r][j].x + v[r][j].y * v[r][j].y) + (v[r][j].z * v[r][j].z + v[r][j].w * v[r][j].w);
        s[r] = a; }
#pragma unroll
    for (int o = 1; o < 64; o <<= 1) {
#pragma unroll
        for (int r = 0; r < R; ++r) s[r] += __shfl_xor(s[r], o); }
#pragma unroll
    for (int r = 0; r < R; ++r) { const float rstd = __builtin_amdgcn_rsqf(s[r] * (1.f / D) + EPS);
        GAS unsigned long long* o8 = (GAS unsigned long long*)(XN + (size_t)(m0 + r) * D) + lane;
#pragma unroll
        for (int j = 0; j < 4; ++j) o8[64 * j] = (unsigned long long)pk2(v[r][j].x * rstd * gg[j].x, v[r][j].y * rstd * gg[j].y) | ((unsigned long long)pk2(v[r][j].z * rstd * gg[j].z, v[r][j].w * rstd * gg[j].w) << 32); }
}

__device__ __forceinline__ void p0_prologue(Frame& F) {
    LAS float* scr = (LAS float*)(F.lds + RING_OFF + F.wave * 16384);
    if (F.wave >= 4) {
        const int gw = F.vcu * 4 + (F.wave - 4), NGW = F.G * 4;
        constexpr int KB = D / 64;
        constexpr int I_QKV = KB * (3 * NA / 32), I_O = KB * (D / 32), I_G = KB * (FF / 32), I_DN = (FF / 64) * (D / 32);
        constexpr int NITEMS = I_QKV + I_O + 2 * I_G + I_DN;
        for (int it = gw; it < (D / 8) * (NA / 32); it += NGW) { const int nb = it & 15, kb = it >> 4; p0_fold_item(F.w_in, F.w_pool, F.pscale, 8 * kb, 32 * nb, F.Win_t, win_drow(3 * NA + 32 * nb), F.lane); }
        for (int it = gw; it < NITEMS; it += NGW) {
            int r = it;
            if (r < I_QKV) { const int nb = r % (3 * NA / 32), kb = r / (3 * NA / 32); p0_transpose_item(F.w_in, NIN, D, 64 * kb, 32 * nb, nullptr, F.Win_t, win_drow(32 * nb), scr, F.lane); continue; } r -= I_QKV;
            if (r < I_O) { const int nb = r % (D / 32), kb = r / (D / 32); p0_transpose_item(F.w_out, D, D, 64 * kb, 32 * nb, nullptr, F.Wout_t, 32 * nb, scr, F.lane); continue; } r -= I_O;
            if (r < 2 * I_G) { const int up = r >= I_G; if (up) r -= I_G; const int nb = r % (FF / 32), kb = r / (FF / 32), n0 = 32 * nb;
                p0_transpose_item(up ? F.w_up : F.w_gate, FF, D, 64 * kb, n0, F.g2, F.Wgu_t, 256 * (n0 >> 7) + (n0 & 127) + 128 * up, scr, F.lane); continue; } r -= 2 * I_G;
            { const int nb = r % (D / 32), kb = r / (D / 32); p0_transpose_item(F.w_down, D, FF, 64 * kb, 32 * nb, nullptr, F.Wdn_t, 32 * nb, scr, F.lane); }
        }
    }
    f32x4 gg[4];
#pragma unroll
    for (int j = 0; j < 4; ++j) gg[j] = *((const f32x4*)F.g1 + F.lane + 64 * j);
    const int RPW = (M + F.G - 1) / F.G, rbeg = F.vcu * RPW, rend = (rbeg + RPW) < M ? (rbeg + RPW) : M, nb8 = (rend - rbeg) / 8;
    volatile LAS unsigned* tick = F.MISC + 16;
    for (;;) {
        unsigned t = 0; if (F.lane == 0) t = __hip_atomic_fetch_add((LAS unsigned*)tick, 1u, __ATOMIC_RELAXED, __HIP_MEMORY_SCOPE_WORKGROUP);
        t = __builtin_amdgcn_readfirstlane(t);
        if ((int)t >= nb8) break;
        rms_rows<8>(F.x, gg, F.XN, rbeg + 8 * (int)t, F.lane);
    }
    if (F.wave == 0) for (int m = rbeg + 8 * nb8; m < rend; ++m) rms_rows<1>(F.x, gg, F.XN, m, F.lane);
}

constexpr int AT_A = 0;
constexpr int AT_B = 61440;
constexpr int AT_TAB = 122880;
static_assert(AT_TAB + 15 * 64 * 4 <= RING_BYTES, "attention LDS map");
__device__ __forceinline__ int rs_of(int r) { int v = r - 4; v = v < 0 ? 0 : v; return v > 56 ? 56 : v; }

struct AttnUnit { int b, h, j, r0, krow_lo, nrows, kc0; };
__device__ __forceinline__ AttnUnit attn_decode(int un) {
    AttnUnit u; const int bh = un >> 5, rc = (un >> 2) & 7; u.j = un & 3; u.b = bh >> 3; u.h = bh & 7;
    u.r0 = 8 * rc; u.krow_lo = rs_of(u.r0); u.nrows = rs_of(u.r0 + 7) + 8 - u.krow_lo;
    u.kc0 = (u.j == 0) ? 0 : (u.j == 1) ? 8 : (u.j == 2) ? 24 : 32;
    return u;
}
__device__ __forceinline__ void glds16(const void* gsrc, unsigned lds_dst) { unsigned keep;
    asm volatile("s_mov_b32 %0, m0\n\ts_mov_b32 m0, %2\n\ts_nop 0\n\tglobal_load_lds_dwordx4 %1, off\n\ts_mov_b32 m0, %0" : "=&s"(keep) : "v"(gsrc), "s"(lds_dst) : "memory"); }
#define ATT_WAIT_BAR() do { asm volatile("s_waitcnt vmcnt(0) lgkmcnt(0)" ::: "memory"); __builtin_amdgcn_s_barrier(); asm volatile("" ::: "memory"); } while (0)
template <int KIND> __device__ __forceinline__ void attn_dma(unsigned dst, const bf16_t* src, const AttnUnit& u, int wid, int lane) {
    const int np = u.nrows * 4;
    const char* base = (const char*)(src + ((size_t)(u.b * SEQ + u.krow_lo * 64 + u.kc0)) * NA + u.h * HD);
#pragma unroll
    for (int it = 0; it < 8; ++it) {
        const int pi = it * 8 + wid;
        if (pi < np) {
            const int ts = 8 * pi + (lane >> 3), pos = ts & 31, w = ts >> 5;
            int kk, sw;
            if (KIND == 0) { kk = ((pos >> 4) & 1) * 4 + ((pos >> 2) & 3) * 8 + (pos & 3); sw = (ts >> 1) & 7; }
            else { kk = (pos & 0x13) | ((pos & 4) << 1) | ((pos & 8) >> 1); sw = ((ts >> 1) & 3) << 1; }
            const int ch = (lane & 7) ^ sw;
            const char* gp = base + (size_t)(w * 64 + kk) * (NA * 2) + ch * 16;
            glds16(gp, (unsigned)__builtin_amdgcn_readfirstlane(dst + pi * 1024));
        }
    }
}

__device__ __forceinline__ void p2_attention(Frame& F, const bf16_t* Qg, const bf16_t* Kg, const bf16_t* Vg, bf16_t* MIX) {
    const int lane = F.lane, wid = F.wave;
    LAS unsigned char* lds = F.lds;
    const unsigned lds0 = (unsigned)(size_t)F.lds;
    const int q = lane & 15, g = lane >> 4;
    constexpr int NUNITS = BATCH * NHEAD * 32;
    for (int uidx = F.vcu * 16; uidx < NUNITS; uidx += F.G * 16) {
        const int h = (uidx >> 5) & 7;
        __syncthreads();
        {   LAS float* tab = (LAS float*)(lds + AT_TAB);
            for (int i = F.tid; i < 15 * 64; i += NWAVES * 64) { const int rr = i >> 6, cc = (i & 63) - 16; tab[i] = (cc >= 0 && cc < 31) ? F.rpb[h * 465 + rr * 31 + cc] * LOG2E : 0.f; } }
        AttnUnit u = attn_decode(uidx);
        attn_dma<0>(lds0 + AT_A, Kg, u, wid, lane);
        bf16x8 qf0, qf1;
        { const bf16_t* qp = Qg + ((size_t)(u.b * SEQ + (u.r0 + wid) * 64 + 16 * u.j + q)) * NA + u.h * HD + 8 * g; qf0 = *(const bf16x8*)qp; qf1 = *(const bf16x8*)(qp + 32); }
        ATT_WAIT_BAR();
        for (int ui = 0; ui < 16; ++ui) {
            asm volatile("" : "+v"(qf0), "+v"(qf1));
            attn_dma<1>(lds0 + AT_B, Vg, u, wid, lane);
            const int r = u.r0 + wid, rs = rs_of(r), wbase = rs - u.krow_lo;
            const int cq = 16 * u.j + q;
            int cs = cq - 8; cs = cs < 0 ? 0 : cs; cs = cs > 48 ? 48 : cs;
            f32x4 sc[8][2];
            {
                const int x0 = g ^ (q >> 1);
                const LAS unsigned char* ka = lds + AT_A + wbase * 4096 + q * 128;
                const LAS unsigned char* k0p = ka + x0 * 16;
                const LAS unsigned char* k1p = ka + (x0 ^ 4) * 16;
#pragma unroll
                for (int wl = 0; wl < 8; ++wl)
#pragma unroll
                    for (int blk = 0; blk < 2; ++blk) {
                        const bf16x8 k0 = *(const LAS bf16x8*)(k0p + wl * 4096 + blk * 2048), k1 = *(const LAS bf16x8*)(k1p + wl * 4096 + blk * 2048);
                        f32x4 a = (f32x4){0.f, 0.f, 0.f, 0.f};
                        a = __builtin_amdgcn_mfma_f32_16x16x32_bf16(k0, qf0, a, 0, 0, 0);
                        a = __builtin_amdgcn_mfma_f32_16x16x32_bf16(k1, qf1, a, 0, 0, 0);
                        sc[wl][blk] = a;
                    }
            }
            const LAS float* tab = (const LAS float*)(lds + AT_TAB) + (rs - r + 7) * 64 + 16 + (u.kc0 - cq + 15) + 8 * g;
            const int voff = u.kc0 + 8 * g - cs;
            float mx = -INFINITY;
#pragma unroll
            for (int wl = 0; wl < 8; ++wl)
#pragma unroll
                for (int blk = 0; blk < 2; ++blk)
#pragma unroll
                    for (int e = 0; e < 4; ++e) {
                        const int ep = 4 * blk + e;
                        float s = sc[wl][blk][e] + tab[wl * 64 + ep];
                        s = ((unsigned)(voff + ep) < 16u) ? s : -INFINITY;
                        sc[wl][blk][e] = s; mx = fmaxf(mx, s);
                    }
            mx = fmaxf(mx, __shfl_xor(mx, 16)); mx = fmaxf(mx, __shfl_xor(mx, 32));
            float l = 0.f; u32x4 pw[8];
#pragma unroll
            for (int wl = 0; wl < 8; ++wl) {
                float p[8];
#pragma unroll
                for (int blk = 0; blk < 2; ++blk)
#pragma unroll
                    for (int e = 0; e < 4; ++e) { p[4 * blk + e] = __builtin_amdgcn_exp2f(sc[wl][blk][e] - mx); l += p[4 * blk + e]; }
                pw[wl].x = cvt_pk_bf16(p[0], p[1]); pw[wl].y = cvt_pk_bf16(p[2], p[3]); pw[wl].z = cvt_pk_bf16(p[4], p[5]); pw[wl].w = cvt_pk_bf16(p[6], p[7]);
            }
            l += __shfl_xor(l, 16); l += __shfl_xor(l, 32);
            const float il = __builtin_amdgcn_rcpf(l);
            ATT_WAIT_BAR();
            AttnUnit un = u; bf16x8 nq0 = qf0, nq1 = qf1;
            if (ui < 15) {
                un = attn_decode(uidx + ui + 1);
                attn_dma<0>(lds0 + AT_A, Kg, un, wid, lane);
                const bf16_t* qp = Qg + ((size_t)(un.b * SEQ + (un.r0 + wid) * 64 + 16 * un.j + q)) * NA + un.h * HD + 8 * g; nq0 = *(const bf16x8*)qp; nq1 = *(const bf16x8*)(qp + 32);
            }
            f32x4 o[4];
#pragma unroll
            for (int n = 0; n < 4; ++n) o[n] = (f32x4){0.f, 0.f, 0.f, 0.f};
            {
                const int qr = q >> 2, p = lane & 3;
                const int pos_lo = (g >> 1) * 16 + (g & 1) * 4 + qr, sw = ((g & 1) * 2 + (qr >> 1)) << 1;
                const LAS unsigned char* vb = lds + AT_B + (wbase * 32 + pos_lo) * 128 + (p >> 1) * 16 + (p & 1) * 8;
                const LAS unsigned char* vn[4];
#pragma unroll
                for (int n = 0; n < 4; ++n) vn[n] = vb + ((2 * n) ^ sw) * 16;
#pragma unroll
                for (int wl = 0; wl < 8; ++wl) {
                    const bf16x8 pf = __builtin_bit_cast(bf16x8, pw[wl]);
#pragma unroll
                    for (int n = 0; n < 4; ++n) {
                        const s16x4 lo = __builtin_bit_cast(s16x4, __builtin_amdgcn_ds_read_tr16_b64_v4i16((LAS s16x4*)(vn[n] + wl * 4096)));
                        const s16x4 hi = __builtin_bit_cast(s16x4, __builtin_amdgcn_ds_read_tr16_b64_v4i16((LAS s16x4*)(vn[n] + wl * 4096 + 1024)));
                        const bf16x8 vf = (bf16x8){lo[0], lo[1], lo[2], lo[3], hi[0], hi[1], hi[2], hi[3]};
                        o[n] = __builtin_amdgcn_mfma_f32_16x16x32_bf16(vf, pf, o[n], 0, 0, 0);
                    }
                }
            }
            bf16_t* op = MIX + ((size_t)(u.b * SEQ + r * 64 + cq)) * D + u.h * HD + 4 * g;
#pragma unroll
            for (int n = 0; n < 4; ++n) { u32x2 w; w.x = cvt_pk_bf16(o[n][0] * il, o[n][1] * il); w.y = cvt_pk_bf16(o[n][2] * il, o[n][3] * il); *(u32x2*)(op + 16 * n) = w; }
            ATT_WAIT_BAR();
            u = un; qf0 = nq0; qf1 = nq1;
        }
    }
}

__device__ __forceinline__ void up8(const u32x4 w, float (&v)[8]) {
    v[0] = bflo(w.x); v[1] = bfhi(w.x); v[2] = bflo(w.y); v[3] = bfhi(w.y); v[4] = bflo(w.z); v[5] = bfhi(w.z); v[6] = bflo(w.w); v[7] = bfhi(w.w);
}
__device__ __forceinline__ void pool_run(const bf16_t* __restrict__ Zg, bf16_t* __restrict__ MIX, int gw, int lane) {
    const int tb = 32 * gw, b = tb >> 12, t0 = tb & (SEQ - 1);
    const int half = 1 << (lane >> 4);
    const bf16_t* zb = Zg + (size_t)(b * SEQ) * NA + 8 * lane;
    bf16_t* ob = MIX + (size_t)(b * SEQ) * D + NA + 8 * lane;
    float S[8];
#pragma unroll
    for (int e = 0; e < 8; ++e) S[e] = 0.f;
    {   u32x4 w[16];
#pragma unroll
        for (int d = 0; d < 16; ++d) { int i = t0 + d - 8; i = i < 0 ? 0 : i; i = i > SEQ - 1 ? SEQ - 1 : i; w[d] = *(const u32x4*)(zb + (size_t)i * NA); }
#pragma unroll
        for (int d = 0; d < 16; ++d) { const int dd = d - 8, i = t0 + dd; const float mk = (dd >= -half && dd < half && i >= 0 && i < SEQ) ? 1.f : 0.f; float v[8]; up8(w[d], v);
#pragma unroll
            for (int e = 0; e < 8; ++e) S[e] += mk * v[e]; } }
    for (int c = 0; c < 4; ++c) {
        u32x4 zt[8], za[8], zs[8];
#pragma unroll
        for (int k = 0; k < 8; ++k) { const int t = t0 + 8 * c + k; int ia = t + half, is = t - half; ia = ia > SEQ - 1 ? SEQ - 1 : ia; is = is < 0 ? 0 : is;
            zt[k] = *(const u32x4*)(zb + (size_t)t * NA); za[k] = *(const u32x4*)(zb + (size_t)ia * NA); zs[k] = *(const u32x4*)(zb + (size_t)is * NA); }
#pragma unroll
        for (int k = 0; k < 8; ++k) { const int t = t0 + 8 * c + k;
            const int lo = (t - half) < 0 ? 0 : (t - half), hi = (t + half) > SEQ ? SEQ : (t + half);
            const float inv = 1.0f / (float)(hi - lo);
            float v[8]; up8(zt[k], v);
            u32x4 w;
            w.x = cvt_pk_bf16(S[0] * inv - v[0], S[1] * inv - v[1]); w.y = cvt_pk_bf16(S[2] * inv - v[2], S[3] * inv - v[3]);
            w.z = cvt_pk_bf16(S[4] * inv - v[4], S[5] * inv - v[5]); w.w = cvt_pk_bf16(S[6] * inv - v[6], S[7] * inv - v[7]);
            *(u32x4*)(ob + (size_t)t * D) = w;
            const float ma = (t + half < SEQ) ? 1.f : 0.f, ms = (t - half >= 0) ? 1.f : 0.f;
            float a[8], s[8]; up8(za[k], a); up8(zs[k], s);
#pragma unroll
            for (int e = 0; e < 8; ++e) S[e] += ma * a[e] - ms * s[e]; }
    }
}

__device__ __forceinline__ void p2_mixer(Frame& F) {
    const bf16_t* Qg = F.QKVZ; const bf16_t* Kg = F.QKVZ + (size_t)M * NA; const bf16_t* Vg = F.QKVZ + 2 * (size_t)M * NA; const bf16_t* Zg = F.QKVZ + 3 * (size_t)M * NA;
    bf16_t* MIX = F.XN;
    for (int gw = F.vcu * NWAVES + F.wave; gw < M / 32; gw += F.G * NWAVES) pool_run(Zg, MIX, gw, F.lane);
    p2_attention(F, Qg, Kg, Vg, MIX);
    __syncthreads();
}

struct Args { const float* in[13]; float* out; unsigned char* ws; int ph_lo, ph_hi, li, pad; };
__global__ void __launch_bounds__(NWAVES * 64, 2) fwd_megakernel(Args args) {
    extern __shared__ __attribute__((aligned(16))) unsigned char lds[];
    Frame F;
    F.lds = (LAS unsigned char*)lds;
    F.MISC = (volatile LAS unsigned*)(F.lds + MISC_OFF);
    F.tid = threadIdx.x; F.lane = F.tid & 63; F.wave = __builtin_amdgcn_readfirstlane(F.tid >> 6);
    F.G = gridDim.x; { const int bx = blockIdx.x; F.vcu = (F.G % 8 == 0) ? (bx % 8) * (F.G / 8) + bx / 8 : bx; }
    unsigned char* ws = args.ws;
    F.ctl = (gu32*)(ws + WS_CTL);
    F.x = args.in[0]; F.g1 = args.in[1]; F.w_in = args.in[2]; F.gq = args.in[3]; F.gk = args.in[4]; F.rpb = args.in[5]; F.w_pool = args.in[6];
    F.pscale = args.in[7]; F.w_out = args.in[8]; F.g2 = args.in[9]; F.w_gate = args.in[10]; F.w_up = args.in[11]; F.w_down = args.in[12]; F.out = args.out;
    F.Win_t = (bf16_t*)(ws + WS_WIN); F.Wout_t = (bf16_t*)(ws + WS_WOUT); F.Wgu_t = (bf16_t*)(ws + WS_WGU); F.Wdn_t = (bf16_t*)(ws + WS_WDN);
    F.XN = (bf16_t*)(ws + WS_XN); F.QKVZ = (bf16_t*)(ws + WS_QKVZ); F.XB = (bf16_t*)(ws + WS_XB); F.ACT = (bf16_t*)(ws + WS_ACT);
    F.ss = (float*)(ws + WS_CTL) + CW_SS;
    for (int u = F.tid; u < (LDS_BYTES - LDSCTL_OFF) / 4; u += NWAVES * 64) ((LAS unsigned*)(F.lds + LDSCTL_OFF))[u] = 0u;
    __syncthreads();
    XcdBarrier bar; bar.bar = (unsigned*)(F.ctl + CW_BAR); bar.x = 0; bar.st = nullptr;
    if (N_LAUNCHES != PER_PHASE) bar = xcd_barrier_post((unsigned*)(F.ctl + CW_BAR), F.MISC + 8);
#define GRID_BAR() do { if (N_LAUNCHES != PER_PHASE) xcd_barrier(bar); } while (0)
    const int lo = args.ph_lo, hi = args.ph_hi;
#define IN(k) (lo <= (k) && (k) < hi)
#define BOTH(k) (IN(k) && IN((k) + 1))

    if (IN(0)) { p0_prologue(F); if (BOTH(0)) GRID_BAR(); }

    if (IN(1)) {
        pg8::Gemm g{F.XN, F.Win_t, M, NIN, D}; pg8::StaticOrder S; S.init(M, NIN, F.G, (int)blockIdx.x);
        { LAS float* gl = (LAS float*)(F.lds + LDS_GAIN_OFF);
          if (F.tid < 64) gl[F.tid] = F.gq[F.tid] * (0.125f * LOG2E); else if (F.tid < 128) gl[F.tid] = F.gk[F.tid - 64];
          __syncthreads(); }
        pg8::EpiIn E{F.QKVZ, (const LAS float*)(F.lds + LDS_GAIN_OFF)};
        pg8::gemm_phase<pg8::EpiIn, pg8::StaticOrder, true, PG8_SP2>(F.lds + RING_OFF, g, S, E);
        if (BOTH(1)) GRID_BAR();
    }

    if (IN(2)) { p2_mixer(F); if (BOTH(2)) GRID_BAR(); }

    if (IN(3)) {
        pg8::Gemm g{F.XN, F.Wout_t, M, D, D}; pg8::StaticOrder S; S.init(M, D, F.G, (int)blockIdx.x);
        pg8::EpiOut E{F.x, F.XB, F.ss};
        pg8::gemm_phase<pg8::EpiOut, pg8::StaticOrder, true, PG8_SP2>(F.lds + RING_OFF, g, S, E);
        if (BOTH(3)) GRID_BAR();
    }

    if (IN(4)) {
        pg8::Gemm g{F.XB, F.Wgu_t, M, NGU, D}; pg8::StaticOrder S; S.init(M, NGU, F.G, (int)blockIdx.x);
        pg8::EpiGU E{F.ACT, F.ss};
        pg8::gemm_phase<pg8::EpiGU, pg8::StaticOrder, true, PG8_SP2>(F.lds + RING_OFF, g, S, E);
        if (BOTH(4)) GRID_BAR();
    }

    if (IN(5)) {
        pg8::Gemm g{F.ACT, F.Wdn_t, M, D, FF}; pg8::StaticOrder S; S.init(M, D, F.G, (int)blockIdx.x);
        pg8::EpiDown E{F.XB, F.out};
        pg8::gemm_phase<pg8::EpiDown, pg8::StaticOrder, true, PG8_SP2>(F.lds + RING_OFF, g, S, E);
    }
#undef IN
#undef BOTH
#undef GRID_BAR
}

extern "C" void kernel_launch(void* const* d_in, const int* in_sizes, int n_in, void* d_out, int out_size, void* d_ws, size_t ws_size, hipStream_t stream) {
    static int grid = 0;
    if (grid == 0) {
        if (n_in != 13 || in_sizes[0] != M * D || out_size != M * D || ws_size < WS_END) { fprintf(stderr, "kernel_launch: unexpected shapes (n_in %d, in0 %d, out %d, ws %zu); nothing launched\n", n_in, n_in > 0 ? in_sizes[0] : -1, out_size, ws_size); grid = -1; return; }
        int dev = 0, cus = 0, per_cu = 0;
        if (hipGetDevice(&dev) != hipSuccess || hipDeviceGetAttribute(&cus, hipDeviceAttributeMultiprocessorCount, dev) != hipSuccess) { fprintf(stderr, "kernel_launch: device query failed\n"); grid = -1; return; }
        if (hipFuncSetAttribute((const void*)fwd_megakernel, hipFuncAttributeMaxDynamicSharedMemorySize, LDS_BYTES) != hipSuccess) { fprintf(stderr, "kernel_launch: hipFuncSetAttribute failed\n"); grid = -1; return; }
        if (hipOccupancyMaxActiveBlocksPerMultiprocessor(&per_cu, (const void*)fwd_megakernel, NWAVES * 64, LDS_BYTES) != hipSuccess || per_cu < 1) {
            fprintf(stderr, "kernel_launch: occupancy query reports %d workgroups per CU; nothing launched\n", per_cu); (void)hipGetLastError(); grid = -1; return; }
        (void)hipGetLastError();
        grid = cus;
    }
    if (grid < 0) return;
    if (hipMemsetAsync((char*)d_ws + WS_CTL, 0, CTL_ZERO_BYTES, stream) != hipSuccess) { fprintf(stderr, "kernel_launch: hipMemsetAsync failed\n"); return; }
    Args a{};
    for (int i = 0; i < 13; ++i) a.in[i] = (const float*)d_in[i];
    a.out = (float*)d_out; a.ws = (unsigned char*)d_ws;
    for (int li = 0; li < N_LAUNCHES; ++li) {
        a.ph_lo = (N_LAUNCHES == PER_PHASE) ? li : 0; a.ph_hi = (N_LAUNCHES == PER_PHASE) ? li + 1 : PER_PHASE; a.li = li;
        hipLaunchKernelGGL(fwd_megakernel, dim3(grid), dim3(NWAVES * 64), LDS_BYTES, stream, a);
        const hipError_t le = hipPeekAtLastError();
        if (le != hipSuccess) { fprintf(stderr, "kernel_launch: launch %d failed: %s\n", li, hipGetErrorName(le)); break; }
    }
}
```

```cpp
#include <hip/hip_runtime.h>
#include <cstdio>
#include <cstdint>

#define LAS __attribute__((address_space(3)))
#define GAS __attribute__((address_space(1)))
typedef unsigned short bf16_t;
typedef short bf16x8 __attribute__((ext_vector_type(8)));
typedef short s16x4 __attribute__((ext_vector_type(4)));
typedef float f32x4 __attribute__((ext_vector_type(4)));
typedef float f32x2 __attribute__((ext_vector_type(2)));
typedef unsigned u32x4 __attribute__((ext_vector_type(4)));
typedef unsigned u32x2 __attribute__((ext_vector_type(2)));

constexpr int BATCH = 16, SEQ = 4096, D = 1024, M = BATCH * SEQ;
constexpr int NA = 512, NHEAD = 8, HD = 64, NIN = 2048, FF = 2816, NGU = 2 * FF;
constexpr float EPS = 1e-6f;
constexpr float LOG2E = 1.4426950408889634f;

__device__ __forceinline__ unsigned cvt_pk_bf16(float lo, float hi) { unsigned r; asm volatile("v_cvt_pk_bf16_f32 %0, %1, %2" : "=v"(r) : "v"(lo), "v"(hi)); return r; }

namespace pg8 {
constexpr int BM = 256, BK = 64, HALF = 128, HTB = HALF * BK * 2, STAGE_BYTES = 8 * HTB, NXCD = 8, WGM = 8;

__host__ __device__ __forceinline__ int lds_byte(int r, int c) { const int st = (r >> 4) * 2 + (c >> 5), rr = r & 15, cc = c & 31, ob = rr * 64 + cc * 2; return st * 1024 + (ob ^ (((ob >> 9) & 1) << 5)); }
__host__ __device__ __forceinline__ void stage_rc(int b, int& R, int& C) { const int st = b / 1024, sb = b % 1024, swz = sb ^ (((sb >> 9) & 1) << 5); R = (st >> 1) * 16 + swz / 64; C = (st & 1) * 32 + (swz % 64) / 2; }
__host__ __device__ __forceinline__ int perm32(int rho) { const int n = rho >> 4, i = rho & 15; return 8 * (i >> 2) + 4 * n + (i & 3); }

struct Unit { int pm, pn; };
struct Gemm { const bf16_t* A; const bf16_t* Bt; int M, N, K; };

struct StaticOrder {
    int nM, nN, nwg, G, c;
    __host__ __device__ void init(int M_, int N_, int G_, int c_) { nM = M_ / BM; nN = N_ / BM; nwg = nM * nN; G = G_; c = c_; }
    __host__ __device__ bool next(int i, Unit& u) const {
        const long L = (long)i * G + c; if (L >= nwg) return false;
        int wgid = (int)L; { const int q = nwg / NXCD, r = nwg % NXCD, xcd = wgid % NXCD, off = wgid / NXCD; wgid = (xcd < r ? xcd * (q + 1) : r * (q + 1) + (xcd - r) * q) + off; }
        const int nig = WGM * nN, gid = wgid / nig, fm = gid * WGM, gsz = (nM - fm) < WGM ? (nM - fm) : WGM;
        u.pm = fm + ((wgid % nig) % gsz); u.pn = (wgid % nig) / gsz; return true;
    }
    __device__ __forceinline__ void a_ready(const Unit&) const {}
    __device__ __forceinline__ void done(const Unit&) const {}
};


struct EpiIn {
    static constexpr bool PERM = true, AFTER_DRAIN = false;
    bf16_t* QKVZ; const LAS float* gl;
    __device__ __forceinline__ void operator()(const f32x4 (&acc)[2][2][4][2], const Unit& u, int wr, int wc, int fr, int fq) const {
        const int kind = u.pn >> 1;
        const int row0 = u.pm * BM + wr * 64 + fr;
        const int head = 4 * (u.pn & 1) + wc; const size_t rstride = kind < 3 ? HD : NA;
        bf16_t* base = QKVZ + (size_t)kind * ((size_t)M * NA) + 8 * fq
                     + (kind < 3 ? ((size_t)((row0 >> 12) * NHEAD + head) * SEQ + (row0 & (SEQ - 1))) * HD : (size_t)row0 * NA + head * HD);
        if (kind < 2) {
            const LAS float* g = gl + 64 * kind + 8 * fq;
            f32x4 gv[2][2];
#pragma unroll
            for (int bj = 0; bj < 2; ++bj)
#pragma unroll
                for (int n = 0; n < 2; ++n) gv[bj][n] = *(const LAS f32x4*)(g + 32 * bj + 4 * n);
            float ss[8];
#pragma unroll
            for (int i = 0; i < 8; ++i) { const int ai = i >> 2, m = i & 3; float a = 0.f;
#pragma unroll
                for (int bj = 0; bj < 2; ++bj)
#pragma unroll
                    for (int n = 0; n < 2; ++n) { const f32x4 v = acc[ai][bj][m][n]; a += (v[0] * v[0] + v[1] * v[1]) + (v[2] * v[2] + v[3] * v[3]); }
                ss[i] = a; }
#pragma unroll
            for (int i = 0; i < 8; ++i) ss[i] += __shfl_xor(ss[i], 16);
#pragma unroll
            for (int i = 0; i < 8; ++i) ss[i] += __shfl_xor(ss[i], 32);
#pragma unroll
            for (int i = 0; i < 8; ++i) { const int ai = i >> 2, m = i & 3;
                bf16_t* rowp = base + (size_t)(ai * HALF + m * 16) * rstride;
                const float r = __builtin_amdgcn_rsqf(ss[i] * (1.0f / 64.0f) + EPS);
#pragma unroll
                for (int bj = 0; bj < 2; ++bj) {
                    const f32x4 v0 = acc[ai][bj][m][0] * r * gv[bj][0], v1 = acc[ai][bj][m][1] * r * gv[bj][1];
                    u32x4 w; w.x = cvt_pk_bf16(v0[0], v0[1]); w.y = cvt_pk_bf16(v0[2], v0[3]); w.z = cvt_pk_bf16(v1[0], v1[1]); w.w = cvt_pk_bf16(v1[2], v1[3]);
                    *(u32x4*)(rowp + bj * 32) = w; }
            }
        } else {
#pragma unroll
            for (int ai = 0; ai < 2; ++ai)
#pragma unroll
                for (int m = 0; m < 4; ++m) {
                    bf16_t* rowp = base + (size_t)(ai * HALF + m * 16) * rstride;
#pragma unroll
                    for (int bj = 0; bj < 2; ++bj) {
                        const f32x4 v0 = acc[ai][bj][m][0], v1 = acc[ai][bj][m][1];
                        u32x4 w; w.x = cvt_pk_bf16(v0[0], v0[1]); w.y = cvt_pk_bf16(v0[2], v0[3]); w.z = cvt_pk_bf16(v1[0], v1[1]); w.w = cvt_pk_bf16(v1[2], v1[3]);
                        *(u32x4*)(rowp + bj * 32) = w; }
                }
        }
    }
};

struct EpiOut {
    static constexpr bool PERM = true, AFTER_DRAIN = false;
    const float* x; bf16_t* XB; float* ss;
    __device__ __forceinline__ void operator()(const f32x4 (&acc)[2][2][4][2], const Unit& u, int wr, int wc, int fr, int fq) const {
        const int row0 = u.pm * BM + wr * 64 + fr, col0 = u.pn * BM + wc * 32 + 8 * fq;
        const size_t off0 = (size_t)row0 * D + col0;
        const float* __restrict__ xp = x + off0; bf16_t* __restrict__ bp = XB + off0;
        f32x4 xa[8][4]; float part[8];
#define EO_LOAD(i) do { const size_t o_ = (size_t)(((i) >> 2) * HALF + ((i) & 3) * 16) * D; \
        xa[i][0] = *(const f32x4*)(xp + o_); xa[i][1] = *(const f32x4*)(xp + o_ + 4); xa[i][2] = *(const f32x4*)(xp + o_ + HALF); xa[i][3] = *(const f32x4*)(xp + o_ + HALF + 4); } while (0)
        EO_LOAD(0); EO_LOAD(1); EO_LOAD(2); EO_LOAD(3);
        asm volatile("" ::: "memory");
#pragma unroll
        for (int i = 0; i < 8; ++i) { const int ai = i >> 2, m = i & 3; const size_t o_ = (size_t)(ai * HALF + m * 16) * D; float p = 0.f;
#pragma unroll
            for (int bj = 0; bj < 2; ++bj) {
                const f32x4 v0 = acc[ai][bj][m][0] + xa[i][2 * bj], v1 = acc[ai][bj][m][1] + xa[i][2 * bj + 1];
                u32x4 w; w.x = cvt_pk_bf16(v0[0], v0[1]); w.y = cvt_pk_bf16(v0[2], v0[3]); w.z = cvt_pk_bf16(v1[0], v1[1]); w.w = cvt_pk_bf16(v1[2], v1[3]);
                *(u32x4*)(bp + o_ + bj * HALF) = w;
                p += (v0[0] * v0[0] + v0[1] * v0[1]) + (v0[2] * v0[2] + v0[3] * v0[3]) + (v1[0] * v1[0] + v1[1] * v1[1]) + (v1[2] * v1[2] + v1[3] * v1[3]); }
            part[i] = p;
            if (i + 4 < 8) { EO_LOAD((i + 4) & 7); }
            asm volatile("" ::: "memory"); }
#undef EO_LOAD
#pragma unroll
        for (int i = 0; i < 8; ++i) part[i] += __shfl_xor(part[i], 16);
#pragma unroll
        for (int i = 0; i < 8; ++i) part[i] += __shfl_xor(part[i], 32);
        if (fq == 0) {
#pragma unroll
            for (int i = 0; i < 8; ++i) atomicAdd(ss + row0 + (i >> 2) * HALF + (i & 3) * 16, part[i]);
        }
    }
};

struct EpiGU {
    static constexpr bool PERM = true, AFTER_DRAIN = false;
    bf16_t* ACT; const float* ss;
    __device__ __forceinline__ void operator()(const f32x4 (&acc)[2][2][4][2], const Unit& u, int wr, int wc, int fr, int fq) const {
        const int row0 = u.pm * BM + wr * 64 + fr, col0 = u.pn * HALF + wc * 32 + 8 * fq;
        float sv[8];
#pragma unroll
        for (int i = 0; i < 8; ++i) sv[i] = ss[row0 + (i >> 2) * HALF + (i & 3) * 16];
        asm volatile("" ::: "memory");
#pragma unroll
        for (int i = 0; i < 8; ++i) { const int ai = i >> 2, m = i & 3;
            const float rstd = __builtin_amdgcn_rsqf(sv[i] * (1.0f / (float)D) + EPS), ne = -LOG2E * rstd, r2 = rstd * rstd;
            unsigned w[4];
#pragma unroll
            for (int n = 0; n < 2; ++n)
#pragma unroll
                for (int h = 0; h < 2; ++h) {
                    const f32x2 g = {acc[ai][0][m][n][2 * h], acc[ai][0][m][n][2 * h + 1]}, up = {acc[ai][1][m][n][2 * h], acc[ai][1][m][n][2 * h + 1]};
                    const f32x2 t = g * ne; f32x2 e; e.x = __builtin_amdgcn_exp2f(t.x); e.y = __builtin_amdgcn_exp2f(t.y);
                    const f32x2 d = e + 1.0f; f32x2 r; r.x = __builtin_amdgcn_rcpf(d.x); r.y = __builtin_amdgcn_rcpf(d.y);
                    const f32x2 a = (g * up) * (r * r2);
                    w[2 * n + h] = cvt_pk_bf16(a.x, a.y); }
            *(u32x4*)(ACT + (size_t)(row0 + ai * HALF + m * 16) * FF + col0) = (u32x4){w[0], w[1], w[2], w[3]};
        }
    }
};

struct EpiDown {
    static constexpr bool PERM = true, AFTER_DRAIN = false;
    const bf16_t* XB; float* out;
    __device__ __forceinline__ void operator()(const f32x4 (&acc)[2][2][4][2], const Unit& u, int wr, int wc, int fr, int fq) const {
        const int row0 = u.pm * BM + wr * 64 + fr, col0 = u.pn * BM + wc * 32 + 8 * fq;
        const size_t off0 = (size_t)row0 * D + col0;
        const bf16_t* __restrict__ bp = XB + off0; float* __restrict__ op = out + off0;
        u32x4 xa[8][2];
#define ED_LOAD(i) do { const size_t o_ = (size_t)(((i) >> 2) * HALF + ((i) & 3) * 16) * D; xa[i][0] = *(const u32x4*)(bp + o_); xa[i][1] = *(const u32x4*)(bp + o_ + HALF); } while (0)
        ED_LOAD(0); ED_LOAD(1); ED_LOAD(2); ED_LOAD(3);
        asm volatile("" ::: "memory");
#pragma unroll
        for (int i = 0; i < 8; ++i) { const int ai = i >> 2, m = i & 3; const size_t o_ = (size_t)(ai * HALF + m * 16) * D;
#pragma unroll
            for (int bj = 0; bj < 2; ++bj) { const u32x4 w = xa[i][bj];
                const f32x4 r0 = {__builtin_bit_cast(float, w.x << 16), __builtin_bit_cast(float, w.x & 0xffff0000u), __builtin_bit_cast(float, w.y << 16), __builtin_bit_cast(float, w.y & 0xffff0000u)};
                const f32x4 r1 = {__builtin_bit_cast(float, w.z << 16), __builtin_bit_cast(float, w.z & 0xffff0000u), __builtin_bit_cast(float, w.w << 16), __builtin_bit_cast(float, w.w & 0xffff0000u)};
                *(f32x4*)(op + o_ + bj * HALF) = acc[ai][bj][m][0] + r0; *(f32x4*)(op + o_ + bj * HALF + 4) = acc[ai][bj][m][1] + r1; }
            if (i + 4 < 8) { ED_LOAD((i + 4) & 7); }
            asm volatile("" ::: "memory"); }
#undef ED_LOAD
    }
};

template <class Epi, class Sched, bool ALIGN_EPI = false, bool SP2 = false>
__device__ __forceinline__ void gemm_phase(LAS unsigned char* lds, const Gemm g, const Sched& S, const Epi& E) {
    const int tid = threadIdx.x, wid = __builtin_amdgcn_readfirstlane(tid >> 6), lane = tid & 63, wr = wid >> 2, wc = wid & 3, fr = lane & 15, fq = lane >> 4;
    const int K = g.K, nt = K / BK;
    unsigned voffA[2], voffB[2];
#pragma unroll
    for (int i = 0; i < 2; ++i) { int R, C; stage_rc(tid * 16 + i * 8192, R, C); const int Rb = Epi::PERM ? ((R & ~31) + perm32(R & 31)) : R;
        voffA[i] = (unsigned)(R * K + C) * 2u; voffB[i] = (unsigned)(Rb * K + C) * 2u; }
    const size_t kstep = (size_t)(BK * 2);
    const size_t hstep = (size_t)HALF * K * 2;
    const size_t tstep = 2 * hstep;
    const unsigned ldsw = (unsigned)wid * 1024u;
    const int aoff = lds_byte(wr * 64 + fr, fq * 8), boff = lds_byte(wc * 32 + fr, fq * 8);
#define PG8_SA(b, h) (((b) * 2 + (h)) * HTB)
#define PG8_SB(b, h) ((4 + (b) * 2 + (h)) * HTB)
#define PG8_STAGE(bufoff, gbase, voff) do { _Pragma("unroll") for (int _i = 0; _i < 2; ++_i) \
        __builtin_amdgcn_global_load_lds((const unsigned*)((const char*)(gbase) + (voff)[_i]), (LAS unsigned*)(lds + (bufoff) + ldsw + _i * 8192), 16, 0, 0); } while (0)
#define PG8_LDA(dst, b, h) do { _Pragma("unroll") for (int m = 0; m < 4; ++m) _Pragma("unroll") for (int k = 0; k < 2; ++k) dst[m][k] = *(const LAS bf16x8*)(lds + PG8_SA(b, h) + aoff + m * 2048 + k * 1024); } while (0)
#define PG8_LDB(dst, b, h) do { _Pragma("unroll") for (int n = 0; n < 2; ++n) _Pragma("unroll") for (int k = 0; k < 2; ++k) dst[n][k] = *(const LAS bf16x8*)(lds + PG8_SB(b, h) + boff + n * 2048 + k * 1024); } while (0)
#define PG8_MMA(ai, bj, At, Bt) do { __builtin_amdgcn_s_setprio(1); _Pragma("unroll") for (int m = 0; m < 4; ++m) _Pragma("unroll") for (int n = 0; n < 2; ++n) _Pragma("unroll") for (int k = 0; k < 2; ++k) \
        acc[ai][bj][m][n] = __builtin_amdgcn_mfma_f32_16x16x32_bf16(Bt[n][k], At[m][k], acc[ai][bj][m][n], 0, 0, 0); __builtin_amdgcn_s_setprio(0); } while (0)
#define PG8_WAIT_V(n) asm volatile("s_waitcnt vmcnt(" #n ")" ::: "memory")
#define PG8_WAIT_L(n) asm volatile("s_waitcnt lgkmcnt(" #n ")" ::: "memory")
#define PG8_BAR __builtin_amdgcn_s_barrier()
#define PG8_SCHED __builtin_amdgcn_sched_barrier(0)
    Unit cur, nxt; int ui = 0;
    if (!S.next(0, cur)) return;
    f32x4 acc[2][2][4][2];
#pragma unroll
    for (int a = 0; a < 2; ++a)
#pragma unroll
        for (int b = 0; b < 2; ++b)
#pragma unroll
            for (int m = 0; m < 4; ++m)
#pragma unroll
                for (int n = 0; n < 2; ++n) acc[a][b][m][n] = (f32x4){0.f, 0.f, 0.f, 0.f};
    bf16x8 At[4][2], B0[2][2], B1[2][2];
    const char* cA = (const char*)g.A + (size_t)cur.pm * tstep; const char* cB = (const char*)g.Bt + (size_t)cur.pn * tstep;
    S.a_ready(cur);
    if constexpr (SP2) {
        PG8_STAGE(PG8_SB(0, 0), cB, voffB); PG8_STAGE(PG8_SB(0, 1), cB + hstep, voffB); PG8_STAGE(PG8_SA(0, 0), cA, voffA); PG8_STAGE(PG8_SA(0, 1), cA + hstep, voffA);
        if (wr == 1) PG8_BAR;
        PG8_WAIT_V(2); PG8_BAR;
        PG8_STAGE(PG8_SB(1, 0), cB + kstep, voffB); PG8_STAGE(PG8_SA(1, 0), cA + kstep, voffA); PG8_STAGE(PG8_SB(1, 1), cB + hstep + kstep, voffB);
        PG8_WAIT_V(6); PG8_BAR;
    } else {
        PG8_STAGE(PG8_SB(0, 0), cB, voffB); PG8_STAGE(PG8_SA(0, 0), cA, voffA); PG8_STAGE(PG8_SB(0, 1), cB + hstep, voffB); PG8_STAGE(PG8_SA(0, 1), cA + hstep, voffA);
        if (wr == 1) PG8_BAR;
        PG8_WAIT_V(4); PG8_BAR;
        PG8_STAGE(PG8_SB(1, 0), cB + kstep, voffB); PG8_STAGE(PG8_SA(1, 0), cA + kstep, voffA); PG8_STAGE(PG8_SB(1, 1), cB + hstep + kstep, voffB);
        PG8_WAIT_V(6); PG8_BAR;
    }
    for (;;) {
        const bool has_next = S.next(ui + 1, nxt);
        const char* nA = has_next ? (const char*)g.A + (size_t)nxt.pm * tstep : cA; const char* nB = has_next ? (const char*)g.Bt + (size_t)nxt.pn * tstep : cB;
        for (int t = 0; t < nt; t += 2) {
            const bool last = (t == nt - 2);
            const char* a1 = cA + (size_t)(t + 1) * kstep;
            const char* a2 = last ? nA : cA + (size_t)(t + 2) * kstep; const char* b2 = last ? nB : cB + (size_t)(t + 2) * kstep;
            const char* a3 = a2 + kstep; const char* b3 = b2 + kstep;
            if (last && has_next) S.a_ready(nxt);
            if constexpr (SP2) {
            PG8_LDB(B0, 0, 0); PG8_LDB(B1, 0, 1); PG8_SCHED; PG8_LDA(At, 0, 0); PG8_STAGE(PG8_SA(1, 1), a1 + hstep, voffA);
            PG8_WAIT_V(8); PG8_WAIT_L(0); PG8_BAR; PG8_MMA(0, 0, At, B0); PG8_MMA(0, 1, At, B1); PG8_BAR; PG8_SCHED;
            PG8_LDA(At, 0, 1); PG8_STAGE(PG8_SB(0, 0), b2, voffB); PG8_STAGE(PG8_SB(0, 1), b2 + hstep, voffB); PG8_STAGE(PG8_SA(0, 0), a2, voffA);
            PG8_WAIT_V(8); PG8_WAIT_L(0); PG8_BAR; PG8_MMA(1, 0, At, B0); PG8_MMA(1, 1, At, B1); PG8_BAR; PG8_SCHED;
            PG8_LDB(B0, 1, 0); PG8_LDB(B1, 1, 1); PG8_SCHED; PG8_LDA(At, 1, 0); PG8_STAGE(PG8_SA(0, 1), a2 + hstep, voffA);
            PG8_WAIT_V(8); PG8_WAIT_L(0); PG8_BAR; PG8_MMA(0, 0, At, B0); PG8_MMA(0, 1, At, B1); PG8_BAR; PG8_SCHED;
            PG8_LDA(At, 1, 1); PG8_STAGE(PG8_SB(1, 0), b3, voffB); PG8_STAGE(PG8_SB(1, 1), b3 + hstep, voffB); PG8_STAGE(PG8_SA(1, 0), a3, voffA);
            PG8_WAIT_V(8); PG8_WAIT_L(0); PG8_BAR; PG8_MMA(1, 0, At, B0); PG8_MMA(1, 1, At, B1); PG8_BAR; PG8_SCHED;
            } else {
            PG8_LDB(B0, 0, 0); PG8_SCHED; PG8_LDA(At, 0, 0); PG8_STAGE(PG8_SA(1, 1), a1 + hstep, voffA);
            PG8_WAIT_L(8); PG8_BAR; PG8_WAIT_L(0); PG8_MMA(0, 0, At, B0); PG8_BAR; PG8_SCHED;
            PG8_LDB(B1, 0, 1); PG8_STAGE(PG8_SB(0, 0), b2, voffB);
            PG8_BAR; PG8_WAIT_L(0); PG8_MMA(0, 1, At, B1); PG8_BAR;
            PG8_LDA(At, 0, 1); PG8_STAGE(PG8_SA(0, 0), a2, voffA);
            PG8_BAR; PG8_WAIT_L(0); PG8_MMA(1, 0, At, B0); PG8_BAR; PG8_SCHED;
            PG8_STAGE(PG8_SB(0, 1), b2 + hstep, voffB);
            PG8_WAIT_V(6); PG8_BAR; PG8_MMA(1, 1, At, B1); PG8_BAR;
            PG8_LDB(B0, 1, 0); PG8_SCHED; PG8_LDA(At, 1, 0); PG8_STAGE(PG8_SA(0, 1), a2 + hstep, voffA);
            PG8_WAIT_L(8); PG8_BAR; PG8_WAIT_L(0); PG8_MMA(0, 0, At, B0); PG8_BAR; PG8_SCHED;
            PG8_LDB(B1, 1, 1); PG8_STAGE(PG8_SB(1, 0), b3, voffB);
            PG8_BAR; PG8_WAIT_L(0); PG8_MMA(0, 1, At, B1); PG8_BAR;
            PG8_LDA(At, 1, 1); PG8_STAGE(PG8_SA(1, 0), a3, voffA);
            PG8_BAR; PG8_WAIT_L(0); PG8_MMA(1, 0, At, B0); PG8_BAR; PG8_SCHED;
            PG8_STAGE(PG8_SB(1, 1), b3 + hstep, voffB);
            PG8_WAIT_V(6); PG8_BAR; PG8_MMA(1, 1, At, B1); PG8_BAR;
            }
        }
        if constexpr (ALIGN_EPI) { if (wr == 0) PG8_BAR; }
        if constexpr (!Epi::AFTER_DRAIN) { E(acc, cur, wr, wc, fr, fq); S.done(cur); }
        if (!has_next) break;
#pragma unroll
        for (int a = 0; a < 2; ++a)
#pragma unroll
            for (int b = 0; b < 2; ++b)
#pragma unroll
                for (int m = 0; m < 4; ++m)
#pragma unroll
                    for (int n = 0; n < 2; ++n) acc[a][b][m][n] = (f32x4){0.f, 0.f, 0.f, 0.f};
        cur = nxt; cA = nA; cB = nB; ++ui;
        if constexpr (ALIGN_EPI) { if (wr == 1) PG8_BAR; }
    }
    PG8_WAIT_V(0);
    if constexpr (!ALIGN_EPI) { if (wr == 0) PG8_BAR; }
    PG8_BAR;
#undef PG8_SA
#undef PG8_SB
#undef PG8_STAGE
#undef PG8_LDA
#undef PG8_LDB
#undef PG8_MMA
#undef PG8_WAIT_V
#undef PG8_WAIT_L
#undef PG8_BAR
#undef PG8_SCHED
}
}

constexpr int NWAVES = 8;
#ifndef MK_N_LAUNCHES
#define MK_N_LAUNCHES 1
#endif
constexpr int N_LAUNCHES = MK_N_LAUNCHES;
constexpr int PER_PHASE = 6;
#ifndef PG8_SP2
#define PG8_SP2 true
#endif

constexpr size_t MiB = 1u << 20;
constexpr size_t WS_CTL = 0, CTL_ZERO_BYTES = 1 * MiB;
constexpr size_t WS_WIN = 2 * MiB;
constexpr size_t WS_WOUT = 6 * MiB;
constexpr size_t WS_WGU = 8 * MiB;
constexpr size_t WS_WDN = 20 * MiB;
constexpr size_t WS_XN = 32 * MiB;
constexpr size_t WS_QKVZ = 160 * MiB;
constexpr size_t WS_ACT = 416 * MiB;
constexpr size_t WS_XB = 768 * MiB;
constexpr size_t WS_END = 896 * MiB;
static_assert(WS_WGU + (size_t)NGU * D * 2 <= WS_WDN && WS_WDN + (size_t)D * FF * 2 <= WS_XN && WS_ACT + (size_t)M * FF * 2 <= WS_END, "d_ws map");
constexpr int CW_BAR = 4096;
constexpr int CW_SS = 65536;
static_assert((size_t)(CW_SS + M) * 4 <= CTL_ZERO_BYTES, "ss inside the memset region");

constexpr int RING_OFF = 0, RING_BYTES = 131072;
constexpr int LDSCTL_OFF = 157696, MISC_OFF = LDSCTL_OFF + 320;
constexpr int LDS_GAIN_OFF = LDSCTL_OFF + 512;
constexpr int LDS_BYTES = 163840;

typedef GAS unsigned gu32;
#define RLX_AGENT __ATOMIC_RELAXED, __HIP_MEMORY_SCOPE_AGENT
#define LDS_WAIT() asm volatile("s_waitcnt lgkmcnt(0)" ::: "memory")
__device__ __forceinline__ unsigned f2bf(float f) { unsigned u = __builtin_bit_cast(unsigned, f); return (u + 0x7fffu + ((u >> 16) & 1u)) >> 16; }
__device__ __forceinline__ unsigned pk2(float lo, float hi) { return f2bf(lo) | (f2bf(hi) << 16); }
__device__ __forceinline__ float bflo(unsigned w) { return __builtin_bit_cast(float, w << 16); }
__device__ __forceinline__ float bfhi(unsigned w) { return __builtin_bit_cast(float, w & 0xffff0000u); }

#define XB_TMO      128
#define XB_XCNT(j)  (256  + 64 * (j))
#define XB_XSUB(j)  (1280 + 64 * (j))
#define XB_XGEN(j)  (2304 + 64 * (j))
#define XB_TOP      3328
#define XB_TOPGEN   3392
#define XCD_BAR_WORDS 3456
#define XB_SPIN_CAP (1u << 18)

__device__ __forceinline__ unsigned xb_ld(unsigned* p)              { return __hip_atomic_load(p, __ATOMIC_RELAXED, __HIP_MEMORY_SCOPE_AGENT); }
__device__ __forceinline__ unsigned xb_add(unsigned* p, unsigned v) { return __hip_atomic_fetch_add(p, v, __ATOMIC_RELAXED, __HIP_MEMORY_SCOPE_AGENT); }
__device__ __forceinline__ unsigned xb_xcc_id() { return (unsigned)__builtin_amdgcn_s_getreg((3 << 11) | 20) & 0xFu; }
#define XB_SPIN(cond, bar) do { unsigned _sp = 0; while (cond) { __builtin_amdgcn_s_sleep(1); \
    if ((++_sp & 255u) == 0u) { if (xb_ld(&(bar)[XB_TMO])) break; if (_sp > XB_SPIN_CAP) { atomicAdd(&(bar)[XB_TMO], 1u); break; } } } } while (0)

struct XcdBarrier { unsigned* bar; unsigned x; volatile LAS unsigned* st; };

__device__ __forceinline__ XcdBarrier xcd_barrier_post(unsigned* bar, volatile LAS unsigned* st) {
    XcdBarrier b; b.bar = bar; b.x = xb_xcc_id(); b.st = st;
    if (threadIdx.x == 0) (void)xb_add(&bar[XB_XCNT(b.x)], 1u);
    return b;
}
__device__ __forceinline__ void xcd_barrier_complete(unsigned* bar, unsigned x, unsigned& nloc, unsigned& nx) {
    const unsigned G = gridDim.x * gridDim.y * gridDim.z;
    unsigned sum, cnt, mine, sp = 0u;
    for (;;) {
        sum = 0u; cnt = 0u; mine = 0u;
#pragma unroll
        for (unsigned j = 0; j < 16; ++j) { const unsigned c = xb_ld(&bar[XB_XCNT(j)]); sum += c; cnt += (c > 0u) ? 1u : 0u; mine = (j == x) ? c : mine; }
        if (sum == G) break;
        __builtin_amdgcn_s_sleep(1);
        if ((++sp & 255u) == 0u) { if (xb_ld(&bar[XB_TMO])) break; if (sp > XB_SPIN_CAP) { atomicAdd(&bar[XB_TMO], 1u); break; } }
    }
    nloc = mine > 0u ? mine : 1u; nx = cnt > 0u ? cnt : 1u;
}
__device__ __forceinline__ void xcd_barrier(const XcdBarrier& b) {
    asm volatile("s_waitcnt vmcnt(0)" ::: "memory");
    __syncthreads();
    if (threadIdx.x == 0) {
        unsigned* bar = b.bar;
        __builtin_amdgcn_s_waitcnt(0);
        unsigned nloc = b.st[0], nx = b.st[1];
        if (nloc == 0u) { xcd_barrier_complete(bar, b.x, nloc, nx); b.st[0] = nloc; b.st[1] = nx; }
        const unsigned old = xb_add(&bar[XB_XSUB(b.x)], 1u);
        const unsigned gen = old / nloc;
        if (old + 1u == (gen + 1u) * nloc) {
            __builtin_amdgcn_fence(__ATOMIC_RELEASE, "agent");
            asm volatile("s_waitcnt vmcnt(0)" ::: "memory");
            const unsigned og = xb_add(&bar[XB_TOP], 1u);
            const unsigned tg = og / nx;
            if (og + 1u == (tg + 1u) * nx) xb_add(&bar[XB_TOPGEN], 1u);
            else XB_SPIN(xb_ld(&bar[XB_TOPGEN]) == tg, bar);
            __builtin_amdgcn_fence(__ATOMIC_ACQUIRE, "agent");
            xb_add(&bar[XB_XGEN(b.x)], 1u);
            asm volatile("s_waitcnt vmcnt(0)" ::: "memory");
        } else {
            XB_SPIN(xb_ld(&bar[XB_XGEN(b.x)]) == gen, bar);
            __builtin_amdgcn_fence(__ATOMIC_ACQUIRE, "agent");
            asm volatile("s_waitcnt vmcnt(0)" ::: "memory");
        }
    }
    __syncthreads();
}

struct Frame {
    LAS unsigned char* lds;
    volatile LAS unsigned* MISC;
    gu32* ctl;
    int tid, lane, wave;
    int vcu, G;
    const float *x, *g1, *w_in, *gq, *gk, *rpb, *w_pool, *pscale, *w_out, *g2, *w_gate, *w_up, *w_down;
    float* out;
    bf16_t *Win_t, *Wout_t, *Wgu_t, *Wdn_t;
    bf16_t *XN, *QKVZ, *XB, *ACT;
    float* ss;
};

__device__ __forceinline__ float wave_sum(float v) {
#pragma unroll
    for (int o = 1; o < 64; o <<= 1) v += __shfl_xor(v, o);
    return v;
}

__device__ __forceinline__ void p0_tile_out(bf16_t* WT, int K, int drow0, int k0, LAS float* scr, int lane) {
    LDS_WAIT(); asm volatile("" ::: "memory");
    const int c = lane & 7;
#pragma unroll
    for (int j = 0; j < 4; ++j) { const int n = (lane >> 3) + 8 * j; const LAS float* s = scr + (8 * c) * 33 + n;
        u32x4 o; o.x = pk2(s[0 * 33], s[1 * 33]); o.y = pk2(s[2 * 33], s[3 * 33]); o.z = pk2(s[4 * 33], s[5 * 33]); o.w = pk2(s[6 * 33], s[7 * 33]);
        *(GAS u32x4*)(WT + (size_t)(drow0 + n) * K + k0 + 8 * c) = o; }
    LDS_WAIT(); asm volatile("" ::: "memory");
}
__device__ __forceinline__ void p0_transpose_item(const float* W, int ldw, int K, int k0, int n0, const float* gkv, bf16_t* WT, int drow0, LAS float* scr, int lane) {
#pragma unroll
    for (int i = 0; i < 32; ++i) { const int kk = 2 * i + (lane >> 5); float v = W[(size_t)(k0 + kk) * ldw + n0 + (lane & 31)]; if (gkv) v *= gkv[k0 + kk]; scr[kk * 33 + (lane & 31)] = v; }
    p0_tile_out(WT, K, drow0, k0, scr, lane);
}
__device__ __forceinline__ void p0_fold_item(const float* w_in, const float* w_pool, const float* pscale, int k0, int n0z, bf16_t* WT, int drow0, int lane) {
    const int n = lane & 31, kh = lane >> 5, g = n0z >> 7, d = (n0z & 127) + n;
    float acc[4] = {0.f, 0.f, 0.f, 0.f};
    const float* wrow = w_in + (size_t)(k0 + 4 * kh) * NIN + 3 * NA + 128 * g;
    const float* wp = w_pool + (size_t)g * 128 * 128 + d;
#pragma unroll 8
    for (int c4 = 0; c4 < 32; ++c4) {
        const float p0 = wp[(4 * c4 + 0) * 128], p1 = wp[(4 * c4 + 1) * 128], p2 = wp[(4 * c4 + 2) * 128], p3 = wp[(4 * c4 + 3) * 128];
#pragma unroll
        for (int i = 0; i < 4; ++i) { const f32x4 w = *(const f32x4*)(wrow + (size_t)i * NIN + 4 * c4); acc[i] += (w[0] * p0 + w[1] * p1) + (w[2] * p2 + w[3] * p3); }
    }
    const float ps = pscale[n0z + n];
    float hi[4];
#pragma unroll
    for (int i = 0; i < 4; ++i) { acc[i] *= ps; hi[i] = __shfl(acc[i], (lane + 32) & 63); }
    if (lane < 32) { u32x4 o; o.x = pk2(acc[0], acc[1]); o.y = pk2(acc[2], acc[3]); o.z = pk2(hi[0], hi[1]); o.w = pk2(hi[2], hi[3]);
        *(GAS u32x4*)(WT + (size_t)(drow0 + n) * D + k0) = o; }
}
__device__ __forceinline__ int win_drow(int n0) { const int pn = n0 >> 8, c = n0 & 255; return 256 * pn + 128 * ((c >> 5) & 1) + 32 * (c >> 6); }

template <int R> __device__ __forceinline__ void rms_rows(const float* x, const f32x4 (&gg)[4], bf16_t* XN, int m0, int lane) {
    f32x4 v[R][4]; float s[R];
#pragma unroll
    for (int r = 0; r < R; ++r) { const GAS f32x4* xr = (const GAS f32x4*)(x + (size_t)(m0 + r) * D) + lane;
#pragma unroll
        for (int j = 0; j < 4; ++j) v[r][j] = xr[64 * j]; }
#pragma unroll
    for (int r = 0; r < R; ++r) { float a = 0.f;
#pragma unroll
        for (int j = 0; j < 4; ++j) a += (v[r][j].x * v[r][j].x + v[r][j].y * v[r][j].y) + (v[r][j].z * v[r][j].z + v[r][j].w * v[r][j].w);
        s[r] = a; }
#pragma unroll
    for (int o = 1; o < 64; o <<= 1) {
#pragma unroll
        for (int r = 0; r < R; ++r) s[r] += __shfl_xor(s[r], o); }
#pragma unroll
    for (int r = 0; r < R; ++r) { const float rstd = __builtin_amdgcn_rsqf(s[r] * (1.f / D) + EPS);
        GAS unsigned long long* o8 = (GAS unsigned long long*)(XN + (size_t)(m0 + r) * D) + lane;
#pragma unroll
        for (int j = 0; j < 4; ++j) o8[64 * j] = (unsigned long long)pk2(v[r][j].x * rstd * gg[j].x, v[r][j].y * rstd * gg[j].y) | ((unsigned long long)pk2(v[r][j].z * rstd * gg[j].z, v[r][j].w * rstd * gg[j].w) << 32); }
}

__device__ __forceinline__ void p0_prologue(Frame& F) {
    LAS float* scr = (LAS float*)(F.lds + RING_OFF + F.wave * 16384);
    if (F.wave >= 4) {
        const int gw = F.vcu * 4 + (F.wave - 4), NGW = F.G * 4;
        constexpr int KB = D / 64;
        constexpr int I_QKV = KB * (3 * NA / 32), I_O = KB * (D / 32), I_G = KB * (FF / 32), I_DN = (FF / 64) * (D / 32);
        constexpr int NITEMS = I_QKV + I_O + 2 * I_G + I_DN;
        for (int it = gw; it < (D / 8) * (NA / 32); it += NGW) { const int nb = it & 15, kb = it >> 4; p0_fold_item(F.w_in, F.w_pool, F.pscale, 8 * kb, 32 * nb, F.Win_t, win_drow(3 * NA + 32 * nb), F.lane); }
        for (int it = gw; it < NITEMS; it += NGW) {
            int r = it;
            if (r < I_QKV) { const int nb = r % (3 * NA / 32), kb = r / (3 * NA / 32); p0_transpose_item(F.w_in, NIN, D, 64 * kb, 32 * nb, nullptr, F.Win_t, win_drow(32 * nb), scr, F.lane); continue; } r -= I_QKV;
            if (r < I_O) { const int nb = r % (D / 32), kb = r / (D / 32); p0_transpose_item(F.w_out, D, D, 64 * kb, 32 * nb, nullptr, F.Wout_t, 32 * nb, scr, F.lane); continue; } r -= I_O;
            if (r < 2 * I_G) { const int up = r >= I_G; if (up) r -= I_G; const int nb = r % (FF / 32), kb = r / (FF / 32), n0 = 32 * nb;
                p0_transpose_item(up ? F.w_up : F.w_gate, FF, D, 64 * kb, n0, F.g2, F.Wgu_t, 256 * (n0 >> 7) + (n0 & 127) + 128 * up, scr, F.lane); continue; } r -= 2 * I_G;
            { const int nb = r % (D / 32), kb = r / (D / 32); p0_transpose_item(F.w_down, D, FF, 64 * kb, 32 * nb, nullptr, F.Wdn_t, 32 * nb, scr, F.lane); }
        }
    }
    f32x4 gg[4];
#pragma unroll
    for (int j = 0; j < 4; ++j) gg[j] = *((const f32x4*)F.g1 + F.lane + 64 * j);
    const int RPW = (M + F.G - 1) / F.G, rbeg = F.vcu * RPW, rend = (rbeg + RPW) < M ? (rbeg + RPW) : M, nb8 = (rend - rbeg) / 8;
    volatile LAS unsigned* tick = F.MISC + 16;
    for (;;) {
        unsigned t = 0; if (F.lane == 0) t = __hip_atomic_fetch_add((LAS unsigned*)tick, 1u, __ATOMIC_RELAXED, __HIP_MEMORY_SCOPE_WORKGROUP);
        t = __builtin_amdgcn_readfirstlane(t);
        if ((int)t >= nb8) break;
        rms_rows<8>(F.x, gg, F.XN, rbeg + 8 * (int)t, F.lane);
    }
    if (F.wave == 0) for (int m = rbeg + 8 * nb8; m < rend; ++m) rms_rows<1>(F.x, gg, F.XN, m, F.lane);
}

constexpr int AT_IMG = 15 * 40 * 128;
constexpr int AT_A = 0;
constexpr int AT_B = AT_IMG;
constexpr int AT_TAB = 2 * AT_IMG;
static_assert(AT_TAB + 15 * 64 * 4 <= LDSCTL_OFF, "attention LDS map");
__device__ __forceinline__ int rs_of(int r) { int v = r - 4; v = v < 0 ? 0 : v; return v > 56 ? 56 : v; }

struct AttnUnit { int b, h, jh, r0, krow_lo, nrows; };
__device__ __forceinline__ AttnUnit attn_decode(int un) {
    AttnUnit u; const int bh = un >> 4, rc = (un >> 1) & 7; u.jh = un & 1; u.b = bh >> 3; u.h = bh & 7;
    u.r0 = 8 * rc; u.krow_lo = rs_of(u.r0); u.nrows = rs_of(u.r0 + 7) + 8 - u.krow_lo;
    return u;
}
__device__ __forceinline__ void glds16(const void* gsrc, unsigned lds_dst) { unsigned keep;
    asm volatile("s_mov_b32 %0, m0\n\ts_mov_b32 m0, %2\n\ts_nop 0\n\tglobal_load_lds_dwordx4 %1, off\n\ts_mov_b32 m0, %0" : "=&s"(keep) : "v"(gsrc), "s"(lds_dst) : "memory"); }
#define ATT_WAIT_BAR() do { asm volatile("s_waitcnt vmcnt(0) lgkmcnt(0)" ::: "memory"); __builtin_amdgcn_s_barrier(); asm volatile("" ::: "memory"); } while (0)
template <int KIND> __device__ __forceinline__ void attn_dma(unsigned dst, const bf16_t* src, const AttnUnit& u, int wid, int lane) {
    const int np = u.nrows * 5;
    const char* base = (const char*)(src + ((size_t)(u.b * NHEAD + u.h) * SEQ + u.krow_lo * 64 + 24 * u.jh) * HD);
#pragma unroll
    for (int it = 0; it < 10; ++it) {
        const int pi = it * 8 + wid;
        if (pi < np) {
            const int w = (pi * 205) >> 10, p = pi - 5 * w, c = 8 * p + (lane >> 3);
            const int sw = (KIND == 0) ? (((c >> 1) & 1) | (((c >> 3) & 3) << 1)) : ((((c >> 1) & 1) << 1) | (((c >> 3) & 1) << 2));
            const int ch = (lane & 7) ^ sw;
            const char* gp = base + (w * 64 + c) * (HD * 2) + ch * 16;
            glds16(gp, (unsigned)__builtin_amdgcn_readfirstlane(dst + pi * 1024));
        }
    }
}

__device__ __forceinline__ void p2_attention(Frame& F, const bf16_t* Qg, const bf16_t* Kg, const bf16_t* Vg, bf16_t* MIX) {
    const int lane = F.lane, wid = F.wave;
    LAS unsigned char* lds = F.lds;
    const unsigned lds0 = (unsigned)(size_t)F.lds;
    const int q = lane & 15, g = lane >> 4;
    constexpr int NUNITS = BATCH * NHEAD * 16, UW = 8;
    for (int uidx = F.vcu * UW; uidx < NUNITS; uidx += F.G * UW) {
        const int h = (uidx >> 4) & 7;
        __syncthreads();
        {   LAS float* tab = (LAS float*)(lds + AT_TAB);
            for (int i = F.tid; i < 15 * 64; i += NWAVES * 64) { const int rr = i >> 6, cc = (i & 63) - 16; tab[i] = (cc >= 0 && cc < 31) ? F.rpb[h * 465 + rr * 31 + cc] * LOG2E : 0.f; } }
        AttnUnit u = attn_decode(uidx);
        attn_dma<0>(lds0 + AT_A, Kg, u, wid, lane);
        bf16x8 qf[2][2];
#pragma unroll
        for (int jb = 0; jb < 2; ++jb) { const bf16_t* qp = Qg + ((size_t)(u.b * NHEAD + u.h) * SEQ + (u.r0 + wid) * 64 + 32 * u.jh + 16 * jb + q) * HD + 8 * g; qf[jb][0] = *(const bf16x8*)qp; qf[jb][1] = *(const bf16x8*)(qp + 32); }
        ATT_WAIT_BAR();
        for (int ui = 0; ui < UW; ++ui) {
            asm volatile("" : "+v"(qf[0][0]), "+v"(qf[0][1]), "+v"(qf[1][0]), "+v"(qf[1][1]));
            attn_dma<1>(lds0 + AT_B, Vg, u, wid, lane);
            const int r = u.r0 + wid, rs = rs_of(r), wbase = rs - u.krow_lo;
            u32x4 pw[2][8]; float il[2];
#pragma unroll
            for (int jb = 0; jb < 2; ++jb) {
                const int o = 8 * jb, kcol0 = 24 * u.jh + o, cq = 32 * u.jh + 16 * jb + q;
                int cs = cq - 8; cs = cs < 0 ? 0 : cs; cs = cs > 48 ? 48 : cs;
                f32x4 sc[8][2];
                {
                    const int fk = ((q >> 1) & 1) | (((jb + (q >> 2)) & 3) << 1), x0 = g ^ fk;
                    const LAS unsigned char* ka = lds + AT_A + (wbase * 40 + o + 8 * (q >> 2) + (q & 3)) * 128;
                    const LAS unsigned char* k0p = ka + x0 * 16;
                    const LAS unsigned char* k1p = ka + (x0 ^ 4) * 16;
#pragma unroll
                    for (int wl = 0; wl < 8; ++wl)
#pragma unroll
                        for (int blk = 0; blk < 2; ++blk) {
                            const bf16x8 k0 = *(const LAS bf16x8*)(k0p + wl * 5120 + blk * 512), k1 = *(const LAS bf16x8*)(k1p + wl * 5120 + blk * 512);
                            f32x4 a = (f32x4){0.f, 0.f, 0.f, 0.f};
                            a = __builtin_amdgcn_mfma_f32_16x16x32_bf16(k0, qf[jb][0], a, 0, 0, 0);
                            a = __builtin_amdgcn_mfma_f32_16x16x32_bf16(k1, qf[jb][1], a, 0, 0, 0);
                            sc[wl][blk] = a;
                        }
                }
                const LAS float* tab = (const LAS float*)(lds + AT_TAB) + (rs - r + 7) * 64 + 16 + (kcol0 - cq + 15) + 8 * g;
                const int voff = kcol0 + 8 * g - cs;
                float mx = -INFINITY;
#pragma unroll
                for (int wl = 0; wl < 8; ++wl)
#pragma unroll
                    for (int blk = 0; blk < 2; ++blk)
#pragma unroll
                        for (int e = 0; e < 4; ++e) {
                            const int ep = 4 * blk + e;
                            float s_ = sc[wl][blk][e] + tab[wl * 64 + ep];
                            s_ = ((unsigned)(voff + ep) < 16u) ? s_ : -INFINITY;
                            sc[wl][blk][e] = s_; mx = fmaxf(mx, s_);
                        }
                mx = fmaxf(mx, __shfl_xor(mx, 16)); mx = fmaxf(mx, __shfl_xor(mx, 32));
                float l = 0.f;
#pragma unroll
                for (int wl = 0; wl < 8; ++wl) {
                    float p[8];
#pragma unroll
                    for (int blk = 0; blk < 2; ++blk)
#pragma unroll
                        for (int e = 0; e < 4; ++e) { p[4 * blk + e] = __builtin_amdgcn_exp2f(sc[wl][blk][e] - mx); l += p[4 * blk + e]; }
                    pw[jb][wl].x = cvt_pk_bf16(p[0], p[1]); pw[jb][wl].y = cvt_pk_bf16(p[2], p[3]); pw[jb][wl].z = cvt_pk_bf16(p[4], p[5]); pw[jb][wl].w = cvt_pk_bf16(p[6], p[7]);
                }
                l += __shfl_xor(l, 16); l += __shfl_xor(l, 32);
                il[jb] = __builtin_amdgcn_rcpf(l);
            }
            ATT_WAIT_BAR();
            AttnUnit un = u; bf16x8 nq[2][2];
#pragma unroll
            for (int jb = 0; jb < 2; ++jb) { nq[jb][0] = qf[jb][0]; nq[jb][1] = qf[jb][1]; }
            if (ui < UW - 1) {
                un = attn_decode(uidx + ui + 1);
                attn_dma<0>(lds0 + AT_A, Kg, un, wid, lane);
#pragma unroll
                for (int jb = 0; jb < 2; ++jb) { const bf16_t* qp = Qg + ((size_t)(un.b * NHEAD + un.h) * SEQ + (un.r0 + wid) * 64 + 32 * un.jh + 16 * jb + q) * HD + 8 * g; nq[jb][0] = *(const bf16x8*)qp; nq[jb][1] = *(const bf16x8*)(qp + 32); }
            }
#pragma unroll
            for (int jb = 0; jb < 2; ++jb) {
                const int o = 8 * jb, cq = 32 * u.jh + 16 * jb + q;
                f32x4 ov[4];
#pragma unroll
                for (int n = 0; n < 4; ++n) ov[n] = (f32x4){0.f, 0.f, 0.f, 0.f};
                {
                    const int qr = q >> 2, p = lane & 3;
                    const int fv = (((qr >> 1) & 1) << 1) | (((jb + g) & 1) << 2);
                    const LAS unsigned char* vb = lds + AT_B + (wbase * 40 + o + 8 * g + qr) * 128 + (p >> 1) * 16 + (p & 1) * 8;
                    const LAS unsigned char* vn[4];
#pragma unroll
                    for (int n = 0; n < 4; ++n) vn[n] = vb + ((2 * n) ^ fv) * 16;
#pragma unroll
                    for (int wl = 0; wl < 8; ++wl) {
                        const bf16x8 pf = __builtin_bit_cast(bf16x8, pw[jb][wl]);
#pragma unroll
                        for (int n = 0; n < 4; ++n) {
                            const s16x4 lo = __builtin_bit_cast(s16x4, __builtin_amdgcn_ds_read_tr16_b64_v4i16((LAS s16x4*)(vn[n] + wl * 5120)));
                            const s16x4 hi = __builtin_bit_cast(s16x4, __builtin_amdgcn_ds_read_tr16_b64_v4i16((LAS s16x4*)(vn[n] + wl * 5120 + 512)));
                            const bf16x8 vf = (bf16x8){lo[0], lo[1], lo[2], lo[3], hi[0], hi[1], hi[2], hi[3]};
                            ov[n] = __builtin_amdgcn_mfma_f32_16x16x32_bf16(vf, pf, ov[n], 0, 0, 0);
                        }
                    }
                }
                bf16_t* op = MIX + ((size_t)(u.b * SEQ + r * 64 + cq)) * D + u.h * HD + 4 * g;
#pragma unroll
                for (int n = 0; n < 4; ++n) { u32x2 w; w.x = cvt_pk_bf16(ov[n][0] * il[jb], ov[n][1] * il[jb]); w.y = cvt_pk_bf16(ov[n][2] * il[jb], ov[n][3] * il[jb]); *(u32x2*)(op + 16 * n) = w; }
            }
            ATT_WAIT_BAR();
            u = un;
#pragma unroll
            for (int jb = 0; jb < 2; ++jb) { qf[jb][0] = nq[jb][0]; qf[jb][1] = nq[jb][1]; }
        }
    }
}

__device__ __forceinline__ void up8(const u32x4 w, float (&v)[8]) {
    v[0] = bflo(w.x); v[1] = bfhi(w.x); v[2] = bflo(w.y); v[3] = bfhi(w.y); v[4] = bflo(w.z); v[5] = bfhi(w.z); v[6] = bflo(w.w); v[7] = bfhi(w.w);
}
__device__ __forceinline__ void pool_run(const bf16_t* __restrict__ Zg, bf16_t* __restrict__ MIX, int gw, int lane) {
    const int tb = 32 * gw, b = tb >> 12, t0 = tb & (SEQ - 1);
    const int half = 1 << (lane >> 4);
    const bf16_t* zb = Zg + (size_t)(b * SEQ) * NA + 8 * lane;
    bf16_t* ob = MIX + (size_t)(b * SEQ) * D + NA + 8 * lane;
    float S[8];
#pragma unroll
    for (int e = 0; e < 8; ++e) S[e] = 0.f;
    {   u32x4 w[16];
#pragma unroll
        for (int d = 0; d < 16; ++d) { int i = t0 + d - 8; i = i < 0 ? 0 : i; i = i > SEQ - 1 ? SEQ - 1 : i; w[d] = *(const u32x4*)(zb + (size_t)i * NA); }
#pragma unroll
        for (int d = 0; d < 16; ++d) { const int dd = d - 8, i = t0 + dd; const float mk = (dd >= -half && dd < half && i >= 0 && i < SEQ) ? 1.f : 0.f; float v[8]; up8(w[d], v);
#pragma unroll
            for (int e = 0; e < 8; ++e) S[e] += mk * v[e]; } }
    for (int c = 0; c < 4; ++c) {
        u32x4 zt[8], za[8], zs[8];
#pragma unroll
        for (int k = 0; k < 8; ++k) { const int t = t0 + 8 * c + k; int ia = t + half, is = t - half; ia = ia > SEQ - 1 ? SEQ - 1 : ia; is = is < 0 ? 0 : is;
            zt[k] = *(const u32x4*)(zb + (size_t)t * NA); za[k] = *(const u32x4*)(zb + (size_t)ia * NA); zs[k] = *(const u32x4*)(zb + (size_t)is * NA); }
#pragma unroll
        for (int k = 0; k < 8; ++k) { const int t = t0 + 8 * c + k;
            const int lo = (t - half) < 0 ? 0 : (t - half), hi = (t + half) > SEQ ? SEQ : (t + half);
            const float inv = 1.0f / (float)(hi - lo);
            float v[8]; up8(zt[k], v);
            u32x4 w;
            w.x = cvt_pk_bf16(S[0] * inv - v[0], S[1] * inv - v[1]); w.y = cvt_pk_bf16(S[2] * inv - v[2], S[3] * inv - v[3]);
            w.z = cvt_pk_bf16(S[4] * inv - v[4], S[5] * inv - v[5]); w.w = cvt_pk_bf16(S[6] * inv - v[6], S[7] * inv - v[7]);
            *(u32x4*)(ob + (size_t)t * D) = w;
            const float ma = (t + half < SEQ) ? 1.f : 0.f, ms = (t - half >= 0) ? 1.f : 0.f;
            float a[8], s[8]; up8(za[k], a); up8(zs[k], s);
#pragma unroll
            for (int e = 0; e < 8; ++e) S[e] += ma * a[e] - ms * s[e]; }
    }
}

__device__ __forceinline__ void p2_mixer(Frame& F) {
    const bf16_t* Qg = F.QKVZ; const bf16_t* Kg = F.QKVZ + (size_t)M * NA; const bf16_t* Vg = F.QKVZ + 2 * (size_t)M * NA; const bf16_t* Zg = F.QKVZ + 3 * (size_t)M * NA;
    bf16_t* MIX = F.XN;
    for (int gw = F.vcu * NWAVES + F.wave; gw < M / 32; gw += F.G * NWAVES) pool_run(Zg, MIX, gw, F.lane);
    p2_attention(F, Qg, Kg, Vg, MIX);
    __syncthreads();
}

struct Args { const float* in[13]; float* out; unsigned char* ws; int ph_lo, ph_hi, li, pad; };
__global__ void __launch_bounds__(NWAVES * 64, 2) fwd_megakernel(Args args) {
    extern __shared__ __attribute__((aligned(16))) unsigned char lds[];
    Frame F;
    F.lds = (LAS unsigned char*)lds;
    F.MISC = (volatile LAS unsigned*)(F.lds + MISC_OFF);
    F.tid = threadIdx.x; F.lane = F.tid & 63; F.wave = __builtin_amdgcn_readfirstlane(F.tid >> 6);
    F.G = gridDim.x; { const int bx = blockIdx.x; F.vcu = (F.G % 8 == 0) ? (bx % 8) * (F.G / 8) + bx / 8 : bx; }
    unsigned char* ws = args.ws;
    F.ctl = (gu32*)(ws + WS_CTL);
    F.x = args.in[0]; F.g1 = args.in[1]; F.w_in = args.in[2]; F.gq = args.in[3]; F.gk = args.in[4]; F.rpb = args.in[5]; F.w_pool = args.in[6];
    F.pscale = args.in[7]; F.w_out = args.in[8]; F.g2 = args.in[9]; F.w_gate = args.in[10]; F.w_up = args.in[11]; F.w_down = args.in[12]; F.out = args.out;
    F.Win_t = (bf16_t*)(ws + WS_WIN); F.Wout_t = (bf16_t*)(ws + WS_WOUT); F.Wgu_t = (bf16_t*)(ws + WS_WGU); F.Wdn_t = (bf16_t*)(ws + WS_WDN);
    F.XN = (bf16_t*)(ws + WS_XN); F.QKVZ = (bf16_t*)(ws + WS_QKVZ); F.XB = (bf16_t*)(ws + WS_XB); F.ACT = (bf16_t*)(ws + WS_ACT);
    F.ss = (float*)(ws + WS_CTL) + CW_SS;
    for (int u = F.tid; u < (LDS_BYTES - LDSCTL_OFF) / 4; u += NWAVES * 64) ((LAS unsigned*)(F.lds + LDSCTL_OFF))[u] = 0u;
    __syncthreads();
    XcdBarrier bar; bar.bar = (unsigned*)(F.ctl + CW_BAR); bar.x = 0; bar.st = nullptr;
    if (N_LAUNCHES != PER_PHASE) bar = xcd_barrier_post((unsigned*)(F.ctl + CW_BAR), F.MISC + 8);
#define GRID_BAR() do { if (N_LAUNCHES != PER_PHASE) xcd_barrier(bar); } while (0)
    const int lo = args.ph_lo, hi = args.ph_hi;
#define IN(k) (lo <= (k) && (k) < hi)
#define BOTH(k) (IN(k) && IN((k) + 1))

    if (IN(0)) { p0_prologue(F); if (BOTH(0)) GRID_BAR(); }

    if (IN(1)) {
        pg8::Gemm g{F.XN, F.Win_t, M, NIN, D}; pg8::StaticOrder S; S.init(M, NIN, F.G, (int)blockIdx.x);
        { LAS float* gl = (LAS float*)(F.lds + LDS_GAIN_OFF);
          if (F.tid < 64) gl[F.tid] = F.gq[F.tid] * (0.125f * LOG2E); else if (F.tid < 128) gl[F.tid] = F.gk[F.tid - 64];
          __syncthreads(); }
        pg8::EpiIn E{F.QKVZ, (const LAS float*)(F.lds + LDS_GAIN_OFF)};
        pg8::gemm_phase<pg8::EpiIn, pg8::StaticOrder, true, PG8_SP2>(F.lds + RING_OFF, g, S, E);
        if (BOTH(1)) GRID_BAR();
    }

    if (IN(2)) { p2_mixer(F); if (BOTH(2)) GRID_BAR(); }

    if (IN(3)) {
        pg8::Gemm g{F.XN, F.Wout_t, M, D, D}; pg8::StaticOrder S; S.init(M, D, F.G, (int)blockIdx.x);
        pg8::EpiOut E{F.x, F.XB, F.ss};
        pg8::gemm_phase<pg8::EpiOut, pg8::StaticOrder, true, PG8_SP2>(F.lds + RING_OFF, g, S, E);
        if (BOTH(3)) GRID_BAR();
    }

    if (IN(4)) {
        pg8::Gemm g{F.XB, F.Wgu_t, M, NGU, D}; pg8::StaticOrder S; S.init(M, NGU, F.G, (int)blockIdx.x);
        pg8::EpiGU E{F.ACT, F.ss};
        pg8::gemm_phase<pg8::EpiGU, pg8::StaticOrder, true, PG8_SP2>(F.lds + RING_OFF, g, S, E);
        if (BOTH(4)) GRID_BAR();
    }

    if (IN(5)) {
        pg8::Gemm g{F.ACT, F.Wdn_t, M, D, FF}; pg8::StaticOrder S; S.init(M, D, F.G, (int)blockIdx.x);
        pg8::EpiDown E{F.XB, F.out};
        pg8::gemm_phase<pg8::EpiDown, pg8::StaticOrder, true, PG8_SP2>(F.lds + RING_OFF, g, S, E);
    }
#undef IN
#undef BOTH
#undef GRID_BAR
}

extern "C" void kernel_launch(void* const* d_in, const int* in_sizes, int n_in, void* d_out, int out_size, void* d_ws, size_t ws_size, hipStream_t stream) {
    static int grid = 0;
    if (grid == 0) {
        if (n_in != 13 || in_sizes[0] != M * D || out_size != M * D || ws_size < WS_END) { fprintf(stderr, "kernel_launch: unexpected shapes (n_in %d, in0 %d, out %d, ws %zu); nothing launched\n", n_in, n_in > 0 ? in_sizes[0] : -1, out_size, ws_size); grid = -1; return; }
        int dev = 0, cus = 0, per_cu = 0;
        if (hipGetDevice(&dev) != hipSuccess || hipDeviceGetAttribute(&cus, hipDeviceAttributeMultiprocessorCount, dev) != hipSuccess) { fprintf(stderr, "kernel_launch: device query failed\n"); grid = -1; return; }
        if (hipFuncSetAttribute((const void*)fwd_megakernel, hipFuncAttributeMaxDynamicSharedMemorySize, LDS_BYTES) != hipSuccess) { fprintf(stderr, "kernel_launch: hipFuncSetAttribute failed\n"); grid = -1; return; }
        if (hipOccupancyMaxActiveBlocksPerMultiprocessor(&per_cu, (const void*)fwd_megakernel, NWAVES * 64, LDS_BYTES) != hipSuccess || per_cu < 1) {
            fprintf(stderr, "kernel_launch: occupancy query reports %d workgroups per CU; nothing launched\n", per_cu); (void)hipGetLastError(); grid = -1; return; }
        (void)hipGetLastError();
        grid = cus;
    }
    if (grid < 0) return;
    if (hipMemsetAsync((char*)d_ws + WS_CTL, 0, CTL_ZERO_BYTES, stream) != hipSuccess) { fprintf(stderr, "kernel_launch: hipMemsetAsync failed\n"); return; }
    Args a{};
    for (int i = 0; i < 13; ++i) a.in[i] = (const float*)d_in[i];
    a.out = (float*)d_out; a.ws = (unsigned char*)d_ws;
    for (int li = 0; li < N_LAUNCHES; ++li) {
        a.ph_lo = (N_LAUNCHES == PER_PHASE) ? li : 0; a.ph_hi = (N_LAUNCHES == PER_PHASE) ? li + 1 : PER_PHASE; a.li = li;
        hipLaunchKernelGGL(fwd_megakernel, dim3(grid), dim3(NWAVES * 64), LDS_BYTES, stream, a);
        const hipError_t le = hipPeekAtLastError();
        if (le != hipSuccess) { fprintf(stderr, "kernel_launch: launch %d failed: %s\n", li, hipGetErrorName(le)); break; }
    }
}
```

```cpp
#include <hip/hip_runtime.h>
#include <cstdio>
#include <cstdint>

#define LAS __attribute__((address_space(3)))
#define GAS __attribute__((address_space(1)))
typedef unsigned short bf16_t;
typedef short bf16x8 __attribute__((ext_vector_type(8)));
typedef short s16x4 __attribute__((ext_vector_type(4)));
typedef float f32x4 __attribute__((ext_vector_type(4)));
typedef float f32x2 __attribute__((ext_vector_type(2)));
typedef unsigned u32x4 __attribute__((ext_vector_type(4)));
typedef unsigned u32x2 __attribute__((ext_vector_type(2)));

constexpr int BATCH = 16, SEQ = 4096, D = 1024, M = BATCH * SEQ;
constexpr int NA = 512, NHEAD = 8, HD = 64, NIN = 2048, FF = 2816, NGU = 2 * FF;
constexpr float EPS = 1e-6f;
constexpr float LOG2E = 1.4426950408889634f;

__device__ __forceinline__ unsigned cvt_pk_bf16(float lo, float hi) { unsigned r; asm volatile("v_cvt_pk_bf16_f32 %0, %1, %2" : "=v"(r) : "v"(lo), "v"(hi)); return r; }

namespace pg8 {
constexpr int BM = 256, BK = 64, HALF = 128, HTB = HALF * BK * 2, STAGE_BYTES = 8 * HTB, NXCD = 8, WGM = 8;

__host__ __device__ __forceinline__ int lds_byte(int r, int c) { const int st = (r >> 4) * 2 + (c >> 5), rr = r & 15, cc = c & 31, ob = rr * 64 + cc * 2; return st * 1024 + (ob ^ (((ob >> 9) & 1) << 5)); }
__host__ __device__ __forceinline__ void stage_rc(int b, int& R, int& C) { const int st = b / 1024, sb = b % 1024, swz = sb ^ (((sb >> 9) & 1) << 5); R = (st >> 1) * 16 + swz / 64; C = (st & 1) * 32 + (swz % 64) / 2; }
__host__ __device__ __forceinline__ int perm32(int rho) { const int n = rho >> 4, i = rho & 15; return 8 * (i >> 2) + 4 * n + (i & 3); }

struct Unit { int pm, pn; };
struct Gemm { const bf16_t* A; const bf16_t* Bt; int M, N, K; };

struct StaticOrder {
    int nM, nN, nwg, G, c;
    __host__ __device__ void init(int M_, int N_, int G_, int c_) { nM = M_ / BM; nN = N_ / BM; nwg = nM * nN; G = G_; c = c_; }
    __host__ __device__ bool next(int i, Unit& u) const {
        const long L = (long)i * G + c; if (L >= nwg) return false;
        int wgid = (int)L; { const int q = nwg / NXCD, r = nwg % NXCD, xcd = wgid % NXCD, off = wgid / NXCD; wgid = (xcd < r ? xcd * (q + 1) : r * (q + 1) + (xcd - r) * q) + off; }
        const int nig = WGM * nN, gid = wgid / nig, fm = gid * WGM, gsz = (nM - fm) < WGM ? (nM - fm) : WGM;
        u.pm = fm + ((wgid % nig) % gsz); u.pn = (wgid % nig) / gsz; return true;
    }
    __device__ __forceinline__ void a_ready(const Unit&) const {}
    __device__ __forceinline__ void done(const Unit&) const {}
};


struct EpiIn {
    static constexpr bool PERM = true, AFTER_DRAIN = false;
    bf16_t* QKVZ; const LAS float* gl;
    __device__ __forceinline__ void operator()(const f32x4 (&acc)[2][2][4][2], const Unit& u, int wr, int wc, int fr, int fq) const {
        const int kind = u.pn >> 1;
        const int row0 = u.pm * BM + wr * 64 + fr;
        const int head = 4 * (u.pn & 1) + wc; const size_t rstride = kind < 3 ? HD : NA;
        bf16_t* base = QKVZ + (size_t)kind * ((size_t)M * NA) + 8 * fq
                     + (kind < 3 ? ((size_t)((row0 >> 12) * NHEAD + head) * SEQ + (row0 & (SEQ - 1))) * HD : (size_t)row0 * NA + head * HD);
        if (kind < 2) {
            const LAS float* g = gl + 64 * kind + 8 * fq;
            f32x4 gv[2][2];
#pragma unroll
            for (int bj = 0; bj < 2; ++bj)
#pragma unroll
                for (int n = 0; n < 2; ++n) gv[bj][n] = *(const LAS f32x4*)(g + 32 * bj + 4 * n);
            float ss[8];
#pragma unroll
            for (int i = 0; i < 8; ++i) { const int ai = i >> 2, m = i & 3; float a = 0.f;
#pragma unroll
                for (int bj = 0; bj < 2; ++bj)
#pragma unroll
                    for (int n = 0; n < 2; ++n) { const f32x4 v = acc[ai][bj][m][n]; a += (v[0] * v[0] + v[1] * v[1]) + (v[2] * v[2] + v[3] * v[3]); }
                ss[i] = a; }
#pragma unroll
            for (int i = 0; i < 8; ++i) ss[i] += __shfl_xor(ss[i], 16);
#pragma unroll
            for (int i = 0; i < 8; ++i) ss[i] += __shfl_xor(ss[i], 32);
#pragma unroll
            for (int i = 0; i < 8; ++i) { const int ai = i >> 2, m = i & 3;
                bf16_t* rowp = base + (size_t)(ai * HALF + m * 16) * rstride;
                const float r = __builtin_amdgcn_rsqf(ss[i] * (1.0f / 64.0f) + EPS);
#pragma unroll
                for (int bj = 0; bj < 2; ++bj) {
                    const f32x4 v0 = acc[ai][bj][m][0] * r * gv[bj][0], v1 = acc[ai][bj][m][1] * r * gv[bj][1];
                    u32x4 w; w.x = cvt_pk_bf16(v0[0], v0[1]); w.y = cvt_pk_bf16(v0[2], v0[3]); w.z = cvt_pk_bf16(v1[0], v1[1]); w.w = cvt_pk_bf16(v1[2], v1[3]);
                    *(u32x4*)(rowp + bj * 32) = w; }
            }
        } else {
#pragma unroll
            for (int ai = 0; ai < 2; ++ai)
#pragma unroll
                for (int m = 0; m < 4; ++m) {
                    bf16_t* rowp = base + (size_t)(ai * HALF + m * 16) * rstride;
#pragma unroll
                    for (int bj = 0; bj < 2; ++bj) {
                        const f32x4 v0 = acc[ai][bj][m][0], v1 = acc[ai][bj][m][1];
                        u32x4 w; w.x = cvt_pk_bf16(v0[0], v0[1]); w.y = cvt_pk_bf16(v0[2], v0[3]); w.z = cvt_pk_bf16(v1[0], v1[1]); w.w = cvt_pk_bf16(v1[2], v1[3]);
                        *(u32x4*)(rowp + bj * 32) = w; }
                }
        }
    }
};

struct EpiOut {
    static constexpr bool PERM = true, AFTER_DRAIN = false;
    const bf16_t* XN; const float* rrow; const float* g1; bf16_t* XB; float* ss;
    __device__ __forceinline__ void operator()(const f32x4 (&acc)[2][2][4][2], const Unit& u, int wr, int wc, int fr, int fq) const {
        const int row0 = u.pm * BM + wr * 64 + fr, col0 = u.pn * BM + wc * 32 + 8 * fq;
        const size_t off0 = (size_t)row0 * D + col0;
        const bf16_t* __restrict__ xp = XN + off0; bf16_t* __restrict__ bp = XB + off0;
        f32x4 gi[2][2];
#pragma unroll
        for (int bj = 0; bj < 2; ++bj)
#pragma unroll
            for (int n = 0; n < 2; ++n) { const f32x4 gv = *(const f32x4*)(g1 + col0 + bj * HALF + 4 * n);
                gi[bj][n] = (f32x4){__builtin_amdgcn_rcpf(gv[0]), __builtin_amdgcn_rcpf(gv[1]), __builtin_amdgcn_rcpf(gv[2]), __builtin_amdgcn_rcpf(gv[3])}; }
        u32x4 xa[8][2]; float rr[8], part[8];
#pragma unroll
        for (int i = 0; i < 8; ++i) rr[i] = rrow[row0 + (i >> 2) * HALF + (i & 3) * 16];
#define EO_LOAD(i) do { const size_t o_ = (size_t)(((i) >> 2) * HALF + ((i) & 3) * 16) * D; xa[i][0] = *(const u32x4*)(xp + o_); xa[i][1] = *(const u32x4*)(xp + o_ + HALF); } while (0)
        EO_LOAD(0); EO_LOAD(1); EO_LOAD(2); EO_LOAD(3);
        asm volatile("" ::: "memory");
#pragma unroll
        for (int i = 0; i < 8; ++i) { const int ai = i >> 2, m = i & 3; const size_t o_ = (size_t)(ai * HALF + m * 16) * D; float p = 0.f;
#pragma unroll
            for (int bj = 0; bj < 2; ++bj) { const u32x4 w_ = xa[i][bj];
                const f32x4 x0 = {__builtin_bit_cast(float, w_.x << 16), __builtin_bit_cast(float, w_.x & 0xffff0000u), __builtin_bit_cast(float, w_.y << 16), __builtin_bit_cast(float, w_.y & 0xffff0000u)};
                const f32x4 x1 = {__builtin_bit_cast(float, w_.z << 16), __builtin_bit_cast(float, w_.z & 0xffff0000u), __builtin_bit_cast(float, w_.w << 16), __builtin_bit_cast(float, w_.w & 0xffff0000u)};
                const f32x4 v0 = acc[ai][bj][m][0] + x0 * (gi[bj][0] * rr[i]), v1 = acc[ai][bj][m][1] + x1 * (gi[bj][1] * rr[i]);
                u32x4 w; w.x = cvt_pk_bf16(v0[0], v0[1]); w.y = cvt_pk_bf16(v0[2], v0[3]); w.z = cvt_pk_bf16(v1[0], v1[1]); w.w = cvt_pk_bf16(v1[2], v1[3]);
                *(u32x4*)(bp + o_ + bj * HALF) = w;
                p += (v0[0] * v0[0] + v0[1] * v0[1]) + (v0[2] * v0[2] + v0[3] * v0[3]) + (v1[0] * v1[0] + v1[1] * v1[1]) + (v1[2] * v1[2] + v1[3] * v1[3]); }
            part[i] = p;
            if (i + 4 < 8) { EO_LOAD((i + 4) & 7); }
            asm volatile("" ::: "memory"); }
#undef EO_LOAD
#pragma unroll
        for (int i = 0; i < 8; ++i) part[i] += __shfl_xor(part[i], 16);
#pragma unroll
        for (int i = 0; i < 8; ++i) part[i] += __shfl_xor(part[i], 32);
        if (fq == 0) {
#pragma unroll
            for (int i = 0; i < 8; ++i) atomicAdd(ss + row0 + (i >> 2) * HALF + (i & 3) * 16, part[i]);
        }
    }
};

struct EpiGU {
    static constexpr bool PERM = true, AFTER_DRAIN = false;
    bf16_t* ACT; const float* ss;
    __device__ __forceinline__ void operator()(const f32x4 (&acc)[2][2][4][2], const Unit& u, int wr, int wc, int fr, int fq) const {
        const int row0 = u.pm * BM + wr * 64 + fr, col0 = u.pn * HALF + wc * 32 + 8 * fq;
        float sv[8];
#pragma unroll
        for (int i = 0; i < 8; ++i) sv[i] = ss[row0 + (i >> 2) * HALF + (i & 3) * 16];
        asm volatile("" ::: "memory");
#pragma unroll
        for (int i = 0; i < 8; ++i) { const int ai = i >> 2, m = i & 3;
            const float rstd = __builtin_amdgcn_rsqf(sv[i] * (1.0f / (float)D) + EPS), ne = -LOG2E * rstd, r2 = rstd * rstd;
            unsigned w[4];
#pragma unroll
            for (int n = 0; n < 2; ++n)
#pragma unroll
                for (int h = 0; h < 2; ++h) {
                    const f32x2 g = {acc[ai][0][m][n][2 * h], acc[ai][0][m][n][2 * h + 1]}, up = {acc[ai][1][m][n][2 * h], acc[ai][1][m][n][2 * h + 1]};
                    const f32x2 t = g * ne; f32x2 e; e.x = __builtin_amdgcn_exp2f(t.x); e.y = __builtin_amdgcn_exp2f(t.y);
                    const f32x2 d = e + 1.0f; f32x2 r; r.x = __builtin_amdgcn_rcpf(d.x); r.y = __builtin_amdgcn_rcpf(d.y);
                    const f32x2 a = (g * up) * (r * r2);
                    w[2 * n + h] = cvt_pk_bf16(a.x, a.y); }
            *(u32x4*)(ACT + (size_t)(row0 + ai * HALF + m * 16) * FF + col0) = (u32x4){w[0], w[1], w[2], w[3]};
        }
    }
};

struct EpiDown {
    static constexpr bool PERM = true, AFTER_DRAIN = false;
    const bf16_t* XB; float* out;
    __device__ __forceinline__ void operator()(const f32x4 (&acc)[2][2][4][2], const Unit& u, int wr, int wc, int fr, int fq) const {
        const int row0 = u.pm * BM + wr * 64 + fr, col0 = u.pn * BM + wc * 32 + 8 * fq;
        const size_t off0 = (size_t)row0 * D + col0;
        const bf16_t* __restrict__ bp = XB + off0; float* __restrict__ op = out + off0;
        u32x4 xa[8][2];
#define ED_LOAD(i) do { const size_t o_ = (size_t)(((i) >> 2) * HALF + ((i) & 3) * 16) * D; xa[i][0] = *(const u32x4*)(bp + o_); xa[i][1] = *(const u32x4*)(bp + o_ + HALF); } while (0)
        ED_LOAD(0); ED_LOAD(1); ED_LOAD(2); ED_LOAD(3);
        asm volatile("" ::: "memory");
#pragma unroll
        for (int i = 0; i < 8; ++i) { const int ai = i >> 2, m = i & 3; const size_t o_ = (size_t)(ai * HALF + m * 16) * D;
#pragma unroll
            for (int bj = 0; bj < 2; ++bj) { const u32x4 w = xa[i][bj];
                const f32x4 r0 = {__builtin_bit_cast(float, w.x << 16), __builtin_bit_cast(float, w.x & 0xffff0000u), __builtin_bit_cast(float, w.y << 16), __builtin_bit_cast(float, w.y & 0xffff0000u)};
                const f32x4 r1 = {__builtin_bit_cast(float, w.z << 16), __builtin_bit_cast(float, w.z & 0xffff0000u), __builtin_bit_cast(float, w.w << 16), __builtin_bit_cast(float, w.w & 0xffff0000u)};
                *(f32x4*)(op + o_ + bj * HALF) = acc[ai][bj][m][0] + r0; *(f32x4*)(op + o_ + bj * HALF + 4) = acc[ai][bj][m][1] + r1; }
            if (i + 4 < 8) { ED_LOAD((i + 4) & 7); }
            asm volatile("" ::: "memory"); }
#undef ED_LOAD
    }
};

template <class Epi, class Sched, bool ALIGN_EPI = false, bool SP2 = false>
__device__ __forceinline__ void gemm_phase(LAS unsigned char* lds, const Gemm g, const Sched& S, const Epi& E) {
    const int tid = threadIdx.x, wid = __builtin_amdgcn_readfirstlane(tid >> 6), lane = tid & 63, wr = wid >> 2, wc = wid & 3, fr = lane & 15, fq = lane >> 4;
    const int K = g.K, nt = K / BK;
    unsigned voffA[2], voffB[2];
#pragma unroll
    for (int i = 0; i < 2; ++i) { int R, C; stage_rc(tid * 16 + i * 8192, R, C); const int Rb = Epi::PERM ? ((R & ~31) + perm32(R & 31)) : R;
        voffA[i] = (unsigned)(R * K + C) * 2u; voffB[i] = (unsigned)(Rb * K + C) * 2u; }
    const size_t kstep = (size_t)(BK * 2);
    const size_t hstep = (size_t)HALF * K * 2;
    const size_t tstep = 2 * hstep;
    const unsigned ldsw = (unsigned)wid * 1024u;
    const int aoff = lds_byte(wr * 64 + fr, fq * 8), boff = lds_byte(wc * 32 + fr, fq * 8);
#define PG8_SA(b, h) (((b) * 2 + (h)) * HTB)
#define PG8_SB(b, h) ((4 + (b) * 2 + (h)) * HTB)
#define PG8_STAGE(bufoff, gbase, voff) do { _Pragma("unroll") for (int _i = 0; _i < 2; ++_i) \
        __builtin_amdgcn_global_load_lds((const unsigned*)((const char*)(gbase) + (voff)[_i]), (LAS unsigned*)(lds + (bufoff) + ldsw + _i * 8192), 16, 0, 0); } while (0)
#define PG8_LDA(dst, b, h) do { _Pragma("unroll") for (int m = 0; m < 4; ++m) _Pragma("unroll") for (int k = 0; k < 2; ++k) dst[m][k] = *(const LAS bf16x8*)(lds + PG8_SA(b, h) + aoff + m * 2048 + k * 1024); } while (0)
#define PG8_LDB(dst, b, h) do { _Pragma("unroll") for (int n = 0; n < 2; ++n) _Pragma("unroll") for (int k = 0; k < 2; ++k) dst[n][k] = *(const LAS bf16x8*)(lds + PG8_SB(b, h) + boff + n * 2048 + k * 1024); } while (0)
#define PG8_MMA(ai, bj, At, Bt) do { __builtin_amdgcn_s_setprio(1); _Pragma("unroll") for (int m = 0; m < 4; ++m) _Pragma("unroll") for (int n = 0; n < 2; ++n) _Pragma("unroll") for (int k = 0; k < 2; ++k) \
        acc[ai][bj][m][n] = __builtin_amdgcn_mfma_f32_16x16x32_bf16(Bt[n][k], At[m][k], acc[ai][bj][m][n], 0, 0, 0); __builtin_amdgcn_s_setprio(0); } while (0)
#define PG8_WAIT_V(n) asm volatile("s_waitcnt vmcnt(" #n ")" ::: "memory")
#define PG8_WAIT_L(n) asm volatile("s_waitcnt lgkmcnt(" #n ")" ::: "memory")
#define PG8_BAR __builtin_amdgcn_s_barrier()
#define PG8_SCHED __builtin_amdgcn_sched_barrier(0)
    Unit cur, nxt; int ui = 0;
    if (!S.next(0, cur)) return;
    f32x4 acc[2][2][4][2];
#pragma unroll
    for (int a = 0; a < 2; ++a)
#pragma unroll
        for (int b = 0; b < 2; ++b)
#pragma unroll
            for (int m = 0; m < 4; ++m)
#pragma unroll
                for (int n = 0; n < 2; ++n) acc[a][b][m][n] = (f32x4){0.f, 0.f, 0.f, 0.f};
    bf16x8 At[4][2], B0[2][2], B1[2][2];
    const char* cA = (const char*)g.A + (size_t)cur.pm * tstep; const char* cB = (const char*)g.Bt + (size_t)cur.pn * tstep;
    S.a_ready(cur);
    if constexpr (SP2) {
        PG8_STAGE(PG8_SB(0, 0), cB, voffB); PG8_STAGE(PG8_SB(0, 1), cB + hstep, voffB); PG8_STAGE(PG8_SA(0, 0), cA, voffA); PG8_STAGE(PG8_SA(0, 1), cA + hstep, voffA);
        if (wr == 1) PG8_BAR;
        PG8_WAIT_V(2); PG8_BAR;
        PG8_STAGE(PG8_SB(1, 0), cB + kstep, voffB); PG8_STAGE(PG8_SA(1, 0), cA + kstep, voffA); PG8_STAGE(PG8_SB(1, 1), cB + hstep + kstep, voffB);
        PG8_WAIT_V(6); PG8_BAR;
    } else {
        PG8_STAGE(PG8_SB(0, 0), cB, voffB); PG8_STAGE(PG8_SA(0, 0), cA, voffA); PG8_STAGE(PG8_SB(0, 1), cB + hstep, voffB); PG8_STAGE(PG8_SA(0, 1), cA + hstep, voffA);
        if (wr == 1) PG8_BAR;
        PG8_WAIT_V(4); PG8_BAR;
        PG8_STAGE(PG8_SB(1, 0), cB + kstep, voffB); PG8_STAGE(PG8_SA(1, 0), cA + kstep, voffA); PG8_STAGE(PG8_SB(1, 1), cB + hstep + kstep, voffB);
        PG8_WAIT_V(6); PG8_BAR;
    }
    for (;;) {
        const bool has_next = S.next(ui + 1, nxt);
        const char* nA = has_next ? (const char*)g.A + (size_t)nxt.pm * tstep : cA; const char* nB = has_next ? (const char*)g.Bt + (size_t)nxt.pn * tstep : cB;
        for (int t = 0; t < nt; t += 2) {
            const bool last = (t == nt - 2);
            const char* a1 = cA + (size_t)(t + 1) * kstep;
            const char* a2 = last ? nA : cA + (size_t)(t + 2) * kstep; const char* b2 = last ? nB : cB + (size_t)(t + 2) * kstep;
            const char* a3 = a2 + kstep; const char* b3 = b2 + kstep;
            if (last && has_next) S.a_ready(nxt);
            if constexpr (SP2) {
            PG8_LDB(B0, 0, 0); PG8_LDB(B1, 0, 1); PG8_SCHED; PG8_LDA(At, 0, 0); PG8_STAGE(PG8_SA(1, 1), a1 + hstep, voffA);
            PG8_WAIT_V(8); PG8_WAIT_L(0); PG8_BAR; PG8_MMA(0, 0, At, B0); PG8_MMA(0, 1, At, B1); PG8_BAR; PG8_SCHED;
            PG8_LDA(At, 0, 1); PG8_STAGE(PG8_SB(0, 0), b2, voffB); PG8_STAGE(PG8_SB(0, 1), b2 + hstep, voffB); PG8_STAGE(PG8_SA(0, 0), a2, voffA);
            PG8_WAIT_V(8); PG8_WAIT_L(0); PG8_BAR; PG8_MMA(1, 0, At, B0); PG8_MMA(1, 1, At, B1); PG8_BAR; PG8_SCHED;
            PG8_LDB(B0, 1, 0); PG8_LDB(B1, 1, 1); PG8_SCHED; PG8_LDA(At, 1, 0); PG8_STAGE(PG8_SA(0, 1), a2 + hstep, voffA);
            PG8_WAIT_V(8); PG8_WAIT_L(0); PG8_BAR; PG8_MMA(0, 0, At, B0); PG8_MMA(0, 1, At, B1); PG8_BAR; PG8_SCHED;
            PG8_LDA(At, 1, 1); PG8_STAGE(PG8_SB(1, 0), b3, voffB); PG8_STAGE(PG8_SB(1, 1), b3 + hstep, voffB); PG8_STAGE(PG8_SA(1, 0), a3, voffA);
            PG8_WAIT_V(8); PG8_WAIT_L(0); PG8_BAR; PG8_MMA(1, 0, At, B0); PG8_MMA(1, 1, At, B1); PG8_BAR; PG8_SCHED;
            } else {
            PG8_LDB(B0, 0, 0); PG8_SCHED; PG8_LDA(At, 0, 0); PG8_STAGE(PG8_SA(1, 1), a1 + hstep, voffA);
            PG8_WAIT_L(8); PG8_BAR; PG8_WAIT_L(0); PG8_MMA(0, 0, At, B0); PG8_BAR; PG8_SCHED;
            PG8_LDB(B1, 0, 1); PG8_STAGE(PG8_SB(0, 0), b2, voffB);
            PG8_BAR; PG8_WAIT_L(0); PG8_MMA(0, 1, At, B1); PG8_BAR;
            PG8_LDA(At, 0, 1); PG8_STAGE(PG8_SA(0, 0), a2, voffA);
            PG8_BAR; PG8_WAIT_L(0); PG8_MMA(1, 0, At, B0); PG8_BAR; PG8_SCHED;
            PG8_STAGE(PG8_SB(0, 1), b2 + hstep, voffB);
            PG8_WAIT_V(6); PG8_BAR; PG8_MMA(1, 1, At, B1); PG8_BAR;
            PG8_LDB(B0, 1, 0); PG8_SCHED; PG8_LDA(At, 1, 0); PG8_STAGE(PG8_SA(0, 1), a2 + hstep, voffA);
            PG8_WAIT_L(8); PG8_BAR; PG8_WAIT_L(0); PG8_MMA(0, 0, At, B0); PG8_BAR; PG8_SCHED;
            PG8_LDB(B1, 1, 1); PG8_STAGE(PG8_SB(1, 0), b3, voffB);
            PG8_BAR; PG8_WAIT_L(0); PG8_MMA(0, 1, At, B1); PG8_BAR;
            PG8_LDA(At, 1, 1); PG8_STAGE(PG8_SA(1, 0), a3, voffA);
            PG8_BAR; PG8_WAIT_L(0); PG8_MMA(1, 0, At, B0); PG8_BAR; PG8_SCHED;
            PG8_STAGE(PG8_SB(1, 1), b3 + hstep, voffB);
            PG8_WAIT_V(6); PG8_BAR; PG8_MMA(1, 1, At, B1); PG8_BAR;
            }
        }
        if constexpr (ALIGN_EPI) { if (wr == 0) PG8_BAR; }
        if constexpr (!Epi::AFTER_DRAIN) { E(acc, cur, wr, wc, fr, fq); S.done(cur); }
        if (!has_next) break;
#pragma unroll
        for (int a = 0; a < 2; ++a)
#pragma unroll
            for (int b = 0; b < 2; ++b)
#pragma unroll
                for (int m = 0; m < 4; ++m)
#pragma unroll
                    for (int n = 0; n < 2; ++n) acc[a][b][m][n] = (f32x4){0.f, 0.f, 0.f, 0.f};
        cur = nxt; cA = nA; cB = nB; ++ui;
        if constexpr (ALIGN_EPI) { if (wr == 1) PG8_BAR; }
    }
    PG8_WAIT_V(0);
    if constexpr (!ALIGN_EPI) { if (wr == 0) PG8_BAR; }
    PG8_BAR;
#undef PG8_SA
#undef PG8_SB
#undef PG8_STAGE
#undef PG8_LDA
#undef PG8_LDB
#undef PG8_MMA
#undef PG8_WAIT_V
#undef PG8_WAIT_L
#undef PG8_BAR
#undef PG8_SCHED
}
}

constexpr int NWAVES = 8;
#ifndef MK_N_LAUNCHES
#define MK_N_LAUNCHES 1
#endif
constexpr int N_LAUNCHES = MK_N_LAUNCHES;
constexpr int PER_PHASE = 6;
#ifndef PG8_SP2
#define PG8_SP2 true
#endif

constexpr size_t MiB = 1u << 20;
constexpr size_t WS_CTL = 0, CTL_ZERO_BYTES = 1 * MiB;
constexpr size_t WS_WIN = 2 * MiB;
constexpr size_t WS_WOUT = 6 * MiB;
constexpr size_t WS_WGU = 8 * MiB;
constexpr size_t WS_WDN = 20 * MiB;
constexpr size_t WS_XN = 32 * MiB;
constexpr size_t WS_QKVZ = 160 * MiB;
constexpr size_t WS_ACT = 416 * MiB;
constexpr size_t WS_XB = 768 * MiB;
constexpr size_t WS_END = 896 * MiB;
static_assert(WS_WGU + (size_t)NGU * D * 2 <= WS_WDN && WS_WDN + (size_t)D * FF * 2 <= WS_XN && WS_ACT + (size_t)M * FF * 2 <= WS_END, "d_ws map");
constexpr int CW_BAR = 4096;
constexpr int CW_SS = 65536;
static_assert((size_t)(CW_SS + 2 * M) * 4 <= CTL_ZERO_BYTES, "ss, rrow inside the control region");

constexpr int RING_OFF = 0, RING_BYTES = 131072;
constexpr int LDSCTL_OFF = 157696, MISC_OFF = LDSCTL_OFF + 320;
constexpr int LDS_GAIN_OFF = LDSCTL_OFF + 512;
constexpr int LDS_BYTES = 163840;

typedef GAS unsigned gu32;
#define RLX_AGENT __ATOMIC_RELAXED, __HIP_MEMORY_SCOPE_AGENT
#define LDS_WAIT() asm volatile("s_waitcnt lgkmcnt(0)" ::: "memory")
__device__ __forceinline__ unsigned f2bf(float f) { unsigned u = __builtin_bit_cast(unsigned, f); return (u + 0x7fffu + ((u >> 16) & 1u)) >> 16; }
__device__ __forceinline__ unsigned pk2(float lo, float hi) { return f2bf(lo) | (f2bf(hi) << 16); }
__device__ __forceinline__ float bflo(unsigned w) { return __builtin_bit_cast(float, w << 16); }
__device__ __forceinline__ float bfhi(unsigned w) { return __builtin_bit_cast(float, w & 0xffff0000u); }

#define XB_TMO      128
#define XB_XCNT(j)  (256  + 64 * (j))
#define XB_XSUB(j)  (1280 + 64 * (j))
#define XB_XGEN(j)  (2304 + 64 * (j))
#define XB_TOP      3328
#define XB_TOPGEN   3392
#define XCD_BAR_WORDS 3456
#define XB_SPIN_CAP (1u << 18)

__device__ __forceinline__ unsigned xb_ld(unsigned* p)              { return __hip_atomic_load(p, __ATOMIC_RELAXED, __HIP_MEMORY_SCOPE_AGENT); }
__device__ __forceinline__ unsigned xb_add(unsigned* p, unsigned v) { return __hip_atomic_fetch_add(p, v, __ATOMIC_RELAXED, __HIP_MEMORY_SCOPE_AGENT); }
__device__ __forceinline__ unsigned xb_xcc_id() { return (unsigned)__builtin_amdgcn_s_getreg((3 << 11) | 20) & 0xFu; }
#define XB_SPIN(cond, bar) do { unsigned _sp = 0; while (cond) { __builtin_amdgcn_s_sleep(1); \
    if ((++_sp & 255u) == 0u) { if (xb_ld(&(bar)[XB_TMO])) break; if (_sp > XB_SPIN_CAP) { atomicAdd(&(bar)[XB_TMO], 1u); break; } } } } while (0)

struct XcdBarrier { unsigned* bar; unsigned x; volatile LAS unsigned* st; };

__device__ __forceinline__ XcdBarrier xcd_barrier_post(unsigned* bar, volatile LAS unsigned* st) {
    XcdBarrier b; b.bar = bar; b.x = xb_xcc_id(); b.st = st;
    if (threadIdx.x == 0) (void)xb_add(&bar[XB_XCNT(b.x)], 1u);
    return b;
}
__device__ __forceinline__ void xcd_barrier_complete(unsigned* bar, unsigned x, unsigned& nloc, unsigned& nx) {
    const unsigned G = gridDim.x * gridDim.y * gridDim.z;
    unsigned sum, cnt, mine, sp = 0u;
    for (;;) {
        sum = 0u; cnt = 0u; mine = 0u;
#pragma unroll
        for (unsigned j = 0; j < 16; ++j) { const unsigned c = xb_ld(&bar[XB_XCNT(j)]); sum += c; cnt += (c > 0u) ? 1u : 0u; mine = (j == x) ? c : mine; }
        if (sum == G) break;
        __builtin_amdgcn_s_sleep(1);
        if ((++sp & 255u) == 0u) { if (xb_ld(&bar[XB_TMO])) break; if (sp > XB_SPIN_CAP) { atomicAdd(&bar[XB_TMO], 1u); break; } }
    }
    nloc = mine > 0u ? mine : 1u; nx = cnt > 0u ? cnt : 1u;
}
__device__ __forceinline__ void xcd_barrier(const XcdBarrier& b) {
    asm volatile("s_waitcnt vmcnt(0)" ::: "memory");
    __syncthreads();
    if (threadIdx.x == 0) {
        unsigned* bar = b.bar;
        __builtin_amdgcn_s_waitcnt(0);
        unsigned nloc = b.st[0], nx = b.st[1];
        if (nloc == 0u) { xcd_barrier_complete(bar, b.x, nloc, nx); b.st[0] = nloc; b.st[1] = nx; }
        const unsigned old = xb_add(&bar[XB_XSUB(b.x)], 1u);
        const unsigned gen = old / nloc;
        if (old + 1u == (gen + 1u) * nloc) {
            __builtin_amdgcn_fence(__ATOMIC_RELEASE, "agent");
            asm volatile("s_waitcnt vmcnt(0)" ::: "memory");
            const unsigned og = xb_add(&bar[XB_TOP], 1u);
            const unsigned tg = og / nx;
            if (og + 1u == (tg + 1u) * nx) xb_add(&bar[XB_TOPGEN], 1u);
            else XB_SPIN(xb_ld(&bar[XB_TOPGEN]) == tg, bar);
            __builtin_amdgcn_fence(__ATOMIC_ACQUIRE, "agent");
            xb_add(&bar[XB_XGEN(b.x)], 1u);
            asm volatile("s_waitcnt vmcnt(0)" ::: "memory");
        } else {
            XB_SPIN(xb_ld(&bar[XB_XGEN(b.x)]) == gen, bar);
            __builtin_amdgcn_fence(__ATOMIC_ACQUIRE, "agent");
            asm volatile("s_waitcnt vmcnt(0)" ::: "memory");
        }
    }
    __syncthreads();
}

struct Frame {
    LAS unsigned char* lds;
    volatile LAS unsigned* MISC;
    gu32* ctl;
    int tid, lane, wave;
    int vcu, G;
    const float *x, *g1, *w_in, *gq, *gk, *rpb, *w_pool, *pscale, *w_out, *g2, *w_gate, *w_up, *w_down;
    float* out;
    bf16_t *Win_t, *Wout_t, *Wgu_t, *Wdn_t;
    bf16_t *XN, *QKVZ, *XB, *ACT;
    float* ss; float* rrow; bf16_t* MIX;
};

__device__ __forceinline__ float wave_sum(float v) {
#pragma unroll
    for (int o = 1; o < 64; o <<= 1) v += __shfl_xor(v, o);
    return v;
}

__device__ __forceinline__ void p0_tile_out(bf16_t* WT, int K, int drow0, int k0, LAS float* scr, int lane) {
    LDS_WAIT(); asm volatile("" ::: "memory");
    const int c = lane & 7;
#pragma unroll
    for (int j = 0; j < 4; ++j) { const int n = (lane >> 3) + 8 * j; const LAS float* s = scr + (8 * c) * 33 + n;
        u32x4 o; o.x = pk2(s[0 * 33], s[1 * 33]); o.y = pk2(s[2 * 33], s[3 * 33]); o.z = pk2(s[4 * 33], s[5 * 33]); o.w = pk2(s[6 * 33], s[7 * 33]);
        *(GAS u32x4*)(WT + (size_t)(drow0 + n) * K + k0 + 8 * c) = o; }
    LDS_WAIT(); asm volatile("" ::: "memory");
}
__device__ __forceinline__ void p0_transpose_item(const float* W, int ldw, int K, int k0, int n0, const float* gkv, bf16_t* WT, int drow0, LAS float* scr, int lane) {
#pragma unroll
    for (int i = 0; i < 32; ++i) { const int kk = 2 * i + (lane >> 5); float v = W[(size_t)(k0 + kk) * ldw + n0 + (lane & 31)]; if (gkv) v *= gkv[k0 + kk]; scr[kk * 33 + (lane & 31)] = v; }
    p0_tile_out(WT, K, drow0, k0, scr, lane);
}
__device__ __forceinline__ void p0_fold_item(const float* w_in, const float* w_pool, const float* pscale, int k0, int n0z, bf16_t* WT, int drow0, int lane) {
    const int n = lane & 31, kh = lane >> 5, g = n0z >> 7, d = (n0z & 127) + n;
    float acc[4] = {0.f, 0.f, 0.f, 0.f};
    const float* wrow = w_in + (size_t)(k0 + 4 * kh) * NIN + 3 * NA + 128 * g;
    const float* wp = w_pool + (size_t)g * 128 * 128 + d;
#pragma unroll 8
    for (int c4 = 0; c4 < 32; ++c4) {
        const float p0 = wp[(4 * c4 + 0) * 128], p1 = wp[(4 * c4 + 1) * 128], p2 = wp[(4 * c4 + 2) * 128], p3 = wp[(4 * c4 + 3) * 128];
#pragma unroll
        for (int i = 0; i < 4; ++i) { const f32x4 w = *(const f32x4*)(wrow + (size_t)i * NIN + 4 * c4); acc[i] += (w[0] * p0 + w[1] * p1) + (w[2] * p2 + w[3] * p3); }
    }
    const float ps = pscale[n0z + n];
    float hi[4];
#pragma unroll
    for (int i = 0; i < 4; ++i) { acc[i] *= ps; hi[i] = __shfl(acc[i], (lane + 32) & 63); }
    if (lane < 32) { u32x4 o; o.x = pk2(acc[0], acc[1]); o.y = pk2(acc[2], acc[3]); o.z = pk2(hi[0], hi[1]); o.w = pk2(hi[2], hi[3]);
        *(GAS u32x4*)(WT + (size_t)(drow0 + n) * D + k0) = o; }
}
__device__ __forceinline__ int win_drow(int n0) { const int pn = n0 >> 8, c = n0 & 255; return 256 * pn + 128 * ((c >> 5) & 1) + 32 * (c >> 6); }

template <int R> __device__ __forceinline__ void rms_rows(const float* x, const f32x4 (&gg)[4], bf16_t* XN, float* rrow, int m0, int lane) {
    f32x4 v[R][4]; float s[R];
#pragma unroll
    for (int r = 0; r < R; ++r) { const GAS f32x4* xr = (const GAS f32x4*)(x + (size_t)(m0 + r) * D) + lane;
#pragma unroll
        for (int j = 0; j < 4; ++j) v[r][j] = xr[64 * j]; }
#pragma unroll
    for (int r = 0; r < R; ++r) { float a = 0.f;
#pragma unroll
        for (int j = 0; j < 4; ++j) a += (v[r][j].x * v[r][j].x + v[r][j].y * v[r][j].y) + (v[r][j].z * v[r][j].z + v[r][j].w * v[r][j].w);
        s[r] = a; }
#pragma unroll
    for (int o = 1; o < 64; o <<= 1) {
#pragma unroll
        for (int r = 0; r < R; ++r) s[r] += __shfl_xor(s[r], o); }
#pragma unroll
    for (int r = 0; r < R; ++r) { const float ms = s[r] * (1.f / D) + EPS, rstd = __builtin_amdgcn_rsqf(ms);
        if (lane == 0) rrow[m0 + r] = ms * rstd;
        GAS unsigned long long* o8 = (GAS unsigned long long*)(XN + (size_t)(m0 + r) * D) + lane;
#pragma unroll
        for (int j = 0; j < 4; ++j) o8[64 * j] = (unsigned long long)pk2(v[r][j].x * rstd * gg[j].x, v[r][j].y * rstd * gg[j].y) | ((unsigned long long)pk2(v[r][j].z * rstd * gg[j].z, v[r][j].w * rstd * gg[j].w) << 32); }
}

__device__ __forceinline__ void p0_prologue(Frame& F) {
    LAS float* scr = (LAS float*)(F.lds + RING_OFF + F.wave * 16384);
    if (F.wave >= 4) {
        const int gw = F.vcu * 4 + (F.wave - 4), NGW = F.G * 4;
        constexpr int KB = D / 64;
        constexpr int I_QKV = KB * (3 * NA / 32), I_O = KB * (D / 32), I_G = KB * (FF / 32), I_DN = (FF / 64) * (D / 32);
        constexpr int NITEMS = I_QKV + I_O + 2 * I_G + I_DN;
        for (int it = gw; it < (D / 8) * (NA / 32); it += NGW) { const int nb = it & 15, kb = it >> 4; p0_fold_item(F.w_in, F.w_pool, F.pscale, 8 * kb, 32 * nb, F.Win_t, win_drow(3 * NA + 32 * nb), F.lane); }
        for (int it = gw; it < NITEMS; it += NGW) {
            int r = it;
            if (r < I_QKV) { const int nb = r % (3 * NA / 32), kb = r / (3 * NA / 32); p0_transpose_item(F.w_in, NIN, D, 64 * kb, 32 * nb, nullptr, F.Win_t, win_drow(32 * nb), scr, F.lane); continue; } r -= I_QKV;
            if (r < I_O) { const int nb = r % (D / 32), kb = r / (D / 32); p0_transpose_item(F.w_out, D, D, 64 * kb, 32 * nb, nullptr, F.Wout_t, 32 * nb, scr, F.lane); continue; } r -= I_O;
            if (r < 2 * I_G) { const int up = r >= I_G; if (up) r -= I_G; const int nb = r % (FF / 32), kb = r / (FF / 32), n0 = 32 * nb;
                p0_transpose_item(up ? F.w_up : F.w_gate, FF, D, 64 * kb, n0, F.g2, F.Wgu_t, 256 * (n0 >> 7) + (n0 & 127) + 128 * up, scr, F.lane); continue; } r -= 2 * I_G;
            { const int nb = r % (D / 32), kb = r / (D / 32); p0_transpose_item(F.w_down, D, FF, 64 * kb, 32 * nb, nullptr, F.Wdn_t, 32 * nb, scr, F.lane); }
        }
    }
    f32x4 gg[4];
#pragma unroll
    for (int j = 0; j < 4; ++j) gg[j] = *((const f32x4*)F.g1 + F.lane + 64 * j);
    const int RPW = (M + F.G - 1) / F.G, rbeg = F.vcu * RPW, rend = (rbeg + RPW) < M ? (rbeg + RPW) : M, nb8 = (rend - rbeg) / 8;
    volatile LAS unsigned* tick = F.MISC + 16;
    for (;;) {
        unsigned t = 0; if (F.lane == 0) t = __hip_atomic_fetch_add((LAS unsigned*)tick, 1u, __ATOMIC_RELAXED, __HIP_MEMORY_SCOPE_WORKGROUP);
        t = __builtin_amdgcn_readfirstlane(t);
        if ((int)t >= nb8) break;
        rms_rows<8>(F.x, gg, F.XN, F.rrow, rbeg + 8 * (int)t, F.lane);
    }
    if (F.wave == 0) for (int m = rbeg + 8 * nb8; m < rend; ++m) rms_rows<1>(F.x, gg, F.XN, F.rrow, m, F.lane);
}

constexpr int AT_IMG = 15 * 40 * 128;
constexpr int AT_A = 0;
constexpr int AT_B = AT_IMG;
constexpr int AT_TAB = 2 * AT_IMG;
static_assert(AT_TAB + 15 * 64 * 4 <= LDSCTL_OFF, "attention LDS map");
__device__ __forceinline__ int rs_of(int r) { int v = r - 4; v = v < 0 ? 0 : v; return v > 56 ? 56 : v; }

struct AttnUnit { int b, h, jh, r0, krow_lo, nrows; };
__device__ __forceinline__ AttnUnit attn_decode(int un) {
    AttnUnit u; const int bh = un >> 4, rc = (un >> 1) & 7; u.jh = un & 1; u.b = bh >> 3; u.h = bh & 7;
    u.r0 = 8 * rc; u.krow_lo = rs_of(u.r0); u.nrows = rs_of(u.r0 + 7) + 8 - u.krow_lo;
    return u;
}
__device__ __forceinline__ void glds16(const void* gsrc, unsigned lds_dst) { unsigned keep;
    asm volatile("s_mov_b32 %0, m0\n\ts_mov_b32 m0, %2\n\ts_nop 0\n\tglobal_load_lds_dwordx4 %1, off\n\ts_mov_b32 m0, %0" : "=&s"(keep) : "v"(gsrc), "s"(lds_dst) : "memory"); }
#define ATT_WAIT_BAR() do { asm volatile("s_waitcnt vmcnt(0) lgkmcnt(0)" ::: "memory"); __builtin_amdgcn_s_barrier(); asm volatile("" ::: "memory"); } while (0)
template <int KIND> __device__ __forceinline__ void attn_dma(unsigned dst, const bf16_t* src, const AttnUnit& u, int wid, int lane) {
    const int np = u.nrows * 5;
    const char* base = (const char*)(src + ((size_t)(u.b * NHEAD + u.h) * SEQ + u.krow_lo * 64 + 24 * u.jh) * HD);
#pragma unroll
    for (int it = 0; it < 10; ++it) {
        const int pi = it * 8 + wid;
        if (pi < np) {
            const int w = (pi * 205) >> 10, p = pi - 5 * w, c = 8 * p + (lane >> 3);
            const int sw = (KIND == 0) ? (((c >> 1) & 1) | (((c >> 3) & 3) << 1)) : ((((c >> 1) & 1) << 1) | (((c >> 3) & 1) << 2));
            const int ch = (lane & 7) ^ sw;
            const char* gp = base + (w * 64 + c) * (HD * 2) + ch * 16;
            glds16(gp, (unsigned)__builtin_amdgcn_readfirstlane(dst + pi * 1024));
        }
    }
}

__device__ __forceinline__ void p2_attention(Frame& F, const bf16_t* Qg, const bf16_t* Kg, const bf16_t* Vg, bf16_t* MIX) {
    const int lane = F.lane, wid = F.wave;
    LAS unsigned char* lds = F.lds;
    const unsigned lds0 = (unsigned)(size_t)F.lds;
    const int q = lane & 15, g = lane >> 4;
    constexpr int NUNITS = BATCH * NHEAD * 16, UW = 8;
    for (int uidx = F.vcu * UW; uidx < NUNITS; uidx += F.G * UW) {
        const int h = (uidx >> 4) & 7;
        __syncthreads();
        {   LAS float* tab = (LAS float*)(lds + AT_TAB);
            for (int i = F.tid; i < 15 * 64; i += NWAVES * 64) { const int rr = i >> 6, cc = (i & 63) - 16; tab[i] = (cc >= 0 && cc < 31) ? F.rpb[h * 465 + rr * 31 + cc] * LOG2E : 0.f; } }
        AttnUnit u = attn_decode(uidx);
        attn_dma<0>(lds0 + AT_A, Kg, u, wid, lane);
        bf16x8 qf[2][2];
#pragma unroll
        for (int jb = 0; jb < 2; ++jb) { const bf16_t* qp = Qg + ((size_t)(u.b * NHEAD + u.h) * SEQ + (u.r0 + wid) * 64 + 32 * u.jh + 16 * jb + q) * HD + 8 * g; qf[jb][0] = *(const bf16x8*)qp; qf[jb][1] = *(const bf16x8*)(qp + 32); }
        ATT_WAIT_BAR();
        for (int ui = 0; ui < UW; ++ui) {
            asm volatile("" : "+v"(qf[0][0]), "+v"(qf[0][1]), "+v"(qf[1][0]), "+v"(qf[1][1]));
            attn_dma<1>(lds0 + AT_B, Vg, u, wid, lane);
            const int r = u.r0 + wid, rs = rs_of(r), wbase = rs - u.krow_lo;
            u32x4 pw[2][8]; float il[2];
#pragma unroll
            for (int jb = 0; jb < 2; ++jb) {
                const int o = 8 * jb, kcol0 = 24 * u.jh + o, cq = 32 * u.jh + 16 * jb + q;
                int cs = cq - 8; cs = cs < 0 ? 0 : cs; cs = cs > 48 ? 48 : cs;
                f32x4 sc[8][2];
                {
                    const int fk = ((q >> 1) & 1) | (((jb + (q >> 2)) & 3) << 1), x0 = g ^ fk;
                    const LAS unsigned char* ka = lds + AT_A + (wbase * 40 + o + 8 * (q >> 2) + (q & 3)) * 128;
                    const LAS unsigned char* k0p = ka + x0 * 16;
                    const LAS unsigned char* k1p = ka + (x0 ^ 4) * 16;
#pragma unroll
                    for (int wl = 0; wl < 8; ++wl)
#pragma unroll
                        for (int blk = 0; blk < 2; ++blk) {
                            const bf16x8 k0 = *(const LAS bf16x8*)(k0p + wl * 5120 + blk * 512), k1 = *(const LAS bf16x8*)(k1p + wl * 5120 + blk * 512);
                            f32x4 a = (f32x4){0.f, 0.f, 0.f, 0.f};
                            a = __builtin_amdgcn_mfma_f32_16x16x32_bf16(k0, qf[jb][0], a, 0, 0, 0);
                            a = __builtin_amdgcn_mfma_f32_16x16x32_bf16(k1, qf[jb][1], a, 0, 0, 0);
                            sc[wl][blk] = a;
                        }
                }
                const LAS float* tab = (const LAS float*)(lds + AT_TAB) + (rs - r + 7) * 64 + 16 + (kcol0 - cq + 15) + 8 * g;
                const int voff = kcol0 + 8 * g - cs;
                float mx = -INFINITY;
#pragma unroll
                for (int wl = 0; wl < 8; ++wl)
#pragma unroll
                    for (int blk = 0; blk < 2; ++blk)
#pragma unroll
                        for (int e = 0; e < 4; ++e) {
                            const int ep = 4 * blk + e;
                            float s_ = sc[wl][blk][e] + tab[wl * 64 + ep];
                            s_ = ((unsigned)(voff + ep) < 16u) ? s_ : -INFINITY;
                            sc[wl][blk][e] = s_; mx = fmaxf(mx, s_);
                        }
                mx = fmaxf(mx, __shfl_xor(mx, 16)); mx = fmaxf(mx, __shfl_xor(mx, 32));
                float l = 0.f;
#pragma unroll
                for (int wl = 0; wl < 8; ++wl) {
                    float p[8];
#pragma unroll
                    for (int blk = 0; blk < 2; ++blk)
#pragma unroll
                        for (int e = 0; e < 4; ++e) { p[4 * blk + e] = __builtin_amdgcn_exp2f(sc[wl][blk][e] - mx); l += p[4 * blk + e]; }
                    pw[jb][wl].x = cvt_pk_bf16(p[0], p[1]); pw[jb][wl].y = cvt_pk_bf16(p[2], p[3]); pw[jb][wl].z = cvt_pk_bf16(p[4], p[5]); pw[jb][wl].w = cvt_pk_bf16(p[6], p[7]);
                }
                l += __shfl_xor(l, 16); l += __shfl_xor(l, 32);
                il[jb] = __builtin_amdgcn_rcpf(l);
            }
            ATT_WAIT_BAR();
            AttnUnit un = u; bf16x8 nq[2][2];
#pragma unroll
            for (int jb = 0; jb < 2; ++jb) { nq[jb][0] = qf[jb][0]; nq[jb][1] = qf[jb][1]; }
            if (ui < UW - 1) {
                un = attn_decode(uidx + ui + 1);
                attn_dma<0>(lds0 + AT_A, Kg, un, wid, lane);
#pragma unroll
                for (int jb = 0; jb < 2; ++jb) { const bf16_t* qp = Qg + ((size_t)(un.b * NHEAD + un.h) * SEQ + (un.r0 + wid) * 64 + 32 * un.jh + 16 * jb + q) * HD + 8 * g; nq[jb][0] = *(const bf16x8*)qp; nq[jb][1] = *(const bf16x8*)(qp + 32); }
            }
#pragma unroll
            for (int jb = 0; jb < 2; ++jb) {
                const int o = 8 * jb, cq = 32 * u.jh + 16 * jb + q;
                f32x4 ov[4];
#pragma unroll
                for (int n = 0; n < 4; ++n) ov[n] = (f32x4){0.f, 0.f, 0.f, 0.f};
                {
                    const int qr = q >> 2, p = lane & 3;
                    const int fv = (((qr >> 1) & 1) << 1) | (((jb + g) & 1) << 2);
                    const LAS unsigned char* vb = lds + AT_B + (wbase * 40 + o + 8 * g + qr) * 128 + (p >> 1) * 16 + (p & 1) * 8;
                    const LAS unsigned char* vn[4];
#pragma unroll
                    for (int n = 0; n < 4; ++n) vn[n] = vb + ((2 * n) ^ fv) * 16;
#pragma unroll
                    for (int wl = 0; wl < 8; ++wl) {
                        const bf16x8 pf = __builtin_bit_cast(bf16x8, pw[jb][wl]);
#pragma unroll
                        for (int n = 0; n < 4; ++n) {
                            const s16x4 lo = __builtin_bit_cast(s16x4, __builtin_amdgcn_ds_read_tr16_b64_v4i16((LAS s16x4*)(vn[n] + wl * 5120)));
                            const s16x4 hi = __builtin_bit_cast(s16x4, __builtin_amdgcn_ds_read_tr16_b64_v4i16((LAS s16x4*)(vn[n] + wl * 5120 + 512)));
                            const bf16x8 vf = (bf16x8){lo[0], lo[1], lo[2], lo[3], hi[0], hi[1], hi[2], hi[3]};
                            ov[n] = __builtin_amdgcn_mfma_f32_16x16x32_bf16(vf, pf, ov[n], 0, 0, 0);
                        }
                    }
                }
                bf16_t* op = MIX + ((size_t)(u.b * SEQ + r * 64 + cq)) * D + u.h * HD + 4 * g;
#pragma unroll
                for (int n = 0; n < 4; ++n) { u32x2 w; w.x = cvt_pk_bf16(ov[n][0] * il[jb], ov[n][1] * il[jb]); w.y = cvt_pk_bf16(ov[n][2] * il[jb], ov[n][3] * il[jb]); *(u32x2*)(op + 16 * n) = w; }
            }
            ATT_WAIT_BAR();
            u = un;
#pragma unroll
            for (int jb = 0; jb < 2; ++jb) { qf[jb][0] = nq[jb][0]; qf[jb][1] = nq[jb][1]; }
        }
    }
}

__device__ __forceinline__ void up8(const u32x4 w, float (&v)[8]) {
    v[0] = bflo(w.x); v[1] = bfhi(w.x); v[2] = bflo(w.y); v[3] = bfhi(w.y); v[4] = bflo(w.z); v[5] = bfhi(w.z); v[6] = bflo(w.w); v[7] = bfhi(w.w);
}
__device__ __forceinline__ void pool_run(const bf16_t* __restrict__ Zg, bf16_t* __restrict__ MIX, int gw, int lane) {
    const int tb = 32 * gw, b = tb >> 12, t0 = tb & (SEQ - 1);
    const int half = 1 << (lane >> 4);
    const bf16_t* zb = Zg + (size_t)(b * SEQ) * NA + 8 * lane;
    bf16_t* ob = MIX + (size_t)(b * SEQ) * D + NA + 8 * lane;
    float S[8];
#pragma unroll
    for (int e = 0; e < 8; ++e) S[e] = 0.f;
    {   u32x4 w[16];
#pragma unroll
        for (int d = 0; d < 16; ++d) { int i = t0 + d - 8; i = i < 0 ? 0 : i; i = i > SEQ - 1 ? SEQ - 1 : i; w[d] = *(const u32x4*)(zb + (size_t)i * NA); }
#pragma unroll
        for (int d = 0; d < 16; ++d) { const int dd = d - 8, i = t0 + dd; const float mk = (dd >= -half && dd < half && i >= 0 && i < SEQ) ? 1.f : 0.f; float v[8]; up8(w[d], v);
#pragma unroll
            for (int e = 0; e < 8; ++e) S[e] += mk * v[e]; } }
    for (int c = 0; c < 4; ++c) {
        u32x4 zt[8], za[8], zs[8];
#pragma unroll
        for (int k = 0; k < 8; ++k) { const int t = t0 + 8 * c + k; int ia = t + half, is = t - half; ia = ia > SEQ - 1 ? SEQ - 1 : ia; is = is < 0 ? 0 : is;
            zt[k] = *(const u32x4*)(zb + (size_t)t * NA); za[k] = *(const u32x4*)(zb + (size_t)ia * NA); zs[k] = *(const u32x4*)(zb + (size_t)is * NA); }
#pragma unroll
        for (int k = 0; k < 8; ++k) { const int t = t0 + 8 * c + k;
            const int lo = (t - half) < 0 ? 0 : (t - half), hi = (t + half) > SEQ ? SEQ : (t + half);
            const float inv = 1.0f / (float)(hi - lo);
            float v[8]; up8(zt[k], v);
            u32x4 w;
            w.x = cvt_pk_bf16(S[0] * inv - v[0], S[1] * inv - v[1]); w.y = cvt_pk_bf16(S[2] * inv - v[2], S[3] * inv - v[3]);
            w.z = cvt_pk_bf16(S[4] * inv - v[4], S[5] * inv - v[5]); w.w = cvt_pk_bf16(S[6] * inv - v[6], S[7] * inv - v[7]);
            *(u32x4*)(ob + (size_t)t * D) = w;
            const float ma = (t + half < SEQ) ? 1.f : 0.f, ms = (t - half >= 0) ? 1.f : 0.f;
            float a[8], s[8]; up8(za[k], a); up8(zs[k], s);
#pragma unroll
            for (int e = 0; e < 8; ++e) S[e] += ma * a[e] - ms * s[e]; }
    }
}

__device__ __forceinline__ void p2_mixer(Frame& F) {
    const bf16_t* Qg = F.QKVZ; const bf16_t* Kg = F.QKVZ + (size_t)M * NA; const bf16_t* Vg = F.QKVZ + 2 * (size_t)M * NA; const bf16_t* Zg = F.QKVZ + 3 * (size_t)M * NA;
    bf16_t* MIX = F.MIX;
    for (int gw = F.vcu * NWAVES + F.wave; gw < M / 32; gw += F.G * NWAVES) pool_run(Zg, MIX, gw, F.lane);
    p2_attention(F, Qg, Kg, Vg, MIX);
    __syncthreads();
}

struct Args { const float* in[13]; float* out; unsigned char* ws; int ph_lo, ph_hi, li, pad; };
__global__ void __launch_bounds__(NWAVES * 64, 2) fwd_megakernel(Args args) {
    extern __shared__ __attribute__((aligned(16))) unsigned char lds[];
    Frame F;
    F.lds = (LAS unsigned char*)lds;
    F.MISC = (volatile LAS unsigned*)(F.lds + MISC_OFF);
    F.tid = threadIdx.x; F.lane = F.tid & 63; F.wave = __builtin_amdgcn_readfirstlane(F.tid >> 6);
    F.G = gridDim.x; { const int bx = blockIdx.x; F.vcu = (F.G % 8 == 0) ? (bx % 8) * (F.G / 8) + bx / 8 : bx; }
    unsigned char* ws = args.ws;
    F.ctl = (gu32*)(ws + WS_CTL);
    F.x = args.in[0]; F.g1 = args.in[1]; F.w_in = args.in[2]; F.gq = args.in[3]; F.gk = args.in[4]; F.rpb = args.in[5]; F.w_pool = args.in[6];
    F.pscale = args.in[7]; F.w_out = args.in[8]; F.g2 = args.in[9]; F.w_gate = args.in[10]; F.w_up = args.in[11]; F.w_down = args.in[12]; F.out = args.out;
    F.Win_t = (bf16_t*)(ws + WS_WIN); F.Wout_t = (bf16_t*)(ws + WS_WOUT); F.Wgu_t = (bf16_t*)(ws + WS_WGU); F.Wdn_t = (bf16_t*)(ws + WS_WDN);
    F.XN = (bf16_t*)(ws + WS_XN); F.QKVZ = (bf16_t*)(ws + WS_QKVZ); F.XB = (bf16_t*)(ws + WS_XB); F.ACT = (bf16_t*)(ws + WS_ACT);
    F.ss = (float*)(ws + WS_CTL) + CW_SS; F.rrow = (float*)(ws + WS_CTL) + CW_SS + M; F.MIX = (bf16_t*)(ws + WS_ACT);
    for (int u = F.tid; u < (LDS_BYTES - LDSCTL_OFF) / 4; u += NWAVES * 64) ((LAS unsigned*)(F.lds + LDSCTL_OFF))[u] = 0u;
    __syncthreads();
    XcdBarrier bar; bar.bar = (unsigned*)(F.ctl + CW_BAR); bar.x = 0; bar.st = nullptr;
    if (N_LAUNCHES != PER_PHASE) bar = xcd_barrier_post((unsigned*)(F.ctl + CW_BAR), F.MISC + 8);
#define GRID_BAR() do { if (N_LAUNCHES != PER_PHASE) xcd_barrier(bar); } while (0)
    const int lo = args.ph_lo, hi = args.ph_hi;
#define IN(k) (lo <= (k) && (k) < hi)
#define BOTH(k) (IN(k) && IN((k) + 1))

    if (IN(0)) { p0_prologue(F); if (BOTH(0)) GRID_BAR(); }

    if (IN(1)) {
        pg8::Gemm g{F.XN, F.Win_t, M, NIN, D}; pg8::StaticOrder S; S.init(M, NIN, F.G, (int)blockIdx.x);
        { LAS float* gl = (LAS float*)(F.lds + LDS_GAIN_OFF);
          if (F.tid < 64) gl[F.tid] = F.gq[F.tid] * (0.125f * LOG2E); else if (F.tid < 128) gl[F.tid] = F.gk[F.tid - 64];
          __syncthreads(); }
        pg8::EpiIn E{F.QKVZ, (const LAS float*)(F.lds + LDS_GAIN_OFF)};
        pg8::gemm_phase<pg8::EpiIn, pg8::StaticOrder, true, PG8_SP2>(F.lds + RING_OFF, g, S, E);
        if (BOTH(1)) GRID_BAR();
    }

    if (IN(2)) { p2_mixer(F); if (BOTH(2)) GRID_BAR(); }

    if (IN(3)) {
        pg8::Gemm g{F.MIX, F.Wout_t, M, D, D}; pg8::StaticOrder S; S.init(M, D, F.G, (int)blockIdx.x);
        pg8::EpiOut E{F.XN, F.rrow, F.g1, F.XB, F.ss};
        pg8::gemm_phase<pg8::EpiOut, pg8::StaticOrder, true, PG8_SP2>(F.lds + RING_OFF, g, S, E);
        if (BOTH(3)) GRID_BAR();
    }

    if (IN(4)) {
        pg8::Gemm g{F.XB, F.Wgu_t, M, NGU, D}; pg8::StaticOrder S; S.init(M, NGU, F.G, (int)blockIdx.x);
        pg8::EpiGU E{F.ACT, F.ss};
        pg8::gemm_phase<pg8::EpiGU, pg8::StaticOrder, true, PG8_SP2>(F.lds + RING_OFF, g, S, E);
        if (BOTH(4)) GRID_BAR();
    }

    if (IN(5)) {
        pg8::Gemm g{F.ACT, F.Wdn_t, M, D, FF}; pg8::StaticOrder S; S.init(M, D, F.G, (int)blockIdx.x);
        pg8::EpiDown E{F.XB, F.out};
        pg8::gemm_phase<pg8::EpiDown, pg8::StaticOrder, true, PG8_SP2>(F.lds + RING_OFF, g, S, E);
    }
#undef IN
#undef BOTH
#undef GRID_BAR
}

extern "C" void kernel_launch(void* const* d_in, const int* in_sizes, int n_in, void* d_out, int out_size, void* d_ws, size_t ws_size, hipStream_t stream) {
    static int grid = 0;
    if (grid == 0) {
        if (n_in != 13 || in_sizes[0] != M * D || out_size != M * D || ws_size < WS_END) { fprintf(stderr, "kernel_launch: unexpected shapes (n_in %d, in0 %d, out %d, ws %zu); nothing launched\n", n_in, n_in > 0 ? in_sizes[0] : -1, out_size, ws_size); grid = -1; return; }
        int dev = 0, cus = 0, per_cu = 0;
        if (hipGetDevice(&dev) != hipSuccess || hipDeviceGetAttribute(&cus, hipDeviceAttributeMultiprocessorCount, dev) != hipSuccess) { fprintf(stderr, "kernel_launch: device query failed\n"); grid = -1; return; }
        if (hipFuncSetAttribute((const void*)fwd_megakernel, hipFuncAttributeMaxDynamicSharedMemorySize, LDS_BYTES) != hipSuccess) { fprintf(stderr, "kernel_launch: hipFuncSetAttribute failed\n"); grid = -1; return; }
        if (hipOccupancyMaxActiveBlocksPerMultiprocessor(&per_cu, (const void*)fwd_megakernel, NWAVES * 64, LDS_BYTES) != hipSuccess || per_cu < 1) {
            fprintf(stderr, "kernel_launch: occupancy query reports %d workgroups per CU; nothing launched\n", per_cu); (void)hipGetLastError(); grid = -1; return; }
        (void)hipGetLastError();
        grid = cus;
    }
    if (grid < 0) return;
    if (hipMemsetAsync((char*)d_ws + WS_CTL, 0, CTL_ZERO_BYTES, stream) != hipSuccess) { fprintf(stderr, "kernel_launch: hipMemsetAsync failed\n"); return; }
    Args a{};
    for (int i = 0; i < 13; ++i) a.in[i] = (const float*)d_in[i];
    a.out = (float*)d_out; a.ws = (unsigned char*)d_ws;
    for (int li = 0; li < N_LAUNCHES; ++li) {
        a.ph_lo = (N_LAUNCHES == PER_PHASE) ? li : 0; a.ph_hi = (N_LAUNCHES == PER_PHASE) ? li + 1 : PER_PHASE; a.li = li;
        hipLaunchKernelGGL(fwd_megakernel, dim3(grid), dim3(NWAVES * 64), LDS_BYTES, stream, a);
        const hipError_t le = hipPeekAtLastError();
        if (le != hipSuccess) { fprintf(stderr, "kernel_launch: launch %d failed: %s\n", li, hipGetErrorName(le)); break; }
    }
}
```

```cpp
#include <hip/hip_runtime.h>
#include <cstdio>
#include <cstdint>

#define LAS __attribute__((address_space(3)))
#define GAS __attribute__((address_space(1)))
typedef unsigned short bf16_t;
typedef short bf16x8 __attribute__((ext_vector_type(8)));
typedef short s16x4 __attribute__((ext_vector_type(4)));
typedef float f32x4 __attribute__((ext_vector_type(4)));
typedef float f32x2 __attribute__((ext_vector_type(2)));
typedef unsigned u32x4 __attribute__((ext_vector_type(4)));
typedef unsigned u32x2 __attribute__((ext_vector_type(2)));

constexpr int BATCH = 16, SEQ = 4096, D = 1024, M = BATCH * SEQ;
constexpr int NA = 512, NHEAD = 8, HD = 64, NIN = 2048, FF = 2816, NGU = 2 * FF;
constexpr float EPS = 1e-6f;
constexpr float LOG2E = 1.4426950408889634f;

__device__ __forceinline__ unsigned cvt_pk_bf16(float lo, float hi) { unsigned r; asm volatile("v_cvt_pk_bf16_f32 %0, %1, %2" : "=v"(r) : "v"(lo), "v"(hi)); return r; }

namespace pg8 {
constexpr int BM = 256, BK = 64, HALF = 128, HTB = HALF * BK * 2, STAGE_BYTES = 8 * HTB, NXCD = 8, WGM = 8;

__host__ __device__ __forceinline__ int lds_byte(int r, int c) { const int st = (r >> 4) * 2 + (c >> 5), rr = r & 15, cc = c & 31, ob = rr * 64 + cc * 2; return st * 1024 + (ob ^ (((ob >> 9) & 1) << 5)); }
__host__ __device__ __forceinline__ void stage_rc(int b, int& R, int& C) { const int st = b / 1024, sb = b % 1024, swz = sb ^ (((sb >> 9) & 1) << 5); R = (st >> 1) * 16 + swz / 64; C = (st & 1) * 32 + (swz % 64) / 2; }
__host__ __device__ __forceinline__ int perm32(int rho) { const int n = rho >> 4, i = rho & 15; return 8 * (i >> 2) + 4 * n + (i & 3); }

struct Unit { int pm, pn; };
struct Gemm { const bf16_t* A; const bf16_t* Bt; int M, N, K; };

struct StaticOrder {
    int nM, nN, nwg, G, c;
    __host__ __device__ void init(int M_, int N_, int G_, int c_) { nM = M_ / BM; nN = N_ / BM; nwg = nM * nN; G = G_; c = c_; }
    __host__ __device__ bool next(int i, Unit& u) const {
        const long L = (long)i * G + c; if (L >= nwg) return false;
        int wgid = (int)L; { const int q = nwg / NXCD, r = nwg % NXCD, xcd = wgid % NXCD, off = wgid / NXCD; wgid = (xcd < r ? xcd * (q + 1) : r * (q + 1) + (xcd - r) * q) + off; }
        const int nig = WGM * nN, gid = wgid / nig, fm = gid * WGM, gsz = (nM - fm) < WGM ? (nM - fm) : WGM;
        u.pm = fm + ((wgid % nig) % gsz); u.pn = (wgid % nig) / gsz; return true;
    }
    __device__ __forceinline__ void a_ready(const Unit&) const {}
    __device__ __forceinline__ void done(const Unit&) const {}
};


struct EpiIn {
    static constexpr bool PERM = true, AFTER_DRAIN = false;
    bf16_t* QKVZ; const LAS float* gl;
    __device__ __forceinline__ void operator()(const f32x4 (&acc)[2][2][4][2], const Unit& u, int wr, int wc, int fr, int fq) const {
        const int kind = u.pn >> 1;
        const int row0 = u.pm * BM + wr * 64 + fr;
        const int head = 4 * (u.pn & 1) + wc; const size_t rstride = kind < 3 ? HD : NA;
        bf16_t* base = QKVZ + (size_t)kind * ((size_t)M * NA) + 8 * fq
                     + (kind < 3 ? ((size_t)((row0 >> 12) * NHEAD + head) * SEQ + (row0 & (SEQ - 1))) * HD : (size_t)row0 * NA + head * HD);
        if (kind < 2) {
            const LAS float* g = gl + 64 * kind + 8 * fq;
            f32x4 gv[2][2];
#pragma unroll
            for (int bj = 0; bj < 2; ++bj)
#pragma unroll
                for (int n = 0; n < 2; ++n) gv[bj][n] = *(const LAS f32x4*)(g + 32 * bj + 4 * n);
            float ss[8];
#pragma unroll
            for (int i = 0; i < 8; ++i) { const int ai = i >> 2, m = i & 3; float a = 0.f;
#pragma unroll
                for (int bj = 0; bj < 2; ++bj)
#pragma unroll
                    for (int n = 0; n < 2; ++n) { const f32x4 v = acc[ai][bj][m][n]; a += (v[0] * v[0] + v[1] * v[1]) + (v[2] * v[2] + v[3] * v[3]); }
                ss[i] = a; }
#pragma unroll
            for (int i = 0; i < 8; ++i) ss[i] += __shfl_xor(ss[i], 16);
#pragma unroll
            for (int i = 0; i < 8; ++i) ss[i] += __shfl_xor(ss[i], 32);
#pragma unroll
            for (int i = 0; i < 8; ++i) { const int ai = i >> 2, m = i & 3;
                bf16_t* rowp = base + (size_t)(ai * HALF + m * 16) * rstride;
                const float r = __builtin_amdgcn_rsqf(ss[i] * (1.0f / 64.0f) + EPS);
#pragma unroll
                for (int bj = 0; bj < 2; ++bj) {
                    const f32x4 v0 = acc[ai][bj][m][0] * r * gv[bj][0], v1 = acc[ai][bj][m][1] * r * gv[bj][1];
                    u32x4 w; w.x = cvt_pk_bf16(v0[0], v0[1]); w.y = cvt_pk_bf16(v0[2], v0[3]); w.z = cvt_pk_bf16(v1[0], v1[1]); w.w = cvt_pk_bf16(v1[2], v1[3]);
                    *(u32x4*)(rowp + bj * 32) = w; }
            }
        } else {
#pragma unroll
            for (int ai = 0; ai < 2; ++ai)
#pragma unroll
                for (int m = 0; m < 4; ++m) {
                    bf16_t* rowp = base + (size_t)(ai * HALF + m * 16) * rstride;
#pragma unroll
                    for (int bj = 0; bj < 2; ++bj) {
                        const f32x4 v0 = acc[ai][bj][m][0], v1 = acc[ai][bj][m][1];
                        u32x4 w; w.x = cvt_pk_bf16(v0[0], v0[1]); w.y = cvt_pk_bf16(v0[2], v0[3]); w.z = cvt_pk_bf16(v1[0], v1[1]); w.w = cvt_pk_bf16(v1[2], v1[3]);
                        *(u32x4*)(rowp + bj * 32) = w; }
                }
        }
    }
};

struct EpiOut {
    static constexpr bool PERM = true, AFTER_DRAIN = false;
    const bf16_t* XN; const float* rrow; const float* g1; bf16_t* XB; float* ss;
    __device__ __forceinline__ void operator()(const f32x4 (&acc)[2][2][4][2], const Unit& u, int wr, int wc, int fr, int fq) const {
        const int row0 = u.pm * BM + wr * 64 + fr, col0 = u.pn * BM + wc * 32 + 8 * fq;
        const size_t off0 = (size_t)row0 * D + col0;
        const bf16_t* __restrict__ xp = XN + off0; bf16_t* __restrict__ bp = XB + off0;
        f32x4 gi[2][2];
#pragma unroll
        for (int bj = 0; bj < 2; ++bj)
#pragma unroll
            for (int n = 0; n < 2; ++n) { const f32x4 gv = *(const f32x4*)(g1 + col0 + bj * HALF + 4 * n);
                gi[bj][n] = (f32x4){__builtin_amdgcn_rcpf(gv[0]), __builtin_amdgcn_rcpf(gv[1]), __builtin_amdgcn_rcpf(gv[2]), __builtin_amdgcn_rcpf(gv[3])}; }
        u32x4 xa[8][2]; float rr[8], part[8];
#pragma unroll
        for (int i = 0; i < 8; ++i) rr[i] = rrow[row0 + (i >> 2) * HALF + (i & 3) * 16];
#define EO_LOAD(i) do { const size_t o_ = (size_t)(((i) >> 2) * HALF + ((i) & 3) * 16) * D; xa[i][0] = *(const u32x4*)(xp + o_); xa[i][1] = *(const u32x4*)(xp + o_ + HALF); } while (0)
        EO_LOAD(0); EO_LOAD(1); EO_LOAD(2); EO_LOAD(3);
        asm volatile("" ::: "memory");
#pragma unroll
        for (int i = 0; i < 8; ++i) { const int ai = i >> 2, m = i & 3; const size_t o_ = (size_t)(ai * HALF + m * 16) * D; float p = 0.f;
#pragma unroll
            for (int bj = 0; bj < 2; ++bj) { const u32x4 w_ = xa[i][bj];
                const f32x4 x0 = {__builtin_bit_cast(float, w_.x << 16), __builtin_bit_cast(float, w_.x & 0xffff0000u), __builtin_bit_cast(float, w_.y << 16), __builtin_bit_cast(float, w_.y & 0xffff0000u)};
                const f32x4 x1 = {__builtin_bit_cast(float, w_.z << 16), __builtin_bit_cast(float, w_.z & 0xffff0000u), __builtin_bit_cast(float, w_.w << 16), __builtin_bit_cast(float, w_.w & 0xffff0000u)};
                const f32x4 v0 = acc[ai][bj][m][0] + x0 * (gi[bj][0] * rr[i]), v1 = acc[ai][bj][m][1] + x1 * (gi[bj][1] * rr[i]);
                u32x4 w; w.x = cvt_pk_bf16(v0[0], v0[1]); w.y = cvt_pk_bf16(v0[2], v0[3]); w.z = cvt_pk_bf16(v1[0], v1[1]); w.w = cvt_pk_bf16(v1[2], v1[3]);
                *(u32x4*)(bp + o_ + bj * HALF) = w;
                p += (v0[0] * v0[0] + v0[1] * v0[1]) + (v0[2] * v0[2] + v0[3] * v0[3]) + (v1[0] * v1[0] + v1[1] * v1[1]) + (v1[2] * v1[2] + v1[3] * v1[3]); }
            part[i] = p;
            if (i + 4 < 8) { EO_LOAD((i + 4) & 7); }
            asm volatile("" ::: "memory"); }
#undef EO_LOAD
#pragma unroll
        for (int i = 0; i < 8; ++i) part[i] += __shfl_xor(part[i], 16);
#pragma unroll
        for (int i = 0; i < 8; ++i) part[i] += __shfl_xor(part[i], 32);
        if (fq == 0) {
#pragma unroll
            for (int i = 0; i < 8; ++i) atomicAdd(ss + row0 + (i >> 2) * HALF + (i & 3) * 16, part[i]);
        }
    }
};

struct EpiGU {
    static constexpr bool PERM = true, AFTER_DRAIN = false;
    bf16_t* ACT; const float* ss;
    __device__ __forceinline__ void operator()(const f32x4 (&acc)[2][2][4][2], const Unit& u, int wr, int wc, int fr, int fq) const {
        const int row0 = u.pm * BM + wr * 64 + fr, col0 = u.pn * HALF + wc * 32 + 8 * fq;
        float sv[8];
#pragma unroll
        for (int i = 0; i < 8; ++i) sv[i] = ss[row0 + (i >> 2) * HALF + (i & 3) * 16];
        asm volatile("" ::: "memory");
#pragma unroll
        for (int i = 0; i < 8; ++i) { const int ai = i >> 2, m = i & 3;
            const float rstd = __builtin_amdgcn_rsqf(sv[i] * (1.0f / (float)D) + EPS), ne = -LOG2E * rstd, r2 = rstd * rstd;
            unsigned w[4];
#pragma unroll
            for (int n = 0; n < 2; ++n)
#pragma unroll
                for (int h = 0; h < 2; ++h) {
                    const f32x2 g = {acc[ai][0][m][n][2 * h], acc[ai][0][m][n][2 * h + 1]}, up = {acc[ai][1][m][n][2 * h], acc[ai][1][m][n][2 * h + 1]};
                    const f32x2 t = g * ne; f32x2 e; e.x = __builtin_amdgcn_exp2f(t.x); e.y = __builtin_amdgcn_exp2f(t.y);
                    const f32x2 d = e + 1.0f; f32x2 r; r.x = __builtin_amdgcn_rcpf(d.x); r.y = __builtin_amdgcn_rcpf(d.y);
                    const f32x2 a = (g * up) * (r * r2);
                    w[2 * n + h] = cvt_pk_bf16(a.x, a.y); }
            *(u32x4*)(ACT + (size_t)(row0 + ai * HALF + m * 16) * FF + col0) = (u32x4){w[0], w[1], w[2], w[3]};
        }
    }
};

struct EpiDown {
    static constexpr bool PERM = true, AFTER_DRAIN = false;
    const bf16_t* XB; float* out;
    __device__ __forceinline__ void operator()(const f32x4 (&acc)[2][2][4][2], const Unit& u, int wr, int wc, int fr, int fq) const {
        const int row0 = u.pm * BM + wr * 64 + fr, col0 = u.pn * BM + wc * 32 + 8 * fq;
        const size_t off0 = (size_t)row0 * D + col0;
        const bf16_t* __restrict__ bp = XB + off0; float* __restrict__ op = out + off0;
        u32x4 xa[8][2];
#define ED_LOAD(i) do { const size_t o_ = (size_t)(((i) >> 2) * HALF + ((i) & 3) * 16) * D; xa[i][0] = *(const u32x4*)(bp + o_); xa[i][1] = *(const u32x4*)(bp + o_ + HALF); } while (0)
        ED_LOAD(0); ED_LOAD(1); ED_LOAD(2); ED_LOAD(3);
        asm volatile("" ::: "memory");
#pragma unroll
        for (int i = 0; i < 8; ++i) { const int ai = i >> 2, m = i & 3; const size_t o_ = (size_t)(ai * HALF + m * 16) * D;
#pragma unroll
            for (int bj = 0; bj < 2; ++bj) { const u32x4 w = xa[i][bj];
                const f32x4 r0 = {__builtin_bit_cast(float, w.x << 16), __builtin_bit_cast(float, w.x & 0xffff0000u), __builtin_bit_cast(float, w.y << 16), __builtin_bit_cast(float, w.y & 0xffff0000u)};
                const f32x4 r1 = {__builtin_bit_cast(float, w.z << 16), __builtin_bit_cast(float, w.z & 0xffff0000u), __builtin_bit_cast(float, w.w << 16), __builtin_bit_cast(float, w.w & 0xffff0000u)};
                *(f32x4*)(op + o_ + bj * HALF) = acc[ai][bj][m][0] + r0; *(f32x4*)(op + o_ + bj * HALF + 4) = acc[ai][bj][m][1] + r1; }
            if (i + 4 < 8) { ED_LOAD((i + 4) & 7); }
            asm volatile("" ::: "memory"); }
#undef ED_LOAD
    }
};

template <class Epi, class Sched, bool ALIGN_EPI = false, bool SP2 = false>
__device__ __forceinline__ void gemm_phase(LAS unsigned char* lds, const Gemm g, const Sched& S, const Epi& E) {
    const int tid = threadIdx.x, wid = __builtin_amdgcn_readfirstlane(tid >> 6), lane = tid & 63, wr = wid >> 2, wc = wid & 3, fr = lane & 15, fq = lane >> 4;
    const int K = g.K, nt = K / BK;
    unsigned voffA[2], voffB[2];
#pragma unroll
    for (int i = 0; i < 2; ++i) { int R, C; stage_rc(tid * 16 + i * 8192, R, C); const int Rb = Epi::PERM ? ((R & ~31) + perm32(R & 31)) : R;
        voffA[i] = (unsigned)(R * K + C) * 2u; voffB[i] = (unsigned)(Rb * K + C) * 2u; }
    const size_t kstep = (size_t)(BK * 2);
    const size_t hstep = (size_t)HALF * K * 2;
    const size_t tstep = 2 * hstep;
    const unsigned ldsw = (unsigned)wid * 1024u;
    const int aoff = lds_byte(wr * 64 + fr, fq * 8), boff = lds_byte(wc * 32 + fr, fq * 8);
#define PG8_SA(b, h) (((b) * 2 + (h)) * HTB)
#define PG8_SB(b, h) ((4 + (b) * 2 + (h)) * HTB)
#define PG8_STAGE(bufoff, gbase, voff) do { _Pragma("unroll") for (int _i = 0; _i < 2; ++_i) \
        __builtin_amdgcn_global_load_lds((const unsigned*)((const char*)(gbase) + (voff)[_i]), (LAS unsigned*)(lds + (bufoff) + ldsw + _i * 8192), 16, 0, 0); } while (0)
#define PG8_LDA(dst, b, h) do { _Pragma("unroll") for (int m = 0; m < 4; ++m) _Pragma("unroll") for (int k = 0; k < 2; ++k) dst[m][k] = *(const LAS bf16x8*)(lds + PG8_SA(b, h) + aoff + m * 2048 + k * 1024); } while (0)
#define PG8_LDB(dst, b, h) do { _Pragma("unroll") for (int n = 0; n < 2; ++n) _Pragma("unroll") for (int k = 0; k < 2; ++k) dst[n][k] = *(const LAS bf16x8*)(lds + PG8_SB(b, h) + boff + n * 2048 + k * 1024); } while (0)
#define PG8_MMA(ai, bj, At, Bt) do { __builtin_amdgcn_s_setprio(1); _Pragma("unroll") for (int m = 0; m < 4; ++m) _Pragma("unroll") for (int n = 0; n < 2; ++n) _Pragma("unroll") for (int k = 0; k < 2; ++k) \
        acc[ai][bj][m][n] = __builtin_amdgcn_mfma_f32_16x16x32_bf16(Bt[n][k], At[m][k], acc[ai][bj][m][n], 0, 0, 0); __builtin_amdgcn_s_setprio(0); } while (0)
#define PG8_WAIT_V(n) asm volatile("s_waitcnt vmcnt(" #n ")" ::: "memory")
#define PG8_WAIT_L(n) asm volatile("s_waitcnt lgkmcnt(" #n ")" ::: "memory")
#define PG8_BAR __builtin_amdgcn_s_barrier()
#define PG8_SCHED __builtin_amdgcn_sched_barrier(0)
    Unit cur, nxt; int ui = 0;
    if (!S.next(0, cur)) return;
    f32x4 acc[2][2][4][2];
#pragma unroll
    for (int a = 0; a < 2; ++a)
#pragma unroll
        for (int b = 0; b < 2; ++b)
#pragma unroll
            for (int m = 0; m < 4; ++m)
#pragma unroll
                for (int n = 0; n < 2; ++n) acc[a][b][m][n] = (f32x4){0.f, 0.f, 0.f, 0.f};
    bf16x8 At[4][2], B0[2][2], B1[2][2];
    const char* cA = (const char*)g.A + (size_t)cur.pm * tstep; const char* cB = (const char*)g.Bt + (size_t)cur.pn * tstep;
    S.a_ready(cur);
    if constexpr (SP2) {
        PG8_STAGE(PG8_SB(0, 0), cB, voffB); PG8_STAGE(PG8_SB(0, 1), cB + hstep, voffB); PG8_STAGE(PG8_SA(0, 0), cA, voffA); PG8_STAGE(PG8_SA(0, 1), cA + hstep, voffA);
        if (wr == 1) PG8_BAR;
        PG8_WAIT_V(2); PG8_BAR;
        PG8_STAGE(PG8_SB(1, 0), cB + kstep, voffB); PG8_STAGE(PG8_SA(1, 0), cA + kstep, voffA); PG8_STAGE(PG8_SB(1, 1), cB + hstep + kstep, voffB);
        PG8_WAIT_V(6); PG8_BAR;
    } else {
        PG8_STAGE(PG8_SB(0, 0), cB, voffB); PG8_STAGE(PG8_SA(0, 0), cA, voffA); PG8_STAGE(PG8_SB(0, 1), cB + hstep, voffB); PG8_STAGE(PG8_SA(0, 1), cA + hstep, voffA);
        if (wr == 1) PG8_BAR;
        PG8_WAIT_V(4); PG8_BAR;
        PG8_STAGE(PG8_SB(1, 0), cB + kstep, voffB); PG8_STAGE(PG8_SA(1, 0), cA + kstep, voffA); PG8_STAGE(PG8_SB(1, 1), cB + hstep + kstep, voffB);
        PG8_WAIT_V(6); PG8_BAR;
    }
    for (;;) {
        const bool has_next = S.next(ui + 1, nxt);
        const char* nA = has_next ? (const char*)g.A + (size_t)nxt.pm * tstep : cA; const char* nB = has_next ? (const char*)g.Bt + (size_t)nxt.pn * tstep : cB;
        for (int t = 0; t < nt; t += 2) {
            const bool last = (t == nt - 2);
            const char* a1 = cA + (size_t)(t + 1) * kstep;
            const char* a2 = last ? nA : cA + (size_t)(t + 2) * kstep; const char* b2 = last ? nB : cB + (size_t)(t + 2) * kstep;
            const char* a3 = a2 + kstep; const char* b3 = b2 + kstep;
            if (last && has_next) S.a_ready(nxt);
            if constexpr (SP2) {
            PG8_LDB(B0, 0, 0); PG8_LDB(B1, 0, 1); PG8_SCHED; PG8_LDA(At, 0, 0); PG8_STAGE(PG8_SA(1, 1), a1 + hstep, voffA);
            PG8_WAIT_V(8); PG8_WAIT_L(0); PG8_BAR; PG8_MMA(0, 0, At, B0); PG8_MMA(0, 1, At, B1); PG8_BAR; PG8_SCHED;
            PG8_LDA(At, 0, 1); PG8_STAGE(PG8_SB(0, 0), b2, voffB); PG8_STAGE(PG8_SB(0, 1), b2 + hstep, voffB); PG8_STAGE(PG8_SA(0, 0), a2, voffA);
            PG8_WAIT_V(8); PG8_WAIT_L(0); PG8_BAR; PG8_MMA(1, 0, At, B0); PG8_MMA(1, 1, At, B1); PG8_BAR; PG8_SCHED;
            PG8_LDB(B0, 1, 0); PG8_LDB(B1, 1, 1); PG8_SCHED; PG8_LDA(At, 1, 0); PG8_STAGE(PG8_SA(0, 1), a2 + hstep, voffA);
            PG8_WAIT_V(8); PG8_WAIT_L(0); PG8_BAR; PG8_MMA(0, 0, At, B0); PG8_MMA(0, 1, At, B1); PG8_BAR; PG8_SCHED;
            PG8_LDA(At, 1, 1); PG8_STAGE(PG8_SB(1, 0), b3, voffB); PG8_STAGE(PG8_SB(1, 1), b3 + hstep, voffB); PG8_STAGE(PG8_SA(1, 0), a3, voffA);
            PG8_WAIT_V(8); PG8_WAIT_L(0); PG8_BAR; PG8_MMA(1, 0, At, B0); PG8_MMA(1, 1, At, B1); PG8_BAR; PG8_SCHED;
            } else {
            PG8_LDB(B0, 0, 0); PG8_SCHED; PG8_LDA(At, 0, 0); PG8_STAGE(PG8_SA(1, 1), a1 + hstep, voffA);
            PG8_WAIT_L(8); PG8_BAR; PG8_WAIT_L(0); PG8_MMA(0, 0, At, B0); PG8_BAR; PG8_SCHED;
            PG8_LDB(B1, 0, 1); PG8_STAGE(PG8_SB(0, 0), b2, voffB);
            PG8_BAR; PG8_WAIT_L(0); PG8_MMA(0, 1, At, B1); PG8_BAR;
            PG8_LDA(At, 0, 1); PG8_STAGE(PG8_SA(0, 0), a2, voffA);
            PG8_BAR; PG8_WAIT_L(0); PG8_MMA(1, 0, At, B0); PG8_BAR; PG8_SCHED;
            PG8_STAGE(PG8_SB(0, 1), b2 + hstep, voffB);
            PG8_WAIT_V(6); PG8_BAR; PG8_MMA(1, 1, At, B1); PG8_BAR;
            PG8_LDB(B0, 1, 0); PG8_SCHED; PG8_LDA(At, 1, 0); PG8_STAGE(PG8_SA(0, 1), a2 + hstep, voffA);
            PG8_WAIT_L(8); PG8_BAR; PG8_WAIT_L(0); PG8_MMA(0, 0, At, B0); PG8_BAR; PG8_SCHED;
            PG8_LDB(B1, 1, 1); PG8_STAGE(PG8_SB(1, 0), b3, voffB);
            PG8_BAR; PG8_WAIT_L(0); PG8_MMA(0, 1, At, B1); PG8_BAR;
            PG8_LDA(At, 1, 1); PG8_STAGE(PG8_SA(1, 0), a3, voffA);
            PG8_BAR; PG8_WAIT_L(0); PG8_MMA(1, 0, At, B0); PG8_BAR; PG8_SCHED;
            PG8_STAGE(PG8_SB(1, 1), b3 + hstep, voffB);
            PG8_WAIT_V(6); PG8_BAR; PG8_MMA(1, 1, At, B1); PG8_BAR;
            }
        }
        if constexpr (ALIGN_EPI) { if (wr == 0) PG8_BAR; }
        if constexpr (!Epi::AFTER_DRAIN) { E(acc, cur, wr, wc, fr, fq); S.done(cur); }
        if (!has_next) break;
#pragma unroll
        for (int a = 0; a < 2; ++a)
#pragma unroll
            for (int b = 0; b < 2; ++b)
#pragma unroll
                for (int m = 0; m < 4; ++m)
#pragma unroll
                    for (int n = 0; n < 2; ++n) acc[a][b][m][n] = (f32x4){0.f, 0.f, 0.f, 0.f};
        cur = nxt; cA = nA; cB = nB; ++ui;
        if constexpr (ALIGN_EPI) { if (wr == 1) PG8_BAR; }
    }
    PG8_WAIT_V(0);
    if constexpr (!ALIGN_EPI) { if (wr == 0) PG8_BAR; }
    PG8_BAR;
#undef PG8_SA
#undef PG8_SB
#undef PG8_STAGE
#undef PG8_LDA
#undef PG8_LDB
#undef PG8_MMA
#undef PG8_WAIT_V
#undef PG8_WAIT_L
#undef PG8_BAR
#undef PG8_SCHED
}
}

constexpr int NWAVES = 8;
#ifndef MK_N_LAUNCHES
#define MK_N_LAUNCHES 1
#endif
constexpr int N_LAUNCHES = MK_N_LAUNCHES;
constexpr int PER_PHASE = 6;
#ifndef PG8_SP2
#define PG8_SP2 true
#endif

constexpr size_t MiB = 1u << 20;
constexpr size_t WS_CTL = 0, CTL_ZERO_BYTES = 1 * MiB;
constexpr size_t WS_WIN = 2 * MiB;
constexpr size_t WS_WOUT = 6 * MiB;
constexpr size_t WS_WGU = 8 * MiB;
constexpr size_t WS_WDN = 20 * MiB;
constexpr size_t WS_XN = 32 * MiB;
constexpr size_t WS_QKVZ = 160 * MiB;
constexpr size_t WS_ACT = 416 * MiB;
constexpr size_t WS_XB = 768 * MiB;
constexpr size_t WS_END = 896 * MiB;
static_assert(WS_WGU + (size_t)NGU * D * 2 <= WS_WDN && WS_WDN + (size_t)D * FF * 2 <= WS_XN && WS_ACT + (size_t)M * FF * 2 <= WS_END, "d_ws map");
constexpr int CW_BAR = 4096;
constexpr int CW_SS = 65536;
static_assert((size_t)(CW_SS + 2 * M) * 4 <= CTL_ZERO_BYTES, "ss, rrow inside the control region");

constexpr int RING_OFF = 0, RING_BYTES = 131072;
constexpr int LDSCTL_OFF = 157696, MISC_OFF = LDSCTL_OFF + 320;
constexpr int LDS_GAIN_OFF = LDSCTL_OFF + 512;
constexpr int LDS_BYTES = 163840;

typedef GAS unsigned gu32;
#define RLX_AGENT __ATOMIC_RELAXED, __HIP_MEMORY_SCOPE_AGENT
#define LDS_WAIT() asm volatile("s_waitcnt lgkmcnt(0)" ::: "memory")
__device__ __forceinline__ unsigned f2bf(float f) { unsigned u = __builtin_bit_cast(unsigned, f); return (u + 0x7fffu + ((u >> 16) & 1u)) >> 16; }
__device__ __forceinline__ unsigned pk2(float lo, float hi) { return f2bf(lo) | (f2bf(hi) << 16); }
__device__ __forceinline__ float bflo(unsigned w) { return __builtin_bit_cast(float, w << 16); }
__device__ __forceinline__ float bfhi(unsigned w) { return __builtin_bit_cast(float, w & 0xffff0000u); }

#define XB_TMO      128
#define XB_XCNT(j)  (256  + 64 * (j))
#define XB_XSUB(j)  (1280 + 64 * (j))
#define XB_XGEN(j)  (2304 + 64 * (j))
#define XB_TOP      3328
#define XB_TOPGEN   3392
#define XCD_BAR_WORDS 3456
#define XB_SPIN_CAP (1u << 18)

__device__ __forceinline__ unsigned xb_ld(unsigned* p)              { return __hip_atomic_load(p, __ATOMIC_RELAXED, __HIP_MEMORY_SCOPE_AGENT); }
__device__ __forceinline__ unsigned xb_add(unsigned* p, unsigned v) { return __hip_atomic_fetch_add(p, v, __ATOMIC_RELAXED, __HIP_MEMORY_SCOPE_AGENT); }
__device__ __forceinline__ unsigned xb_xcc_id() { return (unsigned)__builtin_amdgcn_s_getreg((3 << 11) | 20) & 0xFu; }
#define XB_SPIN(cond, bar) do { unsigned _sp = 0; while (cond) { __builtin_amdgcn_s_sleep(1); \
    if ((++_sp & 255u) == 0u) { if (xb_ld(&(bar)[XB_TMO])) break; if (_sp > XB_SPIN_CAP) { atomicAdd(&(bar)[XB_TMO], 1u); break; } } } } while (0)

struct XcdBarrier { unsigned* bar; unsigned x; volatile LAS unsigned* st; };

__device__ __forceinline__ XcdBarrier xcd_barrier_post(unsigned* bar, volatile LAS unsigned* st) {
    XcdBarrier b; b.bar = bar; b.x = xb_xcc_id(); b.st = st;
    if (threadIdx.x == 0) (void)xb_add(&bar[XB_XCNT(b.x)], 1u);
    return b;
}
__device__ __forceinline__ void xcd_barrier_complete(unsigned* bar, unsigned x, unsigned& nloc, unsigned& nx) {
    const unsigned G = gridDim.x * gridDim.y * gridDim.z;
    unsigned sum, cnt, mine, sp = 0u;
    for (;;) {
        sum = 0u; cnt = 0u; mine = 0u;
#pragma unroll
        for (unsigned j = 0; j < 16; ++j) { const unsigned c = xb_ld(&bar[XB_XCNT(j)]); sum += c; cnt += (c > 0u) ? 1u : 0u; mine = (j == x) ? c : mine; }
        if (sum == G) break;
        __builtin_amdgcn_s_sleep(1);
        if ((++sp & 255u) == 0u) { if (xb_ld(&bar[XB_TMO])) break; if (sp > XB_SPIN_CAP) { atomicAdd(&bar[XB_TMO], 1u); break; } }
    }
    nloc = mine > 0u ? mine : 1u; nx = cnt > 0u ? cnt : 1u;
}
__device__ __forceinline__ void xcd_barrier(const XcdBarrier& b) {
    asm volatile("s_waitcnt vmcnt(0)" ::: "memory");
    __syncthreads();
    if (threadIdx.x == 0) {
        unsigned* bar = b.bar;
        __builtin_amdgcn_s_waitcnt(0);
        unsigned nloc = b.st[0], nx = b.st[1];
        if (nloc == 0u) { xcd_barrier_complete(bar, b.x, nloc, nx); b.st[0] = nloc; b.st[1] = nx; }
        const unsigned old = xb_add(&bar[XB_XSUB(b.x)], 1u);
        const unsigned gen = old / nloc;
        if (old + 1u == (gen + 1u) * nloc) {
            __builtin_amdgcn_fence(__ATOMIC_RELEASE, "agent");
            asm volatile("s_waitcnt vmcnt(0)" ::: "memory");
            const unsigned og = xb_add(&bar[XB_TOP], 1u);
            const unsigned tg = og / nx;
            if (og + 1u == (tg + 1u) * nx) xb_add(&bar[XB_TOPGEN], 1u);
            else XB_SPIN(xb_ld(&bar[XB_TOPGEN]) == tg, bar);
            __builtin_amdgcn_fence(__ATOMIC_ACQUIRE, "agent");
            xb_add(&bar[XB_XGEN(b.x)], 1u);
            asm volatile("s_waitcnt vmcnt(0)" ::: "memory");
        } else {
            XB_SPIN(xb_ld(&bar[XB_XGEN(b.x)]) == gen, bar);
            __builtin_amdgcn_fence(__ATOMIC_ACQUIRE, "agent");
            asm volatile("s_waitcnt vmcnt(0)" ::: "memory");
        }
    }
    __syncthreads();
}

struct Frame {
    LAS unsigned char* lds;
    volatile LAS unsigned* MISC;
    gu32* ctl;
    int tid, lane, wave;
    int vcu, G;
    const float *x, *g1, *w_in, *gq, *gk, *rpb, *w_pool, *pscale, *w_out, *g2, *w_gate, *w_up, *w_down;
    float* out;
    bf16_t *Win_t, *Wout_t, *Wgu_t, *Wdn_t;
    bf16_t *XN, *QKVZ, *XB, *ACT;
    float* ss; float* rrow; bf16_t* MIX;
};

__device__ __forceinline__ float wave_sum(float v) {
#pragma unroll
    for (int o = 1; o < 64; o <<= 1) v += __shfl_xor(v, o);
    return v;
}

__device__ __forceinline__ void p0_tile_out(bf16_t* WT, int K, int drow0, int k0, LAS float* scr, int lane) {
    LDS_WAIT(); asm volatile("" ::: "memory");
    const int c = lane & 7;
#pragma unroll
    for (int j = 0; j < 4; ++j) { const int n = (lane >> 3) + 8 * j; const LAS float* s = scr + (8 * c) * 33 + n;
        u32x4 o; o.x = pk2(s[0 * 33], s[1 * 33]); o.y = pk2(s[2 * 33], s[3 * 33]); o.z = pk2(s[4 * 33], s[5 * 33]); o.w = pk2(s[6 * 33], s[7 * 33]);
        *(GAS u32x4*)(WT + (size_t)(drow0 + n) * K + k0 + 8 * c) = o; }
    LDS_WAIT(); asm volatile("" ::: "memory");
}
__device__ __forceinline__ void p0_transpose_item(const float* W, int ldw, int K, int k0, int n0, const float* gkv, bf16_t* WT, int drow0, LAS float* scr, int lane) {
#pragma unroll
    for (int i = 0; i < 32; ++i) { const int kk = 2 * i + (lane >> 5); float v = W[(size_t)(k0 + kk) * ldw + n0 + (lane & 31)]; if (gkv) v *= gkv[k0 + kk]; scr[kk * 33 + (lane & 31)] = v; }
    p0_tile_out(WT, K, drow0, k0, scr, lane);
}
__device__ __forceinline__ void p0_fold_item(const float* w_in, const float* w_pool, const float* pscale, int k0, int n0z, bf16_t* WT, int drow0, int lane) {
    const int n = lane & 31, kh = lane >> 5, g = n0z >> 7, d = (n0z & 127) + n;
    float acc[4] = {0.f, 0.f, 0.f, 0.f};
    const float* wrow = w_in + (size_t)(k0 + 4 * kh) * NIN + 3 * NA + 128 * g;
    const float* wp = w_pool + (size_t)g * 128 * 128 + d;
#pragma unroll 8
    for (int c4 = 0; c4 < 32; ++c4) {
        const float p0 = wp[(4 * c4 + 0) * 128], p1 = wp[(4 * c4 + 1) * 128], p2 = wp[(4 * c4 + 2) * 128], p3 = wp[(4 * c4 + 3) * 128];
#pragma unroll
        for (int i = 0; i < 4; ++i) { const f32x4 w = *(const f32x4*)(wrow + (size_t)i * NIN + 4 * c4); acc[i] += (w[0] * p0 + w[1] * p1) + (w[2] * p2 + w[3] * p3); }
    }
    const float ps = pscale[n0z + n];
    float hi[4];
#pragma unroll
    for (int i = 0; i < 4; ++i) { acc[i] *= ps; hi[i] = __shfl(acc[i], (lane + 32) & 63); }
    if (lane < 32) { u32x4 o; o.x = pk2(acc[0], acc[1]); o.y = pk2(acc[2], acc[3]); o.z = pk2(hi[0], hi[1]); o.w = pk2(hi[2], hi[3]);
        *(GAS u32x4*)(WT + (size_t)(drow0 + n) * D + k0) = o; }
}
__device__ __forceinline__ int win_drow(int n0) { const int pn = n0 >> 8, c = n0 & 255; return 256 * pn + 128 * ((c >> 5) & 1) + 32 * (c >> 6); }

template <int R> __device__ __forceinline__ void rms_rows(const float* x, const f32x4 (&gg)[4], bf16_t* XN, float* rrow, int m0, int lane) {
    f32x4 v[R][4]; float s[R];
#pragma unroll
    for (int r = 0; r < R; ++r) { const GAS f32x4* xr = (const GAS f32x4*)(x + (size_t)(m0 + r) * D) + lane;
#pragma unroll
        for (int j = 0; j < 4; ++j) v[r][j] = xr[64 * j]; }
#pragma unroll
    for (int r = 0; r < R; ++r) { float a = 0.f;
#pragma unroll
        for (int j = 0; j < 4; ++j) a += (v[r][j].x * v[r][j].x + v[r][j].y * v[r][j].y) + (v[r][j].z * v[r][j].z + v[r][j].w * v[r][j].w);
        s[r] = a; }
#pragma unroll
    for (int o = 1; o < 64; o <<= 1) {
#pragma unroll
        for (int r = 0; r < R; ++r) s[r] += __shfl_xor(s[r], o); }
#pragma unroll
    for (int r = 0; r < R; ++r) { const float ms = s[r] * (1.f / D) + EPS, rstd = __builtin_amdgcn_rsqf(ms);
        if (lane == 0) rrow[m0 + r] = ms * rstd;
        GAS unsigned long long* o8 = (GAS unsigned long long*)(XN + (size_t)(m0 + r) * D) + lane;
#pragma unroll
        for (int j = 0; j < 4; ++j) o8[64 * j] = (unsigned long long)pk2(v[r][j].x * rstd * gg[j].x, v[r][j].y * rstd * gg[j].y) | ((unsigned long long)pk2(v[r][j].z * rstd * gg[j].z, v[r][j].w * rstd * gg[j].w) << 32); }
}

struct P0Item { const float* W; const float* gk; bf16_t* WT; int ldw, K, k0, n0, drow0; };
__device__ __forceinline__ void p0_prologue(Frame& F) {
    LAS float* scr = (LAS float*)(F.lds + RING_OFF + F.wave * 16384);
    const int gw = F.vcu * NWAVES + F.wave, NGW = F.G * NWAVES, lane = F.lane;
    constexpr int KB = D / 64;
    constexpr int I_QKV = KB * (3 * NA / 32), I_O = KB * (D / 32), I_G = KB * (FF / 32), I_DN = (FF / 64) * (D / 32);
    constexpr int NITEMS = I_QKV + I_O + 2 * I_G + I_DN;
    for (int it = gw; it < (D / 8) * (NA / 32); it += NGW) { const int nb = it & 15, kb = it >> 4; p0_fold_item(F.w_in, F.w_pool, F.pscale, 8 * kb, 32 * nb, F.Win_t, win_drow(3 * NA + 32 * nb), lane); }
    f32x4 gg[4];
#pragma unroll
    for (int j = 0; j < 4; ++j) gg[j] = *((const f32x4*)F.g1 + lane + 64 * j);
    const int RPW = (M + F.G - 1) / F.G, rbeg = F.vcu * RPW, rend = (rbeg + RPW) < M ? (rbeg + RPW) : M, nb8 = (rend - rbeg) / 8;
    volatile LAS unsigned* tick = F.MISC + 16;
    int it = gw; bool rows_left = true;
    while (it < NITEMS || rows_left) {
        const bool has_item = it < NITEMS; P0Item I{};
        if (has_item) {
            int r = it;
            if (r < I_QKV) { const int nb = r % (3 * NA / 32), kb = r / (3 * NA / 32); I = P0Item{F.w_in, nullptr, F.Win_t, NIN, D, 64 * kb, 32 * nb, win_drow(32 * nb)}; }
            else if ((r -= I_QKV) < I_O) { const int nb = r % (D / 32), kb = r / (D / 32); I = P0Item{F.w_out, nullptr, F.Wout_t, D, D, 64 * kb, 32 * nb, 32 * nb}; }
            else if ((r -= I_O) < 2 * I_G) { const int up = r >= I_G; if (up) r -= I_G; const int nb = r % (FF / 32), kb = r / (FF / 32), n0 = 32 * nb;
                I = P0Item{up ? F.w_up : F.w_gate, F.g2, F.Wgu_t, FF, D, 64 * kb, n0, 256 * (n0 >> 7) + (n0 & 127) + 128 * up}; }
            else { r -= 2 * I_G; const int nb = r % (D / 32), kb = r / (D / 32); I = P0Item{F.w_down, nullptr, F.Wdn_t, D, FF, 64 * kb, 32 * nb, 32 * nb}; }
        }
        float wv[32];
        if (has_item) {
#pragma unroll
            for (int i = 0; i < 32; ++i) { const int kk = 2 * i + (lane >> 5); wv[i] = I.W[(size_t)(I.k0 + kk) * I.ldw + I.n0 + (lane & 31)]; }
        }
        int m0 = 0;
        if (rows_left) { unsigned t = 0; if (lane == 0) t = __hip_atomic_fetch_add((LAS unsigned*)tick, 1u, __ATOMIC_RELAXED, __HIP_MEMORY_SCOPE_WORKGROUP);
            t = __builtin_amdgcn_readfirstlane(t); rows_left = (int)t < nb8; m0 = rbeg + 8 * (int)t; }
        f32x4 v[8][4];
        if (rows_left) {
#pragma unroll
            for (int r = 0; r < 8; ++r) { const GAS f32x4* xr = (const GAS f32x4*)(F.x + (size_t)(m0 + r) * D) + lane;
#pragma unroll
                for (int j = 0; j < 4; ++j) v[r][j] = xr[64 * j]; }
        }
        if (has_item) {
            if (I.gk) {
#pragma unroll
                for (int i = 0; i < 32; ++i) wv[i] *= I.gk[I.k0 + 2 * i + (lane >> 5)];
            }
#pragma unroll
            for (int i = 0; i < 32; ++i) scr[(2 * i + (lane >> 5)) * 33 + (lane & 31)] = wv[i];
            p0_tile_out(I.WT, I.K, I.drow0, I.k0, scr, lane);
        }
        if (rows_left) {
            float s[8];
#pragma unroll
            for (int r = 0; r < 8; ++r) { float a = 0.f;
#pragma unroll
                for (int j = 0; j < 4; ++j) a += (v[r][j].x * v[r][j].x + v[r][j].y * v[r][j].y) + (v[r][j].z * v[r][j].z + v[r][j].w * v[r][j].w);
                s[r] = a; }
#pragma unroll
            for (int o = 1; o < 64; o <<= 1) {
#pragma unroll
                for (int r = 0; r < 8; ++r) s[r] += __shfl_xor(s[r], o); }
#pragma unroll
            for (int r = 0; r < 8; ++r) { const float ms = s[r] * (1.f / D) + EPS, rstd = __builtin_amdgcn_rsqf(ms);
                if (lane == 0) F.rrow[m0 + r] = ms * rstd;
                GAS unsigned long long* o8 = (GAS unsigned long long*)(F.XN + (size_t)(m0 + r) * D) + lane;
#pragma unroll
                for (int j = 0; j < 4; ++j) o8[64 * j] = (unsigned long long)pk2(v[r][j].x * rstd * gg[j].x, v[r][j].y * rstd * gg[j].y) | ((unsigned long long)pk2(v[r][j].z * rstd * gg[j].z, v[r][j].w * rstd * gg[j].w) << 32); }
        }
        it += NGW;
    }
    if (F.wave == 0) for (int m = rbeg + 8 * nb8; m < rend; ++m) rms_rows<1>(F.x, gg, F.XN, F.rrow, m, lane);
}

constexpr int AT_IMG = 15 * 40 * 128;
constexpr int AT_A = 0;
constexpr int AT_B = AT_IMG;
constexpr int AT_TAB = 2 * AT_IMG;
static_assert(AT_TAB + 15 * 64 * 4 <= LDSCTL_OFF, "attention LDS map");
__device__ __forceinline__ int rs_of(int r) { int v = r - 4; v = v < 0 ? 0 : v; return v > 56 ? 56 : v; }

struct AttnUnit { int b, h, jh, r0, krow_lo, nrows; };
__device__ __forceinline__ AttnUnit attn_decode(int un) {
    AttnUnit u; const int bh = un >> 4, rc = (un >> 1) & 7; u.jh = un & 1; u.b = bh >> 3; u.h = bh & 7;
    u.r0 = 8 * rc; u.krow_lo = rs_of(u.r0); u.nrows = rs_of(u.r0 + 7) + 8 - u.krow_lo;
    return u;
}
__device__ __forceinline__ void glds16(const void* gsrc, unsigned lds_dst) { unsigned keep;
    asm volatile("s_mov_b32 %0, m0\n\ts_mov_b32 m0, %2\n\ts_nop 0\n\tglobal_load_lds_dwordx4 %1, off\n\ts_mov_b32 m0, %0" : "=&s"(keep) : "v"(gsrc), "s"(lds_dst) : "memory"); }
#define ATT_WAIT_BAR() do { asm volatile("s_waitcnt vmcnt(0) lgkmcnt(0)" ::: "memory"); __builtin_amdgcn_s_barrier(); asm volatile("" ::: "memory"); } while (0)
template <int KIND> __device__ __forceinline__ void attn_dma(unsigned dst, const bf16_t* src, const AttnUnit& u, int wid, int lane) {
    const int np = u.nrows * 5;
    const char* base = (const char*)(src + ((size_t)(u.b * NHEAD + u.h) * SEQ + u.krow_lo * 64 + 24 * u.jh) * HD);
#pragma unroll
    for (int it = 0; it < 10; ++it) {
        const int pi = it * 8 + wid;
        if (pi < np) {
            const int w = (pi * 205) >> 10, p = pi - 5 * w, c = 8 * p + (lane >> 3);
            const int sw = (KIND == 0) ? (((c >> 1) & 1) | (((c >> 3) & 3) << 1)) : ((((c >> 1) & 1) << 1) | (((c >> 3) & 1) << 2));
            const int ch = (lane & 7) ^ sw;
            const char* gp = base + (w * 64 + c) * (HD * 2) + ch * 16;
            glds16(gp, (unsigned)__builtin_amdgcn_readfirstlane(dst + pi * 1024));
        }
    }
}

__device__ __forceinline__ void p2_attention(Frame& F, const bf16_t* Qg, const bf16_t* Kg, const bf16_t* Vg, bf16_t* MIX) {
    const int lane = F.lane, wid = F.wave;
    LAS unsigned char* lds = F.lds;
    const unsigned lds0 = (unsigned)(size_t)F.lds;
    const int q = lane & 15, g = lane >> 4;
    constexpr int NUNITS = BATCH * NHEAD * 16, UW = 8;
    for (int uidx = F.vcu * UW; uidx < NUNITS; uidx += F.G * UW) {
        const int h = (uidx >> 4) & 7;
        __syncthreads();
        {   LAS float* tab = (LAS float*)(lds + AT_TAB);
            for (int i = F.tid; i < 15 * 64; i += NWAVES * 64) { const int rr = i >> 6, cc = (i & 63) - 16; tab[i] = (cc >= 0 && cc < 31) ? F.rpb[h * 465 + rr * 31 + cc] * LOG2E : 0.f; } }
        AttnUnit u = attn_decode(uidx);
        attn_dma<0>(lds0 + AT_A, Kg, u, wid, lane);
        bf16x8 qf[2][2];
#pragma unroll
        for (int jb = 0; jb < 2; ++jb) { const bf16_t* qp = Qg + ((size_t)(u.b * NHEAD + u.h) * SEQ + (u.r0 + wid) * 64 + 32 * u.jh + 16 * jb + q) * HD + 8 * g; qf[jb][0] = *(const bf16x8*)qp; qf[jb][1] = *(const bf16x8*)(qp + 32); }
        ATT_WAIT_BAR();
        for (int ui = 0; ui < UW; ++ui) {
            asm volatile("" : "+v"(qf[0][0]), "+v"(qf[0][1]), "+v"(qf[1][0]), "+v"(qf[1][1]));
            attn_dma<1>(lds0 + AT_B, Vg, u, wid, lane);
            const int r = u.r0 + wid, rs = rs_of(r), wbase = rs - u.krow_lo;
            u32x4 pw[2][8]; float il[2];
#pragma unroll
            for (int jb = 0; jb < 2; ++jb) {
                const int o = 8 * jb, kcol0 = 24 * u.jh + o, cq = 32 * u.jh + 16 * jb + q;
                int cs = cq - 8; cs = cs < 0 ? 0 : cs; cs = cs > 48 ? 48 : cs;
                f32x4 sc[8][2];
                {
                    const int fk = ((q >> 1) & 1) | (((jb + (q >> 2)) & 3) << 1), x0 = g ^ fk;
                    const LAS unsigned char* ka = lds + AT_A + (wbase * 40 + o + 8 * (q >> 2) + (q & 3)) * 128;
                    const LAS unsigned char* k0p = ka + x0 * 16;
                    const LAS unsigned char* k1p = ka + (x0 ^ 4) * 16;
#pragma unroll
                    for (int wl = 0; wl < 8; ++wl)
#pragma unroll
                        for (int blk = 0; blk < 2; ++blk) {
                            const bf16x8 k0 = *(const LAS bf16x8*)(k0p + wl * 5120 + blk * 512), k1 = *(const LAS bf16x8*)(k1p + wl * 5120 + blk * 512);
                            f32x4 a = (f32x4){0.f, 0.f, 0.f, 0.f};
                            a = __builtin_amdgcn_mfma_f32_16x16x32_bf16(k0, qf[jb][0], a, 0, 0, 0);
                            a = __builtin_amdgcn_mfma_f32_16x16x32_bf16(k1, qf[jb][1], a, 0, 0, 0);
                            sc[wl][blk] = a;
                        }
                }
                const LAS float* tab = (const LAS float*)(lds + AT_TAB) + (rs - r + 7) * 64 + 16 + (kcol0 - cq + 15) + 8 * g;
                const int voff = kcol0 + 8 * g - cs;
                float mx = -INFINITY;
#pragma unroll
                for (int wl = 0; wl < 8; ++wl)
#pragma unroll
                    for (int blk = 0; blk < 2; ++blk)
#pragma unroll
                        for (int e = 0; e < 4; ++e) {
                            const int ep = 4 * blk + e;
                            float s_ = sc[wl][blk][e] + tab[wl * 64 + ep];
                            s_ = ((unsigned)(voff + ep) < 16u) ? s_ : -INFINITY;
                            sc[wl][blk][e] = s_; mx = fmaxf(mx, s_);
                        }
                mx = fmaxf(mx, __shfl_xor(mx, 16)); mx = fmaxf(mx, __shfl_xor(mx, 32));
                float l = 0.f;
#pragma unroll
                for (int wl = 0; wl < 8; ++wl) {
                    float p[8];
#pragma unroll
                    for (int blk = 0; blk < 2; ++blk)
#pragma unroll
                        for (int e = 0; e < 4; ++e) { p[4 * blk + e] = __builtin_amdgcn_exp2f(sc[wl][blk][e] - mx); l += p[4 * blk + e]; }
                    pw[jb][wl].x = cvt_pk_bf16(p[0], p[1]); pw[jb][wl].y = cvt_pk_bf16(p[2], p[3]); pw[jb][wl].z = cvt_pk_bf16(p[4], p[5]); pw[jb][wl].w = cvt_pk_bf16(p[6], p[7]);
                }
                l += __shfl_xor(l, 16); l += __shfl_xor(l, 32);
                il[jb] = __builtin_amdgcn_rcpf(l);
            }
            ATT_WAIT_BAR();
            AttnUnit un = u; bf16x8 nq[2][2];
#pragma unroll
            for (int jb = 0; jb < 2; ++jb) { nq[jb][0] = qf[jb][0]; nq[jb][1] = qf[jb][1]; }
            if (ui < UW - 1) {
                un = attn_decode(uidx + ui + 1);
                attn_dma<0>(lds0 + AT_A, Kg, un, wid, lane);
#pragma unroll
                for (int jb = 0; jb < 2; ++jb) { const bf16_t* qp = Qg + ((size_t)(un.b * NHEAD + un.h) * SEQ + (un.r0 + wid) * 64 + 32 * un.jh + 16 * jb + q) * HD + 8 * g; nq[jb][0] = *(const bf16x8*)qp; nq[jb][1] = *(const bf16x8*)(qp + 32); }
            }
#pragma unroll
            for (int jb = 0; jb < 2; ++jb) {
                const int o = 8 * jb, cq = 32 * u.jh + 16 * jb + q;
                f32x4 ov[4];
#pragma unroll
                for (int n = 0; n < 4; ++n) ov[n] = (f32x4){0.f, 0.f, 0.f, 0.f};
                {
                    const int qr = q >> 2, p = lane & 3;
                    const int fv = (((qr >> 1) & 1) << 1) | (((jb + g) & 1) << 2);
                    const LAS unsigned char* vb = lds + AT_B + (wbase * 40 + o + 8 * g + qr) * 128 + (p >> 1) * 16 + (p & 1) * 8;
                    const LAS unsigned char* vn[4];
#pragma unroll
                    for (int n = 0; n < 4; ++n) vn[n] = vb + ((2 * n) ^ fv) * 16;
#pragma unroll
                    for (int wl = 0; wl < 8; ++wl) {
                        const bf16x8 pf = __builtin_bit_cast(bf16x8, pw[jb][wl]);
#pragma unroll
                        for (int n = 0; n < 4; ++n) {
                            const s16x4 lo = __builtin_bit_cast(s16x4, __builtin_amdgcn_ds_read_tr16_b64_v4i16((LAS s16x4*)(vn[n] + wl * 5120)));
                            const s16x4 hi = __builtin_bit_cast(s16x4, __builtin_amdgcn_ds_read_tr16_b64_v4i16((LAS s16x4*)(vn[n] + wl * 5120 + 512)));
                            const bf16x8 vf = (bf16x8){lo[0], lo[1], lo[2], lo[3], hi[0], hi[1], hi[2], hi[3]};
                            ov[n] = __builtin_amdgcn_mfma_f32_16x16x32_bf16(vf, pf, ov[n], 0, 0, 0);
                        }
                    }
                }
                bf16_t* op = MIX + ((size_t)(u.b * SEQ + r * 64 + cq)) * D + u.h * HD + 4 * g;
#pragma unroll
                for (int n = 0; n < 4; ++n) { u32x2 w; w.x = cvt_pk_bf16(ov[n][0] * il[jb], ov[n][1] * il[jb]); w.y = cvt_pk_bf16(ov[n][2] * il[jb], ov[n][3] * il[jb]); *(u32x2*)(op + 16 * n) = w; }
            }
            ATT_WAIT_BAR();
            u = un;
#pragma unroll
            for (int jb = 0; jb < 2; ++jb) { qf[jb][0] = nq[jb][0]; qf[jb][1] = nq[jb][1]; }
        }
    }
}

__device__ __forceinline__ void up8(const u32x4 w, float (&v)[8]) {
    v[0] = bflo(w.x); v[1] = bfhi(w.x); v[2] = bflo(w.y); v[3] = bfhi(w.y); v[4] = bflo(w.z); v[5] = bfhi(w.z); v[6] = bflo(w.w); v[7] = bfhi(w.w);
}
__device__ __forceinline__ void pool_run(const bf16_t* __restrict__ Zg, bf16_t* __restrict__ MIX, int gw, int lane) {
    const int tb = 32 * gw, b = tb >> 12, t0 = tb & (SEQ - 1);
    const int half = 1 << (lane >> 4);
    const bf16_t* zb = Zg + (size_t)(b * SEQ) * NA + 8 * lane;
    bf16_t* ob = MIX + (size_t)(b * SEQ) * D + NA + 8 * lane;
    float S[8];
#pragma unroll
    for (int e = 0; e < 8; ++e) S[e] = 0.f;
    {   u32x4 w[16];
#pragma unroll
        for (int d = 0; d < 16; ++d) { int i = t0 + d - 8; i = i < 0 ? 0 : i; i = i > SEQ - 1 ? SEQ - 1 : i; w[d] = *(const u32x4*)(zb + (size_t)i * NA); }
#pragma unroll
        for (int d = 0; d < 16; ++d) { const int dd = d - 8, i = t0 + dd; const float mk = (dd >= -half && dd < half && i >= 0 && i < SEQ) ? 1.f : 0.f; float v[8]; up8(w[d], v);
#pragma unroll
            for (int e = 0; e < 8; ++e) S[e] += mk * v[e]; } }
    for (int c = 0; c < 4; ++c) {
        u32x4 zt[8], za[8], zs[8];
#pragma unroll
        for (int k = 0; k < 8; ++k) { const int t = t0 + 8 * c + k; int ia = t + half, is = t - half; ia = ia > SEQ - 1 ? SEQ - 1 : ia; is = is < 0 ? 0 : is;
            zt[k] = *(const u32x4*)(zb + (size_t)t * NA); za[k] = *(const u32x4*)(zb + (size_t)ia * NA); zs[k] = *(const u32x4*)(zb + (size_t)is * NA); }
#pragma unroll
        for (int k = 0; k < 8; ++k) { const int t = t0 + 8 * c + k;
            const int lo = (t - half) < 0 ? 0 : (t - half), hi = (t + half) > SEQ ? SEQ : (t + half);
            const float inv = 1.0f / (float)(hi - lo);
            float v[8]; up8(zt[k], v);
            u32x4 w;
            w.x = cvt_pk_bf16(S[0] * inv - v[0], S[1] * inv - v[1]); w.y = cvt_pk_bf16(S[2] * inv - v[2], S[3] * inv - v[3]);
            w.z = cvt_pk_bf16(S[4] * inv - v[4], S[5] * inv - v[5]); w.w = cvt_pk_bf16(S[6] * inv - v[6], S[7] * inv - v[7]);
            *(u32x4*)(ob + (size_t)t * D) = w;
            const float ma = (t + half < SEQ) ? 1.f : 0.f, ms = (t - half >= 0) ? 1.f : 0.f;
            float a[8], s[8]; up8(za[k], a); up8(zs[k], s);
#pragma unroll
            for (int e = 0; e < 8; ++e) S[e] += ma * a[e] - ms * s[e]; }
    }
}

__device__ __forceinline__ void p2_mixer(Frame& F) {
    const bf16_t* Qg = F.QKVZ; const bf16_t* Kg = F.QKVZ + (size_t)M * NA; const bf16_t* Vg = F.QKVZ + 2 * (size_t)M * NA; const bf16_t* Zg = F.QKVZ + 3 * (size_t)M * NA;
    bf16_t* MIX = F.MIX;
    for (int gw = F.vcu * NWAVES + F.wave; gw < M / 32; gw += F.G * NWAVES) pool_run(Zg, MIX, gw, F.lane);
    p2_attention(F, Qg, Kg, Vg, MIX);
    __syncthreads();
}

struct Args { const float* in[13]; float* out; unsigned char* ws; int ph_lo, ph_hi, li, pad; };
__global__ void __launch_bounds__(NWAVES * 64, 2) fwd_megakernel(Args args) {
    extern __shared__ __attribute__((aligned(16))) unsigned char lds[];
    Frame F;
    F.lds = (LAS unsigned char*)lds;
    F.MISC = (volatile LAS unsigned*)(F.lds + MISC_OFF);
    F.tid = threadIdx.x; F.lane = F.tid & 63; F.wave = __builtin_amdgcn_readfirstlane(F.tid >> 6);
    F.G = gridDim.x; { const int bx = blockIdx.x; F.vcu = (F.G % 8 == 0) ? (bx % 8) * (F.G / 8) + bx / 8 : bx; }
    unsigned char* ws = args.ws;
    F.ctl = (gu32*)(ws + WS_CTL);
    F.x = args.in[0]; F.g1 = args.in[1]; F.w_in = args.in[2]; F.gq = args.in[3]; F.gk = args.in[4]; F.rpb = args.in[5]; F.w_pool = args.in[6];
    F.pscale = args.in[7]; F.w_out = args.in[8]; F.g2 = args.in[9]; F.w_gate = args.in[10]; F.w_up = args.in[11]; F.w_down = args.in[12]; F.out = args.out;
    F.Win_t = (bf16_t*)(ws + WS_WIN); F.Wout_t = (bf16_t*)(ws + WS_WOUT); F.Wgu_t = (bf16_t*)(ws + WS_WGU); F.Wdn_t = (bf16_t*)(ws + WS_WDN);
    F.XN = (bf16_t*)(ws + WS_XN); F.QKVZ = (bf16_t*)(ws + WS_QKVZ); F.XB = (bf16_t*)(ws + WS_XB); F.ACT = (bf16_t*)(ws + WS_ACT);
    F.ss = (float*)(ws + WS_CTL) + CW_SS; F.rrow = (float*)(ws + WS_CTL) + CW_SS + M; F.MIX = (bf16_t*)(ws + WS_ACT);
    for (int u = F.tid; u < (LDS_BYTES - LDSCTL_OFF) / 4; u += NWAVES * 64) ((LAS unsigned*)(F.lds + LDSCTL_OFF))[u] = 0u;
    __syncthreads();
    XcdBarrier bar; bar.bar = (unsigned*)(F.ctl + CW_BAR); bar.x = 0; bar.st = nullptr;
    if (N_LAUNCHES != PER_PHASE) bar = xcd_barrier_post((unsigned*)(F.ctl + CW_BAR), F.MISC + 8);
#define GRID_BAR() do { if (N_LAUNCHES != PER_PHASE) xcd_barrier(bar); } while (0)
    const int lo = args.ph_lo, hi = args.ph_hi;
#define IN(k) (lo <= (k) && (k) < hi)
#define BOTH(k) (IN(k) && IN((k) + 1))

    if (IN(0)) { p0_prologue(F); if (BOTH(0)) GRID_BAR(); }

    if (IN(1)) {
        pg8::Gemm g{F.XN, F.Win_t, M, NIN, D}; pg8::StaticOrder S; S.init(M, NIN, F.G, (int)blockIdx.x);
        { LAS float* gl = (LAS float*)(F.lds + LDS_GAIN_OFF);
          if (F.tid < 64) gl[F.tid] = F.gq[F.tid] * (0.125f * LOG2E); else if (F.tid < 128) gl[F.tid] = F.gk[F.tid - 64];
          __syncthreads(); }
        pg8::EpiIn E{F.QKVZ, (const LAS float*)(F.lds + LDS_GAIN_OFF)};
        pg8::gemm_phase<pg8::EpiIn, pg8::StaticOrder, true, PG8_SP2>(F.lds + RING_OFF, g, S, E);
        if (BOTH(1)) GRID_BAR();
    }

    if (IN(2)) { p2_mixer(F); if (BOTH(2)) GRID_BAR(); }

    if (IN(3)) {
        pg8::Gemm g{F.MIX, F.Wout_t, M, D, D}; pg8::StaticOrder S; S.init(M, D, F.G, (int)blockIdx.x);
        pg8::EpiOut E{F.XN, F.rrow, F.g1, F.XB, F.ss};
        pg8::gemm_phase<pg8::EpiOut, pg8::StaticOrder, true, PG8_SP2>(F.lds + RING_OFF, g, S, E);
        if (BOTH(3)) GRID_BAR();
    }

    if (IN(4)) {
        pg8::Gemm g{F.XB, F.Wgu_t, M, NGU, D}; pg8::StaticOrder S; S.init(M, NGU, F.G, (int)blockIdx.x);
        pg8::EpiGU E{F.ACT, F.ss};
        pg8::gemm_phase<pg8::EpiGU, pg8::StaticOrder, true, PG8_SP2>(F.lds + RING_OFF, g, S, E);
        if (BOTH(4)) GRID_BAR();
    }

    if (IN(5)) {
        pg8::Gemm g{F.ACT, F.Wdn_t, M, D, FF}; pg8::StaticOrder S; S.init(M, D, F.G, (int)blockIdx.x);
        pg8::EpiDown E{F.XB, F.out};
        pg8::gemm_phase<pg8::EpiDown, pg8::StaticOrder, true, PG8_SP2>(F.lds + RING_OFF, g, S, E);
    }
#undef IN
#undef BOTH
#undef GRID_BAR
}

extern "C" void kernel_launch(void* const* d_in, const int* in_sizes, int n_in, void* d_out, int out_size, void* d_ws, size_t ws_size, hipStream_t stream) {
    static int grid = 0;
    if (grid == 0) {
        if (n_in != 13 || in_sizes[0] != M * D || out_size != M * D || ws_size < WS_END) { fprintf(stderr, "kernel_launch: unexpected shapes (n_in %d, in0 %d, out %d, ws %zu); nothing launched\n", n_in, n_in > 0 ? in_sizes[0] : -1, out_size, ws_size); grid = -1; return; }
        int dev = 0, cus = 0, per_cu = 0;
        if (hipGetDevice(&dev) != hipSuccess || hipDeviceGetAttribute(&cus, hipDeviceAttributeMultiprocessorCount, dev) != hipSuccess) { fprintf(stderr, "kernel_launch: device query failed\n"); grid = -1; return; }
        if (hipFuncSetAttribute((const void*)fwd_megakernel, hipFuncAttributeMaxDynamicSharedMemorySize, LDS_BYTES) != hipSuccess) { fprintf(stderr, "kernel_launch: hipFuncSetAttribute failed\n"); grid = -1; return; }
        if (hipOccupancyMaxActiveBlocksPerMultiprocessor(&per_cu, (const void*)fwd_megakernel, NWAVES * 64, LDS_BYTES) != hipSuccess || per_cu < 1) {
            fprintf(stderr, "kernel_launch: occupancy query reports %d workgroups per CU; nothing launched\n", per_cu); (void)hipGetLastError(); grid = -1; return; }
        (void)hipGetLastError();
        grid = cus;
    }
    if (grid < 0) return;
    if (hipMemsetAsync((char*)d_ws + WS_CTL, 0, CTL_ZERO_BYTES, stream) != hipSuccess) { fprintf(stderr, "kernel_launch: hipMemsetAsync failed\n"); return; }
    Args a{};
    for (int i = 0; i < 13; ++i) a.in[i] = (const float*)d_in[i];
    a.out = (float*)d_out; a.ws = (unsigned char*)d_ws;
    for (int li = 0; li < N_LAUNCHES; ++li) {
        a.ph_lo = (N_LAUNCHES == PER_PHASE) ? li : 0; a.ph_hi = (N_LAUNCHES == PER_PHASE) ? li + 1 : PER_PHASE; a.li = li;
        hipLaunchKernelGGL(fwd_megakernel, dim3(grid), dim3(NWAVES * 64), LDS_BYTES, stream, a);
        const hipError_t le = hipPeekAtLastError();
        if (le != hipSuccess) { fprintf(stderr, "kernel_launch: launch %d failed: %s\n", li, hipGetErrorName(le)); break; }
    }
}
```

```cpp
#include <hip/hip_runtime.h>
#include <cstdio>
#include <cstdint>

#define LAS __attribute__((address_space(3)))
#define GAS __attribute__((address_space(1)))
typedef unsigned short bf16_t;
typedef short bf16x8 __attribute__((ext_vector_type(8)));
typedef short s16x4 __attribute__((ext_vector_type(4)));
typedef float f32x4 __attribute__((ext_vector_type(4)));
typedef float f32x2 __attribute__((ext_vector_type(2)));
typedef unsigned u32x4 __attribute__((ext_vector_type(4)));
typedef unsigned u32x2 __attribute__((ext_vector_type(2)));

constexpr int BATCH = 16, SEQ = 4096, D = 1024, M = BATCH * SEQ;
constexpr int NA = 512, NHEAD = 8, HD = 64, NIN = 2048, FF = 2816, NGU = 2 * FF;
constexpr float EPS = 1e-6f;
constexpr float LOG2E = 1.4426950408889634f;

__device__ __forceinline__ unsigned cvt_pk_bf16(float lo, float hi) { unsigned r; asm volatile("v_cvt_pk_bf16_f32 %0, %1, %2" : "=v"(r) : "v"(lo), "v"(hi)); return r; }

namespace pg8 {
constexpr int BM = 256, BK = 64, HALF = 128, HTB = HALF * BK * 2, STAGE_BYTES = 8 * HTB, NXCD = 8, WGM = 8;

__host__ __device__ __forceinline__ int lds_byte(int r, int c) { const int st = (r >> 4) * 2 + (c >> 5), rr = r & 15, cc = c & 31, ob = rr * 64 + cc * 2; return st * 1024 + (ob ^ (((ob >> 9) & 1) << 5)); }
__host__ __device__ __forceinline__ void stage_rc(int b, int& R, int& C) { const int st = b / 1024, sb = b % 1024, swz = sb ^ (((sb >> 9) & 1) << 5); R = (st >> 1) * 16 + swz / 64; C = (st & 1) * 32 + (swz % 64) / 2; }
__host__ __device__ __forceinline__ int perm32(int rho) { const int n = rho >> 4, i = rho & 15; return 8 * (i >> 2) + 4 * n + (i & 3); }

struct Unit { int pm, pn; };
struct Gemm { const bf16_t* A; const bf16_t* Bt; int M, N, K; };

struct StaticOrder {
    int nM, nN, nwg, G, c;
    __host__ __device__ void init(int M_, int N_, int G_, int c_) { nM = M_ / BM; nN = N_ / BM; nwg = nM * nN; G = G_; c = c_; }
    __host__ __device__ bool next(int i, Unit& u) const {
        const long L = (long)i * G + c; if (L >= nwg) return false;
        int wgid = (int)L; { const int q = nwg / NXCD, r = nwg % NXCD, xcd = wgid % NXCD, off = wgid / NXCD; wgid = (xcd < r ? xcd * (q + 1) : r * (q + 1) + (xcd - r) * q) + off; }
        const int nig = WGM * nN, gid = wgid / nig, fm = gid * WGM, gsz = (nM - fm) < WGM ? (nM - fm) : WGM;
        u.pm = fm + ((wgid % nig) % gsz); u.pn = (wgid % nig) / gsz; return true;
    }
    __device__ __forceinline__ void a_ready(const Unit&) const {}
    __device__ __forceinline__ void done(const Unit&) const {}
};

struct RevOrder : StaticOrder {
    __host__ __device__ bool next(int i, Unit& u) const { const bool ok = StaticOrder::next(i, u); if (ok) u.pm = nM - 1 - u.pm; return ok; }
};


struct EpiIn {
    static constexpr bool PERM = true, AFTER_DRAIN = false;
    bf16_t* QKVZ; const LAS float* gl;
    __device__ __forceinline__ void operator()(const f32x4 (&acc)[2][2][4][2], const Unit& u, int wr, int wc, int fr, int fq) const {
        const int kind = u.pn >> 1;
        const int row0 = u.pm * BM + wr * 64 + fr;
        const int head = 4 * (u.pn & 1) + wc; const size_t rstride = kind < 3 ? HD : NA;
        bf16_t* base = QKVZ + (size_t)kind * ((size_t)M * NA) + 8 * fq
                     + (kind < 3 ? ((size_t)((row0 >> 12) * NHEAD + head) * SEQ + (row0 & (SEQ - 1))) * HD : (size_t)row0 * NA + head * HD);
        if (kind < 2) {
            const LAS float* g = gl + 64 * kind + 8 * fq;
            f32x4 gv[2][2];
#pragma unroll
            for (int bj = 0; bj < 2; ++bj)
#pragma unroll
                for (int n = 0; n < 2; ++n) gv[bj][n] = *(const LAS f32x4*)(g + 32 * bj + 4 * n);
            float ss[8];
#pragma unroll
            for (int i = 0; i < 8; ++i) { const int ai = i >> 2, m = i & 3; float a = 0.f;
#pragma unroll
                for (int bj = 0; bj < 2; ++bj)
#pragma unroll
                    for (int n = 0; n < 2; ++n) { const f32x4 v = acc[ai][bj][m][n]; a += (v[0] * v[0] + v[1] * v[1]) + (v[2] * v[2] + v[3] * v[3]); }
                ss[i] = a; }
#pragma unroll
            for (int i = 0; i < 8; ++i) ss[i] += __shfl_xor(ss[i], 16);
#pragma unroll
            for (int i = 0; i < 8; ++i) ss[i] += __shfl_xor(ss[i], 32);
#pragma unroll
            for (int i = 0; i < 8; ++i) { const int ai = i >> 2, m = i & 3;
                bf16_t* rowp = base + (size_t)(ai * HALF + m * 16) * rstride;
                const float r = __builtin_amdgcn_rsqf(ss[i] * (1.0f / 64.0f) + EPS);
#pragma unroll
                for (int bj = 0; bj < 2; ++bj) {
                    const f32x4 v0 = acc[ai][bj][m][0] * r * gv[bj][0], v1 = acc[ai][bj][m][1] * r * gv[bj][1];
                    u32x4 w; w.x = cvt_pk_bf16(v0[0], v0[1]); w.y = cvt_pk_bf16(v0[2], v0[3]); w.z = cvt_pk_bf16(v1[0], v1[1]); w.w = cvt_pk_bf16(v1[2], v1[3]);
                    *(u32x4*)(rowp + bj * 32) = w; }
            }
        } else {
#pragma unroll
            for (int ai = 0; ai < 2; ++ai)
#pragma unroll
                for (int m = 0; m < 4; ++m) {
                    bf16_t* rowp = base + (size_t)(ai * HALF + m * 16) * rstride;
#pragma unroll
                    for (int bj = 0; bj < 2; ++bj) {
                        const f32x4 v0 = acc[ai][bj][m][0], v1 = acc[ai][bj][m][1];
                        u32x4 w; w.x = cvt_pk_bf16(v0[0], v0[1]); w.y = cvt_pk_bf16(v0[2], v0[3]); w.z = cvt_pk_bf16(v1[0], v1[1]); w.w = cvt_pk_bf16(v1[2], v1[3]);
                        *(u32x4*)(rowp + bj * 32) = w; }
                }
        }
    }
};

struct EpiOut {
    static constexpr bool PERM = true, AFTER_DRAIN = false;
    const bf16_t* XN; const float* rrow; const float* g1; bf16_t* XB; float* ss;
    __device__ __forceinline__ void operator()(const f32x4 (&acc)[2][2][4][2], const Unit& u, int wr, int wc, int fr, int fq) const {
        const int row0 = u.pm * BM + wr * 64 + fr, col0 = u.pn * BM + wc * 32 + 8 * fq;
        const size_t off0 = (size_t)row0 * D + col0;
        const bf16_t* __restrict__ xp = XN + off0; bf16_t* __restrict__ bp = XB + off0;
        f32x4 gi[2][2];
#pragma unroll
        for (int bj = 0; bj < 2; ++bj)
#pragma unroll
            for (int n = 0; n < 2; ++n) { const f32x4 gv = *(const f32x4*)(g1 + col0 + bj * HALF + 4 * n);
                gi[bj][n] = (f32x4){__builtin_amdgcn_rcpf(gv[0]), __builtin_amdgcn_rcpf(gv[1]), __builtin_amdgcn_rcpf(gv[2]), __builtin_amdgcn_rcpf(gv[3])}; }
        u32x4 xa[8][2]; float rr[8], part[8];
#pragma unroll
        for (int i = 0; i < 8; ++i) rr[i] = rrow[row0 + (i >> 2) * HALF + (i & 3) * 16];
#define EO_LOAD(i) do { const size_t o_ = (size_t)(((i) >> 2) * HALF + ((i) & 3) * 16) * D; xa[i][0] = *(const u32x4*)(xp + o_); xa[i][1] = *(const u32x4*)(xp + o_ + HALF); } while (0)
        EO_LOAD(0); EO_LOAD(1); EO_LOAD(2); EO_LOAD(3);
        asm volatile("" ::: "memory");
#pragma unroll
        for (int i = 0; i < 8; ++i) { const int ai = i >> 2, m = i & 3; const size_t o_ = (size_t)(ai * HALF + m * 16) * D; float p = 0.f;
#pragma unroll
            for (int bj = 0; bj < 2; ++bj) { const u32x4 w_ = xa[i][bj];
                const f32x4 x0 = {__builtin_bit_cast(float, w_.x << 16), __builtin_bit_cast(float, w_.x & 0xffff0000u), __builtin_bit_cast(float, w_.y << 16), __builtin_bit_cast(float, w_.y & 0xffff0000u)};
                const f32x4 x1 = {__builtin_bit_cast(float, w_.z << 16), __builtin_bit_cast(float, w_.z & 0xffff0000u), __builtin_bit_cast(float, w_.w << 16), __builtin_bit_cast(float, w_.w & 0xffff0000u)};
                const f32x4 v0 = acc[ai][bj][m][0] + x0 * (gi[bj][0] * rr[i]), v1 = acc[ai][bj][m][1] + x1 * (gi[bj][1] * rr[i]);
                u32x4 w; w.x = cvt_pk_bf16(v0[0], v0[1]); w.y = cvt_pk_bf16(v0[2], v0[3]); w.z = cvt_pk_bf16(v1[0], v1[1]); w.w = cvt_pk_bf16(v1[2], v1[3]);
                *(u32x4*)(bp + o_ + bj * HALF) = w;
                p += (v0[0] * v0[0] + v0[1] * v0[1]) + (v0[2] * v0[2] + v0[3] * v0[3]) + (v1[0] * v1[0] + v1[1] * v1[1]) + (v1[2] * v1[2] + v1[3] * v1[3]); }
            part[i] = p;
            if (i + 4 < 8) { EO_LOAD((i + 4) & 7); }
            asm volatile("" ::: "memory"); }
#undef EO_LOAD
#pragma unroll
        for (int i = 0; i < 8; ++i) part[i] += __shfl_xor(part[i], 16);
#pragma unroll
        for (int i = 0; i < 8; ++i) part[i] += __shfl_xor(part[i], 32);
        if (fq == 0) {
#pragma unroll
            for (int i = 0; i < 8; ++i) atomicAdd(ss + row0 + (i >> 2) * HALF + (i & 3) * 16, part[i]);
        }
    }
};

struct EpiGU {
    static constexpr bool PERM = true, AFTER_DRAIN = false;
    bf16_t* ACT; const float* ss;
    __device__ __forceinline__ void operator()(const f32x4 (&acc)[2][2][4][2], const Unit& u, int wr, int wc, int fr, int fq) const {
        const int row0 = u.pm * BM + wr * 64 + fr, col0 = u.pn * HALF + wc * 32 + 8 * fq;
        float sv[8];
#pragma unroll
        for (int i = 0; i < 8; ++i) sv[i] = ss[row0 + (i >> 2) * HALF + (i & 3) * 16];
        asm volatile("" ::: "memory");
#pragma unroll
        for (int i = 0; i < 8; ++i) { const int ai = i >> 2, m = i & 3;
            const float rstd = __builtin_amdgcn_rsqf(sv[i] * (1.0f / (float)D) + EPS), ne = -LOG2E * rstd, r2 = rstd * rstd;
            unsigned w[4];
#pragma unroll
            for (int n = 0; n < 2; ++n)
#pragma unroll
                for (int h = 0; h < 2; ++h) {
                    const f32x2 g = {acc[ai][0][m][n][2 * h], acc[ai][0][m][n][2 * h + 1]}, up = {acc[ai][1][m][n][2 * h], acc[ai][1][m][n][2 * h + 1]};
                    const f32x2 t = g * ne; f32x2 e; e.x = __builtin_amdgcn_exp2f(t.x); e.y = __builtin_amdgcn_exp2f(t.y);
                    const f32x2 d = e + 1.0f; f32x2 r; r.x = __builtin_amdgcn_rcpf(d.x); r.y = __builtin_amdgcn_rcpf(d.y);
                    const f32x2 a = (g * up) * (r * r2);
                    w[2 * n + h] = cvt_pk_bf16(a.x, a.y); }
            *(u32x4*)(ACT + (size_t)(row0 + ai * HALF + m * 16) * FF + col0) = (u32x4){w[0], w[1], w[2], w[3]};
        }
    }
};

struct EpiDown {
    static constexpr bool PERM = true, AFTER_DRAIN = false;
    const bf16_t* XB; float* out;
    __device__ __forceinline__ void operator()(const f32x4 (&acc)[2][2][4][2], const Unit& u, int wr, int wc, int fr, int fq) const {
        const int row0 = u.pm * BM + wr * 64 + fr, col0 = u.pn * BM + wc * 32 + 8 * fq;
        const size_t off0 = (size_t)row0 * D + col0;
        const bf16_t* __restrict__ bp = XB + off0; float* __restrict__ op = out + off0;
        u32x4 xa[8][2];
#define ED_LOAD(i) do { const size_t o_ = (size_t)(((i) >> 2) * HALF + ((i) & 3) * 16) * D; xa[i][0] = *(const u32x4*)(bp + o_); xa[i][1] = *(const u32x4*)(bp + o_ + HALF); } while (0)
        ED_LOAD(0); ED_LOAD(1); ED_LOAD(2); ED_LOAD(3);
        asm volatile("" ::: "memory");
#pragma unroll
        for (int i = 0; i < 8; ++i) { const int ai = i >> 2, m = i & 3; const size_t o_ = (size_t)(ai * HALF + m * 16) * D;
#pragma unroll
            for (int bj = 0; bj < 2; ++bj) { const u32x4 w = xa[i][bj];
                const f32x4 r0 = {__builtin_bit_cast(float, w.x << 16), __builtin_bit_cast(float, w.x & 0xffff0000u), __builtin_bit_cast(float, w.y << 16), __builtin_bit_cast(float, w.y & 0xffff0000u)};
                const f32x4 r1 = {__builtin_bit_cast(float, w.z << 16), __builtin_bit_cast(float, w.z & 0xffff0000u), __builtin_bit_cast(float, w.w << 16), __builtin_bit_cast(float, w.w & 0xffff0000u)};
                *(f32x4*)(op + o_ + bj * HALF) = acc[ai][bj][m][0] + r0; *(f32x4*)(op + o_ + bj * HALF + 4) = acc[ai][bj][m][1] + r1; }
            if (i + 4 < 8) { ED_LOAD((i + 4) & 7); }
            asm volatile("" ::: "memory"); }
#undef ED_LOAD
    }
};

template <class Epi, class Sched, bool ALIGN_EPI = false, bool SP2 = false>
__device__ __forceinline__ void gemm_phase(LAS unsigned char* lds, const Gemm g, const Sched& S, const Epi& E) {
    const int tid = threadIdx.x, wid = __builtin_amdgcn_readfirstlane(tid >> 6), lane = tid & 63, wr = wid >> 2, wc = wid & 3, fr = lane & 15, fq = lane >> 4;
    const int K = g.K, nt = K / BK;
    unsigned voffA[2], voffB[2];
#pragma unroll
    for (int i = 0; i < 2; ++i) { int R, C; stage_rc(tid * 16 + i * 8192, R, C); const int Rb = Epi::PERM ? ((R & ~31) + perm32(R & 31)) : R;
        voffA[i] = (unsigned)(R * K + C) * 2u; voffB[i] = (unsigned)(Rb * K + C) * 2u; }
    const size_t kstep = (size_t)(BK * 2);
    const size_t hstep = (size_t)HALF * K * 2;
    const size_t tstep = 2 * hstep;
    const unsigned ldsw = (unsigned)wid * 1024u;
    const int aoff = lds_byte(wr * 64 + fr, fq * 8), boff = lds_byte(wc * 32 + fr, fq * 8);
#define PG8_SA(b, h) (((b) * 2 + (h)) * HTB)
#define PG8_SB(b, h) ((4 + (b) * 2 + (h)) * HTB)
#define PG8_STAGE(bufoff, gbase, voff) do { _Pragma("unroll") for (int _i = 0; _i < 2; ++_i) \
        __builtin_amdgcn_global_load_lds((const unsigned*)((const char*)(gbase) + (voff)[_i]), (LAS unsigned*)(lds + (bufoff) + ldsw + _i * 8192), 16, 0, 0); } while (0)
#define PG8_LDA(dst, b, h) do { _Pragma("unroll") for (int m = 0; m < 4; ++m) _Pragma("unroll") for (int k = 0; k < 2; ++k) dst[m][k] = *(const LAS bf16x8*)(lds + PG8_SA(b, h) + aoff + m * 2048 + k * 1024); } while (0)
#define PG8_LDB(dst, b, h) do { _Pragma("unroll") for (int n = 0; n < 2; ++n) _Pragma("unroll") for (int k = 0; k < 2; ++k) dst[n][k] = *(const LAS bf16x8*)(lds + PG8_SB(b, h) + boff + n * 2048 + k * 1024); } while (0)
#define PG8_MMA(ai, bj, At, Bt) do { __builtin_amdgcn_s_setprio(1); _Pragma("unroll") for (int m = 0; m < 4; ++m) _Pragma("unroll") for (int n = 0; n < 2; ++n) _Pragma("unroll") for (int k = 0; k < 2; ++k) \
        acc[ai][bj][m][n] = __builtin_amdgcn_mfma_f32_16x16x32_bf16(Bt[n][k], At[m][k], acc[ai][bj][m][n], 0, 0, 0); __builtin_amdgcn_s_setprio(0); } while (0)
#define PG8_WAIT_V(n) asm volatile("s_waitcnt vmcnt(" #n ")" ::: "memory")
#define PG8_WAIT_L(n) asm volatile("s_waitcnt lgkmcnt(" #n ")" ::: "memory")
#define PG8_BAR __builtin_amdgcn_s_barrier()
#define PG8_SCHED __builtin_amdgcn_sched_barrier(0)
    Unit cur, nxt; int ui = 0;
    if (!S.next(0, cur)) return;
    f32x4 acc[2][2][4][2];
#pragma unroll
    for (int a = 0; a < 2; ++a)
#pragma unroll
        for (int b = 0; b < 2; ++b)
#pragma unroll
            for (int m = 0; m < 4; ++m)
#pragma unroll
                for (int n = 0; n < 2; ++n) acc[a][b][m][n] = (f32x4){0.f, 0.f, 0.f, 0.f};
    bf16x8 At[4][2], B0[2][2], B1[2][2];
    const char* cA = (const char*)g.A + (size_t)cur.pm * tstep; const char* cB = (const char*)g.Bt + (size_t)cur.pn * tstep;
    S.a_ready(cur);
    if constexpr (SP2) {
        PG8_STAGE(PG8_SB(0, 0), cB, voffB); PG8_STAGE(PG8_SB(0, 1), cB + hstep, voffB); PG8_STAGE(PG8_SA(0, 0), cA, voffA); PG8_STAGE(PG8_SA(0, 1), cA + hstep, voffA);
        if (wr == 1) PG8_BAR;
        PG8_WAIT_V(2); PG8_BAR;
        PG8_STAGE(PG8_SB(1, 0), cB + kstep, voffB); PG8_STAGE(PG8_SA(1, 0), cA + kstep, voffA); PG8_STAGE(PG8_SB(1, 1), cB + hstep + kstep, voffB);
        PG8_WAIT_V(6); PG8_BAR;
    } else {
        PG8_STAGE(PG8_SB(0, 0), cB, voffB); PG8_STAGE(PG8_SA(0, 0), cA, voffA); PG8_STAGE(PG8_SB(0, 1), cB + hstep, voffB); PG8_STAGE(PG8_SA(0, 1), cA + hstep, voffA);
        if (wr == 1) PG8_BAR;
        PG8_WAIT_V(4); PG8_BAR;
        PG8_STAGE(PG8_SB(1, 0), cB + kstep, voffB); PG8_STAGE(PG8_SA(1, 0), cA + kstep, voffA); PG8_STAGE(PG8_SB(1, 1), cB + hstep + kstep, voffB);
        PG8_WAIT_V(6); PG8_BAR;
    }
    for (;;) {
        const bool has_next = S.next(ui + 1, nxt);
        const char* nA = has_next ? (const char*)g.A + (size_t)nxt.pm * tstep : cA; const char* nB = has_next ? (const char*)g.Bt + (size_t)nxt.pn * tstep : cB;
        for (int t = 0; t < nt; t += 2) {
            const bool last = (t == nt - 2);
            const char* a1 = cA + (size_t)(t + 1) * kstep;
            const char* a2 = last ? nA : cA + (size_t)(t + 2) * kstep; const char* b2 = last ? nB : cB + (size_t)(t + 2) * kstep;
            const char* a3 = a2 + kstep; const char* b3 = b2 + kstep;
            if (last && has_next) S.a_ready(nxt);
            if constexpr (SP2) {
            PG8_LDB(B0, 0, 0); PG8_LDB(B1, 0, 1); PG8_SCHED; PG8_LDA(At, 0, 0); PG8_STAGE(PG8_SA(1, 1), a1 + hstep, voffA);
            PG8_WAIT_V(8); PG8_WAIT_L(0); PG8_BAR; PG8_MMA(0, 0, At, B0); PG8_MMA(0, 1, At, B1); PG8_BAR; PG8_SCHED;
            PG8_LDA(At, 0, 1); PG8_STAGE(PG8_SB(0, 0), b2, voffB); PG8_STAGE(PG8_SB(0, 1), b2 + hstep, voffB); PG8_STAGE(PG8_SA(0, 0), a2, voffA);
            PG8_WAIT_V(8); PG8_WAIT_L(0); PG8_BAR; PG8_MMA(1, 0, At, B0); PG8_MMA(1, 1, At, B1); PG8_BAR; PG8_SCHED;
            PG8_LDB(B0, 1, 0); PG8_LDB(B1, 1, 1); PG8_SCHED; PG8_LDA(At, 1, 0); PG8_STAGE(PG8_SA(0, 1), a2 + hstep, voffA);
            PG8_WAIT_V(8); PG8_WAIT_L(0); PG8_BAR; PG8_MMA(0, 0, At, B0); PG8_MMA(0, 1, At, B1); PG8_BAR; PG8_SCHED;
            PG8_LDA(At, 1, 1); PG8_STAGE(PG8_SB(1, 0), b3, voffB); PG8_STAGE(PG8_SB(1, 1), b3 + hstep, voffB); PG8_STAGE(PG8_SA(1, 0), a3, voffA);
            PG8_WAIT_V(8); PG8_WAIT_L(0); PG8_BAR; PG8_MMA(1, 0, At, B0); PG8_MMA(1, 1, At, B1); PG8_BAR; PG8_SCHED;
            } else {
            PG8_LDB(B0, 0, 0); PG8_SCHED; PG8_LDA(At, 0, 0); PG8_STAGE(PG8_SA(1, 1), a1 + hstep, voffA);
            PG8_WAIT_L(8); PG8_BAR; PG8_WAIT_L(0); PG8_MMA(0, 0, At, B0); PG8_BAR; PG8_SCHED;
            PG8_LDB(B1, 0, 1); PG8_STAGE(PG8_SB(0, 0), b2, voffB);
            PG8_BAR; PG8_WAIT_L(0); PG8_MMA(0, 1, At, B1); PG8_BAR;
            PG8_LDA(At, 0, 1); PG8_STAGE(PG8_SA(0, 0), a2, voffA);
            PG8_BAR; PG8_WAIT_L(0); PG8_MMA(1, 0, At, B0); PG8_BAR; PG8_SCHED;
            PG8_STAGE(PG8_SB(0, 1), b2 + hstep, voffB);
            PG8_WAIT_V(6); PG8_BAR; PG8_MMA(1, 1, At, B1); PG8_BAR;
            PG8_LDB(B0, 1, 0); PG8_SCHED; PG8_LDA(At, 1, 0); PG8_STAGE(PG8_SA(0, 1), a2 + hstep, voffA);
            PG8_WAIT_L(8); PG8_BAR; PG8_WAIT_L(0); PG8_MMA(0, 0, At, B0); PG8_BAR; PG8_SCHED;
            PG8_LDB(B1, 1, 1); PG8_STAGE(PG8_SB(1, 0), b3, voffB);
            PG8_BAR; PG8_WAIT_L(0); PG8_MMA(0, 1, At, B1); PG8_BAR;
            PG8_LDA(At, 1, 1); PG8_STAGE(PG8_SA(1, 0), a3, voffA);
            PG8_BAR; PG8_WAIT_L(0); PG8_MMA(1, 0, At, B0); PG8_BAR; PG8_SCHED;
            PG8_STAGE(PG8_SB(1, 1), b3 + hstep, voffB);
            PG8_WAIT_V(6); PG8_BAR; PG8_MMA(1, 1, At, B1); PG8_BAR;
            }
        }
        if constexpr (ALIGN_EPI) { if (wr == 0) PG8_BAR; }
        if constexpr (!Epi::AFTER_DRAIN) { E(acc, cur, wr, wc, fr, fq); S.done(cur); }
        if (!has_next) break;
#pragma unroll
        for (int a = 0; a < 2; ++a)
#pragma unroll
            for (int b = 0; b < 2; ++b)
#pragma unroll
                for (int m = 0; m < 4; ++m)
#pragma unroll
                    for (int n = 0; n < 2; ++n) acc[a][b][m][n] = (f32x4){0.f, 0.f, 0.f, 0.f};
        cur = nxt; cA = nA; cB = nB; ++ui;
        if constexpr (ALIGN_EPI) { if (wr == 1) PG8_BAR; }
    }
    PG8_WAIT_V(0);
    if constexpr (!ALIGN_EPI) { if (wr == 0) PG8_BAR; }
    PG8_BAR;
#undef PG8_SA
#undef PG8_SB
#undef PG8_STAGE
#undef PG8_LDA
#undef PG8_LDB
#undef PG8_MMA
#undef PG8_WAIT_V
#undef PG8_WAIT_L
#undef PG8_BAR
#undef PG8_SCHED
}
}

constexpr int NWAVES = 8;
#ifndef MK_N_LAUNCHES
#define MK_N_LAUNCHES 1
#endif
constexpr int N_LAUNCHES = MK_N_LAUNCHES;
constexpr int PER_PHASE = 6;
#ifndef PG8_SP2
#define PG8_SP2 true
#endif

constexpr size_t MiB = 1u << 20;
constexpr size_t WS_CTL = 0, CTL_ZERO_BYTES = 1 * MiB;
constexpr size_t WS_WIN = 2 * MiB;
constexpr size_t WS_WOUT = 6 * MiB;
constexpr size_t WS_WGU = 8 * MiB;
constexpr size_t WS_WDN = 20 * MiB;
constexpr size_t WS_XN = 32 * MiB;
constexpr size_t WS_QKVZ = 160 * MiB;
constexpr size_t WS_ACT = 416 * MiB;
constexpr size_t WS_XB = 768 * MiB;
constexpr size_t WS_END = 896 * MiB;
static_assert(WS_WGU + (size_t)NGU * D * 2 <= WS_WDN && WS_WDN + (size_t)D * FF * 2 <= WS_XN && WS_ACT + (size_t)M * FF * 2 <= WS_END, "d_ws map");
constexpr int CW_BAR = 4096;
constexpr int CW_SS = 65536;
static_assert((size_t)(CW_SS + 2 * M) * 4 <= CTL_ZERO_BYTES, "ss, rrow inside the control region");

constexpr int RING_OFF = 0, RING_BYTES = 131072;
constexpr int LDSCTL_OFF = 157696, MISC_OFF = LDSCTL_OFF + 320;
constexpr int LDS_GAIN_OFF = LDSCTL_OFF + 512;
constexpr int LDS_BYTES = 163840;

typedef GAS unsigned gu32;
#define RLX_AGENT __ATOMIC_RELAXED, __HIP_MEMORY_SCOPE_AGENT
#define LDS_WAIT() asm volatile("s_waitcnt lgkmcnt(0)" ::: "memory")
__device__ __forceinline__ unsigned f2bf(float f) { unsigned u = __builtin_bit_cast(unsigned, f); return (u + 0x7fffu + ((u >> 16) & 1u)) >> 16; }
__device__ __forceinline__ unsigned pk2(float lo, float hi) { return f2bf(lo) | (f2bf(hi) << 16); }
__device__ __forceinline__ float bflo(unsigned w) { return __builtin_bit_cast(float, w << 16); }
__device__ __forceinline__ float bfhi(unsigned w) { return __builtin_bit_cast(float, w & 0xffff0000u); }

#define XB_TMO      128
#define XB_XCNT(j)  (256  + 64 * (j))
#define XB_XSUB(j)  (1280 + 64 * (j))
#define XB_XGEN(j)  (2304 + 64 * (j))
#define XB_TOP      3328
#define XB_TOPGEN   3392
#define XCD_BAR_WORDS 3456
#define XB_SPIN_CAP (1u << 18)

__device__ __forceinline__ unsigned xb_ld(unsigned* p)              { return __hip_atomic_load(p, __ATOMIC_RELAXED, __HIP_MEMORY_SCOPE_AGENT); }
__device__ __forceinline__ unsigned xb_add(unsigned* p, unsigned v) { return __hip_atomic_fetch_add(p, v, __ATOMIC_RELAXED, __HIP_MEMORY_SCOPE_AGENT); }
__device__ __forceinline__ unsigned xb_xcc_id() { return (unsigned)__builtin_amdgcn_s_getreg((3 << 11) | 20) & 0xFu; }
#define XB_SPIN(cond, bar) do { unsigned _sp = 0; while (cond) { __builtin_amdgcn_s_sleep(1); \
    if ((++_sp & 255u) == 0u) { if (xb_ld(&(bar)[XB_TMO])) break; if (_sp > XB_SPIN_CAP) { atomicAdd(&(bar)[XB_TMO], 1u); break; } } } } while (0)

struct XcdBarrier { unsigned* bar; unsigned x; volatile LAS unsigned* st; };

__device__ __forceinline__ XcdBarrier xcd_barrier_post(unsigned* bar, volatile LAS unsigned* st) {
    XcdBarrier b; b.bar = bar; b.x = xb_xcc_id(); b.st = st;
    if (threadIdx.x == 0) (void)xb_add(&bar[XB_XCNT(b.x)], 1u);
    return b;
}
__device__ __forceinline__ void xcd_barrier_complete(unsigned* bar, unsigned x, unsigned& nloc, unsigned& nx) {
    const unsigned G = gridDim.x * gridDim.y * gridDim.z;
    unsigned sum, cnt, mine, sp = 0u;
    for (;;) {
        sum = 0u; cnt = 0u; mine = 0u;
#pragma unroll
        for (unsigned j = 0; j < 16; ++j) { const unsigned c = xb_ld(&bar[XB_XCNT(j)]); sum += c; cnt += (c > 0u) ? 1u : 0u; mine = (j == x) ? c : mine; }
        if (sum == G) break;
        __builtin_amdgcn_s_sleep(1);
        if ((++sp & 255u) == 0u) { if (xb_ld(&bar[XB_TMO])) break; if (sp > XB_SPIN_CAP) { atomicAdd(&bar[XB_TMO], 1u); break; } }
    }
    nloc = mine > 0u ? mine : 1u; nx = cnt > 0u ? cnt : 1u;
}
__device__ __forceinline__ void xcd_barrier(const XcdBarrier& b) {
    asm volatile("s_waitcnt vmcnt(0)" ::: "memory");
    __syncthreads();
    if (threadIdx.x == 0) {
        unsigned* bar = b.bar;
        __builtin_amdgcn_s_waitcnt(0);
        unsigned nloc = b.st[0], nx = b.st[1];
        if (nloc == 0u) { xcd_barrier_complete(bar, b.x, nloc, nx); b.st[0] = nloc; b.st[1] = nx; }
        const unsigned old = xb_add(&bar[XB_XSUB(b.x)], 1u);
        const unsigned gen = old / nloc;
        if (old + 1u == (gen + 1u) * nloc) {
            __builtin_amdgcn_fence(__ATOMIC_RELEASE, "agent");
            asm volatile("s_waitcnt vmcnt(0)" ::: "memory");
            const unsigned og = xb_add(&bar[XB_TOP], 1u);
            const unsigned tg = og / nx;
            if (og + 1u == (tg + 1u) * nx) xb_add(&bar[XB_TOPGEN], 1u);
            else XB_SPIN(xb_ld(&bar[XB_TOPGEN]) == tg, bar);
            __builtin_amdgcn_fence(__ATOMIC_ACQUIRE, "agent");
            xb_add(&bar[XB_XGEN(b.x)], 1u);
            asm volatile("s_waitcnt vmcnt(0)" ::: "memory");
        } else {
            XB_SPIN(xb_ld(&bar[XB_XGEN(b.x)]) == gen, bar);
            __builtin_amdgcn_fence(__ATOMIC_ACQUIRE, "agent");
            asm volatile("s_waitcnt vmcnt(0)" ::: "memory");
        }
    }
    __syncthreads();
}

struct Frame {
    LAS unsigned char* lds;
    volatile LAS unsigned* MISC;
    gu32* ctl;
    int tid, lane, wave;
    int vcu, G;
    const float *x, *g1, *w_in, *gq, *gk, *rpb, *w_pool, *pscale, *w_out, *g2, *w_gate, *w_up, *w_down;
    float* out;
    bf16_t *Win_t, *Wout_t, *Wgu_t, *Wdn_t;
    bf16_t *XN, *QKVZ, *XB, *ACT;
    float* ss; float* rrow; bf16_t* MIX;
};

__device__ __forceinline__ float wave_sum(float v) {
#pragma unroll
    for (int o = 1; o < 64; o <<= 1) v += __shfl_xor(v, o);
    return v;
}

__device__ __forceinline__ void p0_tile_out(bf16_t* WT, int K, int drow0, int k0, LAS float* scr, int lane) {
    LDS_WAIT(); asm volatile("" ::: "memory");
    const int c = lane & 7;
#pragma unroll
    for (int j = 0; j < 4; ++j) { const int n = (lane >> 3) + 8 * j; const LAS float* s = scr + (8 * c) * 33 + n;
        u32x4 o; o.x = pk2(s[0 * 33], s[1 * 33]); o.y = pk2(s[2 * 33], s[3 * 33]); o.z = pk2(s[4 * 33], s[5 * 33]); o.w = pk2(s[6 * 33], s[7 * 33]);
        *(GAS u32x4*)(WT + (size_t)(drow0 + n) * K + k0 + 8 * c) = o; }
    LDS_WAIT(); asm volatile("" ::: "memory");
}
__device__ __forceinline__ void p0_transpose_item(const float* W, int ldw, int K, int k0, int n0, const float* gkv, bf16_t* WT, int drow0, LAS float* scr, int lane) {
#pragma unroll
    for (int i = 0; i < 32; ++i) { const int kk = 2 * i + (lane >> 5); float v = W[(size_t)(k0 + kk) * ldw + n0 + (lane & 31)]; if (gkv) v *= gkv[k0 + kk]; scr[kk * 33 + (lane & 31)] = v; }
    p0_tile_out(WT, K, drow0, k0, scr, lane);
}
__device__ __forceinline__ void p0_fold_item(const float* w_in, const float* w_pool, const float* pscale, int k0, int n0z, bf16_t* WT, int drow0, int lane) {
    const int n = lane & 31, kh = lane >> 5, g = n0z >> 7, d = (n0z & 127) + n;
    float acc[4] = {0.f, 0.f, 0.f, 0.f};
    const float* wrow = w_in + (size_t)(k0 + 4 * kh) * NIN + 3 * NA + 128 * g;
    const float* wp = w_pool + (size_t)g * 128 * 128 + d;
#pragma unroll 8
    for (int c4 = 0; c4 < 32; ++c4) {
        const float p0 = wp[(4 * c4 + 0) * 128], p1 = wp[(4 * c4 + 1) * 128], p2 = wp[(4 * c4 + 2) * 128], p3 = wp[(4 * c4 + 3) * 128];
#pragma unroll
        for (int i = 0; i < 4; ++i) { const f32x4 w = *(const f32x4*)(wrow + (size_t)i * NIN + 4 * c4); acc[i] += (w[0] * p0 + w[1] * p1) + (w[2] * p2 + w[3] * p3); }
    }
    const float ps = pscale[n0z + n];
    float hi[4];
#pragma unroll
    for (int i = 0; i < 4; ++i) { acc[i] *= ps; hi[i] = __shfl(acc[i], (lane + 32) & 63); }
    if (lane < 32) { u32x4 o; o.x = pk2(acc[0], acc[1]); o.y = pk2(acc[2], acc[3]); o.z = pk2(hi[0], hi[1]); o.w = pk2(hi[2], hi[3]);
        *(GAS u32x4*)(WT + (size_t)(drow0 + n) * D + k0) = o; }
}
__device__ __forceinline__ int win_drow(int n0) { const int pn = n0 >> 8, c = n0 & 255; return 256 * pn + 128 * ((c >> 5) & 1) + 32 * (c >> 6); }

template <int R> __device__ __forceinline__ void rms_rows(const float* x, const f32x4 (&gg)[4], bf16_t* XN, float* rrow, int m0, int lane) {
    f32x4 v[R][4]; float s[R];
#pragma unroll
    for (int r = 0; r < R; ++r) { const GAS f32x4* xr = (const GAS f32x4*)(x + (size_t)(m0 + r) * D) + lane;
#pragma unroll
        for (int j = 0; j < 4; ++j) v[r][j] = xr[64 * j]; }
#pragma unroll
    for (int r = 0; r < R; ++r) { float a = 0.f;
#pragma unroll
        for (int j = 0; j < 4; ++j) a += (v[r][j].x * v[r][j].x + v[r][j].y * v[r][j].y) + (v[r][j].z * v[r][j].z + v[r][j].w * v[r][j].w);
        s[r] = a; }
#pragma unroll
    for (int o = 1; o < 64; o <<= 1) {
#pragma unroll
        for (int r = 0; r < R; ++r) s[r] += __shfl_xor(s[r], o); }
#pragma unroll
    for (int r = 0; r < R; ++r) { const float ms = s[r] * (1.f / D) + EPS, rstd = __builtin_amdgcn_rsqf(ms);
        if (lane == 0) rrow[m0 + r] = ms * rstd;
        GAS unsigned long long* o8 = (GAS unsigned long long*)(XN + (size_t)(m0 + r) * D) + lane;
#pragma unroll
        for (int j = 0; j < 4; ++j) o8[64 * j] = (unsigned long long)pk2(v[r][j].x * rstd * gg[j].x, v[r][j].y * rstd * gg[j].y) | ((unsigned long long)pk2(v[r][j].z * rstd * gg[j].z, v[r][j].w * rstd * gg[j].w) << 32); }
}

struct P0Item { const float* W; const float* gk; bf16_t* WT; int ldw, K, k0, n0, drow0; };
__device__ __forceinline__ void p0_prologue(Frame& F) {
    LAS float* scr = (LAS float*)(F.lds + RING_OFF + F.wave * 16384);
    const int gw = F.vcu * NWAVES + F.wave, NGW = F.G * NWAVES, lane = F.lane;
    constexpr int KB = D / 64;
    constexpr int I_QKV = KB * (3 * NA / 32), I_O = KB * (D / 32), I_G = KB * (FF / 32), I_DN = (FF / 64) * (D / 32);
    constexpr int NITEMS = I_QKV + I_O + 2 * I_G + I_DN;
    for (int it = gw; it < (D / 8) * (NA / 32); it += NGW) { const int nb = it & 15, kb = it >> 4; p0_fold_item(F.w_in, F.w_pool, F.pscale, 8 * kb, 32 * nb, F.Win_t, win_drow(3 * NA + 32 * nb), lane); }
    f32x4 gg[4];
#pragma unroll
    for (int j = 0; j < 4; ++j) gg[j] = *((const f32x4*)F.g1 + lane + 64 * j);
    const int RPW = (M + F.G - 1) / F.G, rbeg = F.vcu * RPW, rend = (rbeg + RPW) < M ? (rbeg + RPW) : M, nb8 = (rend - rbeg) / 8;
    volatile LAS unsigned* tick = F.MISC + 16;
    int it = gw; bool rows_left = true;
    while (it < NITEMS || rows_left) {
        const bool has_item = it < NITEMS; P0Item I{};
        if (has_item) {
            int r = it;
            if (r < I_QKV) { const int nb = r % (3 * NA / 32), kb = r / (3 * NA / 32); I = P0Item{F.w_in, nullptr, F.Win_t, NIN, D, 64 * kb, 32 * nb, win_drow(32 * nb)}; }
            else if ((r -= I_QKV) < I_O) { const int nb = r % (D / 32), kb = r / (D / 32); I = P0Item{F.w_out, nullptr, F.Wout_t, D, D, 64 * kb, 32 * nb, 32 * nb}; }
            else if ((r -= I_O) < 2 * I_G) { const int up = r >= I_G; if (up) r -= I_G; const int nb = r % (FF / 32), kb = r / (FF / 32), n0 = 32 * nb;
                I = P0Item{up ? F.w_up : F.w_gate, F.g2, F.Wgu_t, FF, D, 64 * kb, n0, 256 * (n0 >> 7) + (n0 & 127) + 128 * up}; }
            else { r -= 2 * I_G; const int nb = r % (D / 32), kb = r / (D / 32); I = P0Item{F.w_down, nullptr, F.Wdn_t, D, FF, 64 * kb, 32 * nb, 32 * nb}; }
        }
        float wv[32];
        if (has_item) {
#pragma unroll
            for (int i = 0; i < 32; ++i) { const int kk = 2 * i + (lane >> 5); wv[i] = I.W[(size_t)(I.k0 + kk) * I.ldw + I.n0 + (lane & 31)]; }
        }
        int m0 = 0;
        if (rows_left) { unsigned t = 0; if (lane == 0) t = __hip_atomic_fetch_add((LAS unsigned*)tick, 1u, __ATOMIC_RELAXED, __HIP_MEMORY_SCOPE_WORKGROUP);
            t = __builtin_amdgcn_readfirstlane(t); rows_left = (int)t < nb8; m0 = rbeg + 8 * (int)t; }
        f32x4 v[8][4];
        if (rows_left) {
#pragma unroll
            for (int r = 0; r < 8; ++r) { const GAS f32x4* xr = (const GAS f32x4*)(F.x + (size_t)(m0 + r) * D) + lane;
#pragma unroll
                for (int j = 0; j < 4; ++j) v[r][j] = xr[64 * j]; }
        }
        if (has_item) {
            if (I.gk) {
#pragma unroll
                for (int i = 0; i < 32; ++i) wv[i] *= I.gk[I.k0 + 2 * i + (lane >> 5)];
            }
#pragma unroll
            for (int i = 0; i < 32; ++i) scr[(2 * i + (lane >> 5)) * 33 + (lane & 31)] = wv[i];
            p0_tile_out(I.WT, I.K, I.drow0, I.k0, scr, lane);
        }
        if (rows_left) {
            float s[8];
#pragma unroll
            for (int r = 0; r < 8; ++r) { float a = 0.f;
#pragma unroll
                for (int j = 0; j < 4; ++j) a += (v[r][j].x * v[r][j].x + v[r][j].y * v[r][j].y) + (v[r][j].z * v[r][j].z + v[r][j].w * v[r][j].w);
                s[r] = a; }
#pragma unroll
            for (int o = 1; o < 64; o <<= 1) {
#pragma unroll
                for (int r = 0; r < 8; ++r) s[r] += __shfl_xor(s[r], o); }
#pragma unroll
            for (int r = 0; r < 8; ++r) { const float ms = s[r] * (1.f / D) + EPS, rstd = __builtin_amdgcn_rsqf(ms);
                if (lane == 0) F.rrow[m0 + r] = ms * rstd;
                GAS unsigned long long* o8 = (GAS unsigned long long*)(F.XN + (size_t)(m0 + r) * D) + lane;
#pragma unroll
                for (int j = 0; j < 4; ++j) o8[64 * j] = (unsigned long long)pk2(v[r][j].x * rstd * gg[j].x, v[r][j].y * rstd * gg[j].y) | ((unsigned long long)pk2(v[r][j].z * rstd * gg[j].z, v[r][j].w * rstd * gg[j].w) << 32); }
        }
        it += NGW;
    }
    if (F.wave == 0) for (int m = rbeg + 8 * nb8; m < rend; ++m) rms_rows<1>(F.x, gg, F.XN, F.rrow, m, lane);
}

constexpr int AT_IMG = 15 * 40 * 128;
constexpr int AT_A = 0;
constexpr int AT_B = AT_IMG;
constexpr int AT_TAB = 2 * AT_IMG;
static_assert(AT_TAB + 15 * 64 * 4 <= LDSCTL_OFF, "attention LDS map");
__device__ __forceinline__ int rs_of(int r) { int v = r - 4; v = v < 0 ? 0 : v; return v > 56 ? 56 : v; }

struct AttnUnit { int b, h, jh, r0, krow_lo, nrows; };
__device__ __forceinline__ AttnUnit attn_decode(int un) {
    AttnUnit u; const int bh = un >> 4, rc = (un >> 1) & 7; u.jh = un & 1; u.b = bh >> 3; u.h = bh & 7;
    u.r0 = 8 * rc; u.krow_lo = rs_of(u.r0); u.nrows = rs_of(u.r0 + 7) + 8 - u.krow_lo;
    return u;
}
__device__ __forceinline__ void glds16(const void* gsrc, unsigned lds_dst) { unsigned keep;
    asm volatile("s_mov_b32 %0, m0\n\ts_mov_b32 m0, %2\n\ts_nop 0\n\tglobal_load_lds_dwordx4 %1, off\n\ts_mov_b32 m0, %0" : "=&s"(keep) : "v"(gsrc), "s"(lds_dst) : "memory"); }
#define ATT_WAIT_BAR() do { asm volatile("s_waitcnt vmcnt(0) lgkmcnt(0)" ::: "memory"); __builtin_amdgcn_s_barrier(); asm volatile("" ::: "memory"); } while (0)
template <int KIND> __device__ __forceinline__ void attn_dma(unsigned dst, const bf16_t* src, const AttnUnit& u, int wid, int lane) {
    const int np = u.nrows * 5;
    const char* base = (const char*)(src + ((size_t)(u.b * NHEAD + u.h) * SEQ + u.krow_lo * 64 + 24 * u.jh) * HD);
#pragma unroll
    for (int it = 0; it < 10; ++it) {
        const int pi = it * 8 + wid;
        if (pi < np) {
            const int w = (pi * 205) >> 10, p = pi - 5 * w, c = 8 * p + (lane >> 3);
            const int sw = (KIND == 0) ? (((c >> 1) & 1) | (((c >> 3) & 3) << 1)) : ((((c >> 1) & 1) << 1) | (((c >> 3) & 1) << 2));
            const int ch = (lane & 7) ^ sw;
            const char* gp = base + (w * 64 + c) * (HD * 2) + ch * 16;
            glds16(gp, (unsigned)__builtin_amdgcn_readfirstlane(dst + pi * 1024));
        }
    }
}

__device__ __forceinline__ void p2_attention(Frame& F, const bf16_t* Qg, const bf16_t* Kg, const bf16_t* Vg, bf16_t* MIX) {
    const int lane = F.lane, wid = F.wave;
    LAS unsigned char* lds = F.lds;
    const unsigned lds0 = (unsigned)(size_t)F.lds;
    const int q = lane & 15, g = lane >> 4;
    constexpr int NUNITS = BATCH * NHEAD * 16, UW = 8;
    for (int uidx = F.vcu * UW; uidx < NUNITS; uidx += F.G * UW) {
        const int h = (uidx >> 4) & 7;
        __syncthreads();
        {   LAS float* tab = (LAS float*)(lds + AT_TAB);
            for (int i = F.tid; i < 15 * 64; i += NWAVES * 64) { const int rr = i >> 6, cc = (i & 63) - 16; tab[i] = (cc >= 0 && cc < 31) ? F.rpb[h * 465 + rr * 31 + cc] * LOG2E : 0.f; } }
        AttnUnit u = attn_decode(uidx);
        attn_dma<0>(lds0 + AT_A, Kg, u, wid, lane);
        bf16x8 qf[2][2];
#pragma unroll
        for (int jb = 0; jb < 2; ++jb) { const bf16_t* qp = Qg + ((size_t)(u.b * NHEAD + u.h) * SEQ + (u.r0 + wid) * 64 + 32 * u.jh + 16 * jb + q) * HD + 8 * g; qf[jb][0] = *(const bf16x8*)qp; qf[jb][1] = *(const bf16x8*)(qp + 32); }
        ATT_WAIT_BAR();
        for (int ui = 0; ui < UW; ++ui) {
            asm volatile("" : "+v"(qf[0][0]), "+v"(qf[0][1]), "+v"(qf[1][0]), "+v"(qf[1][1]));
            attn_dma<1>(lds0 + AT_B, Vg, u, wid, lane);
            const int r = u.r0 + wid, rs = rs_of(r), wbase = rs - u.krow_lo;
            u32x4 pw[2][8]; float il[2];
#pragma unroll
            for (int jb = 0; jb < 2; ++jb) {
                const int o = 8 * jb, kcol0 = 24 * u.jh + o, cq = 32 * u.jh + 16 * jb + q;
                int cs = cq - 8; cs = cs < 0 ? 0 : cs; cs = cs > 48 ? 48 : cs;
                f32x4 sc[8][2];
                {
                    const int fk = ((q >> 1) & 1) | (((jb + (q >> 2)) & 3) << 1), x0 = g ^ fk;
                    const LAS unsigned char* ka = lds + AT_A + (wbase * 40 + o + 8 * (q >> 2) + (q & 3)) * 128;
                    const LAS unsigned char* k0p = ka + x0 * 16;
                    const LAS unsigned char* k1p = ka + (x0 ^ 4) * 16;
#pragma unroll
                    for (int wl = 0; wl < 8; ++wl)
#pragma unroll
                        for (int blk = 0; blk < 2; ++blk) {
                            const bf16x8 k0 = *(const LAS bf16x8*)(k0p + wl * 5120 + blk * 512), k1 = *(const LAS bf16x8*)(k1p + wl * 5120 + blk * 512);
                            f32x4 a = (f32x4){0.f, 0.f, 0.f, 0.f};
                            a = __builtin_amdgcn_mfma_f32_16x16x32_bf16(k0, qf[jb][0], a, 0, 0, 0);
                            a = __builtin_amdgcn_mfma_f32_16x16x32_bf16(k1, qf[jb][1], a, 0, 0, 0);
                            sc[wl][blk] = a;
                        }
                }
                const LAS float* tab = (const LAS float*)(lds + AT_TAB) + (rs - r + 7) * 64 + 16 + (kcol0 - cq + 15) + 8 * g;
                const int voff = kcol0 + 8 * g - cs;
                float mx = -INFINITY;
#pragma unroll
                for (int wl = 0; wl < 8; ++wl)
#pragma unroll
                    for (int blk = 0; blk < 2; ++blk)
#pragma unroll
                        for (int e = 0; e < 4; ++e) {
                            const int ep = 4 * blk + e;
                            float s_ = sc[wl][blk][e] + tab[wl * 64 + ep];
                            s_ = ((unsigned)(voff + ep) < 16u) ? s_ : -INFINITY;
                            sc[wl][blk][e] = s_; mx = fmaxf(mx, s_);
                        }
                mx = fmaxf(mx, __shfl_xor(mx, 16)); mx = fmaxf(mx, __shfl_xor(mx, 32));
                float l = 0.f;
#pragma unroll
                for (int wl = 0; wl < 8; ++wl) {
                    float p[8];
#pragma unroll
                    for (int blk = 0; blk < 2; ++blk)
#pragma unroll
                        for (int e = 0; e < 4; ++e) { p[4 * blk + e] = __builtin_amdgcn_exp2f(sc[wl][blk][e] - mx); l += p[4 * blk + e]; }
                    pw[jb][wl].x = cvt_pk_bf16(p[0], p[1]); pw[jb][wl].y = cvt_pk_bf16(p[2], p[3]); pw[jb][wl].z = cvt_pk_bf16(p[4], p[5]); pw[jb][wl].w = cvt_pk_bf16(p[6], p[7]);
                }
                l += __shfl_xor(l, 16); l += __shfl_xor(l, 32);
                il[jb] = __builtin_amdgcn_rcpf(l);
            }
            ATT_WAIT_BAR();
            AttnUnit un = u; bf16x8 nq[2][2];
#pragma unroll
            for (int jb = 0; jb < 2; ++jb) { nq[jb][0] = qf[jb][0]; nq[jb][1] = qf[jb][1]; }
            if (ui < UW - 1) {
                un = attn_decode(uidx + ui + 1);
                attn_dma<0>(lds0 + AT_A, Kg, un, wid, lane);
#pragma unroll
                for (int jb = 0; jb < 2; ++jb) { const bf16_t* qp = Qg + ((size_t)(un.b * NHEAD + un.h) * SEQ + (un.r0 + wid) * 64 + 32 * un.jh + 16 * jb + q) * HD + 8 * g; nq[jb][0] = *(const bf16x8*)qp; nq[jb][1] = *(const bf16x8*)(qp + 32); }
            }
#pragma unroll
            for (int jb = 0; jb < 2; ++jb) {
                const int o = 8 * jb, cq = 32 * u.jh + 16 * jb + q;
                f32x4 ov[4];
#pragma unroll
                for (int n = 0; n < 4; ++n) ov[n] = (f32x4){0.f, 0.f, 0.f, 0.f};
                {
                    const int qr = q >> 2, p = lane & 3;
                    const int fv = (((qr >> 1) & 1) << 1) | (((jb + g) & 1) << 2);
                    const LAS unsigned char* vb = lds + AT_B + (wbase * 40 + o + 8 * g + qr) * 128 + (p >> 1) * 16 + (p & 1) * 8;
                    const LAS unsigned char* vn[4];
#pragma unroll
                    for (int n = 0; n < 4; ++n) vn[n] = vb + ((2 * n) ^ fv) * 16;
#pragma unroll
                    for (int wl = 0; wl < 8; ++wl) {
                        const bf16x8 pf = __builtin_bit_cast(bf16x8, pw[jb][wl]);
#pragma unroll
                        for (int n = 0; n < 4; ++n) {
                            const s16x4 lo = __builtin_bit_cast(s16x4, __builtin_amdgcn_ds_read_tr16_b64_v4i16((LAS s16x4*)(vn[n] + wl * 5120)));
                            const s16x4 hi = __builtin_bit_cast(s16x4, __builtin_amdgcn_ds_read_tr16_b64_v4i16((LAS s16x4*)(vn[n] + wl * 5120 + 512)));
                            const bf16x8 vf = (bf16x8){lo[0], lo[1], lo[2], lo[3], hi[0], hi[1], hi[2], hi[3]};
                            ov[n] = __builtin_amdgcn_mfma_f32_16x16x32_bf16(vf, pf, ov[n], 0, 0, 0);
                        }
                    }
                }
                bf16_t* op = MIX + ((size_t)(u.b * SEQ + r * 64 + cq)) * D + u.h * HD + 4 * g;
#pragma unroll
                for (int n = 0; n < 4; ++n) { u32x2 w; w.x = cvt_pk_bf16(ov[n][0] * il[jb], ov[n][1] * il[jb]); w.y = cvt_pk_bf16(ov[n][2] * il[jb], ov[n][3] * il[jb]); *(u32x2*)(op + 16 * n) = w; }
            }
            ATT_WAIT_BAR();
            u = un;
#pragma unroll
            for (int jb = 0; jb < 2; ++jb) { qf[jb][0] = nq[jb][0]; qf[jb][1] = nq[jb][1]; }
        }
    }
}

__device__ __forceinline__ void up8(const u32x4 w, float (&v)[8]) {
    v[0] = bflo(w.x); v[1] = bfhi(w.x); v[2] = bflo(w.y); v[3] = bfhi(w.y); v[4] = bflo(w.z); v[5] = bfhi(w.z); v[6] = bflo(w.w); v[7] = bfhi(w.w);
}
__device__ __forceinline__ void pool_run(const bf16_t* __restrict__ Zg, bf16_t* __restrict__ MIX, int gw, int lane) {
    const int tb = 32 * gw, b = tb >> 12, t0 = tb & (SEQ - 1);
    const int half = 1 << (lane >> 4);
    const bf16_t* zb = Zg + (size_t)(b * SEQ) * NA + 8 * lane;
    bf16_t* ob = MIX + (size_t)(b * SEQ) * D + NA + 8 * lane;
    float S[8];
#pragma unroll
    for (int e = 0; e < 8; ++e) S[e] = 0.f;
    {   u32x4 w[16];
#pragma unroll
        for (int d = 0; d < 16; ++d) { int i = t0 + d - 8; i = i < 0 ? 0 : i; i = i > SEQ - 1 ? SEQ - 1 : i; w[d] = *(const u32x4*)(zb + (size_t)i * NA); }
#pragma unroll
        for (int d = 0; d < 16; ++d) { const int dd = d - 8, i = t0 + dd; const float mk = (dd >= -half && dd < half && i >= 0 && i < SEQ) ? 1.f : 0.f; float v[8]; up8(w[d], v);
#pragma unroll
            for (int e = 0; e < 8; ++e) S[e] += mk * v[e]; } }
    for (int c = 0; c < 4; ++c) {
        u32x4 zt[8], za[8], zs[8];
#pragma unroll
        for (int k = 0; k < 8; ++k) { const int t = t0 + 8 * c + k; int ia = t + half, is = t - half; ia = ia > SEQ - 1 ? SEQ - 1 : ia; is = is < 0 ? 0 : is;
            zt[k] = *(const u32x4*)(zb + (size_t)t * NA); za[k] = *(const u32x4*)(zb + (size_t)ia * NA); zs[k] = *(const u32x4*)(zb + (size_t)is * NA); }
#pragma unroll
        for (int k = 0; k < 8; ++k) { const int t = t0 + 8 * c + k;
            const int lo = (t - half) < 0 ? 0 : (t - half), hi = (t + half) > SEQ ? SEQ : (t + half);
            const float inv = 1.0f / (float)(hi - lo);
            float v[8]; up8(zt[k], v);
            u32x4 w;
            w.x = cvt_pk_bf16(S[0] * inv - v[0], S[1] * inv - v[1]); w.y = cvt_pk_bf16(S[2] * inv - v[2], S[3] * inv - v[3]);
            w.z = cvt_pk_bf16(S[4] * inv - v[4], S[5] * inv - v[5]); w.w = cvt_pk_bf16(S[6] * inv - v[6], S[7] * inv - v[7]);
            *(u32x4*)(ob + (size_t)t * D) = w;
            const float ma = (t + half < SEQ) ? 1.f : 0.f, ms = (t - half >= 0) ? 1.f : 0.f;
            float a[8], s[8]; up8(za[k], a); up8(zs[k], s);
#pragma unroll
            for (int e = 0; e < 8; ++e) S[e] += ma * a[e] - ms * s[e]; }
    }
}

__device__ __forceinline__ void p2_mixer(Frame& F) {
    const bf16_t* Qg = F.QKVZ; const bf16_t* Kg = F.QKVZ + (size_t)M * NA; const bf16_t* Vg = F.QKVZ + 2 * (size_t)M * NA; const bf16_t* Zg = F.QKVZ + 3 * (size_t)M * NA;
    bf16_t* MIX = F.MIX;
    for (int gw = F.vcu * NWAVES + F.wave; gw < M / 32; gw += F.G * NWAVES) pool_run(Zg, MIX, gw, F.lane);
    p2_attention(F, Qg, Kg, Vg, MIX);
    __syncthreads();
}

struct Args { const float* in[13]; float* out; unsigned char* ws; int ph_lo, ph_hi, li, pad; };
__global__ void __launch_bounds__(NWAVES * 64, 2) fwd_megakernel(Args args) {
    extern __shared__ __attribute__((aligned(16))) unsigned char lds[];
    Frame F;
    F.lds = (LAS unsigned char*)lds;
    F.MISC = (volatile LAS unsigned*)(F.lds + MISC_OFF);
    F.tid = threadIdx.x; F.lane = F.tid & 63; F.wave = __builtin_amdgcn_readfirstlane(F.tid >> 6);
    F.G = gridDim.x; { const int bx = blockIdx.x; F.vcu = (F.G % 8 == 0) ? (bx % 8) * (F.G / 8) + bx / 8 : bx; }
    unsigned char* ws = args.ws;
    F.ctl = (gu32*)(ws + WS_CTL);
    F.x = args.in[0]; F.g1 = args.in[1]; F.w_in = args.in[2]; F.gq = args.in[3]; F.gk = args.in[4]; F.rpb = args.in[5]; F.w_pool = args.in[6];
    F.pscale = args.in[7]; F.w_out = args.in[8]; F.g2 = args.in[9]; F.w_gate = args.in[10]; F.w_up = args.in[11]; F.w_down = args.in[12]; F.out = args.out;
    F.Win_t = (bf16_t*)(ws + WS_WIN); F.Wout_t = (bf16_t*)(ws + WS_WOUT); F.Wgu_t = (bf16_t*)(ws + WS_WGU); F.Wdn_t = (bf16_t*)(ws + WS_WDN);
    F.XN = (bf16_t*)(ws + WS_XN); F.QKVZ = (bf16_t*)(ws + WS_QKVZ); F.XB = (bf16_t*)(ws + WS_XB); F.ACT = (bf16_t*)(ws + WS_ACT);
    F.ss = (float*)(ws + WS_CTL) + CW_SS; F.rrow = (float*)(ws + WS_CTL) + CW_SS + M; F.MIX = (bf16_t*)(ws + WS_ACT);
    for (int u = F.tid; u < (LDS_BYTES - LDSCTL_OFF) / 4; u += NWAVES * 64) ((LAS unsigned*)(F.lds + LDSCTL_OFF))[u] = 0u;
    __syncthreads();
    XcdBarrier bar; bar.bar = (unsigned*)(F.ctl + CW_BAR); bar.x = 0; bar.st = nullptr;
    if (N_LAUNCHES != PER_PHASE) bar = xcd_barrier_post((unsigned*)(F.ctl + CW_BAR), F.MISC + 8);
#define GRID_BAR() do { if (N_LAUNCHES != PER_PHASE) xcd_barrier(bar); } while (0)
    const int lo = args.ph_lo, hi = args.ph_hi;
#define IN(k) (lo <= (k) && (k) < hi)
#define BOTH(k) (IN(k) && IN((k) + 1))

    if (IN(0)) { p0_prologue(F); if (BOTH(0)) GRID_BAR(); }

    if (IN(1)) {
        pg8::Gemm g{F.XN, F.Win_t, M, NIN, D}; pg8::StaticOrder S; S.init(M, NIN, F.G, (int)blockIdx.x);
        { LAS float* gl = (LAS float*)(F.lds + LDS_GAIN_OFF);
          if (F.tid < 64) gl[F.tid] = F.gq[F.tid] * (0.125f * LOG2E); else if (F.tid < 128) gl[F.tid] = F.gk[F.tid - 64];
          __syncthreads(); }
        pg8::EpiIn E{F.QKVZ, (const LAS float*)(F.lds + LDS_GAIN_OFF)};
        pg8::gemm_phase<pg8::EpiIn, pg8::StaticOrder, true, PG8_SP2>(F.lds + RING_OFF, g, S, E);
        if (BOTH(1)) GRID_BAR();
    }

    if (IN(2)) { p2_mixer(F); if (BOTH(2)) GRID_BAR(); }

    if (IN(3)) {
        pg8::Gemm g{F.MIX, F.Wout_t, M, D, D}; pg8::StaticOrder S; S.init(M, D, F.G, (int)blockIdx.x);
        pg8::EpiOut E{F.XN, F.rrow, F.g1, F.XB, F.ss};
        pg8::gemm_phase<pg8::EpiOut, pg8::StaticOrder, true, PG8_SP2>(F.lds + RING_OFF, g, S, E);
        if (BOTH(3)) GRID_BAR();
    }

    if (IN(4)) {
        pg8::Gemm g{F.XB, F.Wgu_t, M, NGU, D}; pg8::RevOrder S; S.init(M, NGU, F.G, (int)blockIdx.x);
        pg8::EpiGU E{F.ACT, F.ss};
        pg8::gemm_phase<pg8::EpiGU, pg8::RevOrder, true, PG8_SP2>(F.lds + RING_OFF, g, S, E);
        if (BOTH(4)) GRID_BAR();
    }

    if (IN(5)) {
        pg8::Gemm g{F.ACT, F.Wdn_t, M, D, FF}; pg8::StaticOrder S; S.init(M, D, F.G, (int)blockIdx.x);
        pg8::EpiDown E{F.XB, F.out};
        pg8::gemm_phase<pg8::EpiDown, pg8::StaticOrder, true, PG8_SP2>(F.lds + RING_OFF, g, S, E);
    }
#undef IN
#undef BOTH
#undef GRID_BAR
}

extern "C" void kernel_launch(void* const* d_in, const int* in_sizes, int n_in, void* d_out, int out_size, void* d_ws, size_t ws_size, hipStream_t stream) {
    static int grid = 0;
    if (grid == 0) {
        if (n_in != 13 || in_sizes[0] != M * D || out_size != M * D || ws_size < WS_END) { fprintf(stderr, "kernel_launch: unexpected shapes (n_in %d, in0 %d, out %d, ws %zu); nothing launched\n", n_in, n_in > 0 ? in_sizes[0] : -1, out_size, ws_size); grid = -1; return; }
        int dev = 0, cus = 0, per_cu = 0;
        if (hipGetDevice(&dev) != hipSuccess || hipDeviceGetAttribute(&cus, hipDeviceAttributeMultiprocessorCount, dev) != hipSuccess) { fprintf(stderr, "kernel_launch: device query failed\n"); grid = -1; return; }
        if (hipFuncSetAttribute((const void*)fwd_megakernel, hipFuncAttributeMaxDynamicSharedMemorySize, LDS_BYTES) != hipSuccess) { fprintf(stderr, "kernel_launch: hipFuncSetAttribute failed\n"); grid = -1; return; }
        if (hipOccupancyMaxActiveBlocksPerMultiprocessor(&per_cu, (const void*)fwd_megakernel, NWAVES * 64, LDS_BYTES) != hipSuccess || per_cu < 1) {
            fprintf(stderr, "kernel_launch: occupancy query reports %d workgroups per CU; nothing launched\n", per_cu); (void)hipGetLastError(); grid = -1; return; }
        (void)hipGetLastError();
        grid = cus;
    }
    if (grid < 0) return;
    if (hipMemsetAsync((char*)d_ws + WS_CTL, 0, CTL_ZERO_BYTES, stream) != hipSuccess) { fprintf(stderr, "kernel_launch: hipMemsetAsync failed\n"); return; }
    Args a{};
    for (int i = 0; i < 13; ++i) a.in[i] = (const float*)d_in[i];
    a.out = (float*)d_out; a.ws = (unsigned char*)d_ws;
    for (int li = 0; li < N_LAUNCHES; ++li) {
        a.ph_lo = (N_LAUNCHES == PER_PHASE) ? li : 0; a.ph_hi = (N_LAUNCHES == PER_PHASE) ? li + 1 : PER_PHASE; a.li = li;
        hipLaunchKernelGGL(fwd_megakernel, dim3(grid), dim3(NWAVES * 64), LDS_BYTES, stream, a);
        const hipError_t le = hipPeekAtLastError();
        if (le != hipSuccess) { fprintf(stderr, "kernel_launch: launch %d failed: %s\n", li, hipGetErrorName(le)); break; }
    }
}
```

```cpp
#include <hip/hip_runtime.h>
#include <cstdio>
#include <cstdint>

#define LAS __attribute__((address_space(3)))
#define GAS __attribute__((address_space(1)))
typedef unsigned short bf16_t;
typedef short bf16x8 __attribute__((ext_vector_type(8)));
typedef short s16x4 __attribute__((ext_vector_type(4)));
typedef float f32x4 __attribute__((ext_vector_type(4)));
typedef float f32x2 __attribute__((ext_vector_type(2)));
typedef unsigned u32x4 __attribute__((ext_vector_type(4)));
typedef unsigned u32x2 __attribute__((ext_vector_type(2)));

constexpr int BATCH = 16, SEQ = 4096, D = 1024, M = BATCH * SEQ;
constexpr int NA = 512, NHEAD = 8, HD = 64, NIN = 2048, FF = 2816, NGU = 2 * FF;
constexpr float EPS = 1e-6f;
constexpr float LOG2E = 1.4426950408889634f;

__host__ __device__ __forceinline__ size_t tl_off(int row, int k, int K) { return ((((size_t)(row >> 4) * (size_t)(K >> 5)) + (size_t)(k >> 5)) << 9) + (size_t)((row & 15) * 32 + (k & 31)); }

__device__ __forceinline__ unsigned cvt_pk_bf16(float lo, float hi) { unsigned r; asm volatile("v_cvt_pk_bf16_f32 %0, %1, %2" : "=v"(r) : "v"(lo), "v"(hi)); return r; }

namespace pg8 {
constexpr int BM = 256, BK = 64, HALF = 128, HTB = HALF * BK * 2, STAGE_BYTES = 8 * HTB, NXCD = 8, WGM = 8;

__host__ __device__ __forceinline__ int lds_byte(int r, int c) { const int st = (r >> 4) * 2 + (c >> 5), rr = r & 15, cc = c & 31, ob = rr * 64 + cc * 2; return st * 1024 + (ob ^ (((ob >> 9) & 1) << 5)); }
__host__ __device__ __forceinline__ void stage_rc(int b, int& R, int& C) { const int st = b / 1024, sb = b % 1024, swz = sb ^ (((sb >> 9) & 1) << 5); R = (st >> 1) * 16 + swz / 64; C = (st & 1) * 32 + (swz % 64) / 2; }
__host__ __device__ __forceinline__ int perm32(int rho) { const int n = rho >> 4, i = rho & 15; return 8 * (i >> 2) + 4 * n + (i & 3); }

struct Unit { int pm, pn; };
struct Gemm { const bf16_t* A; const bf16_t* Bt; int M, N, K; };

struct StaticOrder {
    int nM, nN, nwg, G, c;
    __host__ __device__ void init(int M_, int N_, int G_, int c_) { nM = M_ / BM; nN = N_ / BM; nwg = nM * nN; G = G_; c = c_; }
    __host__ __device__ bool next(int i, Unit& u) const {
        const long L = (long)i * G + c; if (L >= nwg) return false;
        int wgid = (int)L; { const int q = nwg / NXCD, r = nwg % NXCD, xcd = wgid % NXCD, off = wgid / NXCD; wgid = (xcd < r ? xcd * (q + 1) : r * (q + 1) + (xcd - r) * q) + off; }
        const int nig = WGM * nN, gid = wgid / nig, fm = gid * WGM, gsz = (nM - fm) < WGM ? (nM - fm) : WGM;
        u.pm = fm + ((wgid % nig) % gsz); u.pn = (wgid % nig) / gsz; return true;
    }
    __device__ __forceinline__ void a_ready(const Unit&) const {}
    __device__ __forceinline__ void done(const Unit&) const {}
};

struct RevOrder : StaticOrder {
    __host__ __device__ bool next(int i, Unit& u) const { const bool ok = StaticOrder::next(i, u); if (ok) u.pm = nM - 1 - u.pm; return ok; }
};


struct EpiIn {
    static constexpr bool PERM = true, AFTER_DRAIN = false;
    bf16_t* QKVZ; const LAS float* gl;
    __device__ __forceinline__ void operator()(const f32x4 (&acc)[2][2][4][2], const Unit& u, int wr, int wc, int fr, int fq) const {
        const int kind = u.pn >> 1;
        const int row0 = u.pm * BM + wr * 64 + fr;
        const int head = 4 * (u.pn & 1) + wc; const size_t rstride = kind < 3 ? HD : NA;
        bf16_t* base = QKVZ + (size_t)kind * ((size_t)M * NA) + 8 * fq
                     + (kind < 3 ? ((size_t)((row0 >> 12) * NHEAD + head) * SEQ + (row0 & (SEQ - 1))) * HD : (size_t)row0 * NA + head * HD);
        if (kind < 2) {
            const LAS float* g = gl + 64 * kind + 8 * fq;
            f32x4 gv[2][2];
#pragma unroll
            for (int bj = 0; bj < 2; ++bj)
#pragma unroll
                for (int n = 0; n < 2; ++n) gv[bj][n] = *(const LAS f32x4*)(g + 32 * bj + 4 * n);
            float ss[8];
#pragma unroll
            for (int i = 0; i < 8; ++i) { const int ai = i >> 2, m = i & 3; float a = 0.f;
#pragma unroll
                for (int bj = 0; bj < 2; ++bj)
#pragma unroll
                    for (int n = 0; n < 2; ++n) { const f32x4 v = acc[ai][bj][m][n]; a += (v[0] * v[0] + v[1] * v[1]) + (v[2] * v[2] + v[3] * v[3]); }
                ss[i] = a; }
#pragma unroll
            for (int i = 0; i < 8; ++i) ss[i] += __shfl_xor(ss[i], 16);
#pragma unroll
            for (int i = 0; i < 8; ++i) ss[i] += __shfl_xor(ss[i], 32);
#pragma unroll
            for (int i = 0; i < 8; ++i) { const int ai = i >> 2, m = i & 3;
                bf16_t* rowp = base + (size_t)(ai * HALF + m * 16) * rstride;
                const float r = __builtin_amdgcn_rsqf(ss[i] * (1.0f / 64.0f) + EPS);
#pragma unroll
                for (int bj = 0; bj < 2; ++bj) {
                    const f32x4 v0 = acc[ai][bj][m][0] * r * gv[bj][0], v1 = acc[ai][bj][m][1] * r * gv[bj][1];
                    u32x4 w; w.x = cvt_pk_bf16(v0[0], v0[1]); w.y = cvt_pk_bf16(v0[2], v0[3]); w.z = cvt_pk_bf16(v1[0], v1[1]); w.w = cvt_pk_bf16(v1[2], v1[3]);
                    *(u32x4*)(rowp + bj * 32) = w; }
            }
        } else {
#pragma unroll
            for (int ai = 0; ai < 2; ++ai)
#pragma unroll
                for (int m = 0; m < 4; ++m) {
                    bf16_t* rowp = base + (size_t)(ai * HALF + m * 16) * rstride;
#pragma unroll
                    for (int bj = 0; bj < 2; ++bj) {
                        const f32x4 v0 = acc[ai][bj][m][0], v1 = acc[ai][bj][m][1];
                        u32x4 w; w.x = cvt_pk_bf16(v0[0], v0[1]); w.y = cvt_pk_bf16(v0[2], v0[3]); w.z = cvt_pk_bf16(v1[0], v1[1]); w.w = cvt_pk_bf16(v1[2], v1[3]);
                        *(u32x4*)(rowp + bj * 32) = w; }
                }
        }
    }
};

struct EpiOut {
    static constexpr bool PERM = true, AFTER_DRAIN = false;
    const bf16_t* XN; const float* rrow; const float* g1; bf16_t* XB; float* ss;
    __device__ __forceinline__ void operator()(const f32x4 (&acc)[2][2][4][2], const Unit& u, int wr, int wc, int fr, int fq) const {
        const int row0 = u.pm * BM + wr * 64 + fr, col0 = u.pn * BM + wc * 32 + 8 * fq;
        const size_t off0 = (size_t)row0 * D + col0;
        const bf16_t* __restrict__ xp = XN + tl_off(row0, col0, D); bf16_t* __restrict__ bp = XB + tl_off(row0, col0, D);
        f32x4 gi[2][2];
#pragma unroll
        for (int bj = 0; bj < 2; ++bj)
#pragma unroll
            for (int n = 0; n < 2; ++n) { const f32x4 gv = *(const f32x4*)(g1 + col0 + bj * HALF + 4 * n);
                gi[bj][n] = (f32x4){__builtin_amdgcn_rcpf(gv[0]), __builtin_amdgcn_rcpf(gv[1]), __builtin_amdgcn_rcpf(gv[2]), __builtin_amdgcn_rcpf(gv[3])}; }
        u32x4 xa[8][2]; float rr[8], part[8];
#pragma unroll
        for (int i = 0; i < 8; ++i) rr[i] = rrow[row0 + (i >> 2) * HALF + (i & 3) * 16];
#define EO_LOAD(i) do { const size_t o_ = (size_t)((((i) >> 2) * 8 + ((i) & 3)) * (D / 32)) * 512; xa[i][0] = *(const u32x4*)(xp + o_); xa[i][1] = *(const u32x4*)(xp + o_ + 4 * 512); } while (0)
        EO_LOAD(0); EO_LOAD(1); EO_LOAD(2); EO_LOAD(3);
        asm volatile("" ::: "memory");
#pragma unroll
        for (int i = 0; i < 8; ++i) { const int ai = i >> 2, m = i & 3; const size_t o_ = (size_t)(ai * HALF + m * 16) * D; float p = 0.f;
#pragma unroll
            for (int bj = 0; bj < 2; ++bj) { const u32x4 w_ = xa[i][bj];
                const f32x4 x0 = {__builtin_bit_cast(float, w_.x << 16), __builtin_bit_cast(float, w_.x & 0xffff0000u), __builtin_bit_cast(float, w_.y << 16), __builtin_bit_cast(float, w_.y & 0xffff0000u)};
                const f32x4 x1 = {__builtin_bit_cast(float, w_.z << 16), __builtin_bit_cast(float, w_.z & 0xffff0000u), __builtin_bit_cast(float, w_.w << 16), __builtin_bit_cast(float, w_.w & 0xffff0000u)};
                const f32x4 v0 = acc[ai][bj][m][0] + x0 * (gi[bj][0] * rr[i]), v1 = acc[ai][bj][m][1] + x1 * (gi[bj][1] * rr[i]);
                u32x4 w; w.x = cvt_pk_bf16(v0[0], v0[1]); w.y = cvt_pk_bf16(v0[2], v0[3]); w.z = cvt_pk_bf16(v1[0], v1[1]); w.w = cvt_pk_bf16(v1[2], v1[3]);
                *(u32x4*)(bp + (size_t)((ai * 8 + m) * (D / 32) + 4 * bj) * 512) = w;
                p += (v0[0] * v0[0] + v0[1] * v0[1]) + (v0[2] * v0[2] + v0[3] * v0[3]) + (v1[0] * v1[0] + v1[1] * v1[1]) + (v1[2] * v1[2] + v1[3] * v1[3]); }
            part[i] = p;
            if (i + 4 < 8) { EO_LOAD((i + 4) & 7); }
            asm volatile("" ::: "memory"); }
#undef EO_LOAD
#pragma unroll
        for (int i = 0; i < 8; ++i) part[i] += __shfl_xor(part[i], 16);
#pragma unroll
        for (int i = 0; i < 8; ++i) part[i] += __shfl_xor(part[i], 32);
        if (fq == 0) {
#pragma unroll
            for (int i = 0; i < 8; ++i) atomicAdd(ss + row0 + (i >> 2) * HALF + (i & 3) * 16, part[i]);
        }
    }
};

struct EpiGU {
    static constexpr bool PERM = true, AFTER_DRAIN = false;
    bf16_t* ACT; const float* ss;
    __device__ __forceinline__ void operator()(const f32x4 (&acc)[2][2][4][2], const Unit& u, int wr, int wc, int fr, int fq) const {
        const int row0 = u.pm * BM + wr * 64 + fr, col0 = u.pn * HALF + wc * 32 + 8 * fq;
        float sv[8];
#pragma unroll
        for (int i = 0; i < 8; ++i) sv[i] = ss[row0 + (i >> 2) * HALF + (i & 3) * 16];
        asm volatile("" ::: "memory");
#pragma unroll
        for (int i = 0; i < 8; ++i) { const int ai = i >> 2, m = i & 3;
            const float rstd = __builtin_amdgcn_rsqf(sv[i] * (1.0f / (float)D) + EPS), ne = -LOG2E * rstd, r2 = rstd * rstd;
            unsigned w[4];
#pragma unroll
            for (int n = 0; n < 2; ++n)
#pragma unroll
                for (int h = 0; h < 2; ++h) {
                    const f32x2 g = {acc[ai][0][m][n][2 * h], acc[ai][0][m][n][2 * h + 1]}, up = {acc[ai][1][m][n][2 * h], acc[ai][1][m][n][2 * h + 1]};
                    const f32x2 t = g * ne; f32x2 e; e.x = __builtin_amdgcn_exp2f(t.x); e.y = __builtin_amdgcn_exp2f(t.y);
                    const f32x2 d = e + 1.0f; f32x2 r; r.x = __builtin_amdgcn_rcpf(d.x); r.y = __builtin_amdgcn_rcpf(d.y);
                    const f32x2 a = (g * up) * (r * r2);
                    w[2 * n + h] = cvt_pk_bf16(a.x, a.y); }
            *(u32x4*)(ACT + tl_off(row0 + ai * HALF + m * 16, col0, FF)) = (u32x4){w[0], w[1], w[2], w[3]};
        }
    }
};

struct EpiDown {
    static constexpr bool PERM = true, AFTER_DRAIN = false;
    const bf16_t* XB; float* out;
    __device__ __forceinline__ void operator()(const f32x4 (&acc)[2][2][4][2], const Unit& u, int wr, int wc, int fr, int fq) const {
        const int row0 = u.pm * BM + wr * 64 + fr, col0 = u.pn * BM + wc * 32 + 8 * fq;
        const size_t off0 = (size_t)row0 * D + col0;
        const bf16_t* __restrict__ bp = XB + tl_off(row0, col0, D); float* __restrict__ op = out + off0;
        u32x4 xa[8][2];
#define ED_LOAD(i) do { const size_t o_ = (size_t)((((i) >> 2) * 8 + ((i) & 3)) * (D / 32)) * 512; xa[i][0] = *(const u32x4*)(bp + o_); xa[i][1] = *(const u32x4*)(bp + o_ + 4 * 512); } while (0)
        ED_LOAD(0); ED_LOAD(1); ED_LOAD(2); ED_LOAD(3);
        asm volatile("" ::: "memory");
#pragma unroll
        for (int i = 0; i < 8; ++i) { const int ai = i >> 2, m = i & 3; const size_t o_ = (size_t)(ai * HALF + m * 16) * D;
#pragma unroll
            for (int bj = 0; bj < 2; ++bj) { const u32x4 w = xa[i][bj];
                const f32x4 r0 = {__builtin_bit_cast(float, w.x << 16), __builtin_bit_cast(float, w.x & 0xffff0000u), __builtin_bit_cast(float, w.y << 16), __builtin_bit_cast(float, w.y & 0xffff0000u)};
                const f32x4 r1 = {__builtin_bit_cast(float, w.z << 16), __builtin_bit_cast(float, w.z & 0xffff0000u), __builtin_bit_cast(float, w.w << 16), __builtin_bit_cast(float, w.w & 0xffff0000u)};
                *(f32x4*)(op + o_ + bj * HALF) = acc[ai][bj][m][0] + r0; *(f32x4*)(op + o_ + bj * HALF + 4) = acc[ai][bj][m][1] + r1; }
            if (i + 4 < 8) { ED_LOAD((i + 4) & 7); }
            asm volatile("" ::: "memory"); }
#undef ED_LOAD
    }
};

template <class Epi, class Sched, bool ALIGN_EPI = false, bool SP2 = false, bool A_TILED = true>
__device__ __forceinline__ void gemm_phase(LAS unsigned char* lds, const Gemm g, const Sched& S, const Epi& E) {
    const int tid = threadIdx.x, wid = __builtin_amdgcn_readfirstlane(tid >> 6), lane = tid & 63, wr = wid >> 2, wc = wid & 3, fr = lane & 15, fq = lane >> 4;
    const int K = g.K, nt = K / BK;
    unsigned voffA[2], voffB[2];
#pragma unroll
    for (int i = 0; i < 2; ++i) { int R, C; stage_rc(tid * 16 + i * 8192, R, C); const int Rb = Epi::PERM ? ((R & ~31) + perm32(R & 31)) : R;
        voffA[i] = A_TILED ? (unsigned)tl_off(R, C, K) * 2u : (unsigned)(R * K + C) * 2u; voffB[i] = (unsigned)tl_off(Rb, C, K) * 2u; }
    const size_t kstepA = A_TILED ? (size_t)2048 : (size_t)(BK * 2), kstepB = 2048;
    const size_t hstep = (size_t)HALF * K * 2;
    const size_t tstep = 2 * hstep;
    const unsigned ldsw = (unsigned)wid * 1024u;
    const int aoff = lds_byte(wr * 64 + fr, fq * 8), boff = lds_byte(wc * 32 + fr, fq * 8);
#define PG8_SA(b, h) (((b) * 2 + (h)) * HTB)
#define PG8_SB(b, h) ((4 + (b) * 2 + (h)) * HTB)
#define PG8_STAGE(bufoff, gbase, voff) do { _Pragma("unroll") for (int _i = 0; _i < 2; ++_i) \
        __builtin_amdgcn_global_load_lds((const unsigned*)((const char*)(gbase) + (voff)[_i]), (LAS unsigned*)(lds + (bufoff) + ldsw + _i * 8192), 16, 0, 0); } while (0)
#define PG8_LDA(dst, b, h) do { _Pragma("unroll") for (int m = 0; m < 4; ++m) _Pragma("unroll") for (int k = 0; k < 2; ++k) dst[m][k] = *(const LAS bf16x8*)(lds + PG8_SA(b, h) + aoff + m * 2048 + k * 1024); } while (0)
#define PG8_LDB(dst, b, h) do { _Pragma("unroll") for (int n = 0; n < 2; ++n) _Pragma("unroll") for (int k = 0; k < 2; ++k) dst[n][k] = *(const LAS bf16x8*)(lds + PG8_SB(b, h) + boff + n * 2048 + k * 1024); } while (0)
#define PG8_MMA(ai, bj, At, Bt) do { __builtin_amdgcn_s_setprio(1); _Pragma("unroll") for (int m = 0; m < 4; ++m) _Pragma("unroll") for (int n = 0; n < 2; ++n) _Pragma("unroll") for (int k = 0; k < 2; ++k) \
        acc[ai][bj][m][n] = __builtin_amdgcn_mfma_f32_16x16x32_bf16(Bt[n][k], At[m][k], acc[ai][bj][m][n], 0, 0, 0); __builtin_amdgcn_s_setprio(0); } while (0)
#define PG8_WAIT_V(n) asm volatile("s_waitcnt vmcnt(" #n ")" ::: "memory")
#define PG8_WAIT_L(n) asm volatile("s_waitcnt lgkmcnt(" #n ")" ::: "memory")
#define PG8_BAR __builtin_amdgcn_s_barrier()
#define PG8_SCHED __builtin_amdgcn_sched_barrier(0)
    Unit cur, nxt; int ui = 0;
    if (!S.next(0, cur)) return;
    f32x4 acc[2][2][4][2];
#pragma unroll
    for (int a = 0; a < 2; ++a)
#pragma unroll
        for (int b = 0; b < 2; ++b)
#pragma unroll
            for (int m = 0; m < 4; ++m)
#pragma unroll
                for (int n = 0; n < 2; ++n) acc[a][b][m][n] = (f32x4){0.f, 0.f, 0.f, 0.f};
    bf16x8 At[4][2], B0[2][2], B1[2][2];
    const char* cA = (const char*)g.A + (size_t)cur.pm * tstep; const char* cB = (const char*)g.Bt + (size_t)cur.pn * tstep;
    S.a_ready(cur);
    if constexpr (SP2) {
        PG8_STAGE(PG8_SB(0, 0), cB, voffB); PG8_STAGE(PG8_SB(0, 1), cB + hstep, voffB); PG8_STAGE(PG8_SA(0, 0), cA, voffA); PG8_STAGE(PG8_SA(0, 1), cA + hstep, voffA);
        if (wr == 1) PG8_BAR;
        PG8_WAIT_V(2); PG8_BAR;
        PG8_STAGE(PG8_SB(1, 0), cB + kstepB, voffB); PG8_STAGE(PG8_SA(1, 0), cA + kstepA, voffA); PG8_STAGE(PG8_SB(1, 1), cB + hstep + kstepB, voffB);
        PG8_WAIT_V(6); PG8_BAR;
    } else {
        PG8_STAGE(PG8_SB(0, 0), cB, voffB); PG8_STAGE(PG8_SA(0, 0), cA, voffA); PG8_STAGE(PG8_SB(0, 1), cB + hstep, voffB); PG8_STAGE(PG8_SA(0, 1), cA + hstep, voffA);
        if (wr == 1) PG8_BAR;
        PG8_WAIT_V(4); PG8_BAR;
        PG8_STAGE(PG8_SB(1, 0), cB + kstepB, voffB); PG8_STAGE(PG8_SA(1, 0), cA + kstepA, voffA); PG8_STAGE(PG8_SB(1, 1), cB + hstep + kstepB, voffB);
        PG8_WAIT_V(6); PG8_BAR;
    }
    for (;;) {
        const bool has_next = S.next(ui + 1, nxt);
        const char* nA = has_next ? (const char*)g.A + (size_t)nxt.pm * tstep : cA; const char* nB = has_next ? (const char*)g.Bt + (size_t)nxt.pn * tstep : cB;
        for (int t = 0; t < nt; t += 2) {
            const bool last = (t == nt - 2);
            const char* a1 = cA + (size_t)(t + 1) * kstepA;
            const char* a2 = last ? nA : cA + (size_t)(t + 2) * kstepA; const char* b2 = last ? nB : cB + (size_t)(t + 2) * kstepB;
            const char* a3 = a2 + kstepA; const char* b3 = b2 + kstepB;
            if (last && has_next) S.a_ready(nxt);
            if constexpr (SP2) {
            PG8_LDB(B0, 0, 0); PG8_LDB(B1, 0, 1); PG8_SCHED; PG8_LDA(At, 0, 0); PG8_STAGE(PG8_SA(1, 1), a1 + hstep, voffA);
            PG8_WAIT_V(8); PG8_WAIT_L(0); PG8_BAR; PG8_MMA(0, 0, At, B0); PG8_MMA(0, 1, At, B1); PG8_BAR; PG8_SCHED;
            PG8_LDA(At, 0, 1); PG8_STAGE(PG8_SB(0, 0), b2, voffB); PG8_STAGE(PG8_SB(0, 1), b2 + hstep, voffB); PG8_STAGE(PG8_SA(0, 0), a2, voffA);
            PG8_WAIT_V(8); PG8_WAIT_L(0); PG8_BAR; PG8_MMA(1, 0, At, B0); PG8_MMA(1, 1, At, B1); PG8_BAR; PG8_SCHED;
            PG8_LDB(B0, 1, 0); PG8_LDB(B1, 1, 1); PG8_SCHED; PG8_LDA(At, 1, 0); PG8_STAGE(PG8_SA(0, 1), a2 + hstep, voffA);
            PG8_WAIT_V(8); PG8_WAIT_L(0); PG8_BAR; PG8_MMA(0, 0, At, B0); PG8_MMA(0, 1, At, B1); PG8_BAR; PG8_SCHED;
            PG8_LDA(At, 1, 1); PG8_STAGE(PG8_SB(1, 0), b3, voffB); PG8_STAGE(PG8_SB(1, 1), b3 + hstep, voffB); PG8_STAGE(PG8_SA(1, 0), a3, voffA);
            PG8_WAIT_V(8); PG8_WAIT_L(0); PG8_BAR; PG8_MMA(1, 0, At, B0); PG8_MMA(1, 1, At, B1); PG8_BAR; PG8_SCHED;
            } else {
            PG8_LDB(B0, 0, 0); PG8_SCHED; PG8_LDA(At, 0, 0); PG8_STAGE(PG8_SA(1, 1), a1 + hstep, voffA);
            PG8_WAIT_L(8); PG8_BAR; PG8_WAIT_L(0); PG8_MMA(0, 0, At, B0); PG8_BAR; PG8_SCHED;
            PG8_LDB(B1, 0, 1); PG8_STAGE(PG8_SB(0, 0), b2, voffB);
            PG8_BAR; PG8_WAIT_L(0); PG8_MMA(0, 1, At, B1); PG8_BAR;
            PG8_LDA(At, 0, 1); PG8_STAGE(PG8_SA(0, 0), a2, voffA);
            PG8_BAR; PG8_WAIT_L(0); PG8_MMA(1, 0, At, B0); PG8_BAR; PG8_SCHED;
            PG8_STAGE(PG8_SB(0, 1), b2 + hstep, voffB);
            PG8_WAIT_V(6); PG8_BAR; PG8_MMA(1, 1, At, B1); PG8_BAR;
            PG8_LDB(B0, 1, 0); PG8_SCHED; PG8_LDA(At, 1, 0); PG8_STAGE(PG8_SA(0, 1), a2 + hstep, voffA);
            PG8_WAIT_L(8); PG8_BAR; PG8_WAIT_L(0); PG8_MMA(0, 0, At, B0); PG8_BAR; PG8_SCHED;
            PG8_LDB(B1, 1, 1); PG8_STAGE(PG8_SB(1, 0), b3, voffB);
            PG8_BAR; PG8_WAIT_L(0); PG8_MMA(0, 1, At, B1); PG8_BAR;
            PG8_LDA(At, 1, 1); PG8_STAGE(PG8_SA(1, 0), a3, voffA);
            PG8_BAR; PG8_WAIT_L(0); PG8_MMA(1, 0, At, B0); PG8_BAR; PG8_SCHED;
            PG8_STAGE(PG8_SB(1, 1), b3 + hstep, voffB);
            PG8_WAIT_V(6); PG8_BAR; PG8_MMA(1, 1, At, B1); PG8_BAR;
            }
        }
        if constexpr (ALIGN_EPI) { if (wr == 0) PG8_BAR; }
        if constexpr (!Epi::AFTER_DRAIN) { E(acc, cur, wr, wc, fr, fq); S.done(cur); }
        if (!has_next) break;
#pragma unroll
        for (int a = 0; a < 2; ++a)
#pragma unroll
            for (int b = 0; b < 2; ++b)
#pragma unroll
                for (int m = 0; m < 4; ++m)
#pragma unroll
                    for (int n = 0; n < 2; ++n) acc[a][b][m][n] = (f32x4){0.f, 0.f, 0.f, 0.f};
        cur = nxt; cA = nA; cB = nB; ++ui;
        if constexpr (ALIGN_EPI) { if (wr == 1) PG8_BAR; }
    }
    PG8_WAIT_V(0);
    if constexpr (!ALIGN_EPI) { if (wr == 0) PG8_BAR; }
    PG8_BAR;
#undef PG8_SA
#undef PG8_SB
#undef PG8_STAGE
#undef PG8_LDA
#undef PG8_LDB
#undef PG8_MMA
#undef PG8_WAIT_V
#undef PG8_WAIT_L
#undef PG8_BAR
#undef PG8_SCHED
}
}

constexpr int NWAVES = 8;
#ifndef MK_N_LAUNCHES
#define MK_N_LAUNCHES 1
#endif
constexpr int N_LAUNCHES = MK_N_LAUNCHES;
constexpr int PER_PHASE = 6;
#ifndef PG8_SP2
#define PG8_SP2 true
#endif

constexpr size_t MiB = 1u << 20;
constexpr size_t WS_CTL = 0, CTL_ZERO_BYTES = 1 * MiB;
constexpr size_t WS_WIN = 2 * MiB;
constexpr size_t WS_WOUT = 6 * MiB;
constexpr size_t WS_WGU = 8 * MiB;
constexpr size_t WS_WDN = 20 * MiB;
constexpr size_t WS_XN = 32 * MiB;
constexpr size_t WS_QKVZ = 160 * MiB;
constexpr size_t WS_ACT = 416 * MiB;
constexpr size_t WS_XB = 768 * MiB;
constexpr size_t WS_END = 896 * MiB;
static_assert(WS_WGU + (size_t)NGU * D * 2 <= WS_WDN && WS_WDN + (size_t)D * FF * 2 <= WS_XN && WS_ACT + (size_t)M * FF * 2 <= WS_END, "d_ws map");
constexpr int CW_BAR = 4096;
constexpr int CW_SS = 65536;
static_assert((size_t)(CW_SS + 2 * M) * 4 <= CTL_ZERO_BYTES, "ss, rrow inside the control region");

constexpr int RING_OFF = 0, RING_BYTES = 131072;
constexpr int LDSCTL_OFF = 157696, MISC_OFF = LDSCTL_OFF + 320;
constexpr int LDS_GAIN_OFF = LDSCTL_OFF + 512;
constexpr int LDS_BYTES = 163840;

typedef GAS unsigned gu32;
#define RLX_AGENT __ATOMIC_RELAXED, __HIP_MEMORY_SCOPE_AGENT
#define LDS_WAIT() asm volatile("s_waitcnt lgkmcnt(0)" ::: "memory")
__device__ __forceinline__ unsigned f2bf(float f) { unsigned u = __builtin_bit_cast(unsigned, f); return (u + 0x7fffu + ((u >> 16) & 1u)) >> 16; }
__device__ __forceinline__ unsigned pk2(float lo, float hi) { return f2bf(lo) | (f2bf(hi) << 16); }
__device__ __forceinline__ float bflo(unsigned w) { return __builtin_bit_cast(float, w << 16); }
__device__ __forceinline__ float bfhi(unsigned w) { return __builtin_bit_cast(float, w & 0xffff0000u); }

#define XB_TMO      128
#define XB_XCNT(j)  (256  + 64 * (j))
#define XB_XSUB(j)  (1280 + 64 * (j))
#define XB_XGEN(j)  (2304 + 64 * (j))
#define XB_TOP      3328
#define XB_TOPGEN   3392
#define XCD_BAR_WORDS 3456
#define XB_SPIN_CAP (1u << 18)

__device__ __forceinline__ unsigned xb_ld(unsigned* p)              { return __hip_atomic_load(p, __ATOMIC_RELAXED, __HIP_MEMORY_SCOPE_AGENT); }
__device__ __forceinline__ unsigned xb_add(unsigned* p, unsigned v) { return __hip_atomic_fetch_add(p, v, __ATOMIC_RELAXED, __HIP_MEMORY_SCOPE_AGENT); }
__device__ __forceinline__ unsigned xb_xcc_id() { return (unsigned)__builtin_amdgcn_s_getreg((3 << 11) | 20) & 0xFu; }
#define XB_SPIN(cond, bar) do { unsigned _sp = 0; while (cond) { __builtin_amdgcn_s_sleep(1); \
    if ((++_sp & 255u) == 0u) { if (xb_ld(&(bar)[XB_TMO])) break; if (_sp > XB_SPIN_CAP) { atomicAdd(&(bar)[XB_TMO], 1u); break; } } } } while (0)

struct XcdBarrier { unsigned* bar; unsigned x; volatile LAS unsigned* st; };

__device__ __forceinline__ XcdBarrier xcd_barrier_post(unsigned* bar, volatile LAS unsigned* st) {
    XcdBarrier b; b.bar = bar; b.x = xb_xcc_id(); b.st = st;
    if (threadIdx.x == 0) (void)xb_add(&bar[XB_XCNT(b.x)], 1u);
    return b;
}
__device__ __forceinline__ void xcd_barrier_complete(unsigned* bar, unsigned x, unsigned& nloc, unsigned& nx) {
    const unsigned G = gridDim.x * gridDim.y * gridDim.z;
    unsigned sum, cnt, mine, sp = 0u;
    for (;;) {
        sum = 0u; cnt = 0u; mine = 0u;
#pragma unroll
        for (unsigned j = 0; j < 16; ++j) { const unsigned c = xb_ld(&bar[XB_XCNT(j)]); sum += c; cnt += (c > 0u) ? 1u : 0u; mine = (j == x) ? c : mine; }
        if (sum == G) break;
        __builtin_amdgcn_s_sleep(1);
        if ((++sp & 255u) == 0u) { if (xb_ld(&bar[XB_TMO])) break; if (sp > XB_SPIN_CAP) { atomicAdd(&bar[XB_TMO], 1u); break; } }
    }
    nloc = mine > 0u ? mine : 1u; nx = cnt > 0u ? cnt : 1u;
}
__device__ __forceinline__ void xcd_barrier(const XcdBarrier& b) {
    asm volatile("s_waitcnt vmcnt(0)" ::: "memory");
    __syncthreads();
    if (threadIdx.x == 0) {
        unsigned* bar = b.bar;
        __builtin_amdgcn_s_waitcnt(0);
        unsigned nloc = b.st[0], nx = b.st[1];
        if (nloc == 0u) { xcd_barrier_complete(bar, b.x, nloc, nx); b.st[0] = nloc; b.st[1] = nx; }
        const unsigned old = xb_add(&bar[XB_XSUB(b.x)], 1u);
        const unsigned gen = old / nloc;
        if (old + 1u == (gen + 1u) * nloc) {
            __builtin_amdgcn_fence(__ATOMIC_RELEASE, "agent");
            asm volatile("s_waitcnt vmcnt(0)" ::: "memory");
            const unsigned og = xb_add(&bar[XB_TOP], 1u);
            const unsigned tg = og / nx;
            if (og + 1u == (tg + 1u) * nx) xb_add(&bar[XB_TOPGEN], 1u);
            else XB_SPIN(xb_ld(&bar[XB_TOPGEN]) == tg, bar);
            __builtin_amdgcn_fence(__ATOMIC_ACQUIRE, "agent");
            xb_add(&bar[XB_XGEN(b.x)], 1u);
            asm volatile("s_waitcnt vmcnt(0)" ::: "memory");
        } else {
            XB_SPIN(xb_ld(&bar[XB_XGEN(b.x)]) == gen, bar);
            __builtin_amdgcn_fence(__ATOMIC_ACQUIRE, "agent");
            asm volatile("s_waitcnt vmcnt(0)" ::: "memory");
        }
    }
    __syncthreads();
}

struct Frame {
    LAS unsigned char* lds;
    volatile LAS unsigned* MISC;
    gu32* ctl;
    int tid, lane, wave;
    int vcu, G;
    const float *x, *g1, *w_in, *gq, *gk, *rpb, *w_pool, *pscale, *w_out, *g2, *w_gate, *w_up, *w_down;
    float* out;
    bf16_t *Win_t, *Wout_t, *Wgu_t, *Wdn_t;
    bf16_t *XN, *QKVZ, *XB, *ACT;
    float* ss; float* rrow; bf16_t* MIX;
};

__device__ __forceinline__ float wave_sum(float v) {
#pragma unroll
    for (int o = 1; o < 64; o <<= 1) v += __shfl_xor(v, o);
    return v;
}

__device__ __forceinline__ void p0_tile_out(bf16_t* WT, int K, int drow0, int k0, LAS float* scr, int lane) {
    LDS_WAIT(); asm volatile("" ::: "memory");
    const int c = lane & 7;
#pragma unroll
    for (int j = 0; j < 4; ++j) { const int n = (lane >> 3) + 8 * j; const LAS float* s = scr + (8 * c) * 33 + n;
        u32x4 o; o.x = pk2(s[0 * 33], s[1 * 33]); o.y = pk2(s[2 * 33], s[3 * 33]); o.z = pk2(s[4 * 33], s[5 * 33]); o.w = pk2(s[6 * 33], s[7 * 33]);
        *(GAS u32x4*)(WT + tl_off(drow0 + n, k0 + 8 * c, K)) = o; }
    LDS_WAIT(); asm volatile("" ::: "memory");
}
__device__ __forceinline__ void p0_transpose_item(const float* W, int ldw, int K, int k0, int n0, const float* gkv, bf16_t* WT, int drow0, LAS float* scr, int lane) {
#pragma unroll
    for (int i = 0; i < 32; ++i) { const int kk = 2 * i + (lane >> 5); float v = W[(size_t)(k0 + kk) * ldw + n0 + (lane & 31)]; if (gkv) v *= gkv[k0 + kk]; scr[kk * 33 + (lane & 31)] = v; }
    p0_tile_out(WT, K, drow0, k0, scr, lane);
}
__device__ __forceinline__ void p0_fold_item(const float* w_in, const float* w_pool, const float* pscale, int k0, int n0z, bf16_t* WT, int drow0, int lane) {
    const int n = lane & 31, kh = lane >> 5, g = n0z >> 7, d = (n0z & 127) + n;
    float acc[4] = {0.f, 0.f, 0.f, 0.f};
    const float* wrow = w_in + (size_t)(k0 + 4 * kh) * NIN + 3 * NA + 128 * g;
    const float* wp = w_pool + (size_t)g * 128 * 128 + d;
#pragma unroll 8
    for (int c4 = 0; c4 < 32; ++c4) {
        const float p0 = wp[(4 * c4 + 0) * 128], p1 = wp[(4 * c4 + 1) * 128], p2 = wp[(4 * c4 + 2) * 128], p3 = wp[(4 * c4 + 3) * 128];
#pragma unroll
        for (int i = 0; i < 4; ++i) { const f32x4 w = *(const f32x4*)(wrow + (size_t)i * NIN + 4 * c4); acc[i] += (w[0] * p0 + w[1] * p1) + (w[2] * p2 + w[3] * p3); }
    }
    const float ps = pscale[n0z + n];
    float hi[4];
#pragma unroll
    for (int i = 0; i < 4; ++i) { acc[i] *= ps; hi[i] = __shfl(acc[i], (lane + 32) & 63); }
    if (lane < 32) { u32x4 o; o.x = pk2(acc[0], acc[1]); o.y = pk2(acc[2], acc[3]); o.z = pk2(hi[0], hi[1]); o.w = pk2(hi[2], hi[3]);
        *(GAS u32x4*)(WT + tl_off(drow0 + n, k0, D)) = o; }
}
__device__ __forceinline__ int win_drow(int n0) { const int pn = n0 >> 8, c = n0 & 255; return 256 * pn + 128 * ((c >> 5) & 1) + 32 * (c >> 6); }

template <int R> __device__ __forceinline__ void rms_rows(const float* x, const f32x4 (&gg)[4], bf16_t* XN, float* rrow, int m0, int lane) {
    f32x4 v[R][4]; float s[R];
#pragma unroll
    for (int r = 0; r < R; ++r) { const GAS f32x4* xr = (const GAS f32x4*)(x + (size_t)(m0 + r) * D) + lane;
#pragma unroll
        for (int j = 0; j < 4; ++j) v[r][j] = xr[64 * j]; }
#pragma unroll
    for (int r = 0; r < R; ++r) { float a = 0.f;
#pragma unroll
        for (int j = 0; j < 4; ++j) a += (v[r][j].x * v[r][j].x + v[r][j].y * v[r][j].y) + (v[r][j].z * v[r][j].z + v[r][j].w * v[r][j].w);
        s[r] = a; }
#pragma unroll
    for (int o = 1; o < 64; o <<= 1) {
#pragma unroll
        for (int r = 0; r < R; ++r) s[r] += __shfl_xor(s[r], o); }
#pragma unroll
    for (int r = 0; r < R; ++r) { const float ms = s[r] * (1.f / D) + EPS, rstd = __builtin_amdgcn_rsqf(ms);
        if (lane == 0) rrow[m0 + r] = ms * rstd;
        bf16_t* orow = XN + tl_off(m0 + r, 4 * lane, D);
#pragma unroll
        for (int j = 0; j < 4; ++j) *(GAS unsigned long long*)(orow + (size_t)j * 8 * 512) = (unsigned long long)pk2(v[r][j].x * rstd * gg[j].x, v[r][j].y * rstd * gg[j].y) | ((unsigned long long)pk2(v[r][j].z * rstd * gg[j].z, v[r][j].w * rstd * gg[j].w) << 32); }
}

struct P0Item { const float* W; const float* gk; bf16_t* WT; int ldw, K, k0, n0, drow0; };
__device__ __forceinline__ void p0_prologue(Frame& F) {
    LAS float* scr = (LAS float*)(F.lds + RING_OFF + F.wave * 16384);
    const int gw = F.vcu * NWAVES + F.wave, NGW = F.G * NWAVES, lane = F.lane;
    constexpr int KB = D / 64;
    constexpr int I_QKV = KB * (3 * NA / 32), I_O = KB * (D / 32), I_G = KB * (FF / 32), I_DN = (FF / 64) * (D / 32);
    constexpr int NITEMS = I_QKV + I_O + 2 * I_G + I_DN;
    for (int it = gw; it < (D / 8) * (NA / 32); it += NGW) { const int nb = it & 15, kb = it >> 4; p0_fold_item(F.w_in, F.w_pool, F.pscale, 8 * kb, 32 * nb, F.Win_t, win_drow(3 * NA + 32 * nb), lane); }
    f32x4 gg[4];
#pragma unroll
    for (int j = 0; j < 4; ++j) gg[j] = *((const f32x4*)F.g1 + lane + 64 * j);
    const int RPW = (M + F.G - 1) / F.G, rbeg = F.vcu * RPW, rend = (rbeg + RPW) < M ? (rbeg + RPW) : M, nb8 = (rend - rbeg) / 8;
    volatile LAS unsigned* tick = F.MISC + 16;
    int it = gw; bool rows_left = true;
    while (it < NITEMS || rows_left) {
        const bool has_item = it < NITEMS; P0Item I{};
        if (has_item) {
            int r = it;
            if (r < I_QKV) { const int nb = r % (3 * NA / 32), kb = r / (3 * NA / 32); I = P0Item{F.w_in, nullptr, F.Win_t, NIN, D, 64 * kb, 32 * nb, win_drow(32 * nb)}; }
            else if ((r -= I_QKV) < I_O) { const int nb = r % (D / 32), kb = r / (D / 32); I = P0Item{F.w_out, nullptr, F.Wout_t, D, D, 64 * kb, 32 * nb, 32 * nb}; }
            else if ((r -= I_O) < 2 * I_G) { const int up = r >= I_G; if (up) r -= I_G; const int nb = r % (FF / 32), kb = r / (FF / 32), n0 = 32 * nb;
                I = P0Item{up ? F.w_up : F.w_gate, F.g2, F.Wgu_t, FF, D, 64 * kb, n0, 256 * (n0 >> 7) + (n0 & 127) + 128 * up}; }
            else { r -= 2 * I_G; const int nb = r % (D / 32), kb = r / (D / 32); I = P0Item{F.w_down, nullptr, F.Wdn_t, D, FF, 64 * kb, 32 * nb, 32 * nb}; }
        }
        float wv[32];
        if (has_item) {
#pragma unroll
            for (int i = 0; i < 32; ++i) { const int kk = 2 * i + (lane >> 5); wv[i] = I.W[(size_t)(I.k0 + kk) * I.ldw + I.n0 + (lane & 31)]; }
        }
        int m0 = 0;
        if (rows_left) { unsigned t = 0; if (lane == 0) t = __hip_atomic_fetch_add((LAS unsigned*)tick, 1u, __ATOMIC_RELAXED, __HIP_MEMORY_SCOPE_WORKGROUP);
            t = __builtin_amdgcn_readfirstlane(t); rows_left = (int)t < nb8; m0 = rbeg + 8 * (int)t; }
        f32x4 v[8][4];
        if (rows_left) {
#pragma unroll
            for (int r = 0; r < 8; ++r) { const GAS f32x4* xr = (const GAS f32x4*)(F.x + (size_t)(m0 + r) * D) + lane;
#pragma unroll
                for (int j = 0; j < 4; ++j) v[r][j] = xr[64 * j]; }
        }
        if (has_item) {
            if (I.gk) {
#pragma unroll
                for (int i = 0; i < 32; ++i) wv[i] *= I.gk[I.k0 + 2 * i + (lane >> 5)];
            }
#pragma unroll
            for (int i = 0; i < 32; ++i) scr[(2 * i + (lane >> 5)) * 33 + (lane & 31)] = wv[i];
            p0_tile_out(I.WT, I.K, I.drow0, I.k0, scr, lane);
        }
        if (rows_left) {
            float s[8];
#pragma unroll
            for (int r = 0; r < 8; ++r) { float a = 0.f;
#pragma unroll
                for (int j = 0; j < 4; ++j) a += (v[r][j].x * v[r][j].x + v[r][j].y * v[r][j].y) + (v[r][j].z * v[r][j].z + v[r][j].w * v[r][j].w);
                s[r] = a; }
#pragma unroll
            for (int o = 1; o < 64; o <<= 1) {
#pragma unroll
                for (int r = 0; r < 8; ++r) s[r] += __shfl_xor(s[r], o); }
#pragma unroll
            for (int r = 0; r < 8; ++r) { const float ms = s[r] * (1.f / D) + EPS, rstd = __builtin_amdgcn_rsqf(ms);
                if (lane == 0) F.rrow[m0 + r] = ms * rstd;
                bf16_t* orow = F.XN + tl_off(m0 + r, 4 * lane, D);
#pragma unroll
                for (int j = 0; j < 4; ++j) *(GAS unsigned long long*)(orow + (size_t)j * 8 * 512) = (unsigned long long)pk2(v[r][j].x * rstd * gg[j].x, v[r][j].y * rstd * gg[j].y) | ((unsigned long long)pk2(v[r][j].z * rstd * gg[j].z, v[r][j].w * rstd * gg[j].w) << 32); }
        }
        it += NGW;
    }
    if (F.wave == 0) for (int m = rbeg + 8 * nb8; m < rend; ++m) rms_rows<1>(F.x, gg, F.XN, F.rrow, m, lane);
}

constexpr int AT_IMG = 15 * 40 * 128;
constexpr int AT_A = 0;
constexpr int AT_B = AT_IMG;
constexpr int AT_TAB = 2 * AT_IMG;
static_assert(AT_TAB + 15 * 64 * 4 <= LDSCTL_OFF, "attention LDS map");
__device__ __forceinline__ int rs_of(int r) { int v = r - 4; v = v < 0 ? 0 : v; return v > 56 ? 56 : v; }

struct AttnUnit { int b, h, jh, r0, krow_lo, nrows; };
__device__ __forceinline__ AttnUnit attn_decode(int un) {
    AttnUnit u; const int bh = un >> 4, rc = (un >> 1) & 7; u.jh = un & 1; u.b = bh >> 3; u.h = bh & 7;
    u.r0 = 8 * rc; u.krow_lo = rs_of(u.r0); u.nrows = rs_of(u.r0 + 7) + 8 - u.krow_lo;
    return u;
}
__device__ __forceinline__ void glds16(const void* gsrc, unsigned lds_dst) { unsigned keep;
    asm volatile("s_mov_b32 %0, m0\n\ts_mov_b32 m0, %2\n\ts_nop 0\n\tglobal_load_lds_dwordx4 %1, off\n\ts_mov_b32 m0, %0" : "=&s"(keep) : "v"(gsrc), "s"(lds_dst) : "memory"); }
#define ATT_WAIT_BAR() do { asm volatile("s_waitcnt vmcnt(0) lgkmcnt(0)" ::: "memory"); __builtin_amdgcn_s_barrier(); asm volatile("" ::: "memory"); } while (0)
template <int KIND> __device__ __forceinline__ void attn_dma(unsigned dst, const bf16_t* src, const AttnUnit& u, int wid, int lane) {
    const int np = u.nrows * 5;
    const char* base = (const char*)(src + ((size_t)(u.b * NHEAD + u.h) * SEQ + u.krow_lo * 64 + 24 * u.jh) * HD);
#pragma unroll
    for (int it = 0; it < 10; ++it) {
        const int pi = it * 8 + wid;
        if (pi < np) {
            const int w = (pi * 205) >> 10, p = pi - 5 * w, c = 8 * p + (lane >> 3);
            const int sw = (KIND == 0) ? (((c >> 1) & 1) | (((c >> 3) & 3) << 1)) : ((((c >> 1) & 1) << 1) | (((c >> 3) & 1) << 2));
            const int ch = (lane & 7) ^ sw;
            const char* gp = base + (w * 64 + c) * (HD * 2) + ch * 16;
            glds16(gp, (unsigned)__builtin_amdgcn_readfirstlane(dst + pi * 1024));
        }
    }
}

__device__ __forceinline__ void p2_attention(Frame& F, const bf16_t* Qg, const bf16_t* Kg, const bf16_t* Vg, bf16_t* MIX) {
    const int lane = F.lane, wid = F.wave;
    LAS unsigned char* lds = F.lds;
    const unsigned lds0 = (unsigned)(size_t)F.lds;
    const int q = lane & 15, g = lane >> 4;
    constexpr int NUNITS = BATCH * NHEAD * 16, UW = 8;
    for (int uidx = F.vcu * UW; uidx < NUNITS; uidx += F.G * UW) {
        const int h = (uidx >> 4) & 7;
        __syncthreads();
        {   LAS float* tab = (LAS float*)(lds + AT_TAB);
            for (int i = F.tid; i < 15 * 64; i += NWAVES * 64) { const int rr = i >> 6, cc = (i & 63) - 16; tab[i] = (cc >= 0 && cc < 31) ? F.rpb[h * 465 + rr * 31 + cc] * LOG2E : 0.f; } }
        AttnUnit u = attn_decode(uidx);
        attn_dma<0>(lds0 + AT_A, Kg, u, wid, lane);
        bf16x8 qf[2][2];
#pragma unroll
        for (int jb = 0; jb < 2; ++jb) { const bf16_t* qp = Qg + ((size_t)(u.b * NHEAD + u.h) * SEQ + (u.r0 + wid) * 64 + 32 * u.jh + 16 * jb + q) * HD + 8 * g; qf[jb][0] = *(const bf16x8*)qp; qf[jb][1] = *(const bf16x8*)(qp + 32); }
        ATT_WAIT_BAR();
        for (int ui = 0; ui < UW; ++ui) {
            asm volatile("" : "+v"(qf[0][0]), "+v"(qf[0][1]), "+v"(qf[1][0]), "+v"(qf[1][1]));
            attn_dma<1>(lds0 + AT_B, Vg, u, wid, lane);
            const int r = u.r0 + wid, rs = rs_of(r), wbase = rs - u.krow_lo;
            u32x4 pw[2][8]; float il[2];
#pragma unroll
            for (int jb = 0; jb < 2; ++jb) {
                const int o = 8 * jb, kcol0 = 24 * u.jh + o, cq = 32 * u.jh + 16 * jb + q;
                int cs = cq - 8; cs = cs < 0 ? 0 : cs; cs = cs > 48 ? 48 : cs;
                f32x4 sc[8][2];
                {
                    const int fk = ((q >> 1) & 1) | (((jb + (q >> 2)) & 3) << 1), x0 = g ^ fk;
                    const LAS unsigned char* ka = lds + AT_A + (wbase * 40 + o + 8 * (q >> 2) + (q & 3)) * 128;
                    const LAS unsigned char* k0p = ka + x0 * 16;
                    const LAS unsigned char* k1p = ka + (x0 ^ 4) * 16;
#pragma unroll
                    for (int wl = 0; wl < 8; ++wl)
#pragma unroll
                        for (int blk = 0; blk < 2; ++blk) {
                            const bf16x8 k0 = *(const LAS bf16x8*)(k0p + wl * 5120 + blk * 512), k1 = *(const LAS bf16x8*)(k1p + wl * 5120 + blk * 512);
                            f32x4 a = (f32x4){0.f, 0.f, 0.f, 0.f};
                            a = __builtin_amdgcn_mfma_f32_16x16x32_bf16(k0, qf[jb][0], a, 0, 0, 0);
                            a = __builtin_amdgcn_mfma_f32_16x16x32_bf16(k1, qf[jb][1], a, 0, 0, 0);
                            sc[wl][blk] = a;
                        }
                }
                const LAS float* tab = (const LAS float*)(lds + AT_TAB) + (rs - r + 7) * 64 + 16 + (kcol0 - cq + 15) + 8 * g;
                const int voff = kcol0 + 8 * g - cs;
                float mx = -INFINITY;
#pragma unroll
                for (int wl = 0; wl < 8; ++wl)
#pragma unroll
                    for (int blk = 0; blk < 2; ++blk)
#pragma unroll
                        for (int e = 0; e < 4; ++e) {
                            const int ep = 4 * blk + e;
                            float s_ = sc[wl][blk][e] + tab[wl * 64 + ep];
                            s_ = ((unsigned)(voff + ep) < 16u) ? s_ : -INFINITY;
                            sc[wl][blk][e] = s_; mx = fmaxf(mx, s_);
                        }
                mx = fmaxf(mx, __shfl_xor(mx, 16)); mx = fmaxf(mx, __shfl_xor(mx, 32));
                float l = 0.f;
#pragma unroll
                for (int wl = 0; wl < 8; ++wl) {
                    float p[8];
#pragma unroll
                    for (int blk = 0; blk < 2; ++blk)
#pragma unroll
                        for (int e = 0; e < 4; ++e) { p[4 * blk + e] = __builtin_amdgcn_exp2f(sc[wl][blk][e] - mx); l += p[4 * blk + e]; }
                    pw[jb][wl].x = cvt_pk_bf16(p[0], p[1]); pw[jb][wl].y = cvt_pk_bf16(p[2], p[3]); pw[jb][wl].z = cvt_pk_bf16(p[4], p[5]); pw[jb][wl].w = cvt_pk_bf16(p[6], p[7]);
                }
                l += __shfl_xor(l, 16); l += __shfl_xor(l, 32);
                il[jb] = __builtin_amdgcn_rcpf(l);
            }
            ATT_WAIT_BAR();
            AttnUnit un = u; bf16x8 nq[2][2];
#pragma unroll
            for (int jb = 0; jb < 2; ++jb) { nq[jb][0] = qf[jb][0]; nq[jb][1] = qf[jb][1]; }
            if (ui < UW - 1) {
                un = attn_decode(uidx + ui + 1);
                attn_dma<0>(lds0 + AT_A, Kg, un, wid, lane);
#pragma unroll
                for (int jb = 0; jb < 2; ++jb) { const bf16_t* qp = Qg + ((size_t)(un.b * NHEAD + un.h) * SEQ + (un.r0 + wid) * 64 + 32 * un.jh + 16 * jb + q) * HD + 8 * g; nq[jb][0] = *(const bf16x8*)qp; nq[jb][1] = *(const bf16x8*)(qp + 32); }
            }
#pragma unroll
            for (int jb = 0; jb < 2; ++jb) {
                const int o = 8 * jb, cq = 32 * u.jh + 16 * jb + q;
                f32x4 ov[4];
#pragma unroll
                for (int n = 0; n < 4; ++n) ov[n] = (f32x4){0.f, 0.f, 0.f, 0.f};
                {
                    const int qr = q >> 2, p = lane & 3;
                    const int fv = (((qr >> 1) & 1) << 1) | (((jb + g) & 1) << 2);
                    const LAS unsigned char* vb = lds + AT_B + (wbase * 40 + o + 8 * g + qr) * 128 + (p >> 1) * 16 + (p & 1) * 8;
                    const LAS unsigned char* vn[4];
#pragma unroll
                    for (int n = 0; n < 4; ++n) vn[n] = vb + ((2 * n) ^ fv) * 16;
#pragma unroll
                    for (int wl = 0; wl < 8; ++wl) {
                        const bf16x8 pf = __builtin_bit_cast(bf16x8, pw[jb][wl]);
#pragma unroll
                        for (int n = 0; n < 4; ++n) {
                            const s16x4 lo = __builtin_bit_cast(s16x4, __builtin_amdgcn_ds_read_tr16_b64_v4i16((LAS s16x4*)(vn[n] + wl * 5120)));
                            const s16x4 hi = __builtin_bit_cast(s16x4, __builtin_amdgcn_ds_read_tr16_b64_v4i16((LAS s16x4*)(vn[n] + wl * 5120 + 512)));
                            const bf16x8 vf = (bf16x8){lo[0], lo[1], lo[2], lo[3], hi[0], hi[1], hi[2], hi[3]};
                            ov[n] = __builtin_amdgcn_mfma_f32_16x16x32_bf16(vf, pf, ov[n], 0, 0, 0);
                        }
                    }
                }
                bf16_t* op = MIX + tl_off(u.b * SEQ + r * 64 + cq, u.h * HD + 4 * g, D);
#pragma unroll
                for (int n = 0; n < 4; ++n) { u32x2 w; w.x = cvt_pk_bf16(ov[n][0] * il[jb], ov[n][1] * il[jb]); w.y = cvt_pk_bf16(ov[n][2] * il[jb], ov[n][3] * il[jb]); *(u32x2*)(op + (n >> 1) * 512 + (n & 1) * 16) = w; }
            }
            ATT_WAIT_BAR();
            u = un;
#pragma unroll
            for (int jb = 0; jb < 2; ++jb) { qf[jb][0] = nq[jb][0]; qf[jb][1] = nq[jb][1]; }
        }
    }
}

__device__ __forceinline__ void up8(const u32x4 w, float (&v)[8]) {
    v[0] = bflo(w.x); v[1] = bfhi(w.x); v[2] = bflo(w.y); v[3] = bfhi(w.y); v[4] = bflo(w.z); v[5] = bfhi(w.z); v[6] = bflo(w.w); v[7] = bfhi(w.w);
}
__device__ __forceinline__ void pool_run(const bf16_t* __restrict__ Zg, bf16_t* __restrict__ MIX, int gw, int lane) {
    const int tb = 32 * gw, b = tb >> 12, t0 = tb & (SEQ - 1);
    const int half = 1 << (lane >> 4);
    const bf16_t* zb = Zg + (size_t)(b * SEQ) * NA + 8 * lane;
    bf16_t* ob = MIX + tl_off(b * SEQ, NA + 8 * lane, D);
    float S[8];
#pragma unroll
    for (int e = 0; e < 8; ++e) S[e] = 0.f;
    {   u32x4 w[16];
#pragma unroll
        for (int d = 0; d < 16; ++d) { int i = t0 + d - 8; i = i < 0 ? 0 : i; i = i > SEQ - 1 ? SEQ - 1 : i; w[d] = *(const u32x4*)(zb + (size_t)i * NA); }
#pragma unroll
        for (int d = 0; d < 16; ++d) { const int dd = d - 8, i = t0 + dd; const float mk = (dd >= -half && dd < half && i >= 0 && i < SEQ) ? 1.f : 0.f; float v[8]; up8(w[d], v);
#pragma unroll
            for (int e = 0; e < 8; ++e) S[e] += mk * v[e]; } }
    for (int c = 0; c < 4; ++c) {
        u32x4 zt[8], za[8], zs[8];
#pragma unroll
        for (int k = 0; k < 8; ++k) { const int t = t0 + 8 * c + k; int ia = t + half, is = t - half; ia = ia > SEQ - 1 ? SEQ - 1 : ia; is = is < 0 ? 0 : is;
            zt[k] = *(const u32x4*)(zb + (size_t)t * NA); za[k] = *(const u32x4*)(zb + (size_t)ia * NA); zs[k] = *(const u32x4*)(zb + (size_t)is * NA); }
#pragma unroll
        for (int k = 0; k < 8; ++k) { const int t = t0 + 8 * c + k;
            const int lo = (t - half) < 0 ? 0 : (t - half), hi = (t + half) > SEQ ? SEQ : (t + half);
            const float inv = 1.0f / (float)(hi - lo);
            float v[8]; up8(zt[k], v);
            u32x4 w;
            w.x = cvt_pk_bf16(S[0] * inv - v[0], S[1] * inv - v[1]); w.y = cvt_pk_bf16(S[2] * inv - v[2], S[3] * inv - v[3]);
            w.z = cvt_pk_bf16(S[4] * inv - v[4], S[5] * inv - v[5]); w.w = cvt_pk_bf16(S[6] * inv - v[6], S[7] * inv - v[7]);
            *(u32x4*)(ob + (size_t)(t >> 4) * (D / 32) * 512 + (t & 15) * 32) = w;
            const float ma = (t + half < SEQ) ? 1.f : 0.f, ms = (t - half >= 0) ? 1.f : 0.f;
            float a[8], s[8]; up8(za[k], a); up8(zs[k], s);
#pragma unroll
            for (int e = 0; e < 8; ++e) S[e] += ma * a[e] - ms * s[e]; }
    }
}

__device__ __forceinline__ void p2_mixer(Frame& F) {
    const bf16_t* Qg = F.QKVZ; const bf16_t* Kg = F.QKVZ + (size_t)M * NA; const bf16_t* Vg = F.QKVZ + 2 * (size_t)M * NA; const bf16_t* Zg = F.QKVZ + 3 * (size_t)M * NA;
    bf16_t* MIX = F.MIX;
    for (int gw = F.vcu * NWAVES + F.wave; gw < M / 32; gw += F.G * NWAVES) pool_run(Zg, MIX, gw, F.lane);
    p2_attention(F, Qg, Kg, Vg, MIX);
    __syncthreads();
}

struct Args { const float* in[13]; float* out; unsigned char* ws; int ph_lo, ph_hi, li, pad; };
__global__ void __launch_bounds__(NWAVES * 64, 2) fwd_megakernel(Args args) {
    extern __shared__ __attribute__((aligned(16))) unsigned char lds[];
    Frame F;
    F.lds = (LAS unsigned char*)lds;
    F.MISC = (volatile LAS unsigned*)(F.lds + MISC_OFF);
    F.tid = threadIdx.x; F.lane = F.tid & 63; F.wave = __builtin_amdgcn_readfirstlane(F.tid >> 6);
    F.G = gridDim.x; { const int bx = blockIdx.x; F.vcu = (F.G % 8 == 0) ? (bx % 8) * (F.G / 8) + bx / 8 : bx; }
    unsigned char* ws = args.ws;
    F.ctl = (gu32*)(ws + WS_CTL);
    F.x = args.in[0]; F.g1 = args.in[1]; F.w_in = args.in[2]; F.gq = args.in[3]; F.gk = args.in[4]; F.rpb = args.in[5]; F.w_pool = args.in[6];
    F.pscale = args.in[7]; F.w_out = args.in[8]; F.g2 = args.in[9]; F.w_gate = args.in[10]; F.w_up = args.in[11]; F.w_down = args.in[12]; F.out = args.out;
    F.Win_t = (bf16_t*)(ws + WS_WIN); F.Wout_t = (bf16_t*)(ws + WS_WOUT); F.Wgu_t = (bf16_t*)(ws + WS_WGU); F.Wdn_t = (bf16_t*)(ws + WS_WDN);
    F.XN = (bf16_t*)(ws + WS_XN); F.QKVZ = (bf16_t*)(ws + WS_QKVZ); F.XB = (bf16_t*)(ws + WS_XB); F.ACT = (bf16_t*)(ws + WS_ACT);
    F.ss = (float*)(ws + WS_CTL) + CW_SS; F.rrow = (float*)(ws + WS_CTL) + CW_SS + M; F.MIX = (bf16_t*)(ws + WS_ACT);
    for (int u = F.tid; u < (LDS_BYTES - LDSCTL_OFF) / 4; u += NWAVES * 64) ((LAS unsigned*)(F.lds + LDSCTL_OFF))[u] = 0u;
    __syncthreads();
    XcdBarrier bar; bar.bar = (unsigned*)(F.ctl + CW_BAR); bar.x = 0; bar.st = nullptr;
    if (N_LAUNCHES != PER_PHASE) bar = xcd_barrier_post((unsigned*)(F.ctl + CW_BAR), F.MISC + 8);
#define GRID_BAR() do { if (N_LAUNCHES != PER_PHASE) xcd_barrier(bar); } while (0)
    const int lo = args.ph_lo, hi = args.ph_hi;
#define IN(k) (lo <= (k) && (k) < hi)
#define BOTH(k) (IN(k) && IN((k) + 1))

    if (IN(0)) { p0_prologue(F); if (BOTH(0)) GRID_BAR(); }

    if (IN(1)) {
        pg8::Gemm g{F.XN, F.Win_t, M, NIN, D}; pg8::StaticOrder S; S.init(M, NIN, F.G, (int)blockIdx.x);
        { LAS float* gl = (LAS float*)(F.lds + LDS_GAIN_OFF);
          if (F.tid < 64) gl[F.tid] = F.gq[F.tid] * (0.125f * LOG2E); else if (F.tid < 128) gl[F.tid] = F.gk[F.tid - 64];
          __syncthreads(); }
        pg8::EpiIn E{F.QKVZ, (const LAS float*)(F.lds + LDS_GAIN_OFF)};
        pg8::gemm_phase<pg8::EpiIn, pg8::StaticOrder, true, PG8_SP2>(F.lds + RING_OFF, g, S, E);
        if (BOTH(1)) GRID_BAR();
    }

    if (IN(2)) { p2_mixer(F); if (BOTH(2)) GRID_BAR(); }

    if (IN(3)) {
        pg8::Gemm g{F.MIX, F.Wout_t, M, D, D}; pg8::StaticOrder S; S.init(M, D, F.G, (int)blockIdx.x);
        pg8::EpiOut E{F.XN, F.rrow, F.g1, F.XB, F.ss};
        pg8::gemm_phase<pg8::EpiOut, pg8::StaticOrder, true, PG8_SP2>(F.lds + RING_OFF, g, S, E);
        if (BOTH(3)) GRID_BAR();
    }

    if (IN(4)) {
        pg8::Gemm g{F.XB, F.Wgu_t, M, NGU, D}; pg8::RevOrder S; S.init(M, NGU, F.G, (int)blockIdx.x);
        pg8::EpiGU E{F.ACT, F.ss};
        pg8::gemm_phase<pg8::EpiGU, pg8::RevOrder, true, PG8_SP2>(F.lds + RING_OFF, g, S, E);
        if (BOTH(4)) GRID_BAR();
    }

    if (IN(5)) {
        pg8::Gemm g{F.ACT, F.Wdn_t, M, D, FF}; pg8::StaticOrder S; S.init(M, D, F.G, (int)blockIdx.x);
        pg8::EpiDown E{F.XB, F.out};
        pg8::gemm_phase<pg8::EpiDown, pg8::StaticOrder, true, PG8_SP2>(F.lds + RING_OFF, g, S, E);
    }
#undef IN
#undef BOTH
#undef GRID_BAR
}

extern "C" void kernel_launch(void* const* d_in, const int* in_sizes, int n_in, void* d_out, int out_size, void* d_ws, size_t ws_size, hipStream_t stream) {
    static int grid = 0;
    if (grid == 0) {
        if (n_in != 13 || in_sizes[0] != M * D || out_size != M * D || ws_size < WS_END) { fprintf(stderr, "kernel_launch: unexpected shapes (n_in %d, in0 %d, out %d, ws %zu); nothing launched\n", n_in, n_in > 0 ? in_sizes[0] : -1, out_size, ws_size); grid = -1; return; }
        int dev = 0, cus = 0, per_cu = 0;
        if (hipGetDevice(&dev) != hipSuccess || hipDeviceGetAttribute(&cus, hipDeviceAttributeMultiprocessorCount, dev) != hipSuccess) { fprintf(stderr, "kernel_launch: device query failed\n"); grid = -1; return; }
        if (hipFuncSetAttribute((const void*)fwd_megakernel, hipFuncAttributeMaxDynamicSharedMemorySize, LDS_BYTES) != hipSuccess) { fprintf(stderr, "kernel_launch: hipFuncSetAttribute failed\n"); grid = -1; return; }
        if (hipOccupancyMaxActiveBlocksPerMultiprocessor(&per_cu, (const void*)fwd_megakernel, NWAVES * 64, LDS_BYTES) != hipSuccess || per_cu < 1) {
            fprintf(stderr, "kernel_launch: occupancy query reports %d workgroups per CU; nothing launched\n", per_cu); (void)hipGetLastError(); grid = -1; return; }
        (void)hipGetLastError();
        grid = cus;
    }
    if (grid < 0) return;
    if (hipMemsetAsync((char*)d_ws + WS_CTL, 0, CTL_ZERO_BYTES, stream) != hipSuccess) { fprintf(stderr, "kernel_launch: hipMemsetAsync failed\n"); return; }
    Args a{};
    for (int i = 0; i < 13; ++i) a.in[i] = (const float*)d_in[i];
    a.out = (float*)d_out; a.ws = (unsigned char*)d_ws;
    for (int li = 0; li < N_LAUNCHES; ++li) {
        a.ph_lo = (N_LAUNCHES == PER_PHASE) ? li : 0; a.ph_hi = (N_LAUNCHES == PER_PHASE) ? li + 1 : PER_PHASE; a.li = li;
        hipLaunchKernelGGL(fwd_megakernel, dim3(grid), dim3(NWAVES * 64), LDS_BYTES, stream, a);
        const hipError_t le = hipPeekAtLastError();
        if (le != hipSuccess) { fprintf(stderr, "kernel_launch: launch %d failed: %s\n", li, hipGetErrorName(le)); break; }
    }
}
```

```cpp
#include <hip/hip_runtime.h>
#include <cstdio>
#include <cstdint>

#define LAS __attribute__((address_space(3)))
#define GAS __attribute__((address_space(1)))
typedef unsigned short bf16_t;
typedef short bf16x8 __attribute__((ext_vector_type(8)));
typedef short s16x4 __attribute__((ext_vector_type(4)));
typedef float f32x4 __attribute__((ext_vector_type(4)));
typedef float f32x2 __attribute__((ext_vector_type(2)));
typedef unsigned u32x4 __attribute__((ext_vector_type(4)));
typedef unsigned u32x2 __attribute__((ext_vector_type(2)));
constexpr int KMIX = 768;
typedef int i32x4 __attribute__((ext_vector_type(4)));
typedef int i32x8 __attribute__((ext_vector_type(8)));

constexpr int BATCH = 16, SEQ = 4096, D = 1024, M = BATCH * SEQ;
constexpr int NA = 512, NHEAD = 8, HD = 64, NIN = 2048, FF = 2816, NGU = 2 * FF;
constexpr float EPS = 1e-6f;
constexpr float LOG2E = 1.4426950408889634f;

__host__ __device__ __forceinline__ size_t tl_off(int row, int k, int K) { return ((((size_t)(row >> 4) * (size_t)(K >> 5)) + (size_t)(k >> 5)) << 9) + (size_t)((row & 15) * 32 + (k & 31)); }

__device__ __forceinline__ unsigned cvt_pk_bf16(float lo, float hi) { unsigned r; asm volatile("v_cvt_pk_bf16_f32 %0, %1, %2" : "=v"(r) : "v"(lo), "v"(hi)); return r; }

namespace pg8 {
constexpr int BM = 256, BK = 64, HALF = 128, HTB = HALF * BK * 2, STAGE_BYTES = 8 * HTB, NXCD = 8, WGM = 8;

__host__ __device__ __forceinline__ int lds_byte(int r, int c) { const int st = (r >> 4) * 2 + (c >> 5), rr = r & 15, cc = c & 31, ob = rr * 64 + cc * 2; return st * 1024 + (ob ^ (((ob >> 9) & 1) << 5)); }
__host__ __device__ __forceinline__ void stage_rc(int b, int& R, int& C) { const int st = b / 1024, sb = b % 1024, swz = sb ^ (((sb >> 9) & 1) << 5); R = (st >> 1) * 16 + swz / 64; C = (st & 1) * 32 + (swz % 64) / 2; }
__host__ __device__ __forceinline__ int perm32(int rho) { const int n = rho >> 4, i = rho & 15; return 8 * (i >> 2) + 4 * n + (i & 3); }

struct Unit { int pm, pn; };
struct Gemm { const bf16_t* A; const bf16_t* Bt; int M, N, K; unsigned sw8 = 0x7f7f7f7fu, sa8 = 0x7f7f7f7fu; };

struct StaticOrder {
    int nM, nN, nwg, G, c, wgm;
    __host__ __device__ void init(int M_, int N_, int G_, int c_, int wgm_ = WGM) { nM = M_ / BM; nN = N_ / BM; nwg = nM * nN; G = G_; c = c_; wgm = wgm_; }
    __host__ __device__ bool next(int i, Unit& u) const {
        const long L = (long)i * G + c; if (L >= nwg) return false;
        int wgid = (int)L; { const int q = nwg / NXCD, r = nwg % NXCD, xcd = wgid % NXCD, off = wgid / NXCD; wgid = (xcd < r ? xcd * (q + 1) : r * (q + 1) + (xcd - r) * q) + off; }
        const int nig = wgm * nN, gid = wgid / nig, fm = gid * wgm, gsz = (nM - fm) < wgm ? (nM - fm) : wgm;
        u.pm = fm + ((wgid % nig) % gsz); u.pn = (wgid % nig) / gsz; return true;
    }
    __device__ __forceinline__ void a_ready(const Unit&) const {}
    __device__ __forceinline__ void done(const Unit&) const {}
};

struct RevOrder : StaticOrder {
    __host__ __device__ bool next(int i, Unit& u) const { const bool ok = StaticOrder::next(i, u); if (ok) u.pm = nM - 1 - u.pm; return ok; }
};


struct EpiIn {
    static constexpr bool PERM = true, AFTER_DRAIN = false;
    bf16_t* QKVZ; const LAS float* gl; int pn0;
    __device__ __forceinline__ void operator()(const f32x4 (&acc)[2][2][4][2], const Unit& u, int wr, int wc, int fr, int fq) const {
        const int pn = u.pn + pn0, kind = pn >> 1;
        const int row0 = u.pm * BM + wr * 64 + fr;
        const int head = 4 * (pn & 1) + wc; const size_t rstride = kind < 3 ? HD : NA;
        bf16_t* base = QKVZ + (size_t)kind * ((size_t)M * NA) + 8 * fq
                     + (kind < 3 ? ((size_t)((row0 >> 12) * NHEAD + head) * SEQ + (row0 & (SEQ - 1))) * HD : (size_t)row0 * NA + head * HD);
        if (kind < 2) {
            const LAS float* g = gl + 64 * kind + 8 * fq;
            f32x4 gv[2][2];
#pragma unroll
            for (int bj = 0; bj < 2; ++bj)
#pragma unroll
                for (int n = 0; n < 2; ++n) gv[bj][n] = *(const LAS f32x4*)(g + 32 * bj + 4 * n);
            float ss[8];
#pragma unroll
            for (int i = 0; i < 8; ++i) { const int ai = i >> 2, m = i & 3; float a = 0.f;
#pragma unroll
                for (int bj = 0; bj < 2; ++bj)
#pragma unroll
                    for (int n = 0; n < 2; ++n) { const f32x4 v = acc[ai][bj][m][n]; a += (v[0] * v[0] + v[1] * v[1]) + (v[2] * v[2] + v[3] * v[3]); }
                ss[i] = a; }
#pragma unroll
            for (int i = 0; i < 8; ++i) ss[i] += __shfl_xor(ss[i], 16);
#pragma unroll
            for (int i = 0; i < 8; ++i) ss[i] += __shfl_xor(ss[i], 32);
#pragma unroll
            for (int i = 0; i < 8; ++i) { const int ai = i >> 2, m = i & 3;
                bf16_t* rowp = base + (size_t)(ai * HALF + m * 16) * rstride;
                const float r = __builtin_amdgcn_rsqf(ss[i] * (1.0f / 64.0f) + EPS);
#pragma unroll
                for (int bj = 0; bj < 2; ++bj) {
                    const f32x4 v0 = acc[ai][bj][m][0] * r * gv[bj][0], v1 = acc[ai][bj][m][1] * r * gv[bj][1];
                    u32x4 w; w.x = cvt_pk_bf16(v0[0], v0[1]); w.y = cvt_pk_bf16(v0[2], v0[3]); w.z = cvt_pk_bf16(v1[0], v1[1]); w.w = cvt_pk_bf16(v1[2], v1[3]);
                    *(u32x4*)(rowp + bj * 32) = w; }
            }
        } else {
#pragma unroll
            for (int ai = 0; ai < 2; ++ai)
#pragma unroll
                for (int m = 0; m < 4; ++m) {
                    bf16_t* rowp = base + (size_t)(ai * HALF + m * 16) * rstride;
#pragma unroll
                    for (int bj = 0; bj < 2; ++bj) {
                        const f32x4 v0 = acc[ai][bj][m][0], v1 = acc[ai][bj][m][1];
                        u32x4 w; w.x = cvt_pk_bf16(v0[0], v0[1]); w.y = cvt_pk_bf16(v0[2], v0[3]); w.z = cvt_pk_bf16(v1[0], v1[1]); w.w = cvt_pk_bf16(v1[2], v1[3]);
                        *(u32x4*)(rowp + bj * 32) = w; }
                }
        }
    }
};

struct EpiOut {
    static constexpr bool PERM = true, AFTER_DRAIN = false;
    const bf16_t* XN; const float* rrow; const float* g1; bf16_t* XB; float* ss;
    __device__ __forceinline__ void operator()(const f32x4 (&acc)[2][2][4][2], const Unit& u, int wr, int wc, int fr, int fq) const {
        const int row0 = u.pm * BM + wr * 64 + fr, col0 = u.pn * BM + wc * 32 + 8 * fq;
        const size_t off0 = (size_t)row0 * D + col0;
        const bf16_t* __restrict__ xp = XN + tl_off(row0, col0, D); bf16_t* __restrict__ bp = XB + tl_off(row0, col0, D);
        f32x4 gi[2][2];
#pragma unroll
        for (int bj = 0; bj < 2; ++bj)
#pragma unroll
            for (int n = 0; n < 2; ++n) { const f32x4 gv = *(const f32x4*)(g1 + col0 + bj * HALF + 4 * n);
                gi[bj][n] = (f32x4){__builtin_amdgcn_rcpf(gv[0]), __builtin_amdgcn_rcpf(gv[1]), __builtin_amdgcn_rcpf(gv[2]), __builtin_amdgcn_rcpf(gv[3])}; }
        u32x4 xa[8][2]; float rr[8], part[8];
#pragma unroll
        for (int i = 0; i < 8; ++i) rr[i] = rrow[row0 + (i >> 2) * HALF + (i & 3) * 16];
#define EO_LOAD(i) do { const size_t o_ = (size_t)((((i) >> 2) * 8 + ((i) & 3)) * (D / 32)) * 512; xa[i][0] = *(const u32x4*)(xp + o_); xa[i][1] = *(const u32x4*)(xp + o_ + 4 * 512); } while (0)
        EO_LOAD(0); EO_LOAD(1); EO_LOAD(2); EO_LOAD(3);
        asm volatile("" ::: "memory");
#pragma unroll
        for (int i = 0; i < 8; ++i) { const int ai = i >> 2, m = i & 3; const size_t o_ = (size_t)(ai * HALF + m * 16) * D; float p = 0.f;
#pragma unroll
            for (int bj = 0; bj < 2; ++bj) { const u32x4 w_ = xa[i][bj];
                const f32x4 x0 = {__builtin_bit_cast(float, w_.x << 16), __builtin_bit_cast(float, w_.x & 0xffff0000u), __builtin_bit_cast(float, w_.y << 16), __builtin_bit_cast(float, w_.y & 0xffff0000u)};
                const f32x4 x1 = {__builtin_bit_cast(float, w_.z << 16), __builtin_bit_cast(float, w_.z & 0xffff0000u), __builtin_bit_cast(float, w_.w << 16), __builtin_bit_cast(float, w_.w & 0xffff0000u)};
                const f32x4 v0 = acc[ai][bj][m][0] + x0 * (gi[bj][0] * rr[i]), v1 = acc[ai][bj][m][1] + x1 * (gi[bj][1] * rr[i]);
                u32x4 w; w.x = cvt_pk_bf16(v0[0], v0[1]); w.y = cvt_pk_bf16(v0[2], v0[3]); w.z = cvt_pk_bf16(v1[0], v1[1]); w.w = cvt_pk_bf16(v1[2], v1[3]);
                *(u32x4*)(bp + (size_t)((ai * 8 + m) * (D / 32) + 4 * bj) * 512) = w;
                p += (v0[0] * v0[0] + v0[1] * v0[1]) + (v0[2] * v0[2] + v0[3] * v0[3]) + (v1[0] * v1[0] + v1[1] * v1[1]) + (v1[2] * v1[2] + v1[3] * v1[3]); }
            part[i] = p;
            if (i + 4 < 8) { EO_LOAD((i + 4) & 7); }
            asm volatile("" ::: "memory"); }
#undef EO_LOAD
#pragma unroll
        for (int i = 0; i < 8; ++i) part[i] += __shfl_xor(part[i], 16);
#pragma unroll
        for (int i = 0; i < 8; ++i) part[i] += __shfl_xor(part[i], 32);
        if (fq == 0) {
#pragma unroll
            for (int i = 0; i < 8; ++i) atomicAdd(ss + row0 + (i >> 2) * HALF + (i & 3) * 16, part[i]);
        }
    }
};

struct EpiGU {
    static constexpr bool PERM = true, AFTER_DRAIN = false;
    bf16_t* ACT; const float* ss;
    __device__ __forceinline__ void operator()(const f32x4 (&acc)[2][2][4][2], const Unit& u, int wr, int wc, int fr, int fq) const {
        const int row0 = u.pm * BM + wr * 64 + fr, col0 = u.pn * HALF + wc * 32 + 8 * fq;
        float sv[8];
#pragma unroll
        for (int i = 0; i < 8; ++i) sv[i] = ss[row0 + (i >> 2) * HALF + (i & 3) * 16];
        asm volatile("" ::: "memory");
#pragma unroll
        for (int i = 0; i < 8; ++i) { const int ai = i >> 2, m = i & 3;
            const float rstd = __builtin_amdgcn_rsqf(sv[i] * (1.0f / (float)D) + EPS), ne = -LOG2E * rstd, r2 = rstd * rstd;
            unsigned w[4];
#pragma unroll
            for (int n = 0; n < 2; ++n)
#pragma unroll
                for (int h = 0; h < 2; ++h) {
                    const f32x2 g = {acc[ai][0][m][n][2 * h], acc[ai][0][m][n][2 * h + 1]}, up = {acc[ai][1][m][n][2 * h], acc[ai][1][m][n][2 * h + 1]};
                    const f32x2 t = g * ne; f32x2 e; e.x = __builtin_amdgcn_exp2f(t.x); e.y = __builtin_amdgcn_exp2f(t.y);
                    const f32x2 d = e + 1.0f; f32x2 r; r.x = __builtin_amdgcn_rcpf(d.x); r.y = __builtin_amdgcn_rcpf(d.y);
                    const f32x2 a = (g * up) * (r * r2);
                    w[2 * n + h] = cvt_pk_bf16(a.x, a.y); }
            *(u32x4*)(ACT + tl_off(row0 + ai * HALF + m * 16, col0, FF)) = (u32x4){w[0], w[1], w[2], w[3]};
        }
    }
};

struct EpiDown {
    static constexpr bool PERM = true, AFTER_DRAIN = false;
    const bf16_t* XB; float* out;
    __device__ __forceinline__ void operator()(const f32x4 (&acc)[2][2][4][2], const Unit& u, int wr, int wc, int fr, int fq) const {
        const int row0 = u.pm * BM + wr * 64 + fr, col0 = u.pn * BM + wc * 32 + 8 * fq;
        const size_t off0 = (size_t)row0 * D + col0;
        const bf16_t* __restrict__ bp = XB + tl_off(row0, col0, D); float* __restrict__ op = out + off0;
        u32x4 xa[8][2];
#define ED_LOAD(i) do { const size_t o_ = (size_t)((((i) >> 2) * 8 + ((i) & 3)) * (D / 32)) * 512; xa[i][0] = *(const u32x4*)(bp + o_); xa[i][1] = *(const u32x4*)(bp + o_ + 4 * 512); } while (0)
        ED_LOAD(0); ED_LOAD(1); ED_LOAD(2); ED_LOAD(3);
        asm volatile("" ::: "memory");
#pragma unroll
        for (int i = 0; i < 8; ++i) { const int ai = i >> 2, m = i & 3; const size_t o_ = (size_t)(ai * HALF + m * 16) * D;
#pragma unroll
            for (int bj = 0; bj < 2; ++bj) { const u32x4 w = xa[i][bj];
                const f32x4 r0 = {__builtin_bit_cast(float, w.x << 16), __builtin_bit_cast(float, w.x & 0xffff0000u), __builtin_bit_cast(float, w.y << 16), __builtin_bit_cast(float, w.y & 0xffff0000u)};
                const f32x4 r1 = {__builtin_bit_cast(float, w.z << 16), __builtin_bit_cast(float, w.z & 0xffff0000u), __builtin_bit_cast(float, w.w << 16), __builtin_bit_cast(float, w.w & 0xffff0000u)};
                *(f32x4*)(op + o_ + bj * HALF) = acc[ai][bj][m][0] + r0; *(f32x4*)(op + o_ + bj * HALF + 4) = acc[ai][bj][m][1] + r1; }
            if (i + 4 < 8) { ED_LOAD((i + 4) & 7); }
            asm volatile("" ::: "memory"); }
#undef ED_LOAD
    }
};

constexpr int ALL8 = 1 << 20;
template <class Epi, class Sched, bool ALIGN_EPI = false, bool SP2 = false, bool A_TILED = true, int NT8 = 0>
__device__ __forceinline__ void gemm_phase(LAS unsigned char* lds, const Gemm g, const Sched& S, const Epi& E) {
    static_assert(SP2, "only the two-MMA-blocks-per-barrier schedule is kept");
    int tid_ = threadIdx.x; asm volatile("" : "+v"(tid_));
    const int tid = tid_, wid = __builtin_amdgcn_readfirstlane(tid >> 6), lane = tid & 63, wr = wid >> 2, wc = wid & 3, fr = lane & 15, fq = lane >> 4;
    const int K = g.K, nt = K / BK;
    unsigned voffA[2], voffB[2];
#pragma unroll
    for (int i = 0; i < 2; ++i) { int R, C; stage_rc(tid * 16 + i * 8192, R, C); const int Rb = Epi::PERM ? ((R & ~31) + perm32(R & 31)) : R;
        voffA[i] = A_TILED ? (unsigned)tl_off(R, C, K) * 2u : (unsigned)(R * K + C) * 2u; voffB[i] = (unsigned)tl_off(Rb, C, K) * 2u; }
    const size_t kstepA = A_TILED ? (size_t)2048 : (size_t)(BK * 2), kstepB = 2048;
    const size_t hstep = (size_t)HALF * K * 2;
    const size_t tstep = 2 * hstep;
    const unsigned ldsw = (unsigned)wid * 1024u;
    const int aoff = lds_byte(wr * 64 + fr, fq * 8), boff = lds_byte(wc * 32 + fr, fq * 8);
#define PG8_SA(b, h) (((b) * 2 + (h)) * HTB)
#define PG8_SB(b, h) ((4 + (b) * 2 + (h)) * HTB)
#define PG8_STAGE(bufoff, gbase, voff) do { _Pragma("unroll") for (int _i = 0; _i < 2; ++_i) \
        __builtin_amdgcn_global_load_lds((const unsigned*)((const char*)(gbase) + (voff)[_i]), (LAS unsigned*)(lds + (bufoff) + ldsw + _i * 8192), 16, 0, 0); } while (0)
#define PG8_LDA(dst, b, h) do { _Pragma("unroll") for (int m = 0; m < 4; ++m) _Pragma("unroll") for (int k = 0; k < 2; ++k) dst[m][k] = *(const LAS bf16x8*)(lds + PG8_SA(b, h) + aoff + m * 2048 + k * 1024); } while (0)
#define PG8_LDB(dst, b, h) do { _Pragma("unroll") for (int n = 0; n < 2; ++n) _Pragma("unroll") for (int k = 0; k < 2; ++k) dst[n][k] = *(const LAS bf16x8*)(lds + PG8_SB(b, h) + boff + n * 2048 + k * 1024); } while (0)
#define PG8_CAT8(lo, hi) __builtin_shufflevector(__builtin_bit_cast(i32x4, lo), __builtin_bit_cast(i32x4, hi), 0, 1, 2, 3, 4, 5, 6, 7)
#define PG8_MMA(F8, ai, bj, At, Bt) do { __builtin_amdgcn_s_setprio(1); \
        if constexpr (F8) { _Pragma("unroll") for (int m = 0; m < 4; ++m) _Pragma("unroll") for (int n = 0; n < 2; ++n) \
            asm volatile("v_mfma_scale_f32_16x16x128_f8f6f4 %0, %1, %2, %0, %3, %4 op_sel_hi:[0,0,0]" : "+v"(acc[ai][bj][m][n]) : "v"(PG8_CAT8(Bt[n][0], Bt[n][1])), "v"(PG8_CAT8(At[m][0], At[m][1])), "v"(sc8w), "v"(sc8a)); } \
        else { _Pragma("unroll") for (int m = 0; m < 4; ++m) _Pragma("unroll") for (int n = 0; n < 2; ++n) _Pragma("unroll") for (int k = 0; k < 2; ++k) \
            acc[ai][bj][m][n] = __builtin_amdgcn_mfma_f32_16x16x32_bf16(Bt[n][k], At[m][k], acc[ai][bj][m][n], 0, 0, 0); } \
        __builtin_amdgcn_s_setprio(0); } while (0)
#define PG8_WAIT_V(n) asm volatile("s_waitcnt vmcnt(" #n ")" ::: "memory")
#define PG8_WAIT_L(n) asm volatile("s_waitcnt lgkmcnt(" #n ")" ::: "memory")
#define PG8_BAR __builtin_amdgcn_s_barrier()
#define PG8_SCHED __builtin_amdgcn_sched_barrier(0)
    const unsigned sc8w = g.sw8, sc8a = g.sa8;
    Unit cur, nxt; int ui = 0;
    if (!S.next(0, cur)) return;
    f32x4 acc[2][2][4][2];
#pragma unroll
    for (int a = 0; a < 2; ++a)
#pragma unroll
        for (int b = 0; b < 2; ++b)
#pragma unroll
            for (int m = 0; m < 4; ++m)
#pragma unroll
                for (int n = 0; n < 2; ++n) acc[a][b][m][n] = (f32x4){0.f, 0.f, 0.f, 0.f};
    bf16x8 At[4][2], B0[2][2], B1[2][2];
    const char* cA = (const char*)g.A + (size_t)cur.pm * tstep; const char* cB = (const char*)g.Bt + (size_t)cur.pn * tstep;
    S.a_ready(cur);
    PG8_STAGE(PG8_SB(0, 0), cB, voffB); PG8_STAGE(PG8_SB(0, 1), cB + hstep, voffB); PG8_STAGE(PG8_SA(0, 0), cA, voffA); PG8_STAGE(PG8_SA(0, 1), cA + hstep, voffA);
    if (wr == 1) PG8_BAR;
    PG8_WAIT_V(2); PG8_BAR;
    PG8_STAGE(PG8_SB(1, 0), cB + kstepB, voffB); PG8_STAGE(PG8_SA(1, 0), cA + kstepA, voffA); PG8_STAGE(PG8_SB(1, 1), cB + hstep + kstepB, voffB);
    PG8_WAIT_V(6); PG8_BAR;
    for (;;) {
        const bool has_next = S.next(ui + 1, nxt);
        const char* nA = has_next ? (const char*)g.A + (size_t)nxt.pm * tstep : cA; const char* nB = has_next ? (const char*)g.Bt + (size_t)nxt.pn * tstep : cB;
#define PG8_ITER(F8) { \
            const bool last = (t == nt - 2); \
            const char* a1 = cA + (size_t)(t + 1) * kstepA; \
            const char* a2 = last ? nA : cA + (size_t)(t + 2) * kstepA; const char* b2 = last ? nB : cB + (size_t)(t + 2) * kstepB; \
            const char* a3 = a2 + kstepA; const char* b3 = b2 + kstepB; \
            if (last && has_next) S.a_ready(nxt); \
            PG8_LDB(B0, 0, 0); PG8_LDB(B1, 0, 1); PG8_SCHED; PG8_LDA(At, 0, 0); PG8_STAGE(PG8_SA(1, 1), a1 + hstep, voffA); \
            PG8_WAIT_V(8); PG8_WAIT_L(0); PG8_BAR; PG8_MMA(F8, 0, 0, At, B0); PG8_MMA(F8, 0, 1, At, B1); PG8_BAR; PG8_SCHED; \
            PG8_LDA(At, 0, 1); PG8_STAGE(PG8_SB(0, 0), b2, voffB); PG8_STAGE(PG8_SB(0, 1), b2 + hstep, voffB); PG8_STAGE(PG8_SA(0, 0), a2, voffA); \
            PG8_WAIT_V(8); PG8_WAIT_L(0); PG8_BAR; PG8_MMA(F8, 1, 0, At, B0); PG8_MMA(F8, 1, 1, At, B1); PG8_BAR; PG8_SCHED; \
            PG8_LDB(B0, 1, 0); PG8_LDB(B1, 1, 1); PG8_SCHED; PG8_LDA(At, 1, 0); PG8_STAGE(PG8_SA(0, 1), a2 + hstep, voffA); \
            PG8_WAIT_V(8); PG8_WAIT_L(0); PG8_BAR; PG8_MMA(F8, 0, 0, At, B0); PG8_MMA(F8, 0, 1, At, B1); PG8_BAR; PG8_SCHED; \
            PG8_LDA(At, 1, 1); PG8_STAGE(PG8_SB(1, 0), b3, voffB); PG8_STAGE(PG8_SB(1, 1), b3 + hstep, voffB); PG8_STAGE(PG8_SA(1, 0), a3, voffA); \
            PG8_WAIT_V(8); PG8_WAIT_L(0); PG8_BAR; PG8_MMA(F8, 1, 0, At, B0); PG8_MMA(F8, 1, 1, At, B1); PG8_BAR; PG8_SCHED; }
        int t = 0;
        if constexpr (NT8 > 0) { const int nt8 = NT8 < nt ? NT8 : nt;
            _Pragma("nounroll") for (; t < nt8; t += 2) PG8_ITER(true)
            if constexpr (NT8 < ALL8) asm volatile("s_nop 15\n\ts_nop 15" ::: "memory"); }
        if constexpr (NT8 < ALL8) {
            _Pragma("nounroll") for (; t < nt; t += 2) PG8_ITER(false) }
        if constexpr (NT8 > 0) asm volatile("s_nop 15\n\ts_nop 15\n\ts_nop 15" ::: "memory");
        if constexpr (ALIGN_EPI) { if (wr == 0) PG8_BAR; }
        if constexpr (!Epi::AFTER_DRAIN) { E(acc, cur, wr, wc, fr, fq); S.done(cur); }
        if (!has_next) break;
#pragma unroll
        for (int a = 0; a < 2; ++a)
#pragma unroll
            for (int b = 0; b < 2; ++b)
#pragma unroll
                for (int m = 0; m < 4; ++m)
#pragma unroll
                    for (int n = 0; n < 2; ++n) acc[a][b][m][n] = (f32x4){0.f, 0.f, 0.f, 0.f};
        cur = nxt; cA = nA; cB = nB; ++ui;
        if constexpr (ALIGN_EPI) { if (wr == 1) PG8_BAR; }
    }
    PG8_WAIT_V(0);
    if constexpr (!ALIGN_EPI) { if (wr == 0) PG8_BAR; }
    PG8_BAR;
#undef PG8_SA
#undef PG8_SB
#undef PG8_STAGE
#undef PG8_LDA
#undef PG8_LDB
#undef PG8_MMA
#undef PG8_ITER
#undef PG8_CAT8
#undef PG8_WAIT_V
#undef PG8_WAIT_L
#undef PG8_BAR
#undef PG8_SCHED
}
}

constexpr int NWAVES = 8;
#ifndef MK_N_LAUNCHES
#define MK_N_LAUNCHES 1
#endif
constexpr int N_LAUNCHES = MK_N_LAUNCHES;
constexpr int PER_PHASE = 6;
#ifndef PG8_SP2
#define PG8_SP2 true
#endif

constexpr size_t MiB = 1u << 20;
constexpr size_t WS_CTL = 0, CTL_ZERO_BYTES = 1 * MiB;
constexpr size_t WS_WIN = 2 * MiB;
constexpr size_t WS_WOUT = 6 * MiB;
constexpr size_t WS_WGU = 8 * MiB;
constexpr size_t WS_WDN = 20 * MiB;
constexpr size_t WS_XN = 32 * MiB;
constexpr size_t WS_QKVZ = 160 * MiB;
constexpr size_t WS_ACT = 416 * MiB;
constexpr size_t WS_XB = 768 * MiB;
constexpr size_t WS_XN8 = 896 * MiB;
constexpr size_t WS_WIN8 = 960 * MiB;
constexpr size_t WS_END = 962 * MiB;
static_assert(WS_WGU + (size_t)NGU * D * 2 <= WS_WDN && WS_WDN + (size_t)D * FF * 2 <= WS_XN && WS_ACT + (size_t)M * FF * 2 <= WS_END, "d_ws map");
constexpr int CW_BAR = 4096;
constexpr int CW_SS = 65536;
static_assert((size_t)(CW_SS + 2 * M) * 4 <= CTL_ZERO_BYTES, "ss, rrow inside the control region");

constexpr int RING_OFF = 0, RING_BYTES = 131072;
constexpr int LDSCTL_OFF = 157696, MISC_OFF = LDSCTL_OFF + 320;
constexpr int LDS_GAIN_OFF = LDSCTL_OFF + 512;
constexpr int LDS_BYTES = 163840;

typedef GAS unsigned gu32;
#define RLX_AGENT __ATOMIC_RELAXED, __HIP_MEMORY_SCOPE_AGENT
#define LDS_WAIT() asm volatile("s_waitcnt lgkmcnt(0)" ::: "memory")
__device__ __forceinline__ unsigned f2bf(float f) { unsigned u = __builtin_bit_cast(unsigned, f); return (u + 0x7fffu + ((u >> 16) & 1u)) >> 16; }
__device__ __forceinline__ unsigned pk2(float lo, float hi) { return f2bf(lo) | (f2bf(hi) << 16); }
__device__ __forceinline__ float bflo(unsigned w) { return __builtin_bit_cast(float, w << 16); }
__device__ __forceinline__ float bfhi(unsigned w) { return __builtin_bit_cast(float, w & 0xffff0000u); }

#define XB_TMO      128
#define XB_XCNT(j)  (256  + 64 * (j))
#define XB_XSUB(j)  (1280 + 64 * (j))
#define XB_XGEN(j)  (2304 + 64 * (j))
#define XB_TOP      3328
#define XB_TOPGEN   3392
#define XCD_BAR_WORDS 3456
#define XB_SPIN_CAP (1u << 18)

__device__ __forceinline__ unsigned xb_ld(unsigned* p)              { return __hip_atomic_load(p, __ATOMIC_RELAXED, __HIP_MEMORY_SCOPE_AGENT); }
__device__ __forceinline__ unsigned xb_add(unsigned* p, unsigned v) { return __hip_atomic_fetch_add(p, v, __ATOMIC_RELAXED, __HIP_MEMORY_SCOPE_AGENT); }
__device__ __forceinline__ unsigned xb_xcc_id() { return (unsigned)__builtin_amdgcn_s_getreg((3 << 11) | 20) & 0xFu; }
#define XB_SPIN(cond, bar) do { unsigned _sp = 0; while (cond) { __builtin_amdgcn_s_sleep(1); \
    if ((++_sp & 255u) == 0u) { if (xb_ld(&(bar)[XB_TMO])) break; if (_sp > XB_SPIN_CAP) { atomicAdd(&(bar)[XB_TMO], 1u); break; } } } } while (0)

struct XcdBarrier { unsigned* bar; unsigned x; volatile LAS unsigned* st; };

__device__ __forceinline__ XcdBarrier xcd_barrier_post(unsigned* bar, volatile LAS unsigned* st) {
    XcdBarrier b; b.bar = bar; b.x = xb_xcc_id(); b.st = st;
    if (threadIdx.x == 0) (void)xb_add(&bar[XB_XCNT(b.x)], 1u);
    return b;
}
__device__ __forceinline__ void xcd_barrier_complete(unsigned* bar, unsigned x, unsigned& nloc, unsigned& nx) {
    const unsigned G = gridDim.x * gridDim.y * gridDim.z;
    unsigned sum, cnt, mine, sp = 0u;
    for (;;) {
        sum = 0u; cnt = 0u; mine = 0u;
#pragma unroll
        for (unsigned j = 0; j < 16; ++j) { const unsigned c = xb_ld(&bar[XB_XCNT(j)]); sum += c; cnt += (c > 0u) ? 1u : 0u; mine = (j == x) ? c : mine; }
        if (sum == G) break;
        __builtin_amdgcn_s_sleep(1);
        if ((++sp & 255u) == 0u) { if (xb_ld(&bar[XB_TMO])) break; if (sp > XB_SPIN_CAP) { atomicAdd(&bar[XB_TMO], 1u); break; } }
    }
    nloc = mine > 0u ? mine : 1u; nx = cnt > 0u ? cnt : 1u;
}
__device__ __forceinline__ void xcd_barrier(const XcdBarrier& b) {
    asm volatile("s_waitcnt vmcnt(0)" ::: "memory");
    __syncthreads();
    if (threadIdx.x == 0) {
        unsigned* bar = b.bar;
        __builtin_amdgcn_s_waitcnt(0);
        unsigned nloc = b.st[0], nx = b.st[1];
        if (nloc == 0u) { xcd_barrier_complete(bar, b.x, nloc, nx); b.st[0] = nloc; b.st[1] = nx; }
        const unsigned old = xb_add(&bar[XB_XSUB(b.x)], 1u);
        const unsigned gen = old / nloc;
        if (old + 1u == (gen + 1u) * nloc) {
            __builtin_amdgcn_fence(__ATOMIC_RELEASE, "agent");
            asm volatile("s_waitcnt vmcnt(0)" ::: "memory");
            const unsigned og = xb_add(&bar[XB_TOP], 1u);
            const unsigned tg = og / nx;
            if (og + 1u == (tg + 1u) * nx) xb_add(&bar[XB_TOPGEN], 1u);
            else XB_SPIN(xb_ld(&bar[XB_TOPGEN]) == tg, bar);
            __builtin_amdgcn_fence(__ATOMIC_ACQUIRE, "agent");
            xb_add(&bar[XB_XGEN(b.x)], 1u);
            asm volatile("s_waitcnt vmcnt(0)" ::: "memory");
        } else {
            XB_SPIN(xb_ld(&bar[XB_XGEN(b.x)]) == gen, bar);
            __builtin_amdgcn_fence(__ATOMIC_ACQUIRE, "agent");
            asm volatile("s_waitcnt vmcnt(0)" ::: "memory");
        }
    }
    __syncthreads();
}

struct Frame {
    LAS unsigned char* lds;
    volatile LAS unsigned* MISC;
    gu32* ctl;
    int tid, lane, wave;
    int vcu, G;
    const float *x, *g1, *w_in, *gq, *gk, *rpb, *w_pool, *pscale, *w_out, *g2, *w_gate, *w_up, *w_down;
    float* out;
    bf16_t *Win_t, *Wout_t, *Wgu_t, *Wdn_t;
    bf16_t *XN, *QKVZ, *XB, *ACT;
    unsigned char *XN8, *Win8;
    float* ss; float* rrow; bf16_t* MIX;
};

__device__ __forceinline__ float wave_sum(float v) {
#pragma unroll
    for (int o = 1; o < 64; o <<= 1) v += __shfl_xor(v, o);
    return v;
}

__device__ __forceinline__ void p0_tile_out(bf16_t* WT, int K, int drow0, int k0, LAS float* scr, int lane) {
    LDS_WAIT(); asm volatile("" ::: "memory");
    const int c = lane & 7;
#pragma unroll
    for (int j = 0; j < 4; ++j) { const int n = (lane >> 3) + 8 * j; const LAS float* s = scr + (8 * c) * 33 + n;
        u32x4 o; o.x = pk2(s[0 * 33], s[1 * 33]); o.y = pk2(s[2 * 33], s[3 * 33]); o.z = pk2(s[4 * 33], s[5 * 33]); o.w = pk2(s[6 * 33], s[7 * 33]);
        *(GAS u32x4*)(WT + tl_off(drow0 + n, k0 + 8 * c, K)) = o; }
    LDS_WAIT(); asm volatile("" ::: "memory");
}
__device__ __forceinline__ unsigned pk4_fp8(float a, float b, float c, float d) {
    unsigned w = 0; w = (unsigned)__builtin_amdgcn_cvt_pk_fp8_f32(a, b, (int)w, false); w = (unsigned)__builtin_amdgcn_cvt_pk_fp8_f32(c, d, (int)w, true); return w; }
__device__ __forceinline__ size_t tl8_off(int row, int k, int K) { return (size_t)tl_off(row, k >> 1, K >> 1) * 2 + (k & 1); }
__device__ __forceinline__ void p0_tile_out8(unsigned char* W8, int K, int drow0, int k0, LAS float* scr, int lane) {
    LDS_WAIT(); asm volatile("" ::: "memory");
    const int c = lane & 7;
#pragma unroll
    for (int j = 0; j < 4; ++j) { const int n = (lane >> 3) + 8 * j; const LAS float* s = scr + (8 * c) * 33 + n;
        u32x2 o; o.x = pk4_fp8(32.f * s[0 * 33], 32.f * s[1 * 33], 32.f * s[2 * 33], 32.f * s[3 * 33]); o.y = pk4_fp8(32.f * s[4 * 33], 32.f * s[5 * 33], 32.f * s[6 * 33], 32.f * s[7 * 33]);
        *(GAS u32x2*)(W8 + tl8_off(drow0 + n, k0 + 8 * c, K)) = o; }
    LDS_WAIT(); asm volatile("" ::: "memory");
}
__device__ __forceinline__ void p0_transpose_item(const float* W, int ldw, int K, int k0, int n0, const float* gkv, bf16_t* WT, int drow0, LAS float* scr, int lane) {
#pragma unroll
    for (int i = 0; i < 32; ++i) { const int kk = 2 * i + (lane >> 5); float v = W[(size_t)(k0 + kk) * ldw + n0 + (lane & 31)]; if (gkv) v *= gkv[k0 + kk]; scr[kk * 33 + (lane & 31)] = v; }
    p0_tile_out(WT, K, drow0, k0, scr, lane);
}
__device__ __forceinline__ void p0_fold_item(const float* w_in, const float* w_pool, const float* pscale, int k0, int n0z, bf16_t* WT, int drow0, int lane) {
    const int n = lane & 31, kh = lane >> 5, g = n0z >> 7, d = (n0z & 127) + n;
    float acc[4] = {0.f, 0.f, 0.f, 0.f};
    const float* wrow = w_in + (size_t)(k0 + 4 * kh) * NIN + 3 * NA + 128 * g;
    const float* wp = w_pool + (size_t)g * 128 * 128 + d;
#pragma unroll 8
    for (int c4 = 0; c4 < 32; ++c4) {
        const float p0 = wp[(4 * c4 + 0) * 128], p1 = wp[(4 * c4 + 1) * 128], p2 = wp[(4 * c4 + 2) * 128], p3 = wp[(4 * c4 + 3) * 128];
#pragma unroll
        for (int i = 0; i < 4; ++i) { const f32x4 w = *(const f32x4*)(wrow + (size_t)i * NIN + 4 * c4); acc[i] += (w[0] * p0 + w[1] * p1) + (w[2] * p2 + w[3] * p3); }
    }
    const float ps = pscale[n0z + n];
    float hi[4];
#pragma unroll
    for (int i = 0; i < 4; ++i) { acc[i] *= ps; hi[i] = __shfl(acc[i], (lane + 32) & 63); }
    if (lane < 32) { u32x4 o; o.x = pk2(acc[0], acc[1]); o.y = pk2(acc[2], acc[3]); o.z = pk2(hi[0], hi[1]); o.w = pk2(hi[2], hi[3]);
        *(GAS u32x4*)(WT + tl_off(drow0 + n, k0, D)) = o; }
}
__device__ __forceinline__ int win_drow(int n0) { const int pn = n0 >> 8, c = n0 & 255; return 256 * pn + 128 * ((c >> 5) & 1) + 32 * (c >> 6); }

template <int R> __device__ __forceinline__ void rms_rows(const float* x, const f32x4 (&gg)[4], bf16_t* XN, unsigned char* XN8, float* rrow, int m0, int lane) {
    f32x4 v[R][4]; float s[R];
#pragma unroll
    for (int r = 0; r < R; ++r) { const GAS f32x4* xr = (const GAS f32x4*)(x + (size_t)(m0 + r) * D) + lane;
#pragma unroll
        for (int j = 0; j < 4; ++j) v[r][j] = xr[64 * j]; }
#pragma unroll
    for (int r = 0; r < R; ++r) { float a = 0.f;
#pragma unroll
        for (int j = 0; j < 4; ++j) a += (v[r][j].x * v[r][j].x + v[r][j].y * v[r][j].y) + (v[r][j].z * v[r][j].z + v[r][j].w * v[r][j].w);
        s[r] = a; }
#pragma unroll
    for (int o = 1; o < 64; o <<= 1) {
#pragma unroll
        for (int r = 0; r < R; ++r) s[r] += __shfl_xor(s[r], o); }
#pragma unroll
    for (int r = 0; r < R; ++r) { const float ms = s[r] * (1.f / D) + EPS, rstd = __builtin_amdgcn_rsqf(ms);
        if (lane == 0) rrow[m0 + r] = ms * rstd;
        bf16_t* orow = XN + tl_off(m0 + r, 4 * lane, D);
#pragma unroll
        for (int j = 0; j < 4; ++j) *(GAS unsigned long long*)(orow + (size_t)j * 8 * 512) = (unsigned long long)pk2(v[r][j].x * rstd * gg[j].x, v[r][j].y * rstd * gg[j].y) | ((unsigned long long)pk2(v[r][j].z * rstd * gg[j].z, v[r][j].w * rstd * gg[j].w) << 32);
        unsigned char* orow8 = XN8 + tl8_off(m0 + r, 4 * lane, D);
#pragma unroll
        for (int j = 0; j < 4; ++j) *(GAS unsigned*)(orow8 + (size_t)j * 4 * 1024) = pk4_fp8(v[r][j].x * rstd * gg[j].x, v[r][j].y * rstd * gg[j].y, v[r][j].z * rstd * gg[j].z, v[r][j].w * rstd * gg[j].w); }
}

struct P0Item { const float* W; const float* gk; bf16_t* WT; unsigned char* W8; int ldw, K, k0, n0, drow0, ko; };
__device__ __forceinline__ void p0_prologue(Frame& F) {
    LAS float* scr = (LAS float*)(F.lds + RING_OFF + F.wave * 16384);
    const int gw = F.vcu * NWAVES + F.wave, NGW = F.G * NWAVES, lane = F.lane;
    constexpr int KB = D / 64;
    constexpr int I_QKV = KB * (3 * NA / 32), I_O = KB * (D / 32), I_G = KB * (FF / 32), I_DN = (FF / 64) * (D / 32);
    constexpr int NITEMS = I_QKV + I_O + 2 * I_G + I_DN;
    for (int it = gw; it < (D / 8) * (NA / 32); it += NGW) { const int nb = it & 15, kb = it >> 4; p0_fold_item(F.w_in, F.w_pool, F.pscale, 8 * kb, 32 * nb, F.Win_t, win_drow(3 * NA + 32 * nb), lane); }
    f32x4 gg[4];
#pragma unroll
    for (int j = 0; j < 4; ++j) gg[j] = *((const f32x4*)F.g1 + lane + 64 * j);
    const int RPW = (M + F.G - 1) / F.G, rbeg = F.vcu * RPW, rend = (rbeg + RPW) < M ? (rbeg + RPW) : M, nb8 = (rend - rbeg) / 8;
    volatile LAS unsigned* tick = F.MISC + 16;
    int it = gw; bool rows_left = true;
    while (it < NITEMS || rows_left) {
        const bool has_item = it < NITEMS; P0Item I{};
        if (has_item) {
            int r = it;
            if (r < I_QKV) { const int nb = r % (3 * NA / 32), kb = r / (3 * NA / 32); I = P0Item{F.w_in, nullptr, nullptr, F.Win8, NIN, D, 64 * kb, 32 * nb, win_drow(32 * nb), 64 * kb}; }
            else if ((r -= I_QKV) < I_O) { const int nb = r % (D / 32), kb = r / (D / 32); I = kb < 8 ? P0Item{F.w_out, nullptr, nullptr, (unsigned char*)F.Wout_t, D, 2 * KMIX, 64 * kb, 32 * nb, 32 * nb, 64 * kb}
                                                                                                   : P0Item{F.w_out, nullptr, F.Wout_t, nullptr, D, KMIX, 64 * kb, 32 * nb, 32 * nb, 64 * kb - 256}; }
            else if ((r -= I_O) < 2 * I_G) { const int up = r >= I_G; if (up) r -= I_G; const int nb = r % (FF / 32), kb = r / (FF / 32), n0 = 32 * nb;
                I = P0Item{up ? F.w_up : F.w_gate, F.g2, F.Wgu_t, nullptr, FF, D, 64 * kb, n0, 256 * (n0 >> 7) + (n0 & 127) + 128 * up, 64 * kb}; }
            else { r -= 2 * I_G; const int nb = r % (D / 32), kb = r / (D / 32); I = P0Item{F.w_down, nullptr, F.Wdn_t, nullptr, D, FF, 64 * kb, 32 * nb, 32 * nb, 64 * kb}; }
        }
        float wv[32];
        if (has_item) {
#pragma unroll
            for (int i = 0; i < 32; ++i) { const int kk = 2 * i + (lane >> 5); wv[i] = I.W[(size_t)(I.k0 + kk) * I.ldw + I.n0 + (lane & 31)]; }
        }
        int m0 = 0;
        if (rows_left) { unsigned t = 0; if (lane == 0) t = __hip_atomic_fetch_add((LAS unsigned*)tick, 1u, __ATOMIC_RELAXED, __HIP_MEMORY_SCOPE_WORKGROUP);
            t = __builtin_amdgcn_readfirstlane(t); rows_left = (int)t < nb8; m0 = rbeg + 8 * (int)t; }
        f32x4 v[8][4];
        if (rows_left) {
#pragma unroll
            for (int r = 0; r < 8; ++r) { const GAS f32x4* xr = (const GAS f32x4*)(F.x + (size_t)(m0 + r) * D) + lane;
#pragma unroll
                for (int j = 0; j < 4; ++j) v[r][j] = xr[64 * j]; }
        }
        if (has_item) {
            if (I.gk) {
#pragma unroll
                for (int i = 0; i < 32; ++i) wv[i] *= I.gk[I.k0 + 2 * i + (lane >> 5)];
            }
#pragma unroll
            for (int i = 0; i < 32; ++i) scr[(2 * i + (lane >> 5)) * 33 + (lane & 31)] = wv[i];
            if (I.W8) p0_tile_out8(I.W8, I.K, I.drow0, I.ko, scr, lane); else p0_tile_out(I.WT, I.K, I.drow0, I.ko, scr, lane);
        }
        if (rows_left) {
            float s[8];
#pragma unroll
            for (int r = 0; r < 8; ++r) { float a = 0.f;
#pragma unroll
                for (int j = 0; j < 4; ++j) a += (v[r][j].x * v[r][j].x + v[r][j].y * v[r][j].y) + (v[r][j].z * v[r][j].z + v[r][j].w * v[r][j].w);
                s[r] = a; }
#pragma unroll
            for (int o = 1; o < 64; o <<= 1) {
#pragma unroll
                for (int r = 0; r < 8; ++r) s[r] += __shfl_xor(s[r], o); }
#pragma unroll
            for (int r = 0; r < 8; ++r) { const float ms = s[r] * (1.f / D) + EPS, rstd = __builtin_amdgcn_rsqf(ms);
                if (lane == 0) F.rrow[m0 + r] = ms * rstd;
                bf16_t* orow = F.XN + tl_off(m0 + r, 4 * lane, D);
#pragma unroll
                for (int j = 0; j < 4; ++j) *(GAS unsigned long long*)(orow + (size_t)j * 8 * 512) = (unsigned long long)pk2(v[r][j].x * rstd * gg[j].x, v[r][j].y * rstd * gg[j].y) | ((unsigned long long)pk2(v[r][j].z * rstd * gg[j].z, v[r][j].w * rstd * gg[j].w) << 32);
                unsigned char* orow8 = F.XN8 + tl8_off(m0 + r, 4 * lane, D);
#pragma unroll
                for (int j = 0; j < 4; ++j) *(GAS unsigned*)(orow8 + (size_t)j * 4 * 1024) = pk4_fp8(v[r][j].x * rstd * gg[j].x, v[r][j].y * rstd * gg[j].y, v[r][j].z * rstd * gg[j].z, v[r][j].w * rstd * gg[j].w); }
        }
        it += NGW;
    }
    if (F.wave == 0) for (int m = rbeg + 8 * nb8; m < rend; ++m) rms_rows<1>(F.x, gg, F.XN, F.XN8, F.rrow, m, lane);
}

constexpr int AT_IMG = 15 * 40 * 128;
constexpr int AT_A = 0;
constexpr int AT_B = AT_IMG;
constexpr int AT_TAB = 2 * AT_IMG;
static_assert(AT_TAB + 15 * 64 * 4 <= LDSCTL_OFF, "attention LDS map");
__device__ __forceinline__ int rs_of(int r) { int v = r - 4; v = v < 0 ? 0 : v; return v > 56 ? 56 : v; }

struct AttnUnit { int b, h, jh, r0, krow_lo, nrows; };
__device__ __forceinline__ AttnUnit attn_decode(int un) {
    AttnUnit u; const int bh = un >> 4, rc = (un >> 1) & 7; u.jh = un & 1; u.b = bh >> 3; u.h = bh & 7;
    u.r0 = 8 * rc; u.krow_lo = rs_of(u.r0); u.nrows = rs_of(u.r0 + 7) + 8 - u.krow_lo;
    return u;
}
__device__ __forceinline__ void glds16(const void* gsrc, unsigned lds_dst) { unsigned keep;
    asm volatile("s_mov_b32 %0, m0\n\ts_mov_b32 m0, %2\n\ts_nop 0\n\tglobal_load_lds_dwordx4 %1, off\n\ts_mov_b32 m0, %0" : "=&s"(keep) : "v"(gsrc), "s"(lds_dst) : "memory"); }
#define ATT_WAIT_BAR() do { asm volatile("s_waitcnt vmcnt(0) lgkmcnt(0)" ::: "memory"); __builtin_amdgcn_s_barrier(); asm volatile("" ::: "memory"); } while (0)
template <int KIND> __device__ __forceinline__ void attn_dma(unsigned dst, const bf16_t* src, const AttnUnit& u, int wid, int lane) {
    const int np = u.nrows * 5;
    const char* base = (const char*)(src + ((size_t)(u.b * NHEAD + u.h) * SEQ + u.krow_lo * 64 + 24 * u.jh) * HD);
#pragma unroll
    for (int it = 0; it < 10; ++it) {
        const int pi = it * 8 + wid;
        if (pi < np) {
            const int w = (pi * 205) >> 10, p = pi - 5 * w, c = 8 * p + (lane >> 3);
            const int sw = (KIND == 0) ? (((c >> 1) & 1) | (((c >> 3) & 3) << 1)) : ((((c >> 1) & 1) << 1) | (((c >> 3) & 1) << 2));
            const int ch = (lane & 7) ^ sw;
            const char* gp = base + (w * 64 + c) * (HD * 2) + ch * 16;
            glds16(gp, (unsigned)__builtin_amdgcn_readfirstlane(dst + pi * 1024));
        }
    }
}

__device__ __forceinline__ void p2_attention(Frame& F, const bf16_t* Qg, const bf16_t* Kg, const bf16_t* Vg, bf16_t* MIX) {
    const int lane = F.lane, wid = F.wave;
    LAS unsigned char* lds = F.lds;
    const unsigned lds0 = (unsigned)(size_t)F.lds;
    const int q = lane & 15, g = lane >> 4;
    constexpr int NUNITS = BATCH * NHEAD * 16, UW = 8;
    for (int uidx = F.vcu * UW; uidx < NUNITS; uidx += F.G * UW) {
        const int h = (uidx >> 4) & 7;
        __syncthreads();
        {   LAS float* tab = (LAS float*)(lds + AT_TAB);
            for (int i = F.tid; i < 15 * 64; i += NWAVES * 64) { const int rr = i >> 6, cc = (i & 63) - 16; tab[i] = (cc >= 0 && cc < 31) ? F.rpb[h * 465 + rr * 31 + cc] * LOG2E : 0.f; } }
        AttnUnit u = attn_decode(uidx);
        attn_dma<0>(lds0 + AT_A, Kg, u, wid, lane);
        bf16x8 qf[2][2];
#pragma unroll
        for (int jb = 0; jb < 2; ++jb) { const bf16_t* qp = Qg + ((size_t)(u.b * NHEAD + u.h) * SEQ + (u.r0 + wid) * 64 + 32 * u.jh + 16 * jb + q) * HD + 8 * g; qf[jb][0] = *(const bf16x8*)qp; qf[jb][1] = *(const bf16x8*)(qp + 32); }
        ATT_WAIT_BAR();
        for (int ui = 0; ui < UW; ++ui) {
            asm volatile("" : "+v"(qf[0][0]), "+v"(qf[0][1]), "+v"(qf[1][0]), "+v"(qf[1][1]));
            attn_dma<1>(lds0 + AT_B, Vg, u, wid, lane);
            const int r = u.r0 + wid, rs = rs_of(r), wbase = rs - u.krow_lo;
            u32x4 pw[2][8]; float il[2];
#pragma unroll
            for (int jb = 0; jb < 2; ++jb) {
                const int o = 8 * jb, kcol0 = 24 * u.jh + o, cq = 32 * u.jh + 16 * jb + q;
                int cs = cq - 8; cs = cs < 0 ? 0 : cs; cs = cs > 48 ? 48 : cs;
                f32x4 sc[8][2];
                {
                    const int fk = ((q >> 1) & 1) | (((jb + (q >> 2)) & 3) << 1), x0 = g ^ fk;
                    const LAS unsigned char* ka = lds + AT_A + (wbase * 40 + o + 8 * (q >> 2) + (q & 3)) * 128;
                    const LAS unsigned char* k0p = ka + x0 * 16;
                    const LAS unsigned char* k1p = ka + (x0 ^ 4) * 16;
#pragma unroll
                    for (int wl = 0; wl < 8; ++wl)
#pragma unroll
                        for (int blk = 0; blk < 2; ++blk) {
                            const bf16x8 k0 = *(const LAS bf16x8*)(k0p + wl * 5120 + blk * 512), k1 = *(const LAS bf16x8*)(k1p + wl * 5120 + blk * 512);
                            f32x4 a = (f32x4){0.f, 0.f, 0.f, 0.f};
                            a = __builtin_amdgcn_mfma_f32_16x16x32_bf16(k0, qf[jb][0], a, 0, 0, 0);
                            a = __builtin_amdgcn_mfma_f32_16x16x32_bf16(k1, qf[jb][1], a, 0, 0, 0);
                            sc[wl][blk] = a;
                        }
                }
                const LAS float* tab = (const LAS float*)(lds + AT_TAB) + (rs - r + 7) * 64 + 16 + (kcol0 - cq + 15) + 8 * g;
                const int voff = kcol0 + 8 * g - cs;
                float mx = -INFINITY;
#pragma unroll
                for (int wl = 0; wl < 8; ++wl)
#pragma unroll
                    for (int blk = 0; blk < 2; ++blk)
#pragma unroll
                        for (int e = 0; e < 4; ++e) {
                            const int ep = 4 * blk + e;
                            float s_ = sc[wl][blk][e] + tab[wl * 64 + ep];
                            s_ = ((unsigned)(voff + ep) < 16u) ? s_ : -INFINITY;
                            sc[wl][blk][e] = s_; mx = fmaxf(mx, s_);
                        }
                mx = fmaxf(mx, __shfl_xor(mx, 16)); mx = fmaxf(mx, __shfl_xor(mx, 32));
                float l = 0.f;
#pragma unroll
                for (int wl = 0; wl < 8; ++wl) {
                    float p[8];
#pragma unroll
                    for (int blk = 0; blk < 2; ++blk)
#pragma unroll
                        for (int e = 0; e < 4; ++e) { p[4 * blk + e] = __builtin_amdgcn_exp2f(sc[wl][blk][e] - mx); l += p[4 * blk + e]; }
                    pw[jb][wl].x = cvt_pk_bf16(p[0], p[1]); pw[jb][wl].y = cvt_pk_bf16(p[2], p[3]); pw[jb][wl].z = cvt_pk_bf16(p[4], p[5]); pw[jb][wl].w = cvt_pk_bf16(p[6], p[7]);
                }
                l += __shfl_xor(l, 16); l += __shfl_xor(l, 32);
                il[jb] = __builtin_amdgcn_rcpf(l);
            }
            ATT_WAIT_BAR();
            AttnUnit un = u; bf16x8 nq[2][2];
#pragma unroll
            for (int jb = 0; jb < 2; ++jb) { nq[jb][0] = qf[jb][0]; nq[jb][1] = qf[jb][1]; }
            if (ui < UW - 1) {
                un = attn_decode(uidx + ui + 1);
                attn_dma<0>(lds0 + AT_A, Kg, un, wid, lane);
#pragma unroll
                for (int jb = 0; jb < 2; ++jb) { const bf16_t* qp = Qg + ((size_t)(un.b * NHEAD + un.h) * SEQ + (un.r0 + wid) * 64 + 32 * un.jh + 16 * jb + q) * HD + 8 * g; nq[jb][0] = *(const bf16x8*)qp; nq[jb][1] = *(const bf16x8*)(qp + 32); }
            }
#pragma unroll
            for (int jb = 0; jb < 2; ++jb) {
                const int o = 8 * jb, cq = 32 * u.jh + 16 * jb + q;
                f32x4 ov[4];
#pragma unroll
                for (int n = 0; n < 4; ++n) ov[n] = (f32x4){0.f, 0.f, 0.f, 0.f};
                {
                    const int qr = q >> 2, p = lane & 3;
                    const int fv = (((qr >> 1) & 1) << 1) | (((jb + g) & 1) << 2);
                    const LAS unsigned char* vb = lds + AT_B + (wbase * 40 + o + 8 * g + qr) * 128 + (p >> 1) * 16 + (p & 1) * 8;
                    const LAS unsigned char* vn[4];
#pragma unroll
                    for (int n = 0; n < 4; ++n) vn[n] = vb + ((2 * n) ^ fv) * 16;
#pragma unroll
                    for (int wl = 0; wl < 8; ++wl) {
                        const bf16x8 pf = __builtin_bit_cast(bf16x8, pw[jb][wl]);
#pragma unroll
                        for (int n = 0; n < 4; ++n) {
                            const s16x4 lo = __builtin_bit_cast(s16x4, __builtin_amdgcn_ds_read_tr16_b64_v4i16((LAS s16x4*)(vn[n] + wl * 5120)));
                            const s16x4 hi = __builtin_bit_cast(s16x4, __builtin_amdgcn_ds_read_tr16_b64_v4i16((LAS s16x4*)(vn[n] + wl * 5120 + 512)));
                            const bf16x8 vf = (bf16x8){lo[0], lo[1], lo[2], lo[3], hi[0], hi[1], hi[2], hi[3]};
                            ov[n] = __builtin_amdgcn_mfma_f32_16x16x32_bf16(vf, pf, ov[n], 0, 0, 0);
                        }
                    }
                }
                unsigned char* op = (unsigned char*)MIX + (size_t)tl_off(u.b * SEQ + r * 64 + cq, 32 * u.h, KMIX) * 2 + 4 * g;
                const float il8 = 8.f * il[jb];
#pragma unroll
                for (int n = 0; n < 4; ++n) *(unsigned*)(op + 16 * n) = pk4_fp8(ov[n][0] * il8, ov[n][1] * il8, ov[n][2] * il8, ov[n][3] * il8);
            }
            ATT_WAIT_BAR();
            u = un;
#pragma unroll
            for (int jb = 0; jb < 2; ++jb) { qf[jb][0] = nq[jb][0]; qf[jb][1] = nq[jb][1]; }
        }
    }
}

__device__ __forceinline__ void up8(const u32x4 w, float (&v)[8]) {
    v[0] = bflo(w.x); v[1] = bfhi(w.x); v[2] = bflo(w.y); v[3] = bfhi(w.y); v[4] = bflo(w.z); v[5] = bfhi(w.z); v[6] = bflo(w.w); v[7] = bfhi(w.w);
}
__device__ __forceinline__ void pool_run(const bf16_t* __restrict__ Zg, bf16_t* __restrict__ MIX, int gw, int lane) {
    const int tb = 32 * gw, b = tb >> 12, t0 = tb & (SEQ - 1);
    const int half = 1 << (lane >> 4);
    const bf16_t* zb = Zg + (size_t)(b * SEQ) * NA + 8 * lane;
    bf16_t* ob = MIX + tl_off(b * SEQ, 256 + 8 * lane, KMIX);
    float S[8];
#pragma unroll
    for (int e = 0; e < 8; ++e) S[e] = 0.f;
    {   u32x4 w[16];
#pragma unroll
        for (int d = 0; d < 16; ++d) { int i = t0 + d - 8; i = i < 0 ? 0 : i; i = i > SEQ - 1 ? SEQ - 1 : i; w[d] = *(const u32x4*)(zb + (size_t)i * NA); }
#pragma unroll
        for (int d = 0; d < 16; ++d) { const int dd = d - 8, i = t0 + dd; const float mk = (dd >= -half && dd < half && i >= 0 && i < SEQ) ? 1.f : 0.f; float v[8]; up8(w[d], v);
#pragma unroll
            for (int e = 0; e < 8; ++e) S[e] += mk * v[e]; } }
    for (int c = 0; c < 4; ++c) {
        u32x4 zt[8], za[8], zs[8];
#pragma unroll
        for (int k = 0; k < 8; ++k) { const int t = t0 + 8 * c + k; int ia = t + half, is = t - half; ia = ia > SEQ - 1 ? SEQ - 1 : ia; is = is < 0 ? 0 : is;
            zt[k] = *(const u32x4*)(zb + (size_t)t * NA); za[k] = *(const u32x4*)(zb + (size_t)ia * NA); zs[k] = *(const u32x4*)(zb + (size_t)is * NA); }
#pragma unroll
        for (int k = 0; k < 8; ++k) { const int t = t0 + 8 * c + k;
            const int lo = (t - half) < 0 ? 0 : (t - half), hi = (t + half) > SEQ ? SEQ : (t + half);
            const float inv = 1.0f / (float)(hi - lo);
            float v[8]; up8(zt[k], v);
            u32x4 w;
            w.x = cvt_pk_bf16(S[0] * inv - v[0], S[1] * inv - v[1]); w.y = cvt_pk_bf16(S[2] * inv - v[2], S[3] * inv - v[3]);
            w.z = cvt_pk_bf16(S[4] * inv - v[4], S[5] * inv - v[5]); w.w = cvt_pk_bf16(S[6] * inv - v[6], S[7] * inv - v[7]);
            *(u32x4*)(ob + (size_t)(t >> 4) * (KMIX / 32) * 512 + (t & 15) * 32) = w;
            const float ma = (t + half < SEQ) ? 1.f : 0.f, ms = (t - half >= 0) ? 1.f : 0.f;
            float a[8], s[8]; up8(za[k], a); up8(zs[k], s);
#pragma unroll
            for (int e = 0; e < 8; ++e) S[e] += ma * a[e] - ms * s[e]; }
    }
}

__device__ __forceinline__ void p2_mixer(Frame& F) {
    const bf16_t* Qg = F.QKVZ; const bf16_t* Kg = F.QKVZ + (size_t)M * NA; const bf16_t* Vg = F.QKVZ + 2 * (size_t)M * NA; const bf16_t* Zg = F.QKVZ + 3 * (size_t)M * NA;
    bf16_t* MIX = F.MIX;
    for (int gw = F.vcu * NWAVES + F.wave; gw < M / 32; gw += F.G * NWAVES) pool_run(Zg, MIX, gw, F.lane);
    p2_attention(F, Qg, Kg, Vg, MIX);
    __syncthreads();
}

struct Args { const float* in[13]; float* out; unsigned char* ws; int ph_lo, ph_hi, li, pad; };
__global__ void __launch_bounds__(NWAVES * 64, 2) fwd_megakernel(Args args) {
    extern __shared__ __attribute__((aligned(16))) unsigned char lds[];
    Frame F;
    F.lds = (LAS unsigned char*)lds;
    F.MISC = (volatile LAS unsigned*)(F.lds + MISC_OFF);
    F.tid = threadIdx.x; F.lane = F.tid & 63; F.wave = __builtin_amdgcn_readfirstlane(F.tid >> 6);
    F.G = gridDim.x; { const int bx = blockIdx.x; F.vcu = (F.G % 8 == 0) ? (bx % 8) * (F.G / 8) + bx / 8 : bx; }
    unsigned char* ws = args.ws;
    F.ctl = (gu32*)(ws + WS_CTL);
    F.x = args.in[0]; F.g1 = args.in[1]; F.w_in = args.in[2]; F.gq = args.in[3]; F.gk = args.in[4]; F.rpb = args.in[5]; F.w_pool = args.in[6];
    F.pscale = args.in[7]; F.w_out = args.in[8]; F.g2 = args.in[9]; F.w_gate = args.in[10]; F.w_up = args.in[11]; F.w_down = args.in[12]; F.out = args.out;
    F.Win_t = (bf16_t*)(ws + WS_WIN); F.Wout_t = (bf16_t*)(ws + WS_WOUT); F.Wgu_t = (bf16_t*)(ws + WS_WGU); F.Wdn_t = (bf16_t*)(ws + WS_WDN);
    F.XN8 = ws + WS_XN8; F.Win8 = ws + WS_WIN8;
    F.XN = (bf16_t*)(ws + WS_XN); F.QKVZ = (bf16_t*)(ws + WS_QKVZ); F.XB = (bf16_t*)(ws + WS_XB); F.ACT = (bf16_t*)(ws + WS_ACT);
    F.ss = (float*)(ws + WS_CTL) + CW_SS; F.rrow = (float*)(ws + WS_CTL) + CW_SS + M; F.MIX = (bf16_t*)(ws + WS_ACT);
    for (int u = F.tid; u < (LDS_BYTES - LDSCTL_OFF) / 4; u += NWAVES * 64) ((LAS unsigned*)(F.lds + LDSCTL_OFF))[u] = 0u;
    __syncthreads();
    XcdBarrier bar; bar.bar = (unsigned*)(F.ctl + CW_BAR); bar.x = 0; bar.st = nullptr;
    if (N_LAUNCHES != PER_PHASE) bar = xcd_barrier_post((unsigned*)(F.ctl + CW_BAR), F.MISC + 8);
#define GRID_BAR() do { if (N_LAUNCHES != PER_PHASE) xcd_barrier(bar); } while (0)
    const int lo = args.ph_lo, hi = args.ph_hi;
#define IN(k) (lo <= (k) && (k) < hi)
#define BOTH(k) (IN(k) && IN((k) + 1))

    if (IN(0)) { p0_prologue(F); if (BOTH(0)) GRID_BAR(); }

    if (IN(1)) {
        { LAS float* gl = (LAS float*)(F.lds + LDS_GAIN_OFF);
          if (F.tid < 64) gl[F.tid] = F.gq[F.tid] * (0.125f * LOG2E); else if (F.tid < 128) gl[F.tid] = F.gk[F.tid - 64];
          __syncthreads(); }
        {
            pg8::Gemm g{(const bf16_t*)F.XN8, (const bf16_t*)F.Win8, M, 3 * NA, D / 2, 0x7a7a7a7au, 0x7f7f7f7fu};
            pg8::StaticOrder S; S.init(M, 3 * NA, F.G, (int)blockIdx.x, 16);
            pg8::EpiIn E{F.QKVZ, (const LAS float*)(F.lds + LDS_GAIN_OFF), 0};
            pg8::gemm_phase<pg8::EpiIn, pg8::StaticOrder, true, PG8_SP2, true, pg8::ALL8>(F.lds + RING_OFF, g, S, E);
        }
        {
            pg8::Gemm g{F.XN, F.Win_t + tl_off(3 * NA, 0, D), M, NA, D}; pg8::StaticOrder S; S.init(M, NA, F.G, (int)blockIdx.x);
            pg8::EpiIn E{F.QKVZ, (const LAS float*)(F.lds + LDS_GAIN_OFF), 6};
            pg8::gemm_phase<pg8::EpiIn, pg8::StaticOrder, true, PG8_SP2>(F.lds + RING_OFF, g, S, E);
        }
        if (BOTH(1)) GRID_BAR();
    }

    if (IN(2)) { p2_mixer(F); if (BOTH(2)) GRID_BAR(); }

    if (IN(3)) {
        pg8::Gemm g{F.MIX, F.Wout_t, M, D, KMIX, 0x7a7a7a7au, 0x7c7c7c7cu};
        pg8::StaticOrder S; S.init(M, D, F.G, (int)blockIdx.x);
        pg8::EpiOut E{F.XN, F.rrow, F.g1, F.XB, F.ss};
        pg8::gemm_phase<pg8::EpiOut, pg8::StaticOrder, true, PG8_SP2, true, 4>(F.lds + RING_OFF, g, S, E);
        if (BOTH(3)) GRID_BAR();
    }

    if (IN(4)) {
        pg8::Gemm g{F.XB, F.Wgu_t, M, NGU, D}; pg8::RevOrder S; S.init(M, NGU, F.G, (int)blockIdx.x);
        pg8::EpiGU E{F.ACT, F.ss};
        pg8::gemm_phase<pg8::EpiGU, pg8::RevOrder, true, PG8_SP2>(F.lds + RING_OFF, g, S, E);
        if (BOTH(4)) GRID_BAR();
    }

    if (IN(5)) {
        pg8::Gemm g{F.ACT, F.Wdn_t, M, D, FF}; pg8::StaticOrder S; S.init(M, D, F.G, (int)blockIdx.x);
        pg8::EpiDown E{F.XB, F.out};
        pg8::gemm_phase<pg8::EpiDown, pg8::StaticOrder, true, PG8_SP2>(F.lds + RING_OFF, g, S, E);
    }
#undef IN
#undef BOTH
#undef GRID_BAR
}

extern "C" void kernel_launch(void* const* d_in, const int* in_sizes, int n_in, void* d_out, int out_size, void* d_ws, size_t ws_size, hipStream_t stream) {
    static int grid = 0;
    if (grid == 0) {
        if (n_in != 13 || in_sizes[0] != M * D || out_size != M * D || ws_size < WS_END) { fprintf(stderr, "kernel_launch: unexpected shapes (n_in %d, in0 %d, out %d, ws %zu); nothing launched\n", n_in, n_in > 0 ? in_sizes[0] : -1, out_size, ws_size); grid = -1; return; }
        int dev = 0, cus = 0, per_cu = 0;
        if (hipGetDevice(&dev) != hipSuccess || hipDeviceGetAttribute(&cus, hipDeviceAttributeMultiprocessorCount, dev) != hipSuccess) { fprintf(stderr, "kernel_launch: device query failed\n"); grid = -1; return; }
        if (hipFuncSetAttribute((const void*)fwd_megakernel, hipFuncAttributeMaxDynamicSharedMemorySize, LDS_BYTES) != hipSuccess) { fprintf(stderr, "kernel_launch: hipFuncSetAttribute failed\n"); grid = -1; return; }
        if (hipOccupancyMaxActiveBlocksPerMultiprocessor(&per_cu, (const void*)fwd_megakernel, NWAVES * 64, LDS_BYTES) != hipSuccess || per_cu < 1) {
            fprintf(stderr, "kernel_launch: occupancy query reports %d workgroups per CU; nothing launched\n", per_cu); (void)hipGetLastError(); grid = -1; return; }
        (void)hipGetLastError();
        grid = cus;
    }
    if (grid < 0) return;
    if (hipMemsetAsync((char*)d_ws + WS_CTL, 0, CTL_ZERO_BYTES, stream) != hipSuccess) { fprintf(stderr, "kernel_launch: hipMemsetAsync failed\n"); return; }
    Args a{};
    for (int i = 0; i < 13; ++i) a.in[i] = (const float*)d_in[i];
    a.out = (float*)d_out; a.ws = (unsigned char*)d_ws;
    for (int li = 0; li < N_LAUNCHES; ++li) {
        a.ph_lo = (N_LAUNCHES == PER_PHASE) ? li : 0; a.ph_hi = (N_LAUNCHES == PER_PHASE) ? li + 1 : PER_PHASE; a.li = li;
        hipLaunchKernelGGL(fwd_megakernel, dim3(grid), dim3(NWAVES * 64), LDS_BYTES, stream, a);
        const hipError_t le = hipPeekAtLastError();
        if (le != hipSuccess) { fprintf(stderr, "kernel_launch: launch %d failed: %s\n", li, hipGetErrorName(le)); break; }
    }
}
```

```cpp
#include <hip/hip_runtime.h>
#include <cstdio>
#include <cstdint>

#define LAS __attribute__((address_space(3)))
#define GAS __attribute__((address_space(1)))
typedef unsigned short bf16_t;
typedef short bf16x8 __attribute__((ext_vector_type(8)));
typedef short s16x4 __attribute__((ext_vector_type(4)));
typedef float f32x4 __attribute__((ext_vector_type(4)));
typedef float f32x2 __attribute__((ext_vector_type(2)));
typedef unsigned u32x4 __attribute__((ext_vector_type(4)));
typedef unsigned u32x2 __attribute__((ext_vector_type(2)));
constexpr int KMIX = 768;
typedef int i32x4 __attribute__((ext_vector_type(4)));
typedef int i32x8 __attribute__((ext_vector_type(8)));

constexpr int BATCH = 16, SEQ = 4096, D = 1024, M = BATCH * SEQ;
constexpr int NA = 512, NHEAD = 8, HD = 64, NIN = 2048, FF = 2816, NGU = 2 * FF;
constexpr float EPS = 1e-6f;
constexpr float LOG2E = 1.4426950408889634f;

__host__ __device__ __forceinline__ size_t tl_off(int row, int k, int K) { return ((((size_t)(row >> 4) * (size_t)(K >> 5)) + (size_t)(k >> 5)) << 9) + (size_t)((row & 15) * 32 + (k & 31)); }

__device__ __forceinline__ unsigned cvt_pk_bf16(float lo, float hi) { unsigned r; asm volatile("v_cvt_pk_bf16_f32 %0, %1, %2" : "=v"(r) : "v"(lo), "v"(hi)); return r; }

namespace pg8 {
constexpr int BM = 256, BK = 64, HALF = 128, HTB = HALF * BK * 2, STAGE_BYTES = 8 * HTB, NXCD = 8, WGM = 8;

__host__ __device__ __forceinline__ int lds_byte(int r, int c) { const int st = (r >> 4) * 2 + (c >> 5), rr = r & 15, cc = c & 31, ob = rr * 64 + cc * 2; return st * 1024 + (ob ^ (((ob >> 9) & 1) << 5)); }
__host__ __device__ __forceinline__ void stage_rc(int b, int& R, int& C) { const int st = b / 1024, sb = b % 1024, swz = sb ^ (((sb >> 9) & 1) << 5); R = (st >> 1) * 16 + swz / 64; C = (st & 1) * 32 + (swz % 64) / 2; }
__host__ __device__ __forceinline__ int perm32(int rho) { const int n = rho >> 4, i = rho & 15; return 8 * (i >> 2) + 4 * n + (i & 3); }

struct Unit { int pm, pn; };
struct Gemm { const bf16_t* A; const bf16_t* Bt; int M, N, K; unsigned sw8 = 0x7f7f7f7fu, sa8 = 0x7f7f7f7fu; };

struct StaticOrder {
    int nM, nN, nwg, G, c, wgm;
    __host__ __device__ void init(int M_, int N_, int G_, int c_, int wgm_ = WGM) { nM = M_ / BM; nN = N_ / BM; nwg = nM * nN; G = G_; c = c_; wgm = wgm_; }
    __host__ __device__ bool next(int i, Unit& u) const {
        const long L = (long)i * G + c; if (L >= nwg) return false;
        int wgid = (int)L; { const int q = nwg / NXCD, r = nwg % NXCD, xcd = wgid % NXCD, off = wgid / NXCD; wgid = (xcd < r ? xcd * (q + 1) : r * (q + 1) + (xcd - r) * q) + off; }
        const int nig = wgm * nN, gid = wgid / nig, fm = gid * wgm, gsz = (nM - fm) < wgm ? (nM - fm) : wgm;
        u.pm = fm + ((wgid % nig) % gsz); u.pn = (wgid % nig) / gsz; return true;
    }
    __device__ __forceinline__ void a_ready(const Unit&) const {}
    __device__ __forceinline__ void done(const Unit&) const {}
};

struct RevOrder : StaticOrder {
    __host__ __device__ bool next(int i, Unit& u) const { const bool ok = StaticOrder::next(i, u); if (ok) u.pm = nM - 1 - u.pm; return ok; }
};


struct EpiIn {
    static constexpr bool PERM = true, AFTER_DRAIN = false, LOADS_FIRST = false;
    bf16_t* QKVZ; const LAS float* gl; int pn0;
    __device__ __forceinline__ void operator()(const f32x4 (&acc)[2][2][4][2], const Unit& u, int wr, int wc, int fr, int fq) const {
        const int pn = u.pn + pn0, kind = pn >> 1;
        const int row0 = u.pm * BM + wr * 64 + fr;
        const int head = 4 * (pn & 1) + wc; const size_t rstride = kind < 3 ? HD : NA;
        bf16_t* base = QKVZ + (size_t)kind * ((size_t)M * NA) + 8 * fq
                     + (kind < 3 ? ((size_t)((row0 >> 12) * NHEAD + head) * SEQ + (row0 & (SEQ - 1))) * HD : (size_t)row0 * NA + head * HD);
        if (kind < 2) {
            const LAS float* g = gl + 64 * kind + 8 * fq;
            f32x4 gv[2][2];
#pragma unroll
            for (int bj = 0; bj < 2; ++bj)
#pragma unroll
                for (int n = 0; n < 2; ++n) gv[bj][n] = *(const LAS f32x4*)(g + 32 * bj + 4 * n);
            float ss[8];
#pragma unroll
            for (int i = 0; i < 8; ++i) { const int ai = i >> 2, m = i & 3; float a = 0.f;
#pragma unroll
                for (int bj = 0; bj < 2; ++bj)
#pragma unroll
                    for (int n = 0; n < 2; ++n) { const f32x4 v = acc[ai][bj][m][n]; a += (v[0] * v[0] + v[1] * v[1]) + (v[2] * v[2] + v[3] * v[3]); }
                ss[i] = a; }
#pragma unroll
            for (int i = 0; i < 8; ++i) ss[i] += __shfl_xor(ss[i], 16);
#pragma unroll
            for (int i = 0; i < 8; ++i) ss[i] += __shfl_xor(ss[i], 32);
#pragma unroll
            for (int i = 0; i < 8; ++i) { const int ai = i >> 2, m = i & 3;
                bf16_t* rowp = base + (size_t)(ai * HALF + m * 16) * rstride;
                const float r = __builtin_amdgcn_rsqf(ss[i] * (1.0f / 64.0f) + EPS);
#pragma unroll
                for (int bj = 0; bj < 2; ++bj) {
                    const f32x4 v0 = acc[ai][bj][m][0] * r * gv[bj][0], v1 = acc[ai][bj][m][1] * r * gv[bj][1];
                    u32x4 w; w.x = cvt_pk_bf16(v0[0], v0[1]); w.y = cvt_pk_bf16(v0[2], v0[3]); w.z = cvt_pk_bf16(v1[0], v1[1]); w.w = cvt_pk_bf16(v1[2], v1[3]);
                    *(u32x4*)(rowp + bj * 32) = w; }
            }
        } else {
#pragma unroll
            for (int ai = 0; ai < 2; ++ai)
#pragma unroll
                for (int m = 0; m < 4; ++m) {
                    bf16_t* rowp = base + (size_t)(ai * HALF + m * 16) * rstride;
#pragma unroll
                    for (int bj = 0; bj < 2; ++bj) {
                        const f32x4 v0 = acc[ai][bj][m][0], v1 = acc[ai][bj][m][1];
                        u32x4 w; w.x = cvt_pk_bf16(v0[0], v0[1]); w.y = cvt_pk_bf16(v0[2], v0[3]); w.z = cvt_pk_bf16(v1[0], v1[1]); w.w = cvt_pk_bf16(v1[2], v1[3]);
                        *(u32x4*)(rowp + bj * 32) = w; }
                }
        }
    }
};

struct EpiOut {
    static constexpr bool PERM = true, AFTER_DRAIN = false, LOADS_FIRST = true;
    const bf16_t* XN; const float* rrow; const float* g1; bf16_t* XB; float* ss;
    __device__ __forceinline__ void operator()(const f32x4 (&acc)[2][2][4][2], const Unit& u, int wr, int wc, int fr, int fq) const {
        const int row0 = u.pm * BM + wr * 64 + fr, col0 = u.pn * BM + wc * 32 + 8 * fq;
        const size_t off0 = (size_t)row0 * D + col0;
        const bf16_t* __restrict__ xp = XN + tl_off(row0, col0, D); bf16_t* __restrict__ bp = XB + tl_off(row0, col0, D);
        f32x4 gi[2][2];
#pragma unroll
        for (int bj = 0; bj < 2; ++bj)
#pragma unroll
            for (int n = 0; n < 2; ++n) { const f32x4 gv = *(const f32x4*)(g1 + col0 + bj * HALF + 4 * n);
                gi[bj][n] = (f32x4){__builtin_amdgcn_rcpf(gv[0]), __builtin_amdgcn_rcpf(gv[1]), __builtin_amdgcn_rcpf(gv[2]), __builtin_amdgcn_rcpf(gv[3])}; }
        u32x4 xa[8][2]; float rr[8], part[8];
#pragma unroll
        for (int i = 0; i < 8; ++i) rr[i] = rrow[row0 + (i >> 2) * HALF + (i & 3) * 16];
#define EO_LOAD(i) do { const size_t o_ = (size_t)((((i) >> 2) * 8 + ((i) & 3)) * (D / 32)) * 512; xa[i][0] = *(const u32x4*)(xp + o_); xa[i][1] = *(const u32x4*)(xp + o_ + 4 * 512); } while (0)
        EO_LOAD(0); EO_LOAD(1); EO_LOAD(2); EO_LOAD(3);
        asm volatile("" ::: "memory");
#pragma unroll
        for (int i = 0; i < 8; ++i) { const int ai = i >> 2, m = i & 3; const size_t o_ = (size_t)(ai * HALF + m * 16) * D; float p = 0.f;
#pragma unroll
            for (int bj = 0; bj < 2; ++bj) { const u32x4 w_ = xa[i][bj];
                const f32x4 x0 = {__builtin_bit_cast(float, w_.x << 16), __builtin_bit_cast(float, w_.x & 0xffff0000u), __builtin_bit_cast(float, w_.y << 16), __builtin_bit_cast(float, w_.y & 0xffff0000u)};
                const f32x4 x1 = {__builtin_bit_cast(float, w_.z << 16), __builtin_bit_cast(float, w_.z & 0xffff0000u), __builtin_bit_cast(float, w_.w << 16), __builtin_bit_cast(float, w_.w & 0xffff0000u)};
                const f32x4 v0 = acc[ai][bj][m][0] + x0 * (gi[bj][0] * rr[i]), v1 = acc[ai][bj][m][1] + x1 * (gi[bj][1] * rr[i]);
                u32x4 w; w.x = cvt_pk_bf16(v0[0], v0[1]); w.y = cvt_pk_bf16(v0[2], v0[3]); w.z = cvt_pk_bf16(v1[0], v1[1]); w.w = cvt_pk_bf16(v1[2], v1[3]);
                *(u32x4*)(bp + (size_t)((ai * 8 + m) * (D / 32) + 4 * bj) * 512) = w;
                p += (v0[0] * v0[0] + v0[1] * v0[1]) + (v0[2] * v0[2] + v0[3] * v0[3]) + (v1[0] * v1[0] + v1[1] * v1[1]) + (v1[2] * v1[2] + v1[3] * v1[3]); }
            part[i] = p;
            if (i + 4 < 8) { EO_LOAD((i + 4) & 7); }
            asm volatile("" ::: "memory"); }
#undef EO_LOAD
#pragma unroll
        for (int i = 0; i < 8; ++i) part[i] += __shfl_xor(part[i], 16);
#pragma unroll
        for (int i = 0; i < 8; ++i) part[i] += __shfl_xor(part[i], 32);
        if (fq == 0) {
#pragma unroll
            for (int i = 0; i < 8; ++i) atomicAdd(ss + row0 + (i >> 2) * HALF + (i & 3) * 16, part[i]);
        }
    }
};

struct EpiGU {
    static constexpr bool PERM = true, AFTER_DRAIN = false, LOADS_FIRST = true;
    bf16_t* ACT; const float* ss;
    __device__ __forceinline__ void operator()(const f32x4 (&acc)[2][2][4][2], const Unit& u, int wr, int wc, int fr, int fq) const {
        const int row0 = u.pm * BM + wr * 64 + fr, col0 = u.pn * HALF + wc * 32 + 8 * fq;
        float sv[8];
#pragma unroll
        for (int i = 0; i < 8; ++i) sv[i] = ss[row0 + (i >> 2) * HALF + (i & 3) * 16];
        asm volatile("" ::: "memory");
#pragma unroll
        for (int i = 0; i < 8; ++i) { const int ai = i >> 2, m = i & 3;
            const float rstd = __builtin_amdgcn_rsqf(sv[i] * (1.0f / (float)D) + EPS), ne = -LOG2E * rstd, r2 = rstd * rstd;
            unsigned w[4];
#pragma unroll
            for (int n = 0; n < 2; ++n)
#pragma unroll
                for (int h = 0; h < 2; ++h) {
                    const f32x2 g = {acc[ai][0][m][n][2 * h], acc[ai][0][m][n][2 * h + 1]}, up = {acc[ai][1][m][n][2 * h], acc[ai][1][m][n][2 * h + 1]};
                    const f32x2 t = g * ne; f32x2 e; e.x = __builtin_amdgcn_exp2f(t.x); e.y = __builtin_amdgcn_exp2f(t.y);
                    const f32x2 d = e + 1.0f; f32x2 r; r.x = __builtin_amdgcn_rcpf(d.x); r.y = __builtin_amdgcn_rcpf(d.y);
                    const f32x2 a = (g * up) * (r * r2);
                    w[2 * n + h] = cvt_pk_bf16(a.x, a.y); }
            *(u32x4*)(ACT + tl_off(row0 + ai * HALF + m * 16, col0, FF)) = (u32x4){w[0], w[1], w[2], w[3]};
        }
    }
};

struct EpiDown {
    static constexpr bool PERM = true, AFTER_DRAIN = false, LOADS_FIRST = true;
    const bf16_t* XB; float* out;
    __device__ __forceinline__ void operator()(const f32x4 (&acc)[2][2][4][2], const Unit& u, int wr, int wc, int fr, int fq) const {
        const int row0 = u.pm * BM + wr * 64 + fr, col0 = u.pn * BM + wc * 32 + 8 * fq;
        const size_t off0 = (size_t)row0 * D + col0;
        const bf16_t* __restrict__ bp = XB + tl_off(row0, col0, D); float* __restrict__ op = out + off0;
        u32x4 xa[8][2];
#define ED_LOAD(i) do { const size_t o_ = (size_t)((((i) >> 2) * 8 + ((i) & 3)) * (D / 32)) * 512; xa[i][0] = *(const u32x4*)(bp + o_); xa[i][1] = *(const u32x4*)(bp + o_ + 4 * 512); } while (0)
        ED_LOAD(0); ED_LOAD(1); ED_LOAD(2); ED_LOAD(3);
        asm volatile("" ::: "memory");
#pragma unroll
        for (int i = 0; i < 8; ++i) { const int ai = i >> 2, m = i & 3; const size_t o_ = (size_t)(ai * HALF + m * 16) * D;
#pragma unroll
            for (int bj = 0; bj < 2; ++bj) { const u32x4 w = xa[i][bj];
                const f32x4 r0 = {__builtin_bit_cast(float, w.x << 16), __builtin_bit_cast(float, w.x & 0xffff0000u), __builtin_bit_cast(float, w.y << 16), __builtin_bit_cast(float, w.y & 0xffff0000u)};
                const f32x4 r1 = {__builtin_bit_cast(float, w.z << 16), __builtin_bit_cast(float, w.z & 0xffff0000u), __builtin_bit_cast(float, w.w << 16), __builtin_bit_cast(float, w.w & 0xffff0000u)};
                *(f32x4*)(op + o_ + bj * HALF) = acc[ai][bj][m][0] + r0; *(f32x4*)(op + o_ + bj * HALF + 4) = acc[ai][bj][m][1] + r1; }
            if (i + 4 < 8) { ED_LOAD((i + 4) & 7); }
            asm volatile("" ::: "memory"); }
#undef ED_LOAD
    }
};

constexpr int ALL8 = 1 << 20;
template <class Epi, class Sched, bool ALIGN_EPI = false, bool SP2 = false, bool A_TILED = true, int NT8 = 0>
__device__ __forceinline__ void gemm_phase(LAS unsigned char* lds, const Gemm g, const Sched& S, const Epi& E) {
    static_assert(SP2, "only the two-MMA-blocks-per-barrier schedule is kept");
    int tid_ = threadIdx.x; asm volatile("" : "+v"(tid_));
    const int tid = tid_, wid = __builtin_amdgcn_readfirstlane(tid >> 6), lane = tid & 63, wr = wid >> 2, wc = wid & 3, fr = lane & 15, fq = lane >> 4;
    const int K = g.K, nt = K / BK;
    unsigned voffA[2], voffB[2];
#pragma unroll
    for (int i = 0; i < 2; ++i) { int R, C; stage_rc(tid * 16 + i * 8192, R, C); const int Rb = Epi::PERM ? ((R & ~31) + perm32(R & 31)) : R;
        voffA[i] = A_TILED ? (unsigned)tl_off(R, C, K) * 2u : (unsigned)(R * K + C) * 2u; voffB[i] = (unsigned)tl_off(Rb, C, K) * 2u; }
    const size_t kstepA = A_TILED ? (size_t)2048 : (size_t)(BK * 2), kstepB = 2048;
    const size_t hstep = (size_t)HALF * K * 2;
    const size_t tstep = 2 * hstep;
    const unsigned ldsw = (unsigned)wid * 1024u;
    const int aoff = lds_byte(wr * 64 + fr, fq * 8), boff = lds_byte(wc * 32 + fr, fq * 8);
#define PG8_SA(b, h) (((b) * 2 + (h)) * HTB)
#define PG8_SB(b, h) ((4 + (b) * 2 + (h)) * HTB)
#define PG8_STAGE(bufoff, gbase, voff) do { _Pragma("unroll") for (int _i = 0; _i < 2; ++_i) \
        __builtin_amdgcn_global_load_lds((const unsigned*)((const char*)(gbase) + (voff)[_i]), (LAS unsigned*)(lds + (bufoff) + ldsw + _i * 8192), 16, 0, 0); } while (0)
#define PG8_LDA(dst, b, h) do { _Pragma("unroll") for (int m = 0; m < 4; ++m) _Pragma("unroll") for (int k = 0; k < 2; ++k) dst[m][k] = *(const LAS bf16x8*)(lds + PG8_SA(b, h) + aoff + m * 2048 + k * 1024); } while (0)
#define PG8_LDB(dst, b, h) do { _Pragma("unroll") for (int n = 0; n < 2; ++n) _Pragma("unroll") for (int k = 0; k < 2; ++k) dst[n][k] = *(const LAS bf16x8*)(lds + PG8_SB(b, h) + boff + n * 2048 + k * 1024); } while (0)
#define PG8_CAT8(lo, hi) __builtin_shufflevector(__builtin_bit_cast(i32x4, lo), __builtin_bit_cast(i32x4, hi), 0, 1, 2, 3, 4, 5, 6, 7)
#define PG8_MMA(F8, ai, bj, At, Bt) do { __builtin_amdgcn_s_setprio(1); \
        if constexpr (F8) { _Pragma("unroll") for (int m = 0; m < 4; ++m) _Pragma("unroll") for (int n = 0; n < 2; ++n) \
            asm volatile("v_mfma_scale_f32_16x16x128_f8f6f4 %0, %1, %2, %0, %3, %4 op_sel_hi:[0,0,0]" : "+v"(acc[ai][bj][m][n]) : "v"(PG8_CAT8(Bt[n][0], Bt[n][1])), "v"(PG8_CAT8(At[m][0], At[m][1])), "v"(sc8w), "v"(sc8a)); } \
        else { _Pragma("unroll") for (int m = 0; m < 4; ++m) _Pragma("unroll") for (int n = 0; n < 2; ++n) _Pragma("unroll") for (int k = 0; k < 2; ++k) \
            acc[ai][bj][m][n] = __builtin_amdgcn_mfma_f32_16x16x32_bf16(Bt[n][k], At[m][k], acc[ai][bj][m][n], 0, 0, 0); } \
        __builtin_amdgcn_s_setprio(0); } while (0)
#define PG8_WAIT_V(n) asm volatile("s_waitcnt vmcnt(" #n ")" ::: "memory")
#define PG8_WAIT_L(n) asm volatile("s_waitcnt lgkmcnt(" #n ")" ::: "memory")
#define PG8_BAR __builtin_amdgcn_s_barrier()
#define PG8_SCHED __builtin_amdgcn_sched_barrier(0)
    const unsigned sc8w = g.sw8, sc8a = g.sa8;
    Unit cur, nxt; int ui = 0;
    if (!S.next(0, cur)) return;
    f32x4 acc[2][2][4][2];
#pragma unroll
    for (int a = 0; a < 2; ++a)
#pragma unroll
        for (int b = 0; b < 2; ++b)
#pragma unroll
            for (int m = 0; m < 4; ++m)
#pragma unroll
                for (int n = 0; n < 2; ++n) acc[a][b][m][n] = (f32x4){0.f, 0.f, 0.f, 0.f};
    bf16x8 At[4][2], B0[2][2], B1[2][2];
    const char* cA = (const char*)g.A + (size_t)cur.pm * tstep; const char* cB = (const char*)g.Bt + (size_t)cur.pn * tstep;
    S.a_ready(cur);
    PG8_STAGE(PG8_SB(0, 0), cB, voffB); PG8_STAGE(PG8_SB(0, 1), cB + hstep, voffB); PG8_STAGE(PG8_SA(0, 0), cA, voffA); PG8_STAGE(PG8_SA(0, 1), cA + hstep, voffA);
    if (wr == 1) PG8_BAR;
    PG8_WAIT_V(2); PG8_BAR;
    PG8_STAGE(PG8_SB(1, 0), cB + kstepB, voffB); PG8_STAGE(PG8_SA(1, 0), cA + kstepA, voffA); PG8_STAGE(PG8_SB(1, 1), cB + hstep + kstepB, voffB);
    PG8_WAIT_V(6); PG8_BAR;
    for (;;) {
        const bool has_next = S.next(ui + 1, nxt);
        const char* nA = has_next ? (const char*)g.A + (size_t)nxt.pm * tstep : cA; const char* nB = has_next ? (const char*)g.Bt + (size_t)nxt.pn * tstep : cB;
#define PG8_ITER_X(F8, WV) { \
            const bool last = (t == nt - 2); \
            const char* a1 = cA + (size_t)(t + 1) * kstepA; \
            const char* a2 = last ? nA : cA + (size_t)(t + 2) * kstepA; const char* b2 = last ? nB : cB + (size_t)(t + 2) * kstepB; \
            const char* a3 = a2 + kstepA; const char* b3 = b2 + kstepB; \
            if (last && has_next) S.a_ready(nxt); \
            PG8_LDB(B0, 0, 0); PG8_LDB(B1, 0, 1); PG8_SCHED; PG8_LDA(At, 0, 0); PG8_STAGE(PG8_SA(1, 1), a1 + hstep, voffA); \
            WV; PG8_WAIT_L(0); PG8_BAR; PG8_MMA(F8, 0, 0, At, B0); PG8_MMA(F8, 0, 1, At, B1); PG8_BAR; PG8_SCHED; \
            PG8_LDA(At, 0, 1); PG8_STAGE(PG8_SB(0, 0), b2, voffB); PG8_STAGE(PG8_SB(0, 1), b2 + hstep, voffB); PG8_STAGE(PG8_SA(0, 0), a2, voffA); \
            WV; PG8_WAIT_L(0); PG8_BAR; PG8_MMA(F8, 1, 0, At, B0); PG8_MMA(F8, 1, 1, At, B1); PG8_BAR; PG8_SCHED; \
            PG8_LDB(B0, 1, 0); PG8_LDB(B1, 1, 1); PG8_SCHED; PG8_LDA(At, 1, 0); PG8_STAGE(PG8_SA(0, 1), a2 + hstep, voffA); \
            WV; PG8_WAIT_L(0); PG8_BAR; PG8_MMA(F8, 0, 0, At, B0); PG8_MMA(F8, 0, 1, At, B1); PG8_BAR; PG8_SCHED; \
            PG8_LDA(At, 1, 1); PG8_STAGE(PG8_SB(1, 0), b3, voffB); PG8_STAGE(PG8_SB(1, 1), b3 + hstep, voffB); PG8_STAGE(PG8_SA(1, 0), a3, voffA); \
            PG8_WAIT_V(8); PG8_WAIT_L(0); PG8_BAR; PG8_MMA(F8, 1, 0, At, B0); PG8_MMA(F8, 1, 1, At, B1); PG8_BAR; PG8_SCHED; }
#define PG8_ITER(F8) PG8_ITER_X(F8, PG8_WAIT_V(8))
#define PG8_ITER_FIRST(F8) PG8_ITER_X(F8, (void)0)
        int t = 0;
        const bool peel = Epi::LOADS_FIRST && (ui > 0);
        if constexpr (NT8 > 0) { const int nt8 = NT8 < nt ? NT8 : nt;
            if (peel) { PG8_ITER_FIRST(true) t = 2; }
            _Pragma("nounroll") for (; t < nt8; t += 2) PG8_ITER(true)
            if constexpr (NT8 < ALL8) asm volatile("s_nop 15\n\ts_nop 15" ::: "memory"); }
        if constexpr (NT8 < ALL8) {
            if constexpr (NT8 == 0) { if (peel) { PG8_ITER_FIRST(false) t = 2; } }
            _Pragma("nounroll") for (; t < nt; t += 2) PG8_ITER(false) }
        if constexpr (NT8 > 0) asm volatile("s_nop 15\n\ts_nop 15\n\ts_nop 15" ::: "memory");
        if constexpr (ALIGN_EPI) { if (wr == 0) PG8_BAR; }
        if constexpr (!Epi::AFTER_DRAIN) { int fr_ = fr, fq_ = fq; asm volatile("" : "+v"(fr_), "+v"(fq_));
            E(acc, cur, wr, wc, fr_, fq_); S.done(cur); }
        if (!has_next) break;
#pragma unroll
        for (int a = 0; a < 2; ++a)
#pragma unroll
            for (int b = 0; b < 2; ++b)
#pragma unroll
                for (int m = 0; m < 4; ++m)
#pragma unroll
                    for (int n = 0; n < 2; ++n) acc[a][b][m][n] = (f32x4){0.f, 0.f, 0.f, 0.f};
        cur = nxt; cA = nA; cB = nB; ++ui;
        if constexpr (ALIGN_EPI) { if (wr == 1) PG8_BAR; }
    }
    PG8_WAIT_V(0);
    if constexpr (!ALIGN_EPI) { if (wr == 0) PG8_BAR; }
    PG8_BAR;
#undef PG8_SA
#undef PG8_SB
#undef PG8_STAGE
#undef PG8_LDA
#undef PG8_LDB
#undef PG8_MMA
#undef PG8_ITER
#undef PG8_ITER_X
#undef PG8_ITER_FIRST
#undef PG8_CAT8
#undef PG8_WAIT_V
#undef PG8_WAIT_L
#undef PG8_BAR
#undef PG8_SCHED
}
}

constexpr int NWAVES = 8;
#ifndef MK_N_LAUNCHES
#define MK_N_LAUNCHES 1
#endif
constexpr int N_LAUNCHES = MK_N_LAUNCHES;
constexpr int PER_PHASE = 6;
#ifndef PG8_SP2
#define PG8_SP2 true
#endif

constexpr size_t MiB = 1u << 20;
constexpr size_t WS_CTL = 0, CTL_ZERO_BYTES = 1 * MiB;
constexpr size_t WS_WIN = 2 * MiB;
constexpr size_t WS_WOUT = 6 * MiB;
constexpr size_t WS_WGU = 8 * MiB;
constexpr size_t WS_WDN = 20 * MiB;
constexpr size_t WS_XN = 32 * MiB;
constexpr size_t WS_QKVZ = 160 * MiB;
constexpr size_t WS_ACT = 416 * MiB;
constexpr size_t WS_XB = 768 * MiB;
constexpr size_t WS_XN8 = 896 * MiB;
constexpr size_t WS_WIN8 = 960 * MiB;
constexpr size_t WS_END = 962 * MiB;
static_assert(WS_WGU + (size_t)NGU * D * 2 <= WS_WDN && WS_WDN + (size_t)D * FF * 2 <= WS_XN && WS_ACT + (size_t)M * FF * 2 <= WS_END, "d_ws map");
constexpr int CW_BAR = 4096;
constexpr int CW_SS = 65536;
static_assert((size_t)(CW_SS + 2 * M) * 4 <= CTL_ZERO_BYTES, "ss, rrow inside the control region");

constexpr int RING_OFF = 0, RING_BYTES = 131072;
constexpr int LDSCTL_OFF = 157696, MISC_OFF = LDSCTL_OFF + 320;
constexpr int LDS_GAIN_OFF = LDSCTL_OFF + 512;
constexpr int LDS_BYTES = 163840;

typedef GAS unsigned gu32;
#define RLX_AGENT __ATOMIC_RELAXED, __HIP_MEMORY_SCOPE_AGENT
#define LDS_WAIT() asm volatile("s_waitcnt lgkmcnt(0)" ::: "memory")
__device__ __forceinline__ unsigned f2bf(float f) { unsigned u = __builtin_bit_cast(unsigned, f); return (u + 0x7fffu + ((u >> 16) & 1u)) >> 16; }
__device__ __forceinline__ unsigned pk2(float lo, float hi) { return f2bf(lo) | (f2bf(hi) << 16); }
__device__ __forceinline__ float bflo(unsigned w) { return __builtin_bit_cast(float, w << 16); }
__device__ __forceinline__ float bfhi(unsigned w) { return __builtin_bit_cast(float, w & 0xffff0000u); }

#define XB_TMO      128
#define XB_XCNT(j)  (256  + 64 * (j))
#define XB_XSUB(j)  (1280 + 64 * (j))
#define XB_XGEN(j)  (2304 + 64 * (j))
#define XB_TOP      3328
#define XB_TOPGEN   3392
#define XCD_BAR_WORDS 3456
#define XB_SPIN_CAP (1u << 18)

__device__ __forceinline__ unsigned xb_ld(unsigned* p)              { return __hip_atomic_load(p, __ATOMIC_RELAXED, __HIP_MEMORY_SCOPE_AGENT); }
__device__ __forceinline__ unsigned xb_add(unsigned* p, unsigned v) { return __hip_atomic_fetch_add(p, v, __ATOMIC_RELAXED, __HIP_MEMORY_SCOPE_AGENT); }
__device__ __forceinline__ unsigned xb_xcc_id() { return (unsigned)__builtin_amdgcn_s_getreg((3 << 11) | 20) & 0xFu; }
#define XB_SPIN(cond, bar) do { unsigned _sp = 0; while (cond) { __builtin_amdgcn_s_sleep(1); \
    if ((++_sp & 255u) == 0u) { if (xb_ld(&(bar)[XB_TMO])) break; if (_sp > XB_SPIN_CAP) { atomicAdd(&(bar)[XB_TMO], 1u); break; } } } } while (0)

struct XcdBarrier { unsigned* bar; unsigned x; volatile LAS unsigned* st; };

__device__ __forceinline__ XcdBarrier xcd_barrier_post(unsigned* bar, volatile LAS unsigned* st) {
    XcdBarrier b; b.bar = bar; b.x = xb_xcc_id(); b.st = st;
    if (threadIdx.x == 0) (void)xb_add(&bar[XB_XCNT(b.x)], 1u);
    return b;
}
__device__ __forceinline__ void xcd_barrier_complete(unsigned* bar, unsigned x, unsigned& nloc, unsigned& nx) {
    const unsigned G = gridDim.x * gridDim.y * gridDim.z;
    unsigned sum, cnt, mine, sp = 0u;
    for (;;) {
        sum = 0u; cnt = 0u; mine = 0u;
#pragma unroll
        for (unsigned j = 0; j < 16; ++j) { const unsigned c = xb_ld(&bar[XB_XCNT(j)]); sum += c; cnt += (c > 0u) ? 1u : 0u; mine = (j == x) ? c : mine; }
        if (sum == G) break;
        __builtin_amdgcn_s_sleep(1);
        if ((++sp & 255u) == 0u) { if (xb_ld(&bar[XB_TMO])) break; if (sp > XB_SPIN_CAP) { atomicAdd(&bar[XB_TMO], 1u); break; } }
    }
    nloc = mine > 0u ? mine : 1u; nx = cnt > 0u ? cnt : 1u;
}
__device__ __forceinline__ void xcd_barrier(const XcdBarrier& b) {
    asm volatile("s_waitcnt vmcnt(0)" ::: "memory");
    __syncthreads();
    if (threadIdx.x == 0) {
        unsigned* bar = b.bar;
        __builtin_amdgcn_s_waitcnt(0);
        unsigned nloc = b.st[0], nx = b.st[1];
        if (nloc == 0u) { xcd_barrier_complete(bar, b.x, nloc, nx); b.st[0] = nloc; b.st[1] = nx; }
        const unsigned old = xb_add(&bar[XB_XSUB(b.x)], 1u);
        const unsigned gen = old / nloc;
        if (old + 1u == (gen + 1u) * nloc) {
            __builtin_amdgcn_fence(__ATOMIC_RELEASE, "agent");
            asm volatile("s_waitcnt vmcnt(0)" ::: "memory");
            const unsigned og = xb_add(&bar[XB_TOP], 1u);
            const unsigned tg = og / nx;
            if (og + 1u == (tg + 1u) * nx) xb_add(&bar[XB_TOPGEN], 1u);
            else XB_SPIN(xb_ld(&bar[XB_TOPGEN]) == tg, bar);
            __builtin_amdgcn_fence(__ATOMIC_ACQUIRE, "agent");
            xb_add(&bar[XB_XGEN(b.x)], 1u);
            asm volatile("s_waitcnt vmcnt(0)" ::: "memory");
        } else {
            XB_SPIN(xb_ld(&bar[XB_XGEN(b.x)]) == gen, bar);
            __builtin_amdgcn_fence(__ATOMIC_ACQUIRE, "agent");
            asm volatile("s_waitcnt vmcnt(0)" ::: "memory");
        }
    }
    __syncthreads();
}

struct Frame {
    LAS unsigned char* lds;
    volatile LAS unsigned* MISC;
    gu32* ctl;
    int tid, lane, wave;
    int vcu, G;
    const float *x, *g1, *w_in, *gq, *gk, *rpb, *w_pool, *pscale, *w_out, *g2, *w_gate, *w_up, *w_down;
    float* out;
    bf16_t *Win_t, *Wout_t, *Wgu_t, *Wdn_t;
    bf16_t *XN, *QKVZ, *XB, *ACT;
    unsigned char *XN8, *Win8;
    float* ss; float* rrow; bf16_t* MIX;
};

__device__ __forceinline__ float wave_sum(float v) {
#pragma unroll
    for (int o = 1; o < 64; o <<= 1) v += __shfl_xor(v, o);
    return v;
}

__device__ __forceinline__ void p0_tile_out(bf16_t* WT, int K, int drow0, int k0, LAS float* scr, int lane) {
    LDS_WAIT(); asm volatile("" ::: "memory");
    const int c = lane & 7;
#pragma unroll
    for (int j = 0; j < 4; ++j) { const int n = (lane >> 3) + 8 * j; const LAS float* s = scr + (8 * c) * 33 + n;
        u32x4 o; o.x = pk2(s[0 * 33], s[1 * 33]); o.y = pk2(s[2 * 33], s[3 * 33]); o.z = pk2(s[4 * 33], s[5 * 33]); o.w = pk2(s[6 * 33], s[7 * 33]);
        *(GAS u32x4*)(WT + tl_off(drow0 + n, k0 + 8 * c, K)) = o; }
    LDS_WAIT(); asm volatile("" ::: "memory");
}
__device__ __forceinline__ unsigned pk4_fp8(float a, float b, float c, float d) {
    unsigned w = 0; w = (unsigned)__builtin_amdgcn_cvt_pk_fp8_f32(a, b, (int)w, false); w = (unsigned)__builtin_amdgcn_cvt_pk_fp8_f32(c, d, (int)w, true); return w; }
__device__ __forceinline__ size_t tl8_off(int row, int k, int K) { return (size_t)tl_off(row, k >> 1, K >> 1) * 2 + (k & 1); }
__device__ __forceinline__ void p0_tile_out8(unsigned char* W8, int K, int drow0, int k0, LAS float* scr, int lane) {
    LDS_WAIT(); asm volatile("" ::: "memory");
    const int c = lane & 7;
#pragma unroll
    for (int j = 0; j < 4; ++j) { const int n = (lane >> 3) + 8 * j; const LAS float* s = scr + (8 * c) * 33 + n;
        u32x2 o; o.x = pk4_fp8(32.f * s[0 * 33], 32.f * s[1 * 33], 32.f * s[2 * 33], 32.f * s[3 * 33]); o.y = pk4_fp8(32.f * s[4 * 33], 32.f * s[5 * 33], 32.f * s[6 * 33], 32.f * s[7 * 33]);
        *(GAS u32x2*)(W8 + tl8_off(drow0 + n, k0 + 8 * c, K)) = o; }
    LDS_WAIT(); asm volatile("" ::: "memory");
}
__device__ __forceinline__ void p0_transpose_item(const float* W, int ldw, int K, int k0, int n0, const float* gkv, bf16_t* WT, int drow0, LAS float* scr, int lane) {
#pragma unroll
    for (int i = 0; i < 32; ++i) { const int kk = 2 * i + (lane >> 5); float v = W[(size_t)(k0 + kk) * ldw + n0 + (lane & 31)]; if (gkv) v *= gkv[k0 + kk]; scr[kk * 33 + (lane & 31)] = v; }
    p0_tile_out(WT, K, drow0, k0, scr, lane);
}
__device__ __forceinline__ void p0_fold_item(const float* w_in, const float* w_pool, const float* pscale, int k0, int n0z, bf16_t* WT, int drow0, int lane) {
    const int n = lane & 31, kh = lane >> 5, g = n0z >> 7, d = (n0z & 127) + n;
    float acc[4] = {0.f, 0.f, 0.f, 0.f};
    const float* wrow = w_in + (size_t)(k0 + 4 * kh) * NIN + 3 * NA + 128 * g;
    const float* wp = w_pool + (size_t)g * 128 * 128 + d;
#pragma unroll 8
    for (int c4 = 0; c4 < 32; ++c4) {
        const float p0 = wp[(4 * c4 + 0) * 128], p1 = wp[(4 * c4 + 1) * 128], p2 = wp[(4 * c4 + 2) * 128], p3 = wp[(4 * c4 + 3) * 128];
#pragma unroll
        for (int i = 0; i < 4; ++i) { const f32x4 w = *(const f32x4*)(wrow + (size_t)i * NIN + 4 * c4); acc[i] += (w[0] * p0 + w[1] * p1) + (w[2] * p2 + w[3] * p3); }
    }
    const float ps = pscale[n0z + n];
    float hi[4];
#pragma unroll
    for (int i = 0; i < 4; ++i) { acc[i] *= ps; hi[i] = __shfl(acc[i], (lane + 32) & 63); }
    if (lane < 32) { u32x4 o; o.x = pk2(acc[0], acc[1]); o.y = pk2(acc[2], acc[3]); o.z = pk2(hi[0], hi[1]); o.w = pk2(hi[2], hi[3]);
        *(GAS u32x4*)(WT + tl_off(drow0 + n, k0, D)) = o; }
}
__device__ __forceinline__ int win_drow(int n0) { const int pn = n0 >> 8, c = n0 & 255; return 256 * pn + 128 * ((c >> 5) & 1) + 32 * (c >> 6); }

template <int R> __device__ __forceinline__ void rms_rows(const float* x, const f32x4 (&gg)[4], bf16_t* XN, unsigned char* XN8, float* rrow, int m0, int lane) {
    f32x4 v[R][4]; float s[R];
#pragma unroll
    for (int r = 0; r < R; ++r) { const GAS f32x4* xr = (const GAS f32x4*)(x + (size_t)(m0 + r) * D) + lane;
#pragma unroll
        for (int j = 0; j < 4; ++j) v[r][j] = xr[64 * j]; }
#pragma unroll
    for (int r = 0; r < R; ++r) { float a = 0.f;
#pragma unroll
        for (int j = 0; j < 4; ++j) a += (v[r][j].x * v[r][j].x + v[r][j].y * v[r][j].y) + (v[r][j].z * v[r][j].z + v[r][j].w * v[r][j].w);
        s[r] = a; }
#pragma unroll
    for (int o = 1; o < 64; o <<= 1) {
#pragma unroll
        for (int r = 0; r < R; ++r) s[r] += __shfl_xor(s[r], o); }
#pragma unroll
    for (int r = 0; r < R; ++r) { const float ms = s[r] * (1.f / D) + EPS, rstd = __builtin_amdgcn_rsqf(ms);
        if (lane == 0) rrow[m0 + r] = ms * rstd;
        bf16_t* orow = XN + tl_off(m0 + r, 4 * lane, D);
#pragma unroll
        for (int j = 0; j < 4; ++j) *(GAS unsigned long long*)(orow + (size_t)j * 8 * 512) = (unsigned long long)pk2(v[r][j].x * rstd * gg[j].x, v[r][j].y * rstd * gg[j].y) | ((unsigned long long)pk2(v[r][j].z * rstd * gg[j].z, v[r][j].w * rstd * gg[j].w) << 32);
        unsigned char* orow8 = XN8 + tl8_off(m0 + r, 4 * lane, D);
#pragma unroll
        for (int j = 0; j < 4; ++j) *(GAS unsigned*)(orow8 + (size_t)j * 4 * 1024) = pk4_fp8(v[r][j].x * rstd * gg[j].x, v[r][j].y * rstd * gg[j].y, v[r][j].z * rstd * gg[j].z, v[r][j].w * rstd * gg[j].w); }
}

struct P0Item { const float* W; const float* gk; bf16_t* WT; unsigned char* W8; int ldw, K, k0, n0, drow0, ko; };
__device__ __forceinline__ void p0_prologue(Frame& F) {
    LAS float* scr = (LAS float*)(F.lds + RING_OFF + F.wave * 16384);
    const int gw = F.vcu * NWAVES + F.wave, NGW = F.G * NWAVES, lane = F.lane;
    constexpr int KB = D / 64;
    constexpr int I_QKV = KB * (3 * NA / 32), I_O = KB * (D / 32), I_G = KB * (FF / 32), I_DN = (FF / 64) * (D / 32);
    constexpr int NITEMS = I_QKV + I_O + 2 * I_G + I_DN;
    for (int it = gw; it < (D / 8) * (NA / 32); it += NGW) { const int nb = it & 15, kb = it >> 4; p0_fold_item(F.w_in, F.w_pool, F.pscale, 8 * kb, 32 * nb, F.Win_t, win_drow(3 * NA + 32 * nb), lane); }
    f32x4 gg[4];
#pragma unroll
    for (int j = 0; j < 4; ++j) gg[j] = *((const f32x4*)F.g1 + lane + 64 * j);
    const int RPW = (M + F.G - 1) / F.G, rbeg = F.vcu * RPW, rend = (rbeg + RPW) < M ? (rbeg + RPW) : M, nb8 = (rend - rbeg) / 8;
    volatile LAS unsigned* tick = F.MISC + 16;
    int it = gw; bool rows_left = true;
    while (it < NITEMS || rows_left) {
        const bool has_item = it < NITEMS; P0Item I{};
        if (has_item) {
            int r = it;
            if (r < I_QKV) { const int nb = r % (3 * NA / 32), kb = r / (3 * NA / 32); I = P0Item{F.w_in, nullptr, nullptr, F.Win8, NIN, D, 64 * kb, 32 * nb, win_drow(32 * nb), 64 * kb}; }
            else if ((r -= I_QKV) < I_O) { const int nb = r % (D / 32), kb = r / (D / 32); I = kb < 8 ? P0Item{F.w_out, nullptr, nullptr, (unsigned char*)F.Wout_t, D, 2 * KMIX, 64 * kb, 32 * nb, 32 * nb, 64 * kb}
                                                                                                   : P0Item{F.w_out, nullptr, F.Wout_t, nullptr, D, KMIX, 64 * kb, 32 * nb, 32 * nb, 64 * kb - 256}; }
            else if ((r -= I_O) < 2 * I_G) { const int up = r >= I_G; if (up) r -= I_G; const int nb = r % (FF / 32), kb = r / (FF / 32), n0 = 32 * nb;
                I = P0Item{up ? F.w_up : F.w_gate, F.g2, F.Wgu_t, nullptr, FF, D, 64 * kb, n0, 256 * (n0 >> 7) + (n0 & 127) + 128 * up, 64 * kb}; }
            else { r -= 2 * I_G; const int nb = r % (D / 32), kb = r / (D / 32); I = P0Item{F.w_down, nullptr, F.Wdn_t, nullptr, D, FF, 64 * kb, 32 * nb, 32 * nb, 64 * kb}; }
        }
        float wv[32];
        if (has_item) {
#pragma unroll
            for (int i = 0; i < 32; ++i) { const int kk = 2 * i + (lane >> 5); wv[i] = I.W[(size_t)(I.k0 + kk) * I.ldw + I.n0 + (lane & 31)]; }
        }
        int m0 = 0;
        if (rows_left) { unsigned t = 0; if (lane == 0) t = __hip_atomic_fetch_add((LAS unsigned*)tick, 1u, __ATOMIC_RELAXED, __HIP_MEMORY_SCOPE_WORKGROUP);
            t = __builtin_amdgcn_readfirstlane(t); rows_left = (int)t < nb8; m0 = rbeg + 8 * (int)t; }
        f32x4 v[8][4];
        if (rows_left) {
#pragma unroll
            for (int r = 0; r < 8; ++r) { const GAS f32x4* xr = (const GAS f32x4*)(F.x + (size_t)(m0 + r) * D) + lane;
#pragma unroll
                for (int j = 0; j < 4; ++j) v[r][j] = xr[64 * j]; }
        }
        if (has_item) {
            if (I.gk) {
#pragma unroll
                for (int i = 0; i < 32; ++i) wv[i] *= I.gk[I.k0 + 2 * i + (lane >> 5)];
            }
#pragma unroll
            for (int i = 0; i < 32; ++i) scr[(2 * i + (lane >> 5)) * 33 + (lane & 31)] = wv[i];
            if (I.W8) p0_tile_out8(I.W8, I.K, I.drow0, I.ko, scr, lane); else p0_tile_out(I.WT, I.K, I.drow0, I.ko, scr, lane);
        }
        if (rows_left) {
            float s[8];
#pragma unroll
            for (int r = 0; r < 8; ++r) { float a = 0.f;
#pragma unroll
                for (int j = 0; j < 4; ++j) a += (v[r][j].x * v[r][j].x + v[r][j].y * v[r][j].y) + (v[r][j].z * v[r][j].z + v[r][j].w * v[r][j].w);
                s[r] = a; }
#pragma unroll
            for (int o = 1; o < 64; o <<= 1) {
#pragma unroll
                for (int r = 0; r < 8; ++r) s[r] += __shfl_xor(s[r], o); }
#pragma unroll
            for (int r = 0; r < 8; ++r) { const float ms = s[r] * (1.f / D) + EPS, rstd = __builtin_amdgcn_rsqf(ms);
                if (lane == 0) F.rrow[m0 + r] = ms * rstd;
                bf16_t* orow = F.XN + tl_off(m0 + r, 4 * lane, D);
#pragma unroll
                for (int j = 0; j < 4; ++j) *(GAS unsigned long long*)(orow + (size_t)j * 8 * 512) = (unsigned long long)pk2(v[r][j].x * rstd * gg[j].x, v[r][j].y * rstd * gg[j].y) | ((unsigned long long)pk2(v[r][j].z * rstd * gg[j].z, v[r][j].w * rstd * gg[j].w) << 32);
                unsigned char* orow8 = F.XN8 + tl8_off(m0 + r, 4 * lane, D);
#pragma unroll
                for (int j = 0; j < 4; ++j) *(GAS unsigned*)(orow8 + (size_t)j * 4 * 1024) = pk4_fp8(v[r][j].x * rstd * gg[j].x, v[r][j].y * rstd * gg[j].y, v[r][j].z * rstd * gg[j].z, v[r][j].w * rstd * gg[j].w); }
        }
        it += NGW;
    }
    if (F.wave == 0) for (int m = rbeg + 8 * nb8; m < rend; ++m) rms_rows<1>(F.x, gg, F.XN, F.XN8, F.rrow, m, lane);
}

constexpr int AT_IMG = 15 * 40 * 128;
constexpr int AT_A = 0;
constexpr int AT_B = AT_IMG;
constexpr int AT_TAB = 2 * AT_IMG;
static_assert(AT_TAB + 15 * 64 * 4 <= LDSCTL_OFF, "attention LDS map");
__device__ __forceinline__ int rs_of(int r) { int v = r - 4; v = v < 0 ? 0 : v; return v > 56 ? 56 : v; }

struct AttnUnit { int b, h, jh, r0, krow_lo, nrows; };
__device__ __forceinline__ AttnUnit attn_decode(int un) {
    AttnUnit u; const int bh = un >> 4, rc = (un >> 1) & 7; u.jh = un & 1; u.b = bh >> 3; u.h = bh & 7;
    u.r0 = 8 * rc; u.krow_lo = rs_of(u.r0); u.nrows = rs_of(u.r0 + 7) + 8 - u.krow_lo;
    return u;
}
__device__ __forceinline__ void glds16(const void* gsrc, unsigned lds_dst) { unsigned keep;
    asm volatile("s_mov_b32 %0, m0\n\ts_mov_b32 m0, %2\n\ts_nop 0\n\tglobal_load_lds_dwordx4 %1, off\n\ts_mov_b32 m0, %0" : "=&s"(keep) : "v"(gsrc), "s"(lds_dst) : "memory"); }
#define ATT_WAIT_BAR() do { asm volatile("s_waitcnt vmcnt(0) lgkmcnt(0)" ::: "memory"); __builtin_amdgcn_s_barrier(); asm volatile("" ::: "memory"); } while (0)
template <int KIND> __device__ __forceinline__ void attn_dma(unsigned dst, const bf16_t* src, const AttnUnit& u, int wid, int lane) {
    const int np = u.nrows * 5;
    const char* base = (const char*)(src + ((size_t)(u.b * NHEAD + u.h) * SEQ + u.krow_lo * 64 + 24 * u.jh) * HD);
#pragma unroll
    for (int it = 0; it < 10; ++it) {
        const int pi = it * 8 + wid;
        if (pi < np) {
            const int w = (pi * 205) >> 10, p = pi - 5 * w, c = 8 * p + (lane >> 3);
            const int sw = (KIND == 0) ? (((c >> 1) & 1) | (((c >> 3) & 3) << 1)) : ((((c >> 1) & 1) << 1) | (((c >> 3) & 1) << 2));
            const int ch = (lane & 7) ^ sw;
            const char* gp = base + (w * 64 + c) * (HD * 2) + ch * 16;
            glds16(gp, (unsigned)__builtin_amdgcn_readfirstlane(dst + pi * 1024));
        }
    }
}

__device__ __forceinline__ void p2_attention(Frame& F, const bf16_t* Qg, const bf16_t* Kg, const bf16_t* Vg, bf16_t* MIX) {
    const int lane = F.lane, wid = F.wave;
    LAS unsigned char* lds = F.lds;
    const unsigned lds0 = (unsigned)(size_t)F.lds;
    const int q = lane & 15, g = lane >> 4;
    constexpr int NUNITS = BATCH * NHEAD * 16, UW = 8;
    for (int uidx = F.vcu * UW; uidx < NUNITS; uidx += F.G * UW) {
        const int h = (uidx >> 4) & 7;
        __syncthreads();
        {   LAS float* tab = (LAS float*)(lds + AT_TAB);
            for (int i = F.tid; i < 15 * 64; i += NWAVES * 64) { const int rr = i >> 6, cc = (i & 63) - 16; tab[i] = (cc >= 0 && cc < 31) ? F.rpb[h * 465 + rr * 31 + cc] * LOG2E : 0.f; } }
        AttnUnit u = attn_decode(uidx);
        attn_dma<0>(lds0 + AT_A, Kg, u, wid, lane);
        bf16x8 qf[2][2];
#pragma unroll
        for (int jb = 0; jb < 2; ++jb) { const bf16_t* qp = Qg + ((size_t)(u.b * NHEAD + u.h) * SEQ + (u.r0 + wid) * 64 + 32 * u.jh + 16 * jb + q) * HD + 8 * g; qf[jb][0] = *(const bf16x8*)qp; qf[jb][1] = *(const bf16x8*)(qp + 32); }
        ATT_WAIT_BAR();
        for (int ui = 0; ui < UW; ++ui) {
            asm volatile("" : "+v"(qf[0][0]), "+v"(qf[0][1]), "+v"(qf[1][0]), "+v"(qf[1][1]));
            attn_dma<1>(lds0 + AT_B, Vg, u, wid, lane);
            const int r = u.r0 + wid, rs = rs_of(r), wbase = rs - u.krow_lo;
            u32x4 pw[2][8]; float il[2];
#pragma unroll
            for (int jb = 0; jb < 2; ++jb) {
                const int o = 8 * jb, kcol0 = 24 * u.jh + o, cq = 32 * u.jh + 16 * jb + q;
                int cs = cq - 8; cs = cs < 0 ? 0 : cs; cs = cs > 48 ? 48 : cs;
                f32x4 sc[8][2];
                {
                    const int fk = ((q >> 1) & 1) | (((jb + (q >> 2)) & 3) << 1), x0 = g ^ fk;
                    const LAS unsigned char* ka = lds + AT_A + (wbase * 40 + o + 8 * (q >> 2) + (q & 3)) * 128;
                    const LAS unsigned char* k0p = ka + x0 * 16;
                    const LAS unsigned char* k1p = ka + (x0 ^ 4) * 16;
#pragma unroll
                    for (int wl = 0; wl < 8; ++wl)
#pragma unroll
                        for (int blk = 0; blk < 2; ++blk) {
                            const bf16x8 k0 = *(const LAS bf16x8*)(k0p + wl * 5120 + blk * 512), k1 = *(const LAS bf16x8*)(k1p + wl * 5120 + blk * 512);
                            f32x4 a = (f32x4){0.f, 0.f, 0.f, 0.f};
                            a = __builtin_amdgcn_mfma_f32_16x16x32_bf16(k0, qf[jb][0], a, 0, 0, 0);
                            a = __builtin_amdgcn_mfma_f32_16x16x32_bf16(k1, qf[jb][1], a, 0, 0, 0);
                            sc[wl][blk] = a;
                        }
                }
                const LAS float* tab = (const LAS float*)(lds + AT_TAB) + (rs - r + 7) * 64 + 16 + (kcol0 - cq + 15) + 8 * g;
                const int voff = kcol0 + 8 * g - cs;
                float mx = -INFINITY;
#pragma unroll
                for (int wl = 0; wl < 8; ++wl)
#pragma unroll
                    for (int blk = 0; blk < 2; ++blk)
#pragma unroll
                        for (int e = 0; e < 4; ++e) {
                            const int ep = 4 * blk + e;
                            float s_ = sc[wl][blk][e] + tab[wl * 64 + ep];
                            s_ = ((unsigned)(voff + ep) < 16u) ? s_ : -INFINITY;
                            sc[wl][blk][e] = s_; mx = fmaxf(mx, s_);
                        }
                mx = fmaxf(mx, __shfl_xor(mx, 16)); mx = fmaxf(mx, __shfl_xor(mx, 32));
                float l = 0.f;
#pragma unroll
                for (int wl = 0; wl < 8; ++wl) {
                    float p[8];
#pragma unroll
                    for (int blk = 0; blk < 2; ++blk)
#pragma unroll
                        for (int e = 0; e < 4; ++e) { p[4 * blk + e] = __builtin_amdgcn_exp2f(sc[wl][blk][e] - mx); l += p[4 * blk + e]; }
                    pw[jb][wl].x = cvt_pk_bf16(p[0], p[1]); pw[jb][wl].y = cvt_pk_bf16(p[2], p[3]); pw[jb][wl].z = cvt_pk_bf16(p[4], p[5]); pw[jb][wl].w = cvt_pk_bf16(p[6], p[7]);
                }
                l += __shfl_xor(l, 16); l += __shfl_xor(l, 32);
                il[jb] = __builtin_amdgcn_rcpf(l);
            }
            ATT_WAIT_BAR();
            AttnUnit un = u; bf16x8 nq[2][2];
#pragma unroll
            for (int jb = 0; jb < 2; ++jb) { nq[jb][0] = qf[jb][0]; nq[jb][1] = qf[jb][1]; }
            if (ui < UW - 1) {
                un = attn_decode(uidx + ui + 1);
                attn_dma<0>(lds0 + AT_A, Kg, un, wid, lane);
#pragma unroll
                for (int jb = 0; jb < 2; ++jb) { const bf16_t* qp = Qg + ((size_t)(un.b * NHEAD + un.h) * SEQ + (un.r0 + wid) * 64 + 32 * un.jh + 16 * jb + q) * HD + 8 * g; nq[jb][0] = *(const bf16x8*)qp; nq[jb][1] = *(const bf16x8*)(qp + 32); }
            }
#pragma unroll
            for (int jb = 0; jb < 2; ++jb) {
                const int o = 8 * jb, cq = 32 * u.jh + 16 * jb + q;
                f32x4 ov[4];
#pragma unroll
                for (int n = 0; n < 4; ++n) ov[n] = (f32x4){0.f, 0.f, 0.f, 0.f};
                {
                    const int qr = q >> 2, p = lane & 3;
                    const int fv = (((qr >> 1) & 1) << 1) | (((jb + g) & 1) << 2);
                    const LAS unsigned char* vb = lds + AT_B + (wbase * 40 + o + 8 * g + qr) * 128 + (p >> 1) * 16 + (p & 1) * 8;
                    const LAS unsigned char* vn[4];
#pragma unroll
                    for (int n = 0; n < 4; ++n) vn[n] = vb + ((2 * n) ^ fv) * 16;
#pragma unroll
                    for (int wl = 0; wl < 8; ++wl) {
                        const bf16x8 pf = __builtin_bit_cast(bf16x8, pw[jb][wl]);
#pragma unroll
                        for (int n = 0; n < 4; ++n) {
                            const s16x4 lo = __builtin_bit_cast(s16x4, __builtin_amdgcn_ds_read_tr16_b64_v4i16((LAS s16x4*)(vn[n] + wl * 5120)));
                            const s16x4 hi = __builtin_bit_cast(s16x4, __builtin_amdgcn_ds_read_tr16_b64_v4i16((LAS s16x4*)(vn[n] + wl * 5120 + 512)));
                            const bf16x8 vf = (bf16x8){lo[0], lo[1], lo[2], lo[3], hi[0], hi[1], hi[2], hi[3]};
                            ov[n] = __builtin_amdgcn_mfma_f32_16x16x32_bf16(vf, pf, ov[n], 0, 0, 0);
                        }
                    }
                }
                unsigned char* op = (unsigned char*)MIX + (size_t)tl_off(u.b * SEQ + r * 64 + cq, 32 * u.h, KMIX) * 2 + 4 * g;
                const float il8 = 8.f * il[jb];
#pragma unroll
                for (int n = 0; n < 4; ++n) *(unsigned*)(op + 16 * n) = pk4_fp8(ov[n][0] * il8, ov[n][1] * il8, ov[n][2] * il8, ov[n][3] * il8);
            }
            ATT_WAIT_BAR();
            u = un;
#pragma unroll
            for (int jb = 0; jb < 2; ++jb) { qf[jb][0] = nq[jb][0]; qf[jb][1] = nq[jb][1]; }
        }
    }
}

__device__ __forceinline__ void up8(const u32x4 w, float (&v)[8]) {
    v[0] = bflo(w.x); v[1] = bfhi(w.x); v[2] = bflo(w.y); v[3] = bfhi(w.y); v[4] = bflo(w.z); v[5] = bfhi(w.z); v[6] = bflo(w.w); v[7] = bfhi(w.w);
}
__device__ __forceinline__ void pool_run(const bf16_t* __restrict__ Zg, bf16_t* __restrict__ MIX, int gw, int lane) {
    const int tb = 32 * gw, b = tb >> 12, t0 = tb & (SEQ - 1);
    const int half = 1 << (lane >> 4);
    const bf16_t* zb = Zg + (size_t)(b * SEQ) * NA + 8 * lane;
    bf16_t* ob = MIX + tl_off(b * SEQ, 256 + 8 * lane, KMIX);
    float S[8];
#pragma unroll
    for (int e = 0; e < 8; ++e) S[e] = 0.f;
    {   u32x4 w[16];
#pragma unroll
        for (int d = 0; d < 16; ++d) { int i = t0 + d - 8; i = i < 0 ? 0 : i; i = i > SEQ - 1 ? SEQ - 1 : i; w[d] = *(const u32x4*)(zb + (size_t)i * NA); }
#pragma unroll
        for (int d = 0; d < 16; ++d) { const int dd = d - 8, i = t0 + dd; const float mk = (dd >= -half && dd < half && i >= 0 && i < SEQ) ? 1.f : 0.f; float v[8]; up8(w[d], v);
#pragma unroll
            for (int e = 0; e < 8; ++e) S[e] += mk * v[e]; } }
    for (int c = 0; c < 4; ++c) {
        u32x4 zt[8], za[8], zs[8];
#pragma unroll
        for (int k = 0; k < 8; ++k) { const int t = t0 + 8 * c + k; int ia = t + half, is = t - half; ia = ia > SEQ - 1 ? SEQ - 1 : ia; is = is < 0 ? 0 : is;
            zt[k] = *(const u32x4*)(zb + (size_t)t * NA); za[k] = *(const u32x4*)(zb + (size_t)ia * NA); zs[k] = *(const u32x4*)(zb + (size_t)is * NA); }
#pragma unroll
        for (int k = 0; k < 8; ++k) { const int t = t0 + 8 * c + k;
            const int lo = (t - half) < 0 ? 0 : (t - half), hi = (t + half) > SEQ ? SEQ : (t + half);
            const float inv = 1.0f / (float)(hi - lo);
            float v[8]; up8(zt[k], v);
            u32x4 w;
            w.x = cvt_pk_bf16(S[0] * inv - v[0], S[1] * inv - v[1]); w.y = cvt_pk_bf16(S[2] * inv - v[2], S[3] * inv - v[3]);
            w.z = cvt_pk_bf16(S[4] * inv - v[4], S[5] * inv - v[5]); w.w = cvt_pk_bf16(S[6] * inv - v[6], S[7] * inv - v[7]);
            *(u32x4*)(ob + (size_t)(t >> 4) * (KMIX / 32) * 512 + (t & 15) * 32) = w;
            const float ma = (t + half < SEQ) ? 1.f : 0.f, ms = (t - half >= 0) ? 1.f : 0.f;
            float a[8], s[8]; up8(za[k], a); up8(zs[k], s);
#pragma unroll
            for (int e = 0; e < 8; ++e) S[e] += ma * a[e] - ms * s[e]; }
    }
}

__device__ __forceinline__ void p2_mixer(Frame& F) {
    const bf16_t* Qg = F.QKVZ; const bf16_t* Kg = F.QKVZ + (size_t)M * NA; const bf16_t* Vg = F.QKVZ + 2 * (size_t)M * NA; const bf16_t* Zg = F.QKVZ + 3 * (size_t)M * NA;
    bf16_t* MIX = F.MIX;
    for (int gw = F.vcu * NWAVES + F.wave; gw < M / 32; gw += F.G * NWAVES) pool_run(Zg, MIX, gw, F.lane);
    p2_attention(F, Qg, Kg, Vg, MIX);
    __syncthreads();
}

struct Args { const float* in[13]; float* out; unsigned char* ws; int ph_lo, ph_hi, li, pad; };
__global__ void __launch_bounds__(NWAVES * 64, 2) fwd_megakernel(Args args) {
    extern __shared__ __attribute__((aligned(16))) unsigned char lds[];
    Frame F;
    F.lds = (LAS unsigned char*)lds;
    F.MISC = (volatile LAS unsigned*)(F.lds + MISC_OFF);
    F.tid = threadIdx.x; F.lane = F.tid & 63; F.wave = __builtin_amdgcn_readfirstlane(F.tid >> 6);
    F.G = gridDim.x; { const int bx = blockIdx.x; F.vcu = (F.G % 8 == 0) ? (bx % 8) * (F.G / 8) + bx / 8 : bx; }
    unsigned char* ws = args.ws;
    F.ctl = (gu32*)(ws + WS_CTL);
    F.x = args.in[0]; F.g1 = args.in[1]; F.w_in = args.in[2]; F.gq = args.in[3]; F.gk = args.in[4]; F.rpb = args.in[5]; F.w_pool = args.in[6];
    F.pscale = args.in[7]; F.w_out = args.in[8]; F.g2 = args.in[9]; F.w_gate = args.in[10]; F.w_up = args.in[11]; F.w_down = args.in[12]; F.out = args.out;
    F.Win_t = (bf16_t*)(ws + WS_WIN); F.Wout_t = (bf16_t*)(ws + WS_WOUT); F.Wgu_t = (bf16_t*)(ws + WS_WGU); F.Wdn_t = (bf16_t*)(ws + WS_WDN);
    F.XN8 = ws + WS_XN8; F.Win8 = ws + WS_WIN8;
    F.XN = (bf16_t*)(ws + WS_XN); F.QKVZ = (bf16_t*)(ws + WS_QKVZ); F.XB = (bf16_t*)(ws + WS_XB); F.ACT = (bf16_t*)(ws + WS_ACT);
    F.ss = (float*)(ws + WS_CTL) + CW_SS; F.rrow = (float*)(ws + WS_CTL) + CW_SS + M; F.MIX = (bf16_t*)(ws + WS_ACT);
    for (int u = F.tid; u < (LDS_BYTES - LDSCTL_OFF) / 4; u += NWAVES * 64) ((LAS unsigned*)(F.lds + LDSCTL_OFF))[u] = 0u;
    __syncthreads();
    XcdBarrier bar; bar.bar = (unsigned*)(F.ctl + CW_BAR); bar.x = 0; bar.st = nullptr;
    if (N_LAUNCHES != PER_PHASE) bar = xcd_barrier_post((unsigned*)(F.ctl + CW_BAR), F.MISC + 8);
#define GRID_BAR() do { if (N_LAUNCHES != PER_PHASE) xcd_barrier(bar); } while (0)
    const int lo = args.ph_lo, hi = args.ph_hi;
#define IN(k) (lo <= (k) && (k) < hi)
#define BOTH(k) (IN(k) && IN((k) + 1))

    if (IN(0)) { p0_prologue(F); if (BOTH(0)) GRID_BAR(); }

    if (IN(1)) {
        { LAS float* gl = (LAS float*)(F.lds + LDS_GAIN_OFF);
          if (F.tid < 64) gl[F.tid] = F.gq[F.tid] * (0.125f * LOG2E); else if (F.tid < 128) gl[F.tid] = F.gk[F.tid - 64];
          __syncthreads(); }
        {
            pg8::Gemm g{(const bf16_t*)F.XN8, (const bf16_t*)F.Win8, M, 3 * NA, D / 2, 0x7a7a7a7au, 0x7f7f7f7fu};
            pg8::StaticOrder S; S.init(M, 3 * NA, F.G, (int)blockIdx.x, 16);
            pg8::EpiIn E{F.QKVZ, (const LAS float*)(F.lds + LDS_GAIN_OFF), 0};
            pg8::gemm_phase<pg8::EpiIn, pg8::StaticOrder, true, PG8_SP2, true, pg8::ALL8>(F.lds + RING_OFF, g, S, E);
        }
        {
            pg8::Gemm g{F.XN, F.Win_t + tl_off(3 * NA, 0, D), M, NA, D}; pg8::StaticOrder S; S.init(M, NA, F.G, (int)blockIdx.x);
            pg8::EpiIn E{F.QKVZ, (const LAS float*)(F.lds + LDS_GAIN_OFF), 6};
            pg8::gemm_phase<pg8::EpiIn, pg8::StaticOrder, true, PG8_SP2>(F.lds + RING_OFF, g, S, E);
        }
        if (BOTH(1)) GRID_BAR();
    }

    if (IN(2)) { p2_mixer(F); if (BOTH(2)) GRID_BAR(); }

    if (IN(3)) {
        pg8::Gemm g{F.MIX, F.Wout_t, M, D, KMIX, 0x7a7a7a7au, 0x7c7c7c7cu};
        pg8::StaticOrder S; S.init(M, D, F.G, (int)blockIdx.x);
        pg8::EpiOut E{F.XN, F.rrow, F.g1, F.XB, F.ss};
        pg8::gemm_phase<pg8::EpiOut, pg8::StaticOrder, true, PG8_SP2, true, 4>(F.lds + RING_OFF, g, S, E);
        if (BOTH(3)) GRID_BAR();
    }

    if (IN(4)) {
        pg8::Gemm g{F.XB, F.Wgu_t, M, NGU, D}; pg8::RevOrder S; S.init(M, NGU, F.G, (int)blockIdx.x);
        pg8::EpiGU E{F.ACT, F.ss};
        pg8::gemm_phase<pg8::EpiGU, pg8::RevOrder, true, PG8_SP2>(F.lds + RING_OFF, g, S, E);
        if (BOTH(4)) GRID_BAR();
    }

    if (IN(5)) {
        pg8::Gemm g{F.ACT, F.Wdn_t, M, D, FF}; pg8::StaticOrder S; S.init(M, D, F.G, (int)blockIdx.x);
        pg8::EpiDown E{F.XB, F.out};
        pg8::gemm_phase<pg8::EpiDown, pg8::StaticOrder, true, PG8_SP2>(F.lds + RING_OFF, g, S, E);
    }
#undef IN
#undef BOTH
#undef GRID_BAR
}

extern "C" void kernel_launch(void* const* d_in, const int* in_sizes, int n_in, void* d_out, int out_size, void* d_ws, size_t ws_size, hipStream_t stream) {
    static int grid = 0;
    if (grid == 0) {
        if (n_in != 13 || in_sizes[0] != M * D || out_size != M * D || ws_size < WS_END) { fprintf(stderr, "kernel_launch: unexpected shapes (n_in %d, in0 %d, out %d, ws %zu); nothing launched\n", n_in, n_in > 0 ? in_sizes[0] : -1, out_size, ws_size); grid = -1; return; }
        int dev = 0, cus = 0, per_cu = 0;
        if (hipGetDevice(&dev) != hipSuccess || hipDeviceGetAttribute(&cus, hipDeviceAttributeMultiprocessorCount, dev) != hipSuccess) { fprintf(stderr, "kernel_launch: device query failed\n"); grid = -1; return; }
        if (hipFuncSetAttribute((const void*)fwd_megakernel, hipFuncAttributeMaxDynamicSharedMemorySize, LDS_BYTES) != hipSuccess) { fprintf(stderr, "kernel_launch: hipFuncSetAttribute failed\n"); grid = -1; return; }
        if (hipOccupancyMaxActiveBlocksPerMultiprocessor(&per_cu, (const void*)fwd_megakernel, NWAVES * 64, LDS_BYTES) != hipSuccess || per_cu < 1) {
            fprintf(stderr, "kernel_launch: occupancy query reports %d workgroups per CU; nothing launched\n", per_cu); (void)hipGetLastError(); grid = -1; return; }
        (void)hipGetLastError();
        grid = cus;
    }
    if (grid < 0) return;
    if (hipMemsetAsync((char*)d_ws + WS_CTL, 0, CTL_ZERO_BYTES, stream) != hipSuccess) { fprintf(stderr, "kernel_launch: hipMemsetAsync failed\n"); return; }
    Args a{};
    for (int i = 0; i < 13; ++i) a.in[i] = (const float*)d_in[i];
    a.out = (float*)d_out; a.ws = (unsigned char*)d_ws;
    for (int li = 0; li < N_LAUNCHES; ++li) {
        a.ph_lo = (N_LAUNCHES == PER_PHASE) ? li : 0; a.ph_hi = (N_LAUNCHES == PER_PHASE) ? li + 1 : PER_PHASE; a.li = li;
        hipLaunchKernelGGL(fwd_megakernel, dim3(grid), dim3(NWAVES * 64), LDS_BYTES, stream, a);
        const hipError_t le = hipPeekAtLastError();
        if (le != hipSuccess) { fprintf(stderr, "kernel_launch: launch %d failed: %s\n", li, hipGetErrorName(le)); break; }
    }
}
```

```cpp
#include <hip/hip_runtime.h>
#include <cstdio>
#include <cstdint>

#define LAS __attribute__((address_space(3)))
#define GAS __attribute__((address_space(1)))
typedef unsigned short bf16_t;
typedef short bf16x8 __attribute__((ext_vector_type(8)));
typedef short s16x4 __attribute__((ext_vector_type(4)));
typedef float f32x4 __attribute__((ext_vector_type(4)));
typedef float f32x2 __attribute__((ext_vector_type(2)));
typedef unsigned u32x4 __attribute__((ext_vector_type(4)));
typedef unsigned u32x2 __attribute__((ext_vector_type(2)));
constexpr int KMIX = 768;
typedef int i32x4 __attribute__((ext_vector_type(4)));
typedef int i32x8 __attribute__((ext_vector_type(8)));

constexpr int BATCH = 16, SEQ = 4096, D = 1024, M = BATCH * SEQ;
constexpr int NA = 512, NHEAD = 8, HD = 64, NIN = 2048, FF = 2816, NGU = 2 * FF;
constexpr float EPS = 1e-6f;
constexpr float LOG2E = 1.4426950408889634f;

__host__ __device__ __forceinline__ size_t tl_off(int row, int k, int K) { return ((((size_t)(row >> 4) * (size_t)(K >> 5)) + (size_t)(k >> 5)) << 9) + (size_t)((row & 15) * 32 + (k & 31)); }

__device__ __forceinline__ unsigned cvt_pk_bf16(float lo, float hi) { unsigned r; asm volatile("v_cvt_pk_bf16_f32 %0, %1, %2" : "=v"(r) : "v"(lo), "v"(hi)); return r; }

namespace pg8 {
constexpr int BM = 256, BK = 64, HALF = 128, HTB = HALF * BK * 2, STAGE_BYTES = 8 * HTB, NXCD = 8, WGM = 8;

__host__ __device__ __forceinline__ int lds_byte(int r, int c) { const int st = (r >> 4) * 2 + (c >> 5), rr = r & 15, cc = c & 31, ob = rr * 64 + cc * 2; return st * 1024 + (ob ^ (((ob >> 9) & 1) << 5)); }
__host__ __device__ __forceinline__ void stage_rc(int b, int& R, int& C) { const int st = b / 1024, sb = b % 1024, swz = sb ^ (((sb >> 9) & 1) << 5); R = (st >> 1) * 16 + swz / 64; C = (st & 1) * 32 + (swz % 64) / 2; }
__host__ __device__ __forceinline__ int perm32(int rho) { const int n = rho >> 4, i = rho & 15; return 8 * (i >> 2) + 4 * n + (i & 3); }

struct Unit { int pm, pn; };
struct Gemm { const bf16_t* A; const bf16_t* Bt; int M, N, K; unsigned sw8 = 0x7f7f7f7fu, sa8 = 0x7f7f7f7fu; };

struct StaticOrder {
    int nM, nN, nwg, G, c, wgm;
    __host__ __device__ void init(int M_, int N_, int G_, int c_, int wgm_ = WGM) { nM = M_ / BM; nN = N_ / BM; nwg = nM * nN; G = G_; c = c_; wgm = wgm_; }
    __host__ __device__ bool next(int i, Unit& u) const {
        const long L = (long)i * G + c; if (L >= nwg) return false;
        int wgid = (int)L; { const int q = nwg / NXCD, r = nwg % NXCD, xcd = wgid % NXCD, off = wgid / NXCD; wgid = (xcd < r ? xcd * (q + 1) : r * (q + 1) + (xcd - r) * q) + off; }
        const int nig = wgm * nN, gid = wgid / nig, fm = gid * wgm, gsz = (nM % wgm == 0) ? wgm : ((nM - fm) < wgm ? (nM - fm) : wgm);
        u.pm = fm + ((wgid % nig) % gsz); u.pn = (wgid % nig) / gsz; return true;
    }
    __device__ __forceinline__ void a_ready(const Unit&) const {}
    __device__ __forceinline__ void done(const Unit&) const {}
};

struct RevOrder : StaticOrder {
    __host__ __device__ bool next(int i, Unit& u) const { const bool ok = StaticOrder::next(i, u); if (ok) u.pm = nM - 1 - u.pm; return ok; }
};


__device__ __forceinline__ void store_rowpair_nt(bf16_t* pe, size_t rstride, bool lodd, const u32x4 w0, const u32x4 w1) {
    const u32x4 t = lodd ? w0 : w1; u32x4 g;
    { const unsigned t0 = t.x, t1 = t.y, t2 = t.z, t3 = t.w;
      g.x = (unsigned)__builtin_amdgcn_mov_dpp((int)t0, 0xB1, 0xf, 0xf, true); g.y = (unsigned)__builtin_amdgcn_mov_dpp((int)t1, 0xB1, 0xf, 0xf, true);
      g.z = (unsigned)__builtin_amdgcn_mov_dpp((int)t2, 0xB1, 0xf, 0xf, true); g.w = (unsigned)__builtin_amdgcn_mov_dpp((int)t3, 0xB1, 0xf, 0xf, true); }
    const u32x4 s1 = lodd ? g : w0, s2 = lodd ? w1 : g;
    __builtin_nontemporal_store(s1, (u32x4*)pe); __builtin_nontemporal_store(s2, (u32x4*)(pe + rstride));
}
struct EpiIn {
    static constexpr bool PERM = true, AFTER_DRAIN = false, PREFETCH = false;
    bf16_t* QKVZ; const LAS float* gl; int pn0;
    __device__ __forceinline__ void operator()(const f32x4 (&acc)[2][2][4][2], const Unit& u, int wr, int wc, int fr, int fq) const {
        const int pn = u.pn + pn0, kind = pn >> 1;
        const int row0 = u.pm * BM + wr * 64 + fr;
        const int head = 4 * (pn & 1) + wc; const size_t rstride = kind < 3 ? HD : NA;
        bf16_t* base = QKVZ + (size_t)kind * ((size_t)M * NA) + 8 * fq
                     + (kind < 3 ? ((size_t)((row0 >> 12) * NHEAD + head) * SEQ + (row0 & (SEQ - 1))) * HD : (size_t)row0 * NA + head * HD);
        const bool lodd = fr & 1; bf16_t* base_e = base - (size_t)(fr & 1) * rstride + 32 * (fr & 1);
        if (kind < 2) {
            const LAS float* g = gl + 64 * kind + 8 * fq;
            f32x4 gv[2][2];
#pragma unroll
            for (int bj = 0; bj < 2; ++bj)
#pragma unroll
                for (int n = 0; n < 2; ++n) gv[bj][n] = *(const LAS f32x4*)(g + 32 * bj + 4 * n);
            float ss[8];
#pragma unroll
            for (int i = 0; i < 8; ++i) { const int ai = i >> 2, m = i & 3; float a = 0.f;
#pragma unroll
                for (int bj = 0; bj < 2; ++bj)
#pragma unroll
                    for (int n = 0; n < 2; ++n) { const f32x4 v = acc[ai][bj][m][n]; a += (v[0] * v[0] + v[1] * v[1]) + (v[2] * v[2] + v[3] * v[3]); }
                ss[i] = a; }
#pragma unroll
            for (int i = 0; i < 8; ++i) ss[i] += __shfl_xor(ss[i], 16);
#pragma unroll
            for (int i = 0; i < 8; ++i) ss[i] += __shfl_xor(ss[i], 32);
#pragma unroll
            for (int i = 0; i < 8; ++i) { const int ai = i >> 2, m = i & 3;
                const float r = __builtin_amdgcn_rsqf(ss[i] * (1.0f / 64.0f) + EPS);
                u32x4 w[2];
#pragma unroll
                for (int bj = 0; bj < 2; ++bj) {
                    const f32x4 v0 = acc[ai][bj][m][0] * r * gv[bj][0], v1 = acc[ai][bj][m][1] * r * gv[bj][1];
                    w[bj].x = cvt_pk_bf16(v0[0], v0[1]); w[bj].y = cvt_pk_bf16(v0[2], v0[3]); w[bj].z = cvt_pk_bf16(v1[0], v1[1]); w[bj].w = cvt_pk_bf16(v1[2], v1[3]); }
                store_rowpair_nt(base_e + (size_t)(ai * HALF + m * 16) * rstride, rstride, lodd, w[0], w[1]);
            }
        } else {
#pragma unroll
            for (int ai = 0; ai < 2; ++ai)
#pragma unroll
                for (int m = 0; m < 4; ++m) {
                    u32x4 w[2];
#pragma unroll
                    for (int bj = 0; bj < 2; ++bj) {
                        const f32x4 v0 = acc[ai][bj][m][0], v1 = acc[ai][bj][m][1];
                        w[bj].x = cvt_pk_bf16(v0[0], v0[1]); w[bj].y = cvt_pk_bf16(v0[2], v0[3]); w[bj].z = cvt_pk_bf16(v1[0], v1[1]); w[bj].w = cvt_pk_bf16(v1[2], v1[3]); }
                    store_rowpair_nt(base_e + (size_t)(ai * HALF + m * 16) * rstride, rstride, lodd, w[0], w[1]);
                }
        }
    }
};

struct EpiOut {
    static constexpr bool PERM = true, AFTER_DRAIN = false, PREFETCH = false;
    const bf16_t* XN; const float* rrow; const float* g1; bf16_t* XB; float* ss;
    __device__ __forceinline__ void operator()(const f32x4 (&acc)[2][2][4][2], const Unit& u, int wr, int wc, int fr, int fq) const {
        const int row0 = u.pm * BM + wr * 64 + fr, col0 = u.pn * BM + wc * 32 + 8 * fq;
        const size_t off0 = (size_t)row0 * D + col0;
        const bf16_t* __restrict__ xp = XN + tl_off(row0, col0, D); bf16_t* __restrict__ bp = XB + tl_off(row0, col0, D);
        f32x4 gi[2][2];
#pragma unroll
        for (int bj = 0; bj < 2; ++bj)
#pragma unroll
            for (int n = 0; n < 2; ++n) { const f32x4 gv = *(const f32x4*)(g1 + col0 + bj * HALF + 4 * n);
                gi[bj][n] = (f32x4){__builtin_amdgcn_rcpf(gv[0]), __builtin_amdgcn_rcpf(gv[1]), __builtin_amdgcn_rcpf(gv[2]), __builtin_amdgcn_rcpf(gv[3])}; }
        u32x4 xa[8][2]; float rr[8], part[8];
#pragma unroll
        for (int i = 0; i < 8; ++i) rr[i] = rrow[row0 + (i >> 2) * HALF + (i & 3) * 16];
#define EO_LOAD(i) do { const size_t o_ = (size_t)((((i) >> 2) * 8 + ((i) & 3)) * (D / 32)) * 512; xa[i][0] = __builtin_nontemporal_load((const u32x4*)(xp + o_)); xa[i][1] = __builtin_nontemporal_load((const u32x4*)(xp + o_ + 4 * 512)); } while (0)
        EO_LOAD(0); EO_LOAD(1); EO_LOAD(2); EO_LOAD(3);
        asm volatile("" ::: "memory");
#pragma unroll
        for (int i = 0; i < 8; ++i) { const int ai = i >> 2, m = i & 3; const size_t o_ = (size_t)(ai * HALF + m * 16) * D; float p = 0.f;
#pragma unroll
            for (int bj = 0; bj < 2; ++bj) { const u32x4 w_ = xa[i][bj];
                const f32x4 x0 = {__builtin_bit_cast(float, w_.x << 16), __builtin_bit_cast(float, w_.x & 0xffff0000u), __builtin_bit_cast(float, w_.y << 16), __builtin_bit_cast(float, w_.y & 0xffff0000u)};
                const f32x4 x1 = {__builtin_bit_cast(float, w_.z << 16), __builtin_bit_cast(float, w_.z & 0xffff0000u), __builtin_bit_cast(float, w_.w << 16), __builtin_bit_cast(float, w_.w & 0xffff0000u)};
                const f32x4 v0 = acc[ai][bj][m][0] + x0 * (gi[bj][0] * rr[i]), v1 = acc[ai][bj][m][1] + x1 * (gi[bj][1] * rr[i]);
                u32x4 w; w.x = cvt_pk_bf16(v0[0], v0[1]); w.y = cvt_pk_bf16(v0[2], v0[3]); w.z = cvt_pk_bf16(v1[0], v1[1]); w.w = cvt_pk_bf16(v1[2], v1[3]);
                __builtin_nontemporal_store(w, (u32x4*)(bp + (size_t)((ai * 8 + m) * (D / 32) + 4 * bj) * 512));
                p += (v0[0] * v0[0] + v0[1] * v0[1]) + (v0[2] * v0[2] + v0[3] * v0[3]) + (v1[0] * v1[0] + v1[1] * v1[1]) + (v1[2] * v1[2] + v1[3] * v1[3]); }
            part[i] = p;
            if (i + 4 < 8) { EO_LOAD((i + 4) & 7); }
            asm volatile("" ::: "memory"); }
#undef EO_LOAD
#pragma unroll
        for (int i = 0; i < 8; ++i) part[i] += __shfl_xor(part[i], 16);
#pragma unroll
        for (int i = 0; i < 8; ++i) part[i] += __shfl_xor(part[i], 32);
        if (fq == 0) {
#pragma unroll
            for (int i = 0; i < 8; ++i) atomicAdd(ss + row0 + (i >> 2) * HALF + (i & 3) * 16, part[i]);
        }
    }
};

struct EpiGU {
    static constexpr bool PERM = true, AFTER_DRAIN = false, PREFETCH = true;
    bf16_t* ACT; const float* ss; unsigned lds_ss; const LAS float* ssl;
    __device__ __forceinline__ void prefetch(const Unit& u, int wid) const {
        if (wid == 0) { const int l = (int)__builtin_amdgcn_mbcnt_hi(~0u, __builtin_amdgcn_mbcnt_lo(~0u, 0u)); const float* src = ss + u.pm * BM + 4 * l;
            asm volatile("s_mov_b32 m0, %1\n\ts_nop 0\n\tglobal_load_lds_dwordx4 %0, off" :: "v"(src), "s"(lds_ss) : "memory"); }
    }
    __device__ __forceinline__ void operator()(const f32x4 (&acc)[2][2][4][2], const Unit& u, int wr, int wc, int fr, int fq) const {
        const int row0 = u.pm * BM + wr * 64 + fr, col0 = u.pn * HALF + wc * 32 + 8 * fq;
        float sv[8];
#pragma unroll
        for (int i = 0; i < 8; ++i) sv[i] = ssl[wr * 64 + fr + (i >> 2) * HALF + (i & 3) * 16];
        asm volatile("" ::: "memory");
#pragma unroll
        for (int i = 0; i < 8; ++i) { const int ai = i >> 2, m = i & 3;
            const float rstd = __builtin_amdgcn_rsqf(sv[i] * (1.0f / (float)D) + EPS), ne = -LOG2E * rstd, r2 = rstd * rstd;
            unsigned w[4];
#pragma unroll
            for (int n = 0; n < 2; ++n)
#pragma unroll
                for (int h = 0; h < 2; ++h) {
                    const f32x2 g = {acc[ai][0][m][n][2 * h], acc[ai][0][m][n][2 * h + 1]}, up = {acc[ai][1][m][n][2 * h], acc[ai][1][m][n][2 * h + 1]};
                    const f32x2 t = g * ne; f32x2 e; e.x = __builtin_amdgcn_exp2f(t.x); e.y = __builtin_amdgcn_exp2f(t.y);
                    const f32x2 d = e + 1.0f; f32x2 r; r.x = __builtin_amdgcn_rcpf(d.x); r.y = __builtin_amdgcn_rcpf(d.y);
                    const f32x2 a = (g * up) * (r * r2);
                    w[2 * n + h] = cvt_pk_bf16(a.x, a.y); }
            __builtin_nontemporal_store((u32x4){w[0], w[1], w[2], w[3]}, (u32x4*)(ACT + tl_off(row0 + ai * HALF + m * 16, col0, FF)));
        }
    }
};

struct EpiDown {
    static constexpr bool PERM = true, AFTER_DRAIN = false, PREFETCH = false;
    const bf16_t* XB; float* out;
    __device__ __forceinline__ void operator()(const f32x4 (&acc)[2][2][4][2], const Unit& u, int wr, int wc, int fr, int fq) const {
        const int row0 = u.pm * BM + wr * 64 + fr, col0 = u.pn * BM + wc * 32 + 8 * fq;
        const bf16_t* __restrict__ bp = XB + tl_off(row0, col0, D);
        const bool lodd = fr & 1; float* __restrict__ ope = out + (size_t)(row0 - (fr & 1)) * D + col0 + 4 * (fr & 1);
        u32x4 xa[8][2];
#define ED_LOAD(i) do { const size_t o_ = (size_t)((((i) >> 2) * 8 + ((i) & 3)) * (D / 32)) * 512; xa[i][0] = __builtin_nontemporal_load((const u32x4*)(bp + o_)); xa[i][1] = __builtin_nontemporal_load((const u32x4*)(bp + o_ + 4 * 512)); } while (0)
        ED_LOAD(0); ED_LOAD(1); ED_LOAD(2); ED_LOAD(3);
        asm volatile("" ::: "memory");
#pragma unroll
        for (int i = 0; i < 8; ++i) { const int ai = i >> 2, m = i & 3; const size_t o_ = (size_t)(ai * HALF + m * 16) * D;
#pragma unroll
            for (int bj = 0; bj < 2; ++bj) { const u32x4 w = xa[i][bj];
                const f32x4 r0 = {__builtin_bit_cast(float, w.x << 16), __builtin_bit_cast(float, w.x & 0xffff0000u), __builtin_bit_cast(float, w.y << 16), __builtin_bit_cast(float, w.y & 0xffff0000u)};
                const f32x4 r1 = {__builtin_bit_cast(float, w.z << 16), __builtin_bit_cast(float, w.z & 0xffff0000u), __builtin_bit_cast(float, w.w << 16), __builtin_bit_cast(float, w.w & 0xffff0000u)};
                const f32x4 vA = acc[ai][bj][m][0] + r0, vB = acc[ai][bj][m][1] + r1, t = lodd ? vA : vB; f32x4 g;
#pragma unroll
                for (int e = 0; e < 4; ++e) { const float te = t[e]; g[e] = __builtin_bit_cast(float, __builtin_amdgcn_mov_dpp(__builtin_bit_cast(int, te), 0xB1, 0xf, 0xf, true)); }
                const f32x4 s1 = lodd ? g : vA, s2 = lodd ? vB : g;
                *(f32x4*)(ope + o_ + bj * HALF) = s1; *(f32x4*)(ope + D + o_ + bj * HALF) = s2; }
            if (i + 4 < 8) { ED_LOAD((i + 4) & 7); }
            asm volatile("" ::: "memory"); }
#undef ED_LOAD
    }
};

constexpr int ALL8 = 1 << 20;
template <class Epi, class Sched, bool ALIGN_EPI = false, bool SP2 = false, bool A_TILED = true, int NT8 = 0>
__device__ __forceinline__ void gemm_phase(LAS unsigned char* lds, const Gemm g, const Sched& S, const Epi& E, const int wave) {
    static_assert(SP2, "only the two-MMA-blocks-per-barrier schedule is kept");
    int tid_ = wave * 64 + (int)__builtin_amdgcn_mbcnt_hi(~0u, __builtin_amdgcn_mbcnt_lo(~0u, 0u)); asm volatile("" : "+v"(tid_));
    const int tid = tid_, wid = __builtin_amdgcn_readfirstlane(tid >> 6), lane = tid & 63, wr = wid >> 2, wc = wid & 3, fr = lane & 15, fq = lane >> 4;
    const int K = g.K, nt = K / BK;
    unsigned voffA[2], voffB[2];
#pragma unroll
    for (int i = 0; i < 2; ++i) { int R, C; stage_rc(tid * 16 + i * 8192, R, C); const int Rb = Epi::PERM ? ((R & ~31) + perm32(R & 31)) : R;
        voffA[i] = A_TILED ? (unsigned)tl_off(R, C, K) * 2u : (unsigned)(R * K + C) * 2u; voffB[i] = (unsigned)tl_off(Rb, C, K) * 2u; }
    const size_t kstepA = A_TILED ? (size_t)2048 : (size_t)(BK * 2), kstepB = 2048;
    const size_t hstep = (size_t)HALF * K * 2;
    const size_t tstep = 2 * hstep;
    const unsigned ldsw = (unsigned)wid * 1024u;
    const unsigned ldsbase = (unsigned)(size_t)lds + ldsw;
    const int aoff = lds_byte(wr * 64 + fr, fq * 8), boff = lds_byte(wc * 32 + fr, fq * 8);
#define PG8_SA(b, h) (((b) * 2 + (h)) * HTB)
#define PG8_SB(b, h) ((4 + (b) * 2 + (h)) * HTB)
#define PG8_STAGE(bufoff, gbase, voff) do { _Pragma("unroll") for (int _i = 0; _i < 2; ++_i) \
        asm volatile("s_mov_b32 m0, %2\n\ts_nop 0\n\tglobal_load_lds_dwordx4 %0, %1" :: "v"((voff)[_i]), "s"((const char*)(gbase)), "s"(ldsbase + (unsigned)((bufoff) + _i * 8192)) : "memory"); } while (0)
#define PG8_LDA(dst, b, h) do { _Pragma("unroll") for (int m = 0; m < 4; ++m) _Pragma("unroll") for (int k = 0; k < 2; ++k) dst[m][k] = *(const LAS bf16x8*)(lds + PG8_SA(b, h) + aoff + m * 2048 + k * 1024); } while (0)
#define PG8_LDB(dst, b, h) do { _Pragma("unroll") for (int n = 0; n < 2; ++n) _Pragma("unroll") for (int k = 0; k < 2; ++k) dst[n][k] = *(const LAS bf16x8*)(lds + PG8_SB(b, h) + boff + n * 2048 + k * 1024); } while (0)
#define PG8_CAT8(lo, hi) __builtin_shufflevector(__builtin_bit_cast(i32x4, lo), __builtin_bit_cast(i32x4, hi), 0, 1, 2, 3, 4, 5, 6, 7)
#define PG8_MMA(F8, Z, ai, bj, At, Bt) do { __builtin_amdgcn_s_setprio(1); \
        if constexpr (F8) { _Pragma("unroll") for (int m = 0; m < 4; ++m) _Pragma("unroll") for (int n = 0; n < 2; ++n) { \
            if constexpr (Z) asm volatile("v_mfma_scale_f32_16x16x128_f8f6f4 %0, %1, %2, 0, %3, %4 op_sel_hi:[0,0,0]" : "=&v"(acc[ai][bj][m][n]) : "v"(PG8_CAT8(Bt[n][0], Bt[n][1])), "v"(PG8_CAT8(At[m][0], At[m][1])), "v"(sc8w), "v"(sc8a)); \
            else asm volatile("v_mfma_scale_f32_16x16x128_f8f6f4 %0, %1, %2, %0, %3, %4 op_sel_hi:[0,0,0]" : "+v"(acc[ai][bj][m][n]) : "v"(PG8_CAT8(Bt[n][0], Bt[n][1])), "v"(PG8_CAT8(At[m][0], At[m][1])), "v"(sc8w), "v"(sc8a)); } } \
        else if constexpr (Z) {     \
            _Pragma("unroll") for (int m = 0; m < 4; ++m) _Pragma("unroll") for (int n = 0; n < 2; ++n) \
                asm volatile("v_mfma_f32_16x16x32_bf16 %0, %1, %2, 0" : "=&v"(acc[ai][bj][m][n]) : "v"(Bt[n][0]), "v"(At[m][0])); \
            _Pragma("unroll") for (int m = 0; m < 4; ++m) _Pragma("unroll") for (int n = 0; n < 2; ++n) \
                asm volatile("v_mfma_f32_16x16x32_bf16 %0, %1, %2, %0" : "+v"(acc[ai][bj][m][n]) : "v"(Bt[n][1]), "v"(At[m][1])); } \
        else { _Pragma("unroll") for (int m = 0; m < 4; ++m) _Pragma("unroll") for (int n = 0; n < 2; ++n) _Pragma("unroll") for (int k = 0; k < 2; ++k) \
            acc[ai][bj][m][n] = __builtin_amdgcn_mfma_f32_16x16x32_bf16(Bt[n][k], At[m][k], acc[ai][bj][m][n], 0, 0, 0); } \
        __builtin_amdgcn_s_setprio(0); } while (0)
#define PG8_WAIT_V(n) asm volatile("s_waitcnt vmcnt(" #n ")" ::: "memory")
#define PG8_WAIT_L(n) asm volatile("s_waitcnt lgkmcnt(" #n ")" ::: "memory")
#define PG8_BAR __builtin_amdgcn_s_barrier()
#define PG8_SCHED __builtin_amdgcn_sched_barrier(0)
    const unsigned sc8w = g.sw8, sc8a = g.sa8;
    Unit cur, nxt; int ui = 0;
    if (!S.next(0, cur)) return;
    f32x4 acc[2][2][4][2];
    bf16x8 At[4][2], B0[2][2], B1[2][2];
    const char* cA = (const char*)g.A + (size_t)cur.pm * tstep; const char* cB = (const char*)g.Bt + (size_t)cur.pn * tstep;
    S.a_ready(cur);
    PG8_STAGE(PG8_SB(0, 0), cB, voffB); PG8_STAGE(PG8_SB(0, 1), cB + hstep, voffB); PG8_STAGE(PG8_SA(0, 0), cA, voffA); PG8_STAGE(PG8_SA(0, 1), cA + hstep, voffA);
    if (wr == 1) PG8_BAR;
    PG8_WAIT_V(2); PG8_BAR;
    PG8_STAGE(PG8_SB(1, 0), cB + kstepB, voffB); PG8_STAGE(PG8_SA(1, 0), cA + kstepA, voffA); PG8_STAGE(PG8_SB(1, 1), cB + hstep + kstepB, voffB);
    PG8_WAIT_V(6); PG8_BAR;
    for (;;) {
        const bool has_next = S.next(ui + 1, nxt);
        const char* nA = has_next ? (const char*)g.A + (size_t)nxt.pm * tstep : cA; const char* nB = has_next ? (const char*)g.Bt + (size_t)nxt.pn * tstep : cB;
#define PG8_ITER_X(F8, Z) { \
            const bool last = (t == nt - 2); \
            const char* a1 = cA + (size_t)(t + 1) * kstepA; \
            const char* a2 = last ? nA : cA + (size_t)(t + 2) * kstepA; const char* b2 = last ? nB : cB + (size_t)(t + 2) * kstepB; \
            const char* a3 = a2 + kstepA; const char* b3 = b2 + kstepB; \
            if (last && has_next) S.a_ready(nxt); \
            if constexpr (Epi::PREFETCH) { if (last) E.prefetch(cur, wid); } \
            PG8_LDB(B0, 0, 0); PG8_LDB(B1, 0, 1); PG8_SCHED; PG8_LDA(At, 0, 0); PG8_STAGE(PG8_SA(1, 1), a1 + hstep, voffA); \
            PG8_WAIT_V(8); PG8_WAIT_L(0); PG8_BAR; PG8_MMA(F8, Z, 0, 0, At, B0); PG8_MMA(F8, Z, 0, 1, At, B1); PG8_BAR; PG8_SCHED; \
            PG8_LDA(At, 0, 1); PG8_STAGE(PG8_SB(0, 0), b2, voffB); PG8_STAGE(PG8_SB(0, 1), b2 + hstep, voffB); PG8_STAGE(PG8_SA(0, 0), a2, voffA); \
            PG8_WAIT_V(8); PG8_WAIT_L(0); PG8_BAR; PG8_MMA(F8, Z, 1, 0, At, B0); PG8_MMA(F8, Z, 1, 1, At, B1); PG8_BAR; PG8_SCHED; \
            PG8_LDB(B0, 1, 0); PG8_LDB(B1, 1, 1); PG8_SCHED; PG8_LDA(At, 1, 0); PG8_STAGE(PG8_SA(0, 1), a2 + hstep, voffA); \
            PG8_WAIT_V(8); PG8_WAIT_L(0); PG8_BAR; PG8_MMA(F8, false, 0, 0, At, B0); PG8_MMA(F8, false, 0, 1, At, B1); PG8_BAR; PG8_SCHED; \
            PG8_LDA(At, 1, 1); PG8_STAGE(PG8_SB(1, 0), b3, voffB); PG8_STAGE(PG8_SB(1, 1), b3 + hstep, voffB); PG8_STAGE(PG8_SA(1, 0), a3, voffA); \
            PG8_WAIT_V(8); PG8_WAIT_L(0); PG8_BAR; PG8_MMA(F8, false, 1, 0, At, B0); PG8_MMA(F8, false, 1, 1, At, B1); PG8_BAR; PG8_SCHED; }
#define PG8_ITER(F8) PG8_ITER_X(F8, false)
#define PG8_ITER_FIRST(F8) PG8_ITER_X(F8, true)
        int t = 0;
        if constexpr (NT8 > 0) { const int nt8 = NT8 < nt ? NT8 : nt;
            { PG8_ITER_FIRST(true) } t = 2;
            _Pragma("nounroll") for (; t < nt8; t += 2) PG8_ITER(true)
            if constexpr (NT8 < ALL8) asm volatile("s_nop 15\n\ts_nop 15" ::: "memory"); }
        if constexpr (NT8 < ALL8) {
            if constexpr (NT8 == 0) { { PG8_ITER_FIRST(false) } t = 2; }
            _Pragma("nounroll") for (; t < nt; t += 2) PG8_ITER(false) }
        if constexpr (NT8 > 0) asm volatile("s_nop 15\n\ts_nop 15\n\ts_nop 15" ::: "memory");
        if constexpr (ALIGN_EPI) { if (wr == 0) PG8_BAR; }
        if constexpr (!Epi::AFTER_DRAIN) { int fr_ = fr, fq_ = fq; asm volatile("" : "+v"(fr_), "+v"(fq_));
            E(acc, cur, wr, wc, fr_, fq_); S.done(cur); }
        if (!has_next) break;
        cur = nxt; cA = nA; cB = nB; ++ui;
        if constexpr (ALIGN_EPI) { if (wr == 1) PG8_BAR; }
    }
    PG8_WAIT_V(0);
    if constexpr (!ALIGN_EPI) { if (wr == 0) PG8_BAR; }
    PG8_BAR;
#undef PG8_SA
#undef PG8_SB
#undef PG8_STAGE
#undef PG8_LDA
#undef PG8_LDB
#undef PG8_MMA
#undef PG8_ITER
#undef PG8_ITER_X
#undef PG8_ITER_FIRST
#undef PG8_CAT8
#undef PG8_WAIT_V
#undef PG8_WAIT_L
#undef PG8_BAR
#undef PG8_SCHED
}
}

constexpr int NWAVES = 8;
#ifndef MK_N_LAUNCHES
#define MK_N_LAUNCHES 1
#endif
constexpr int N_LAUNCHES = MK_N_LAUNCHES;
constexpr int PER_PHASE = 6;
#ifndef PG8_SP2
#define PG8_SP2 true
#endif

constexpr size_t MiB = 1u << 20;
constexpr size_t WS_CTL = 0, CTL_ZERO_BYTES = 1 * MiB;
constexpr size_t WS_WIN = 2 * MiB;
constexpr size_t WS_WOUT = 6 * MiB;
constexpr size_t WS_WGU = 8 * MiB;
constexpr size_t WS_WDN = 20 * MiB;
constexpr size_t WS_XN = 32 * MiB;
constexpr size_t WS_QKVZ = 160 * MiB;
constexpr size_t WS_ACT = 416 * MiB;
constexpr size_t WS_XB = 768 * MiB;
constexpr size_t WS_XN8 = 896 * MiB;
constexpr size_t WS_WIN8 = 960 * MiB;
constexpr size_t WS_END = 962 * MiB;
static_assert(WS_WGU + (size_t)NGU * D * 2 <= WS_WDN && WS_WDN + (size_t)D * FF * 2 <= WS_XN && WS_ACT + (size_t)M * FF * 2 <= WS_END, "d_ws map");
constexpr int CW_BAR = 4096;
constexpr int CW_SS = 65536;
static_assert((size_t)(CW_SS + 2 * M) * 4 <= CTL_ZERO_BYTES, "ss, rrow inside the control region");

constexpr int RING_OFF = 0, RING_BYTES = 131072;
constexpr int LDSCTL_OFF = 157696, MISC_OFF = LDSCTL_OFF + 320;
constexpr int LDS_GAIN_OFF = LDSCTL_OFF + 512;
constexpr int LDS_BYTES = 163840;

typedef GAS unsigned gu32;
#define RLX_AGENT __ATOMIC_RELAXED, __HIP_MEMORY_SCOPE_AGENT
#define LDS_WAIT() asm volatile("s_waitcnt lgkmcnt(0)" ::: "memory")
__device__ __forceinline__ unsigned f2bf(float f) { unsigned u = __builtin_bit_cast(unsigned, f); return (u + 0x7fffu + ((u >> 16) & 1u)) >> 16; }
__device__ __forceinline__ unsigned pk2(float lo, float hi) { return f2bf(lo) | (f2bf(hi) << 16); }
__device__ __forceinline__ float bflo(unsigned w) { return __builtin_bit_cast(float, w << 16); }
__device__ __forceinline__ float bfhi(unsigned w) { return __builtin_bit_cast(float, w & 0xffff0000u); }

#define XB_TMO      128
#define XB_XCNT(j)  (256  + 64 * (j))
#define XB_XSUB(j)  (1280 + 64 * (j))
#define XB_XGEN(j)  (2304 + 64 * (j))
#define XB_TOP      3328
#define XB_TOPGEN   3392
#define XCD_BAR_WORDS 3456
#define XB_SPIN_CAP (1u << 18)

__device__ __forceinline__ unsigned xb_ld(unsigned* p)              { return __hip_atomic_load(p, __ATOMIC_RELAXED, __HIP_MEMORY_SCOPE_AGENT); }
__device__ __forceinline__ unsigned xb_add(unsigned* p, unsigned v) { return __hip_atomic_fetch_add(p, v, __ATOMIC_RELAXED, __HIP_MEMORY_SCOPE_AGENT); }
__device__ __forceinline__ unsigned xb_xcc_id() { return (unsigned)__builtin_amdgcn_s_getreg((3 << 11) | 20) & 0xFu; }
#define XB_SPIN(cond, bar) do { unsigned _sp = 0; while (cond) { __builtin_amdgcn_s_sleep(1); \
    if ((++_sp & 255u) == 0u) { if (xb_ld(&(bar)[XB_TMO])) break; if (_sp > XB_SPIN_CAP) { atomicAdd(&(bar)[XB_TMO], 1u); break; } } } } while (0)

struct XcdBarrier { unsigned* bar; unsigned x; volatile LAS unsigned* st; };

__device__ __forceinline__ XcdBarrier xcd_barrier_post(unsigned* bar, volatile LAS unsigned* st) {
    XcdBarrier b; b.bar = bar; b.x = xb_xcc_id(); b.st = st;
    if (threadIdx.x == 0) (void)xb_add(&bar[XB_XCNT(b.x)], 1u);
    return b;
}
__device__ __forceinline__ void xcd_barrier_complete(unsigned* bar, unsigned x, unsigned& nloc, unsigned& nx) {
    const unsigned G = gridDim.x * gridDim.y * gridDim.z;
    unsigned sum, cnt, mine, sp = 0u;
    for (;;) {
        sum = 0u; cnt = 0u; mine = 0u;
#pragma unroll
        for (unsigned j = 0; j < 16; ++j) { const unsigned c = xb_ld(&bar[XB_XCNT(j)]); sum += c; cnt += (c > 0u) ? 1u : 0u; mine = (j == x) ? c : mine; }
        if (sum == G) break;
        __builtin_amdgcn_s_sleep(1);
        if ((++sp & 255u) == 0u) { if (xb_ld(&bar[XB_TMO])) break; if (sp > XB_SPIN_CAP) { atomicAdd(&bar[XB_TMO], 1u); break; } }
    }
    nloc = mine > 0u ? mine : 1u; nx = cnt > 0u ? cnt : 1u;
}
__device__ __forceinline__ void xcd_barrier(const XcdBarrier& b) {
    asm volatile("s_waitcnt vmcnt(0)" ::: "memory");
    __syncthreads();
    if (threadIdx.x == 0) {
        unsigned* bar = b.bar;
        __builtin_amdgcn_s_waitcnt(0);
        unsigned nloc = b.st[0], nx = b.st[1];
        if (nloc == 0u) { xcd_barrier_complete(bar, b.x, nloc, nx); b.st[0] = nloc; b.st[1] = nx; }
        const unsigned old = xb_add(&bar[XB_XSUB(b.x)], 1u);
        const unsigned gen = old / nloc;
        if (old + 1u == (gen + 1u) * nloc) {
            __builtin_amdgcn_fence(__ATOMIC_RELEASE, "agent");
            asm volatile("s_waitcnt vmcnt(0)" ::: "memory");
            const unsigned og = xb_add(&bar[XB_TOP], 1u);
            const unsigned tg = og / nx;
            if (og + 1u == (tg + 1u) * nx) xb_add(&bar[XB_TOPGEN], 1u);
            else XB_SPIN(xb_ld(&bar[XB_TOPGEN]) == tg, bar);
            __builtin_amdgcn_fence(__ATOMIC_ACQUIRE, "agent");
            xb_add(&bar[XB_XGEN(b.x)], 1u);
            asm volatile("s_waitcnt vmcnt(0)" ::: "memory");
        } else {
            XB_SPIN(xb_ld(&bar[XB_XGEN(b.x)]) == gen, bar);
            __builtin_amdgcn_fence(__ATOMIC_ACQUIRE, "agent");
            asm volatile("s_waitcnt vmcnt(0)" ::: "memory");
        }
    }
    __syncthreads();
}

struct Frame {
    LAS unsigned char* lds;
    volatile LAS unsigned* MISC;
    gu32* ctl;
    int tid, lane, wave;
    int vcu, G;
    const float *x, *g1, *w_in, *gq, *gk, *rpb, *w_pool, *pscale, *w_out, *g2, *w_gate, *w_up, *w_down;
    float* out;
    bf16_t *Win_t, *Wout_t, *Wgu_t, *Wdn_t;
    bf16_t *XN, *QKVZ, *XB, *ACT;
    unsigned char *XN8, *Win8;
    float* ss; float* rrow; bf16_t* MIX;
};

__device__ __forceinline__ float wave_sum(float v) {
#pragma unroll
    for (int o = 1; o < 64; o <<= 1) v += __shfl_xor(v, o);
    return v;
}

__device__ __forceinline__ void p0_tile_out(bf16_t* WT, int K, int drow0, int k0, LAS float* scr, int lane) {
    LDS_WAIT(); asm volatile("" ::: "memory");
    const int c = lane & 7;
#pragma unroll
    for (int j = 0; j < 4; ++j) { const int n = (lane >> 3) + 8 * j; const LAS float* s = scr + (8 * c) * 33 + n;
        u32x4 o; o.x = pk2(s[0 * 33], s[1 * 33]); o.y = pk2(s[2 * 33], s[3 * 33]); o.z = pk2(s[4 * 33], s[5 * 33]); o.w = pk2(s[6 * 33], s[7 * 33]);
        *(GAS u32x4*)(WT + tl_off(drow0 + n, k0 + 8 * c, K)) = o; }
    LDS_WAIT(); asm volatile("" ::: "memory");
}
__device__ __forceinline__ unsigned pk4_fp8(float a, float b, float c, float d) {
    unsigned w = 0; w = (unsigned)__builtin_amdgcn_cvt_pk_fp8_f32(a, b, (int)w, false); w = (unsigned)__builtin_amdgcn_cvt_pk_fp8_f32(c, d, (int)w, true); return w; }
__device__ __forceinline__ size_t tl8_off(int row, int k, int K) { return (size_t)tl_off(row, k >> 1, K >> 1) * 2 + (k & 1); }
__device__ __forceinline__ void p0_tile_out8(unsigned char* W8, int K, int drow0, int k0, LAS float* scr, int lane) {
    LDS_WAIT(); asm volatile("" ::: "memory");
    const int c = lane & 7;
#pragma unroll
    for (int j = 0; j < 4; ++j) { const int n = (lane >> 3) + 8 * j; const LAS float* s = scr + (8 * c) * 33 + n;
        u32x2 o; o.x = pk4_fp8(32.f * s[0 * 33], 32.f * s[1 * 33], 32.f * s[2 * 33], 32.f * s[3 * 33]); o.y = pk4_fp8(32.f * s[4 * 33], 32.f * s[5 * 33], 32.f * s[6 * 33], 32.f * s[7 * 33]);
        *(GAS u32x2*)(W8 + tl8_off(drow0 + n, k0 + 8 * c, K)) = o; }
    LDS_WAIT(); asm volatile("" ::: "memory");
}
__device__ __forceinline__ void p0_transpose_item(const float* W, int ldw, int K, int k0, int n0, const float* gkv, bf16_t* WT, int drow0, LAS float* scr, int lane) {
#pragma unroll
    for (int i = 0; i < 32; ++i) { const int kk = 2 * i + (lane >> 5); float v = W[(size_t)(k0 + kk) * ldw + n0 + (lane & 31)]; if (gkv) v *= gkv[k0 + kk]; scr[kk * 33 + (lane & 31)] = v; }
    p0_tile_out(WT, K, drow0, k0, scr, lane);
}
__device__ __forceinline__ void p0_fold_item(const float* w_in, const float* w_pool, const float* pscale, int k0, int n0z, bf16_t* WT, int drow0, int lane) {
    const int n = lane & 31, kh = lane >> 5, g = n0z >> 7, d = (n0z & 127) + n;
    float acc[4] = {0.f, 0.f, 0.f, 0.f};
    const float* wrow = w_in + (size_t)(k0 + 4 * kh) * NIN + 3 * NA + 128 * g;
    const float* wp = w_pool + (size_t)g * 128 * 128 + d;
#pragma unroll 8
    for (int c4 = 0; c4 < 32; ++c4) {
        const float p0 = wp[(4 * c4 + 0) * 128], p1 = wp[(4 * c4 + 1) * 128], p2 = wp[(4 * c4 + 2) * 128], p3 = wp[(4 * c4 + 3) * 128];
#pragma unroll
        for (int i = 0; i < 4; ++i) { const f32x4 w = *(const f32x4*)(wrow + (size_t)i * NIN + 4 * c4); acc[i] += (w[0] * p0 + w[1] * p1) + (w[2] * p2 + w[3] * p3); }
    }
    const float ps = pscale[n0z + n];
    float hi[4];
#pragma unroll
    for (int i = 0; i < 4; ++i) { acc[i] *= ps; hi[i] = __shfl(acc[i], (lane + 32) & 63); }
    if (lane < 32) { u32x4 o; o.x = pk2(acc[0], acc[1]); o.y = pk2(acc[2], acc[3]); o.z = pk2(hi[0], hi[1]); o.w = pk2(hi[2], hi[3]);
        *(GAS u32x4*)(WT + tl_off(drow0 + n, k0, D)) = o; }
}
__device__ __forceinline__ int win_drow(int n0) { const int pn = n0 >> 8, c = n0 & 255; return 256 * pn + 128 * ((c >> 5) & 1) + 32 * (c >> 6); }

__device__ __forceinline__ void p0_fold_staged(Frame& F) {
    const int tid = F.tid, lane = F.lane, wave = F.wave;
    const int kb = F.vcu >> 1, g0 = 2 * (F.vcu & 1), k0 = 8 * kb;
    LAS float* Lp = (LAS float*)(F.lds + RING_OFF);
    LAS float* Lw = (LAS float*)(F.lds + RING_OFF + RING_BYTES);
    const f32x4* gp = (const f32x4*)(F.w_pool + (size_t)g0 * 128 * 128);
#pragma unroll
    for (int i = 0; i < 16; ++i) ((LAS f32x4*)Lp)[tid + 512 * i] = gp[tid + 512 * i];
#pragma unroll
    for (int i = 0; i < 2; ++i) { const int ch = tid + 512 * i, row = ch >> 7, c4 = ch & 127; ((LAS f32x4*)Lw)[ch] = *(const f32x4*)(F.w_in + (size_t)(k0 + row) * NIN + 3 * NA + 4 * c4); }
    __syncthreads();
    {   const int nb = 8 * (F.vcu & 1) + wave, n0z = 32 * nb, g = nb >> 2, n = lane & 31, kh = lane >> 5, d = (n0z & 127) + n;
        const LAS float* wp = Lp + (g - g0) * 128 * 128 + d;
        const LAS float* wr = Lw + (4 * kh) * 512 + 128 * g;
        float acc[4] = {0.f, 0.f, 0.f, 0.f};
#pragma unroll 8
        for (int c4 = 0; c4 < 32; ++c4) {
            const float p0 = wp[(4 * c4 + 0) * 128], p1 = wp[(4 * c4 + 1) * 128], p2 = wp[(4 * c4 + 2) * 128], p3 = wp[(4 * c4 + 3) * 128];
#pragma unroll
            for (int i = 0; i < 4; ++i) { const f32x4 w = *(const LAS f32x4*)(wr + i * 512 + 4 * c4); acc[i] += (w[0] * p0 + w[1] * p1) + (w[2] * p2 + w[3] * p3); }
        }
        const float ps = F.pscale[n0z + n];
        float hi[4];
#pragma unroll
        for (int i = 0; i < 4; ++i) { acc[i] *= ps; hi[i] = __shfl(acc[i], (lane + 32) & 63); }
        if (lane < 32) { u32x4 o; o.x = pk2(acc[0], acc[1]); o.y = pk2(acc[2], acc[3]); o.z = pk2(hi[0], hi[1]); o.w = pk2(hi[2], hi[3]);
            *(GAS u32x4*)(F.Win_t + tl_off(win_drow(3 * NA + 32 * nb) + n, k0, D)) = o; }
    }
    __syncthreads();
}

template <int R> __device__ __forceinline__ void rms_rows(const float* x, const f32x4 (&gg)[4], bf16_t* XN, unsigned char* XN8, float* rrow, int m0, int lane) {
    f32x4 v[R][4]; float s[R];
#pragma unroll
    for (int r = 0; r < R; ++r) { const GAS f32x4* xr = (const GAS f32x4*)(x + (size_t)(m0 + r) * D) + lane;
#pragma unroll
        for (int j = 0; j < 4; ++j) v[r][j] = xr[64 * j]; }
#pragma unroll
    for (int r = 0; r < R; ++r) { float a = 0.f;
#pragma unroll
        for (int j = 0; j < 4; ++j) a += (v[r][j].x * v[r][j].x + v[r][j].y * v[r][j].y) + (v[r][j].z * v[r][j].z + v[r][j].w * v[r][j].w);
        s[r] = a; }
#pragma unroll
    for (int o = 1; o < 64; o <<= 1) {
#pragma unroll
        for (int r = 0; r < R; ++r) s[r] += __shfl_xor(s[r], o); }
#pragma unroll
    for (int r = 0; r < R; ++r) { const float ms = s[r] * (1.f / D) + EPS, rstd = __builtin_amdgcn_rsqf(ms);
        if (lane == 0) rrow[m0 + r] = ms * rstd;
        bf16_t* orow = XN + tl_off(m0 + r, 4 * lane, D);
#pragma unroll
        for (int j = 0; j < 4; ++j) *(GAS unsigned long long*)(orow + (size_t)j * 8 * 512) = (unsigned long long)pk2(v[r][j].x * rstd * gg[j].x, v[r][j].y * rstd * gg[j].y) | ((unsigned long long)pk2(v[r][j].z * rstd * gg[j].z, v[r][j].w * rstd * gg[j].w) << 32);
        unsigned char* orow8 = XN8 + tl8_off(m0 + r, 4 * lane, D);
#pragma unroll
        for (int j = 0; j < 4; ++j) *(GAS unsigned*)(orow8 + (size_t)j * 4 * 1024) = pk4_fp8(v[r][j].x * rstd * gg[j].x, v[r][j].y * rstd * gg[j].y, v[r][j].z * rstd * gg[j].z, v[r][j].w * rstd * gg[j].w); }
}

struct P0Item { const float* W; const float* gk; bf16_t* WT; unsigned char* W8; int ldw, K, k0, n0, drow0, ko; };
__device__ __forceinline__ void p0_prologue(Frame& F) {
    LAS float* scr = (LAS float*)(F.lds + RING_OFF + F.wave * 16384);
    const int gw = F.vcu * NWAVES + F.wave, NGW = F.G * NWAVES, lane = F.lane;
    constexpr int KB = D / 64;
    constexpr int I_QKV = KB * (3 * NA / 32), I_O = KB * (D / 32), I_G = KB * (FF / 32), I_DN = (FF / 64) * (D / 32);
    constexpr int NITEMS = I_QKV + I_O + 2 * I_G + I_DN;
    if (F.G == 256) p0_fold_staged(F);
    else for (int it = gw; it < (D / 8) * (NA / 32); it += NGW) { const int nb = it & 15, kb = it >> 4; p0_fold_item(F.w_in, F.w_pool, F.pscale, 8 * kb, 32 * nb, F.Win_t, win_drow(3 * NA + 32 * nb), lane); }
    const int RPW = (M + F.G - 1) / F.G, rbeg = F.vcu * RPW, rend = (rbeg + RPW) < M ? (rbeg + RPW) : M, nb8 = (rend - rbeg) / 8;
    volatile LAS unsigned* tick = F.MISC + 16;
    int it = gw; bool rows_left = true;
    while (it < NITEMS || rows_left) {
        const bool has_item = it < NITEMS; P0Item I{};
        if (has_item) {
            int r = it;
            if (r < I_QKV) { const int nb = r % (3 * NA / 32), kb = r / (3 * NA / 32); I = P0Item{F.w_in, nullptr, nullptr, F.Win8, NIN, D, 64 * kb, 32 * nb, win_drow(32 * nb), 64 * kb}; }
            else if ((r -= I_QKV) < I_O) { const int nb = r % (D / 32), kb = r / (D / 32); I = kb < 8 ? P0Item{F.w_out, nullptr, nullptr, (unsigned char*)F.Wout_t, D, 2 * KMIX, 64 * kb, 32 * nb, 32 * nb, 64 * kb}
                                                                                                   : P0Item{F.w_out, nullptr, F.Wout_t, nullptr, D, KMIX, 64 * kb, 32 * nb, 32 * nb, 64 * kb - 256}; }
            else if ((r -= I_O) < 2 * I_G) { const int up = r >= I_G; if (up) r -= I_G; const int nb = r % (FF / 32), kb = r / (FF / 32), n0 = 32 * nb;
                I = P0Item{up ? F.w_up : F.w_gate, F.g2, F.Wgu_t, nullptr, FF, D, 64 * kb, n0, 256 * (n0 >> 7) + (n0 & 127) + 128 * up, 64 * kb}; }
            else { r -= 2 * I_G; const int nb = r % (D / 32), kb = r / (D / 32); I = P0Item{F.w_down, nullptr, F.Wdn_t, nullptr, D, FF, 64 * kb, 32 * nb, 32 * nb, 64 * kb}; }
        }
        float wv[32];
        if (has_item) {
#pragma unroll
            for (int i = 0; i < 32; ++i) { const int kk = 2 * i + (lane >> 5); wv[i] = __builtin_nontemporal_load(I.W + (size_t)(I.k0 + kk) * I.ldw + I.n0 + (lane & 31)); }
        }
        int m0 = 0;
        if (rows_left) { unsigned t = 0; if (lane == 0) t = __hip_atomic_fetch_add((LAS unsigned*)tick, 1u, __ATOMIC_RELAXED, __HIP_MEMORY_SCOPE_WORKGROUP);
            t = __builtin_amdgcn_readfirstlane(t); rows_left = (int)t < nb8; m0 = rbeg + 8 * (int)t; }
        f32x4 v[8][4];
        if (rows_left) {
#pragma unroll
            for (int r = 0; r < 8; ++r) { const GAS f32x4* xr = (const GAS f32x4*)(F.x + (size_t)(m0 + r) * D) + lane;
#pragma unroll
                for (int j = 0; j < 4; ++j) v[r][j] = __builtin_nontemporal_load(xr + 64 * j); }
        }
        if (has_item) {
            if (I.gk) {
#pragma unroll
                for (int i = 0; i < 32; ++i) wv[i] *= I.gk[I.k0 + 2 * i + (lane >> 5)];
            }
#pragma unroll
            for (int i = 0; i < 32; ++i) scr[(2 * i + (lane >> 5)) * 33 + (lane & 31)] = wv[i];
            if (I.W8) p0_tile_out8(I.W8, I.K, I.drow0, I.ko, scr, lane); else p0_tile_out(I.WT, I.K, I.drow0, I.ko, scr, lane);
        }
        if (rows_left) {
            float s[8];
#pragma unroll
            for (int r = 0; r < 8; ++r) { float a = 0.f;
#pragma unroll
                for (int j = 0; j < 4; ++j) a += (v[r][j].x * v[r][j].x + v[r][j].y * v[r][j].y) + (v[r][j].z * v[r][j].z + v[r][j].w * v[r][j].w);
                s[r] = a; }
#pragma unroll
            for (int o = 1; o < 64; o <<= 1) {
#pragma unroll
                for (int r = 0; r < 8; ++r) s[r] += __shfl_xor(s[r], o); }
            float rs8[8];
#pragma unroll
            for (int r = 0; r < 8; ++r) { const float ms = s[r] * (1.f / D) + EPS; rs8[r] = __builtin_amdgcn_rsqf(ms); if (lane == 0) F.rrow[m0 + r] = ms * rs8[r]; }
            const bool lodd = lane & 1, lhi = lane & 2;
            f32x4 gg[4];
            { int l_ = lane; asm volatile("" : "+v"(l_));
#pragma unroll
              for (int j = 0; j < 4; ++j) gg[j] = *((const f32x4*)F.g1 + l_ + 64 * j); }
#pragma unroll
            for (int rq = 0; rq < 2; ++rq) {
                unsigned q8[4][4];
#pragma unroll
                for (int rh = 0; rh < 2; ++rh) {
                    const int r0 = 4 * rq + 2 * rh, r1 = r0 + 1;
#pragma unroll
                    for (int j = 0; j < 4; ++j) {
                        const float x0 = v[r0][j].x * rs8[r0] * gg[j].x, x1 = v[r0][j].y * rs8[r0] * gg[j].y, x2 = v[r0][j].z * rs8[r0] * gg[j].z, x3 = v[r0][j].w * rs8[r0] * gg[j].w;
                        const float y0 = v[r1][j].x * rs8[r1] * gg[j].x, y1 = v[r1][j].y * rs8[r1] * gg[j].y, y2 = v[r1][j].z * rs8[r1] * gg[j].z, y3 = v[r1][j].w * rs8[r1] * gg[j].w;
                        const unsigned a0 = pk2(x0, x1), a1 = pk2(x2, x3), b0 = pk2(y0, y1), b1 = pk2(y2, y3);
                        q8[2 * rh][j] = pk4_fp8(x0, x1, x2, x3); q8[2 * rh + 1][j] = pk4_fp8(y0, y1, y2, y3);
                        const unsigned t0 = lodd ? a0 : b0, t1 = lodd ? a1 : b1;
                        const unsigned g0 = (unsigned)__builtin_amdgcn_mov_dpp((int)t0, 0xB1, 0xf, 0xf, true), g1 = (unsigned)__builtin_amdgcn_mov_dpp((int)t1, 0xB1, 0xf, 0xf, true);
                        u32x4 o; o.x = lodd ? g0 : a0; o.y = lodd ? g1 : a1; o.z = lodd ? b0 : g0; o.w = lodd ? b1 : g1;
                        *(GAS u32x4*)(F.XN + tl_off(m0 + r0 + (lane & 1), 8 * (lane >> 1) + 256 * j, D)) = o;
                        __builtin_amdgcn_sched_barrier(0);
                    }
                }
#pragma unroll
                for (int j = 0; j < 4; ++j) {
                    const unsigned t0 = q8[0][j], t1 = q8[1][j], t2 = q8[2][j], t3 = q8[3][j];
                    const unsigned sA = lodd ? t0 : t1, sB = lodd ? t2 : t3;
                    const unsigned rA = (unsigned)__builtin_amdgcn_mov_dpp((int)sA, 0xB1, 0xf, 0xf, true), rB = (unsigned)__builtin_amdgcn_mov_dpp((int)sB, 0xB1, 0xf, 0xf, true);
                    const unsigned u0 = lodd ? rA : t0, u1 = lodd ? t1 : rA;
                    const unsigned w0 = lodd ? rB : t2, w1 = lodd ? t3 : rB;
                    const unsigned c0 = lhi ? u0 : w0, c1 = lhi ? u1 : w1;
                    const unsigned d0 = (unsigned)__builtin_amdgcn_mov_dpp((int)c0, 0x4E, 0xf, 0xf, true), d1 = (unsigned)__builtin_amdgcn_mov_dpp((int)c1, 0x4E, 0xf, 0xf, true);
                    u32x4 o; o.x = lhi ? d0 : u0; o.y = lhi ? d1 : u1; o.z = lhi ? w0 : d0; o.w = lhi ? w1 : d1;
                    *(GAS u32x4*)(F.XN8 + tl8_off(m0 + 4 * rq + (lane & 3), 16 * (lane >> 2) + 256 * j, D)) = o;
                    __builtin_amdgcn_sched_barrier(0);
                }
            }
        }
        it += NGW;
    }
    if (F.wave == 0 && rbeg + 8 * nb8 < rend) { f32x4 gt[4];
#pragma unroll
        for (int j = 0; j < 4; ++j) gt[j] = *((const f32x4*)F.g1 + lane + 64 * j);
        for (int m = rbeg + 8 * nb8; m < rend; ++m) rms_rows<1>(F.x, gt, F.XN, F.XN8, F.rrow, m, lane); }
}

constexpr int AT_IMG = 15 * 40 * 128;
constexpr int AT_A = 0;
constexpr int AT_B = AT_IMG;
constexpr int AT_TAB = 2 * AT_IMG;
static_assert(AT_TAB + 15 * 64 * 4 <= LDSCTL_OFF, "attention LDS map");
__device__ __forceinline__ int rs_of(int r) { int v = r - 4; v = v < 0 ? 0 : v; return v > 56 ? 56 : v; }

struct AttnUnit { int b, h, jh, r0, krow_lo, nrows; };
__device__ __forceinline__ AttnUnit attn_decode(int un) {
    AttnUnit u; const int bh = un >> 4, rc = (un >> 1) & 7; u.jh = un & 1; u.b = bh >> 3; u.h = bh & 7;
    u.r0 = 8 * rc; u.krow_lo = rs_of(u.r0); u.nrows = rs_of(u.r0 + 7) + 8 - u.krow_lo;
    return u;
}
__device__ __forceinline__ void glds16(const void* gsrc, unsigned lds_dst) { unsigned keep;
    asm volatile("s_mov_b32 %0, m0\n\ts_mov_b32 m0, %2\n\ts_nop 0\n\tglobal_load_lds_dwordx4 %1, off\n\ts_mov_b32 m0, %0" : "=&s"(keep) : "v"(gsrc), "s"(lds_dst) : "memory"); }
#define ATT_WAIT_BAR() do { asm volatile("s_waitcnt vmcnt(0) lgkmcnt(0)" ::: "memory"); __builtin_amdgcn_s_barrier(); asm volatile("" ::: "memory"); } while (0)
template <int KIND> __device__ __forceinline__ void attn_dma(unsigned dst, const bf16_t* src, const AttnUnit& u, int wid, int lane) {
    const int np = u.nrows * 5;
    const char* base = (const char*)(src + ((size_t)(u.b * NHEAD + u.h) * SEQ + u.krow_lo * 64 + 24 * u.jh) * HD);
#pragma unroll
    for (int it = 0; it < 10; ++it) {
        const int pi = it * 8 + wid;
        if (pi < np) {
            const int w = (pi * 205) >> 10, p = pi - 5 * w, c = 8 * p + (lane >> 3);
            const int sw = (KIND == 0) ? (((c >> 1) & 1) | (((c >> 3) & 3) << 1)) : ((((c >> 1) & 1) << 1) | (((c >> 3) & 1) << 2));
            const int ch = (lane & 7) ^ sw;
            const char* gp = base + (w * 64 + c) * (HD * 2) + ch * 16;
            glds16(gp, (unsigned)__builtin_amdgcn_readfirstlane(dst + pi * 1024));
        }
    }
}

__device__ __forceinline__ void p2_attention(Frame& F, const bf16_t* Qg, const bf16_t* Kg, const bf16_t* Vg, bf16_t* MIX) {
    const int lane = F.lane, wid = F.wave;
    LAS unsigned char* lds = F.lds;
    const unsigned lds0 = (unsigned)(size_t)F.lds;
    const int q = lane & 15, g = lane >> 4;
    constexpr int NUNITS = BATCH * NHEAD * 16, UW = 8;
    for (int uidx = F.vcu * UW; uidx < NUNITS; uidx += F.G * UW) {
        const int h = (uidx >> 4) & 7;
        __syncthreads();
        {   LAS float* tab = (LAS float*)(lds + AT_TAB);
            for (int i = F.tid; i < 15 * 64; i += NWAVES * 64) { const int rr = i >> 6, cc = (i & 63) - 16; tab[i] = (cc >= 0 && cc < 31) ? F.rpb[h * 465 + rr * 31 + cc] * LOG2E : 0.f; } }
        AttnUnit u = attn_decode(uidx);
        attn_dma<0>(lds0 + AT_A, Kg, u, wid, lane);
        bf16x8 qf[2][2];
#pragma unroll
        for (int jb = 0; jb < 2; ++jb) { const bf16_t* qp = Qg + ((size_t)(u.b * NHEAD + u.h) * SEQ + (u.r0 + wid) * 64 + 32 * u.jh + 16 * jb + q) * HD + 8 * g; qf[jb][0] = __builtin_nontemporal_load((const bf16x8*)qp); qf[jb][1] = __builtin_nontemporal_load((const bf16x8*)(qp + 32)); }
        ATT_WAIT_BAR();
        for (int ui = 0; ui < UW; ++ui) {
            asm volatile("" : "+v"(qf[0][0]), "+v"(qf[0][1]), "+v"(qf[1][0]), "+v"(qf[1][1]));
            attn_dma<1>(lds0 + AT_B, Vg, u, wid, lane);
            const int r = u.r0 + wid, rs = rs_of(r), wbase = rs - u.krow_lo;
            u32x4 pw[2][8]; float il[2];
#pragma unroll
            for (int jb = 0; jb < 2; ++jb) {
                const int o = 8 * jb, kcol0 = 24 * u.jh + o, cq = 32 * u.jh + 16 * jb + q;
                int cs = cq - 8; cs = cs < 0 ? 0 : cs; cs = cs > 48 ? 48 : cs;
                f32x4 sc[8][2];
                {
                    const int fk = ((q >> 1) & 1) | (((jb + (q >> 2)) & 3) << 1), x0 = g ^ fk;
                    const LAS unsigned char* ka = lds + AT_A + (wbase * 40 + o + 8 * (q >> 2) + (q & 3)) * 128;
                    const LAS unsigned char* k0p = ka + x0 * 16;
                    const LAS unsigned char* k1p = ka + (x0 ^ 4) * 16;
#pragma unroll
                    for (int wl = 0; wl < 8; ++wl)
#pragma unroll
                        for (int blk = 0; blk < 2; ++blk) {
                            const bf16x8 k0 = *(const LAS bf16x8*)(k0p + wl * 5120 + blk * 512), k1 = *(const LAS bf16x8*)(k1p + wl * 5120 + blk * 512);
                            f32x4 a = (f32x4){0.f, 0.f, 0.f, 0.f};
                            a = __builtin_amdgcn_mfma_f32_16x16x32_bf16(k0, qf[jb][0], a, 0, 0, 0);
                            a = __builtin_amdgcn_mfma_f32_16x16x32_bf16(k1, qf[jb][1], a, 0, 0, 0);
                            sc[wl][blk] = a;
                        }
                }
                const LAS float* tab = (const LAS float*)(lds + AT_TAB) + (rs - r + 7) * 64 + 16 + (kcol0 - cq + 15) + 8 * g;
                const int voff = kcol0 + 8 * g - cs;
                float mx = -INFINITY;
#pragma unroll
                for (int wl = 0; wl < 8; ++wl)
#pragma unroll
                    for (int blk = 0; blk < 2; ++blk)
#pragma unroll
                        for (int e = 0; e < 4; ++e) {
                            const int ep = 4 * blk + e;
                            float s_ = sc[wl][blk][e] + tab[wl * 64 + ep];
                            s_ = ((unsigned)(voff + ep) < 16u) ? s_ : -INFINITY;
                            sc[wl][blk][e] = s_; mx = fmaxf(mx, s_);
                        }
                mx = fmaxf(mx, __shfl_xor(mx, 16)); mx = fmaxf(mx, __shfl_xor(mx, 32));
                float l = 0.f;
#pragma unroll
                for (int wl = 0; wl < 8; ++wl) {
                    float p[8];
#pragma unroll
                    for (int blk = 0; blk < 2; ++blk)
#pragma unroll
                        for (int e = 0; e < 4; ++e) { p[4 * blk + e] = __builtin_amdgcn_exp2f(sc[wl][blk][e] - mx); l += p[4 * blk + e]; }
                    pw[jb][wl].x = cvt_pk_bf16(p[0], p[1]); pw[jb][wl].y = cvt_pk_bf16(p[2], p[3]); pw[jb][wl].z = cvt_pk_bf16(p[4], p[5]); pw[jb][wl].w = cvt_pk_bf16(p[6], p[7]);
                }
                l += __shfl_xor(l, 16); l += __shfl_xor(l, 32);
                il[jb] = __builtin_amdgcn_rcpf(l);
            }
            ATT_WAIT_BAR();
            AttnUnit un = u; bf16x8 nq[2][2];
#pragma unroll
            for (int jb = 0; jb < 2; ++jb) { nq[jb][0] = qf[jb][0]; nq[jb][1] = qf[jb][1]; }
            if (ui < UW - 1) {
                un = attn_decode(uidx + ui + 1);
                attn_dma<0>(lds0 + AT_A, Kg, un, wid, lane);
#pragma unroll
                for (int jb = 0; jb < 2; ++jb) { const bf16_t* qp = Qg + ((size_t)(un.b * NHEAD + un.h) * SEQ + (un.r0 + wid) * 64 + 32 * un.jh + 16 * jb + q) * HD + 8 * g; nq[jb][0] = __builtin_nontemporal_load((const bf16x8*)qp); nq[jb][1] = __builtin_nontemporal_load((const bf16x8*)(qp + 32)); }
            }
#pragma unroll
            for (int jb = 0; jb < 2; ++jb) {
                const int o = 8 * jb, cq = 32 * u.jh + 16 * jb + q;
                f32x4 ov[4];
#pragma unroll
                for (int n = 0; n < 4; ++n) ov[n] = (f32x4){0.f, 0.f, 0.f, 0.f};
                {
                    const int qr = q >> 2, p = lane & 3;
                    const int fv = (((qr >> 1) & 1) << 1) | (((jb + g) & 1) << 2);
                    const LAS unsigned char* vb = lds + AT_B + (wbase * 40 + o + 8 * g + qr) * 128 + (p >> 1) * 16 + (p & 1) * 8;
                    const LAS unsigned char* vn[4];
#pragma unroll
                    for (int n = 0; n < 4; ++n) vn[n] = vb + ((2 * n) ^ fv) * 16;
#pragma unroll
                    for (int wl = 0; wl < 8; ++wl) {
                        const bf16x8 pf = __builtin_bit_cast(bf16x8, pw[jb][wl]);
#pragma unroll
                        for (int n = 0; n < 4; ++n) {
                            const s16x4 lo = __builtin_bit_cast(s16x4, __builtin_amdgcn_ds_read_tr16_b64_v4i16((LAS s16x4*)(vn[n] + wl * 5120)));
                            const s16x4 hi = __builtin_bit_cast(s16x4, __builtin_amdgcn_ds_read_tr16_b64_v4i16((LAS s16x4*)(vn[n] + wl * 5120 + 512)));
                            const bf16x8 vf = (bf16x8){lo[0], lo[1], lo[2], lo[3], hi[0], hi[1], hi[2], hi[3]};
                            ov[n] = __builtin_amdgcn_mfma_f32_16x16x32_bf16(vf, pf, ov[n], 0, 0, 0);
                        }
                    }
                }
                unsigned char* op = (unsigned char*)MIX + (size_t)tl_off(u.b * SEQ + r * 64 + cq, 32 * u.h, KMIX) * 2 + 16 * g;
                const float il8 = 8.f * il[jb];
                unsigned a0 = pk4_fp8(ov[0][0] * il8, ov[0][1] * il8, ov[0][2] * il8, ov[0][3] * il8), a1 = pk4_fp8(ov[1][0] * il8, ov[1][1] * il8, ov[1][2] * il8, ov[1][3] * il8);
                unsigned a2 = pk4_fp8(ov[2][0] * il8, ov[2][1] * il8, ov[2][2] * il8, ov[2][3] * il8), a3 = pk4_fp8(ov[3][0] * il8, ov[3][1] * il8, ov[3][2] * il8, ov[3][3] * il8);
                asm volatile("s_nop 1\n\tv_permlane32_swap_b32 %0, %2\n\tv_permlane32_swap_b32 %1, %3\n\ts_nop 1\n\tv_permlane16_swap_b32 %0, %1\n\tv_permlane16_swap_b32 %2, %3\n\ts_nop 1" : "+v"(a0), "+v"(a1), "+v"(a2), "+v"(a3));
                *(u32x4*)op = (u32x4){a0, a1, a2, a3};
            }
            ATT_WAIT_BAR();
            u = un;
#pragma unroll
            for (int jb = 0; jb < 2; ++jb) { qf[jb][0] = nq[jb][0]; qf[jb][1] = nq[jb][1]; }
        }
    }
}

__device__ __forceinline__ void up8(const u32x4 w, float (&v)[8]) {
    v[0] = bflo(w.x); v[1] = bfhi(w.x); v[2] = bflo(w.y); v[3] = bfhi(w.y); v[4] = bflo(w.z); v[5] = bfhi(w.z); v[6] = bflo(w.w); v[7] = bfhi(w.w);
}
__device__ __forceinline__ void pool_run(const bf16_t* __restrict__ Zg, bf16_t* __restrict__ MIX, int gw, int lane) {
    const int tb = 32 * gw, b = tb >> 12, t0 = tb & (SEQ - 1);
    const int half = 1 << (lane >> 4);
    const bf16_t* zb = Zg + (size_t)(b * SEQ) * NA + 8 * lane;
    bf16_t* ob = MIX + tl_off(b * SEQ, 256 + 8 * lane, KMIX);
    const bool qodd = lane & 4; bf16_t* pa1 = ob + (qodd ? -512 + 32 : 0); u32x4 wprev = {0u, 0u, 0u, 0u};
    float S[8];
#pragma unroll
    for (int e = 0; e < 8; ++e) S[e] = 0.f;
    {   u32x4 w[16];
#pragma unroll
        for (int d = 0; d < 16; ++d) { int i = t0 + d - 8; i = i < 0 ? 0 : i; i = i > SEQ - 1 ? SEQ - 1 : i; w[d] = *(const u32x4*)(zb + (size_t)i * NA); }
#pragma unroll
        for (int d = 0; d < 16; ++d) { const int dd = d - 8, i = t0 + dd; const float mk = (dd >= -half && dd < half && i >= 0 && i < SEQ) ? 1.f : 0.f; float v[8]; up8(w[d], v);
#pragma unroll
            for (int e = 0; e < 8; ++e) S[e] += mk * v[e]; } }
    for (int c = 0; c < 4; ++c) {
        u32x4 zt[8], za[8], zs[8];
#pragma unroll
        for (int k = 0; k < 8; ++k) { const int t = t0 + 8 * c + k; int ia = t + half, is = t - half; ia = ia > SEQ - 1 ? SEQ - 1 : ia; is = is < 0 ? 0 : is;
            zt[k] = *(const u32x4*)(zb + (size_t)t * NA); za[k] = *(const u32x4*)(zb + (size_t)ia * NA); zs[k] = *(const u32x4*)(zb + (size_t)is * NA); }
#pragma unroll
        for (int k = 0; k < 8; ++k) { const int t = t0 + 8 * c + k;
            const int lo = (t - half) < 0 ? 0 : (t - half), hi = (t + half) > SEQ ? SEQ : (t + half);
            const float inv = 1.0f / (float)(hi - lo);
            float v[8]; up8(zt[k], v);
            u32x4 w;
            w.x = cvt_pk_bf16(S[0] * inv - v[0], S[1] * inv - v[1]); w.y = cvt_pk_bf16(S[2] * inv - v[2], S[3] * inv - v[3]);
            w.z = cvt_pk_bf16(S[4] * inv - v[4], S[5] * inv - v[5]); w.w = cvt_pk_bf16(S[6] * inv - v[6], S[7] * inv - v[7]);
            if ((k & 1) == 0) wprev = w;
            else {
                const u32x4 snd = qodd ? wprev : w; u32x4 rcv;
                { const unsigned x0 = snd.x, x1 = snd.y, x2 = snd.z, x3 = snd.w;
                  rcv.x = (unsigned)__builtin_amdgcn_mov_dpp(__builtin_amdgcn_mov_dpp((int)x0, 0x1B, 0xf, 0xf, true), 0x141, 0xf, 0xf, true);
                  rcv.y = (unsigned)__builtin_amdgcn_mov_dpp(__builtin_amdgcn_mov_dpp((int)x1, 0x1B, 0xf, 0xf, true), 0x141, 0xf, 0xf, true);
                  rcv.z = (unsigned)__builtin_amdgcn_mov_dpp(__builtin_amdgcn_mov_dpp((int)x2, 0x1B, 0xf, 0xf, true), 0x141, 0xf, 0xf, true);
                  rcv.w = (unsigned)__builtin_amdgcn_mov_dpp(__builtin_amdgcn_mov_dpp((int)x3, 0x1B, 0xf, 0xf, true), 0x141, 0xf, 0xf, true); }
                const u32x4 s1 = qodd ? rcv : wprev, s2 = qodd ? w : rcv;
                const size_t ro = (size_t)((t - 1) >> 4) * (KMIX / 32) * 512 + ((t - 1) & 15) * 32;
                *(u32x4*)(pa1 + ro) = s1; *(u32x4*)(pa1 + ro + 512) = s2;
            }
            const float ma = (t + half < SEQ) ? 1.f : 0.f, ms = (t - half >= 0) ? 1.f : 0.f;
            float a[8], s[8]; up8(za[k], a); up8(zs[k], s);
#pragma unroll
            for (int e = 0; e < 8; ++e) S[e] += ma * a[e] - ms * s[e]; }
    }
}

__device__ __forceinline__ void p2_mixer(Frame& F) {
    const bf16_t* Qg = F.QKVZ; const bf16_t* Kg = F.QKVZ + (size_t)M * NA; const bf16_t* Vg = F.QKVZ + 2 * (size_t)M * NA; const bf16_t* Zg = F.QKVZ + 3 * (size_t)M * NA;
    bf16_t* MIX = F.MIX;
    for (int gw = F.vcu * NWAVES + F.wave; gw < M / 32; gw += F.G * NWAVES) pool_run(Zg, MIX, gw, F.lane);
    p2_attention(F, Qg, Kg, Vg, MIX);
    __syncthreads();
}

struct Args { const float* in[13]; float* out; unsigned char* ws; int ph_lo, ph_hi, li, pad; };
__global__ void __launch_bounds__(NWAVES * 64, 2) fwd_megakernel(Args args) {
    extern __shared__ __attribute__((aligned(16))) unsigned char lds[];
    Frame F;
    F.lds = (LAS unsigned char*)lds;
    F.MISC = (volatile LAS unsigned*)(F.lds + MISC_OFF);
    F.tid = threadIdx.x; F.lane = F.tid & 63; F.wave = __builtin_amdgcn_readfirstlane(F.tid >> 6);
    F.G = gridDim.x; { const int bx = blockIdx.x; F.vcu = (F.G % 8 == 0) ? (bx % 8) * (F.G / 8) + bx / 8 : bx; }
    unsigned char* ws = args.ws;
    F.ctl = (gu32*)(ws + WS_CTL);
    F.x = args.in[0]; F.g1 = args.in[1]; F.w_in = args.in[2]; F.gq = args.in[3]; F.gk = args.in[4]; F.rpb = args.in[5]; F.w_pool = args.in[6];
    F.pscale = args.in[7]; F.w_out = args.in[8]; F.g2 = args.in[9]; F.w_gate = args.in[10]; F.w_up = args.in[11]; F.w_down = args.in[12]; F.out = args.out;
    F.Win_t = (bf16_t*)(ws + WS_WIN); F.Wout_t = (bf16_t*)(ws + WS_WOUT); F.Wgu_t = (bf16_t*)(ws + WS_WGU); F.Wdn_t = (bf16_t*)(ws + WS_WDN);
    F.XN8 = ws + WS_XN8; F.Win8 = ws + WS_WIN8;
    F.XN = (bf16_t*)(ws + WS_XN); F.QKVZ = (bf16_t*)(ws + WS_QKVZ); F.XB = (bf16_t*)(ws + WS_XB); F.ACT = (bf16_t*)(ws + WS_ACT);
    F.ss = (float*)(ws + WS_CTL) + CW_SS; F.rrow = (float*)(ws + WS_CTL) + CW_SS + M; F.MIX = (bf16_t*)(ws + WS_ACT);
    for (int u = F.tid; u < (LDS_BYTES - LDSCTL_OFF) / 4; u += NWAVES * 64) ((LAS unsigned*)(F.lds + LDSCTL_OFF))[u] = 0u;
    __syncthreads();
    XcdBarrier bar; bar.bar = (unsigned*)(F.ctl + CW_BAR); bar.x = 0; bar.st = nullptr;
    if (N_LAUNCHES != PER_PHASE) bar = xcd_barrier_post((unsigned*)(F.ctl + CW_BAR), F.MISC + 8);
#define GRID_BAR() do { if (N_LAUNCHES != PER_PHASE) xcd_barrier(bar); } while (0)
    const int lo = args.ph_lo, hi = args.ph_hi;
#define IN(k) (lo <= (k) && (k) < hi)
#define BOTH(k) (IN(k) && IN((k) + 1))

    if (IN(0)) { p0_prologue(F); if (BOTH(0)) GRID_BAR(); }

#define FRAME_REFRESH() do { int l_ = (int)__builtin_amdgcn_mbcnt_hi(~0u, __builtin_amdgcn_mbcnt_lo(~0u, 0u)); asm volatile("" : "+v"(l_)); F.lane = l_; F.tid = F.wave * 64 + l_; } while (0)
    if (IN(1)) {
        FRAME_REFRESH();
        { LAS float* gl = (LAS float*)(F.lds + LDS_GAIN_OFF);
          if (F.tid < 64) gl[F.tid] = F.gq[F.tid] * (0.125f * LOG2E); else if (F.tid < 128) gl[F.tid] = F.gk[F.tid - 64];
          __syncthreads(); }
        {
            pg8::Gemm g{(const bf16_t*)F.XN8, (const bf16_t*)F.Win8, M, 3 * NA, D / 2, 0x7a7a7a7au, 0x7f7f7f7fu};
            pg8::StaticOrder S; S.init(M, 3 * NA, F.G, (int)blockIdx.x, 20);
            pg8::EpiIn E{F.QKVZ, (const LAS float*)(F.lds + LDS_GAIN_OFF), 0};
            pg8::gemm_phase<pg8::EpiIn, pg8::StaticOrder, true, PG8_SP2, true, pg8::ALL8>(F.lds + RING_OFF, g, S, E, F.wave);
        }
        {
            pg8::Gemm g{F.XN, F.Win_t + tl_off(3 * NA, 0, D), M, NA, D}; pg8::StaticOrder S; S.init(M, NA, F.G, (int)blockIdx.x);
            pg8::EpiIn E{F.QKVZ, (const LAS float*)(F.lds + LDS_GAIN_OFF), 6};
            pg8::gemm_phase<pg8::EpiIn, pg8::StaticOrder, true, PG8_SP2>(F.lds + RING_OFF, g, S, E, F.wave);
        }
        if (BOTH(1)) GRID_BAR();
    }

    if (IN(2)) { FRAME_REFRESH(); p2_mixer(F); if (BOTH(2)) GRID_BAR(); }

    if (IN(3)) {
        pg8::Gemm g{F.MIX, F.Wout_t, M, D, KMIX, 0x7a7a7a7au, 0x7c7c7c7cu};
        pg8::StaticOrder S; S.init(M, D, F.G, (int)blockIdx.x);
        pg8::EpiOut E{F.XN, F.rrow, F.g1, F.XB, F.ss};
        pg8::gemm_phase<pg8::EpiOut, pg8::StaticOrder, true, PG8_SP2, true, 4>(F.lds + RING_OFF, g, S, E, F.wave);
        if (BOTH(3)) GRID_BAR();
    }

    if (IN(4)) {
        pg8::Gemm g{F.XB, F.Wgu_t, M, NGU, D}; pg8::RevOrder S; S.init(M, NGU, F.G, (int)blockIdx.x);
        pg8::EpiGU E{F.ACT, F.ss, (unsigned)(size_t)(F.lds + RING_OFF + RING_BYTES), (const LAS float*)(F.lds + RING_OFF + RING_BYTES)};
        pg8::gemm_phase<pg8::EpiGU, pg8::RevOrder, true, PG8_SP2>(F.lds + RING_OFF, g, S, E, F.wave);
        if (BOTH(4)) GRID_BAR();
    }

    if (IN(5)) {
        pg8::Gemm g{F.ACT, F.Wdn_t, M, D, FF}; pg8::StaticOrder S; S.init(M, D, F.G, (int)blockIdx.x);
        pg8::EpiDown E{F.XB, F.out};
        pg8::gemm_phase<pg8::EpiDown, pg8::StaticOrder, true, PG8_SP2>(F.lds + RING_OFF, g, S, E, F.wave);
    }
#undef IN
#undef BOTH
#undef GRID_BAR
}

extern "C" void kernel_launch(void* const* d_in, const int* in_sizes, int n_in, void* d_out, int out_size, void* d_ws, size_t ws_size, hipStream_t stream) {
    static int grid = 0;
    if (grid == 0) {
        if (n_in != 13 || in_sizes[0] != M * D || out_size != M * D || ws_size < WS_END) { fprintf(stderr, "kernel_launch: unexpected shapes (n_in %d, in0 %d, out %d, ws %zu); nothing launched\n", n_in, n_in > 0 ? in_sizes[0] : -1, out_size, ws_size); grid = -1; return; }
        int dev = 0, cus = 0, per_cu = 0;
        if (hipGetDevice(&dev) != hipSuccess || hipDeviceGetAttribute(&cus, hipDeviceAttributeMultiprocessorCount, dev) != hipSuccess) { fprintf(stderr, "kernel_launch: device query failed\n"); grid = -1; return; }
        if (hipFuncSetAttribute((const void*)fwd_megakernel, hipFuncAttributeMaxDynamicSharedMemorySize, LDS_BYTES) != hipSuccess) { fprintf(stderr, "kernel_launch: hipFuncSetAttribute failed\n"); grid = -1; return; }
        if (hipOccupancyMaxActiveBlocksPerMultiprocessor(&per_cu, (const void*)fwd_megakernel, NWAVES * 64, LDS_BYTES) != hipSuccess || per_cu < 1) {
            fprintf(stderr, "kernel_launch: occupancy query reports %d workgroups per CU; nothing launched\n", per_cu); (void)hipGetLastError(); grid = -1; return; }
        (void)hipGetLastError();
        grid = cus;
    }
    if (grid < 0) return;
    if (hipMemsetAsync((char*)d_ws + WS_CTL, 0, CTL_ZERO_BYTES, stream) != hipSuccess) { fprintf(stderr, "kernel_launch: hipMemsetAsync failed\n"); return; }
    Args a{};
    for (int i = 0; i < 13; ++i) a.in[i] = (const float*)d_in[i];
    a.out = (float*)d_out; a.ws = (unsigned char*)d_ws;
    for (int li = 0; li < N_LAUNCHES; ++li) {
        a.ph_lo = (N_LAUNCHES == PER_PHASE) ? li : 0; a.ph_hi = (N_LAUNCHES == PER_PHASE) ? li + 1 : PER_PHASE; a.li = li;
        hipLaunchKernelGGL(fwd_megakernel, dim3(grid), dim3(NWAVES * 64), LDS_BYTES, stream, a);
        const hipError_t le = hipPeekAtLastError();
        if (le != hipSuccess) { fprintf(stderr, "kernel_launch: launch %d failed: %s\n", li, hipGetErrorName(le)); break; }
    }
}
```
